# Optimizing an MI355X kernel written in HIP

```python
import jax, jax.numpy as jnp
from jax import lax
import numpy as np

D_MODEL = 1024
BATCH = 8
SEQ = 2048
DEPTH = 1

MEM_LEN = 256
CONV_GROUPS = 8
CONV_GROUP_DIM = 64
CONV_DIM = CONV_GROUPS * CONV_GROUP_DIM
SB_HEADS = 8
SB_HEAD_DIM = 64
SB_DIM = SB_HEADS * SB_HEAD_DIM
MIX_DIM = CONV_DIM + SB_DIM
IN_PROJ_DIM = 3 * CONV_DIM + 3 * SB_DIM
CONV_K = 3
Q_BLOCK = 128
X_HEADS = 4
X_HEAD_DIM = D_MODEL // X_HEADS
N_EXPERTS = 32
TOP_K = 4
D_EXPERT = D_MODEL
SWIGLU_LIMIT = 7.0
SWIGLU_ALPHA = 1.702
EXPERT_BLOCK = 128
EPS = 1e-5

kernel_name = "hymba_conv_stickbreak_memxattn_moe"


def rmsnorm(x, g):
    x32 = x.astype(jnp.float32)
    y = x32 * lax.rsqrt(jnp.mean(x32 * x32, axis=-1, keepdims=True) + EPS)
    return (y * g.astype(jnp.float32)).astype(x.dtype)


def group_rmsnorm(y, g, n_groups):
    b, s, w = y.shape
    y32 = y.astype(jnp.float32).reshape(b, s, n_groups, w // n_groups)
    y32 = y32 * lax.rsqrt(jnp.mean(y32 * y32, axis=-1, keepdims=True) + EPS)
    return (y32.reshape(b, s, w) * g.astype(jnp.float32)).astype(y.dtype)


def short_gated_conv(b_gate, c_gate, xv, conv_w):
    u = c_gate * xv
    s = u.shape[1]
    up = jnp.pad(u, ((0, 0), (CONV_K - 1, 0), (0, 0)))
    y = conv_w[0] * up[:, 0:s]
    for i in range(1, CONV_K):
        y = y + conv_w[i] * up[:, i:i + s]
    return b_gate * y


def stick_breaking_attention(q, k, v):
    s_len = q.shape[1]
    scale = SB_HEAD_DIM ** -0.5
    outs = []
    for i in range(s_len // Q_BLOCK):
        q0 = i * Q_BLOCK
        kend = q0 + Q_BLOCK
        qb = q[:, q0:kend]
        kb = k[:, :kend]
        vb = v[:, :kend]
        z = jnp.einsum('bqhd,bkhd->bhqk', qb, kb).astype(jnp.float32) * scale
        t_idx = q0 + jnp.arange(Q_BLOCK)[:, None]
        s_idx = jnp.arange(kend)[None, :]
        valid = s_idx < t_idx
        log_keep = jnp.where(valid, jax.nn.log_sigmoid(-z), 0.0)
        rest = lax.cumsum(log_keep, axis=3, reverse=True) - log_keep
        a = jnp.where(valid, jnp.exp(jax.nn.log_sigmoid(z) + rest), 0.0)
        outs.append(jnp.einsum('bhqk,bkhd->bqhd', a.astype(v.dtype), vb))
    return jnp.concatenate(outs, axis=1)


def memory_cross_attention(h, mem_n, w_q, w_kv, w_o):
    b, s, _ = h.shape
    m = mem_n.shape[1]
    q = (h @ w_q).reshape(b, s, X_HEADS, X_HEAD_DIM)
    k, v = jnp.split(mem_n @ w_kv, 2, axis=-1)
    k = k.reshape(b, m, X_HEADS, X_HEAD_DIM)
    v = v.reshape(b, m, X_HEADS, X_HEAD_DIM)
    sc = jnp.einsum('bqhd,bkhd->bhqk', q, k).astype(jnp.float32) * (X_HEAD_DIM ** -0.5)
    p = jax.nn.softmax(sc, axis=-1).astype(v.dtype)
    o = jnp.einsum('bhqk,bkhd->bqhd', p, v).reshape(b, s, D_MODEL)
    return o @ w_o


def moe_clamped_swiglu(h, w_router, b_router, w1, b1, w2, b2):
    bn, s, d = h.shape
    n = bn * s
    hf = h.reshape(n, d)
    logits = hf.astype(jnp.float32) @ w_router.astype(jnp.float32) + b_router.astype(jnp.float32)
    top_v, top_i = lax.top_k(logits, TOP_K)
    gate = jax.nn.softmax(top_v, axis=-1)
    n_assign = n * TOP_K
    flat_e = top_i.reshape(-1)
    flat_w = gate.reshape(-1)
    flat_tok = jnp.repeat(jnp.arange(n, dtype=jnp.int32), TOP_K)
    order = jnp.argsort(flat_e)
    sorted_e = flat_e[order]
    sorted_tok = flat_tok[order]
    sorted_w = flat_w[order]
    counts = jnp.bincount(flat_e, length=N_EXPERTS)
    padded = (counts + EXPERT_BLOCK - 1) // EXPERT_BLOCK * EXPERT_BLOCK
    start_sorted = jnp.cumsum(counts) - counts
    padded_end = jnp.cumsum(padded)
    start_padded = padded_end - padded
    rows = jnp.arange(n_assign, dtype=jnp.int32)
    dest = start_padded[sorted_e] + rows - start_sorted[sorted_e]
    n_rows = ((n_assign + N_EXPERTS * EXPERT_BLOCK + EXPERT_BLOCK - 1) // EXPERT_BLOCK) * EXPERT_BLOCK
    n_blocks = n_rows // EXPERT_BLOCK
    pad_tok = jnp.zeros((n_rows,), jnp.int32).at[dest].set(sorted_tok)
    pad_w = jnp.zeros((n_rows,), jnp.float32).at[dest].set(sorted_w)
    block_start = jnp.arange(n_blocks, dtype=jnp.int32) * EXPERT_BLOCK
    block_e = jnp.minimum(jnp.searchsorted(padded_end, block_start, side='right'), N_EXPERTS - 1)

    def expert_block(args):
        e, tok, wt = args
        xb = hf[tok]
        hid = xb @ w1[e] + b1[e]
        glu, lin = jnp.split(hid, 2, axis=-1)
        glu = jnp.minimum(glu, SWIGLU_LIMIT)
        lin = jnp.clip(lin, -SWIGLU_LIMIT, SWIGLU_LIMIT)
        act = glu * jax.nn.sigmoid(SWIGLU_ALPHA * glu) * (lin + 1.0)
        out = act @ w2[e] + b2[e]
        return out * wt[:, None].astype(out.dtype)

    out_blocks = lax.map(expert_block, (block_e,
                                        pad_tok.reshape(n_blocks, EXPERT_BLOCK),
                                        pad_w.reshape(n_blocks, EXPERT_BLOCK)))
    y = jnp.zeros_like(hf).at[pad_tok].add(out_blocks.reshape(n_rows, d))
    return y.reshape(bn, s, d)


def setup_inputs(seed: int = 0) -> dict:
    key = jax.random.key(seed)
    ks = jax.random.split(key, 24)
    f32 = jnp.float32

    def nrm(k, shape, scale):
        return jax.random.normal(k, shape, f32) * scale

    def gain(k, shape):
        return 1.0 + 0.02 * jax.random.normal(k, shape, f32)

    return {
        "x": nrm(ks[0], (BATCH, SEQ, D_MODEL), 1.0),
        "mem": nrm(ks[1], (BATCH, MEM_LEN, D_MODEL), 1.0),
        "g_mix": gain(ks[2], (DEPTH, D_MODEL)),
        "w_in": nrm(ks[3], (DEPTH, D_MODEL, IN_PROJ_DIM), D_MODEL ** -0.5),
        "conv_w": nrm(ks[4], (DEPTH, CONV_K, CONV_DIM), CONV_K ** -0.5),
        "g_conv_out": gain(ks[5], (DEPTH, CONV_DIM)),
        "g_sb_out": gain(ks[6], (DEPTH, SB_DIM)),
        "w_out": nrm(ks[7], (DEPTH, MIX_DIM, D_MODEL), MIX_DIM ** -0.5),
        "g_xattn": gain(ks[8], (DEPTH, D_MODEL)),
        "g_mem": gain(ks[9], (DEPTH, D_MODEL)),
        "w_q_mem": nrm(ks[10], (DEPTH, D_MODEL, D_MODEL), D_MODEL ** -0.5),
        "w_kv_mem": nrm(ks[11], (DEPTH, D_MODEL, 2 * D_MODEL), D_MODEL ** -0.5),
        "w_o_mem": nrm(ks[12], (DEPTH, D_MODEL, D_MODEL), D_MODEL ** -0.5),
        "g_moe": gain(ks[13], (DEPTH, D_MODEL)),
        "w_router": nrm(ks[14], (DEPTH, D_MODEL, N_EXPERTS), D_MODEL ** -0.5),
        "b_router": nrm(ks[15], (DEPTH, N_EXPERTS), 0.01),
        "w1": nrm(ks[16], (DEPTH, N_EXPERTS, D_MODEL, 2 * D_EXPERT), D_MODEL ** -0.5),
        "b1": nrm(ks[17], (DEPTH, N_EXPERTS, 2 * D_EXPERT), 0.02),
        "w2": nrm(ks[18], (DEPTH, N_EXPERTS, D_EXPERT, D_MODEL), D_EXPERT ** -0.5),
        "b2": nrm(ks[19], (DEPTH, N_EXPERTS, D_MODEL), 0.02),
        "g_final": gain(ks[20], (D_MODEL,)),
    }


def reference(x, mem, g_mix, w_in, conv_w, g_conv_out, g_sb_out, w_out, g_xattn, g_mem,
              w_q_mem, w_kv_mem, w_o_mem, g_moe, w_router, b_router, w1, b1, w2, b2, g_final):
    b, s, _ = x.shape
    splits = [CONV_DIM, 2 * CONV_DIM, 3 * CONV_DIM,
              3 * CONV_DIM + SB_DIM, 3 * CONV_DIM + 2 * SB_DIM]
    for l in range(DEPTH):
        h = rmsnorm(x, g_mix[l])
        proj = h @ w_in[l]
        b_gate, c_gate, xv, q, k, v = jnp.split(proj, splits, axis=-1)
        y_conv = short_gated_conv(b_gate, c_gate, xv, conv_w[l])
        y_sb = stick_breaking_attention(q.reshape(b, s, SB_HEADS, SB_HEAD_DIM),
                                        k.reshape(b, s, SB_HEADS, SB_HEAD_DIM),
                                        v.reshape(b, s, SB_HEADS, SB_HEAD_DIM)).reshape(b, s, SB_DIM)
        y_mix = jnp.concatenate([group_rmsnorm(y_conv, g_conv_out[l], CONV_GROUPS),
                                 group_rmsnorm(y_sb, g_sb_out[l], SB_HEADS)], axis=-1)
        x = x + y_mix @ w_out[l]
        x = x + memory_cross_attention(rmsnorm(x, g_xattn[l]), rmsnorm(mem, g_mem[l]),
                                       w_q_mem[l], w_kv_mem[l], w_o_mem[l])
        x = x + moe_clamped_swiglu(rmsnorm(x, g_moe[l]), w_router[l], b_router[l],
                                   w1[l], b1[l], w2[l], b2[l])
    return rmsnorm(x, g_final)
```

```cpp
#include <hip/hip_runtime.h>
#include <hip/hip_cooperative_groups.h>
#include <cstdio>
#include <cstdint>
namespace cg = cooperative_groups;

#ifndef MK_N_LAUNCHES
#define MK_N_LAUNCHES 1
#endif

constexpr int D = 1024, BATCH = 8, SEQ = 2048, M = BATCH * SEQ, MEMLEN = 256, MROWS = BATCH * MEMLEN;
constexpr int NPROJ = 3072, NE = 32, TOPK = 4, DEXP = 1024;
constexpr int XH = 4, XHD = 256;
constexpr float EPS = 1e-5f;
constexpr float LOG2E = 1.4426950408889634f;
constexpr float C2Q = 0.125f * LOG2E;
constexpr float C2X = 0.0625f * LOG2E;
constexpr int LISTCAP = M;
constexpr int ACT_ROWS = M * TOPK + NE * 256;

#define GAS __attribute__((address_space(1)))
#define LAS __attribute__((address_space(3)))
typedef unsigned short bf16_t;
typedef short bf16x8 __attribute__((ext_vector_type(8)));
typedef short s16x4 __attribute__((ext_vector_type(4)));
typedef float f32x4 __attribute__((ext_vector_type(4)));
typedef float f32x2 __attribute__((ext_vector_type(2)));
typedef float f32x16 __attribute__((ext_vector_type(16)));
typedef unsigned u32x4 __attribute__((ext_vector_type(4)));
typedef unsigned u32x2 __attribute__((ext_vector_type(2)));
typedef GAS unsigned gu32;

constexpr size_t MiB = 1u << 20;
constexpr size_t WS_CTL = 0, CTL_ZERO_BYTES = 1 * MiB;
constexpr size_t WS_WIN_T = 2 * MiB, WS_WOUT_T = 8 * MiB, WS_WQ_T = 10 * MiB, WS_WKV_T = 12 * MiB, WS_WO_T = 16 * MiB, WS_WR = 18 * MiB;
constexpr size_t WS_MEMN = 19 * MiB, WS_KMEM = 23 * MiB, WS_VT = 27 * MiB, WS_SS1 = 31 * MiB, WS_SS2 = 32 * MiB, WS_RSTD3 = 33 * MiB, WS_LTOK = 34 * MiB, WS_LGATE = 36 * MiB;
constexpr size_t WS_W1_T = 40 * MiB, WS_W2_T = 168 * MiB;
constexpr size_t WS_XN = 232 * MiB, WS_PROJ = 264 * MiB, WS_YMIX = 360 * MiB;
constexpr size_t WS_X1 = 392 * MiB, WS_X1B = 456 * MiB, WS_QM = 488 * MiB, WS_PB = 520 * MiB, WS_OB = 552 * MiB, WS_X2 = 584 * MiB, WS_X2B = 648 * MiB;
constexpr size_t WS_ACT = 232 * MiB;
constexpr size_t WS_Y = 392 * MiB;
constexpr size_t WS_END = 680 * MiB;
static_assert(WS_ACT + (size_t)ACT_ROWS * DEXP * 2 <= WS_X1 && WS_Y + (size_t)M * TOPK * D * 2 <= WS_PB, "overlays");
constexpr int CW_TMO = 0, CW_CODE = 1, CW_BAR = 4096, CW_CNT = 8192;

__device__ __forceinline__ unsigned cvt_pk_bf16(float lo, float hi) { unsigned r; asm volatile("v_cvt_pk_bf16_f32 %0, %1, %2" : "=v"(r) : "v"(lo), "v"(hi)); return r; }
__device__ __forceinline__ unsigned cvtpk_s(float lo, float hi) { typedef __bf16 bf16x2_t __attribute__((ext_vector_type(2))); f32x2 v = {lo, hi}; bf16x2_t b = __builtin_convertvector(v, bf16x2_t); return __builtin_bit_cast(unsigned, b); }
__device__ __forceinline__ float bf_lo(unsigned w) { return __uint_as_float(w << 16); }
__device__ __forceinline__ float bf_hi(unsigned w) { return __uint_as_float(w & 0xffff0000u); }
__device__ __forceinline__ float wave_sum(float v) {
#pragma unroll
    for (int o = 1; o < 64; o <<= 1) v += __shfl_xor(v, o);
    return v;
}
#define LDS_WAIT() asm volatile("s_waitcnt lgkmcnt(0)" ::: "memory")
#define VM_WAIT() asm volatile("s_waitcnt vmcnt(0)" ::: "memory")

namespace pg8 {
constexpr int BM = 256, BK = 64, HALF = 128, HTB = HALF * BK * 2, STAGE_BYTES = 8 * HTB, NXCD = 8, WGM = 8;
__host__ __device__ __forceinline__ int lds_byte(int r, int c) { const int st = (r >> 4) * 2 + (c >> 5), rr = r & 15, cc = c & 31, ob = rr * 64 + cc * 2; return st * 1024 + (ob ^ (((ob >> 9) & 1) << 5)); }
__host__ __device__ __forceinline__ void stage_rc(int b, int& R, int& C) { const int st = b / 1024, sb = b % 1024, swz = sb ^ (((sb >> 9) & 1) << 5); R = (st >> 1) * 16 + swz / 64; C = (st & 1) * 32 + (swz % 64) / 2; }
__host__ __device__ __forceinline__ int perm32(int rho) { const int n = rho >> 4, i = rho & 15; return 8 * (i >> 2) + 4 * n + (i & 3); }

struct Unit { const char* a; const char* b; const int* tok; int pm, pn, kind, nvalid, e, rowoff; };

struct GridOrder {
    int nM, nN, nwg;
    __device__ __forceinline__ void init(int nM_, int nN_) { nM = nM_; nN = nN_; nwg = nM * nN; }
    __device__ __forceinline__ void map(int L, int& pm, int& pn) const {
        int wgid = L; { const int q = nwg / NXCD, r = nwg % NXCD, xcd = wgid % NXCD, off = wgid / NXCD; wgid = (xcd < r ? xcd * (q + 1) : r * (q + 1) + (xcd - r) * q) + off; }
        const int nig = WGM * nN, gid = wgid / nig, fm = gid * WGM, gsz = (nM - fm) < WGM ? (nM - fm) : WGM;
        pm = fm + ((wgid % nig) % gsz); pn = (wgid % nig) / gsz;
    }
};

typedef f32x4 Acc[2][2][4][2];

template <class Epi, class Sched, bool GATHER, bool ALIGN_EPI, bool SP2>
__device__ __forceinline__ void gemm_phase(LAS unsigned char* lds, const int lda, const int ldb, const int K, const Sched& S, const Epi& E) {
    const int tid = threadIdx.x, wid = __builtin_amdgcn_readfirstlane(tid >> 6), lane = tid & 63, wr = wid >> 2, wc = wid & 3, fr = lane & 15, fq = lane >> 4;
    int nt = K / BK; asm volatile("" : "+s"(nt));
    int RA[2], CA[2]; unsigned voffB[2];
#pragma unroll
    for (int i = 0; i < 2; ++i) { int R, C; stage_rc(tid * 16 + i * 8192, R, C); const int Rb = Epi::PERM ? ((R & ~31) + perm32(R & 31)) : R;
        RA[i] = R; CA[i] = C; voffB[i] = (unsigned)(Rb * ldb + C) * 2u; }
    const size_t kstep = (size_t)(BK * 2);
    const size_t hstepB = (size_t)HALF * ldb * 2;
    const unsigned ldsw = (unsigned)wid * 1024u;
    const int aoff = lds_byte(wr * 64 + fr, fq * 8), boff = lds_byte(wc * 32 + fr, fq * 8);
#define PG8_SA(b, h) (((b) * 2 + (h)) * HTB)
#define PG8_SB(b, h) ((4 + (b) * 2 + (h)) * HTB)
#define PG8_STAGE(bufoff, gbase, voff) do { _Pragma("unroll") for (int _i = 0; _i < 2; ++_i) \
        __builtin_amdgcn_global_load_lds((const unsigned*)((const char*)(gbase) + (voff)[_i]), (LAS unsigned*)(lds + (bufoff) + ldsw + _i * 8192), 16, 0, 0); } while (0)
#define PG8_LDA(dst, b, h) do { _Pragma("unroll") for (int m = 0; m < 4; ++m) _Pragma("unroll") for (int k = 0; k < 2; ++k) dst[m][k] = *(const LAS bf16x8*)(lds + PG8_SA(b, h) + aoff + m * 2048 + k * 1024); } while (0)
#define PG8_LDB(dst, b, h) do { _Pragma("unroll") for (int n = 0; n < 2; ++n) _Pragma("unroll") for (int k = 0; k < 2; ++k) dst[n][k] = *(const LAS bf16x8*)(lds + PG8_SB(b, h) + boff + n * 2048 + k * 1024); } while (0)
#define PG8_MMA(ai, bj, At, Bt) do { __builtin_amdgcn_s_setprio(1); _Pragma("unroll") for (int m = 0; m < 4; ++m) _Pragma("unroll") for (int n = 0; n < 2; ++n) _Pragma("unroll") for (int k = 0; k < 2; ++k) \
        acc[ai][bj][m][n] = __builtin_amdgcn_mfma_f32_16x16x32_bf16(Bt[n][k], At[m][k], acc[ai][bj][m][n], 0, 0, 0); __builtin_amdgcn_s_setprio(0); } while (0)
#define PG8_WAIT_V(n) asm volatile("s_waitcnt vmcnt(" #n ")" ::: "memory")
#define PG8_WAIT_L(n) asm volatile("s_waitcnt lgkmcnt(" #n ")" ::: "memory")
#define PG8_BAR __builtin_amdgcn_s_barrier()
#define PG8_SCHED __builtin_amdgcn_sched_barrier(0)
#define PG8_VOFFA(dst, u) do { _Pragma("unroll") for (int _h = 0; _h < 2; ++_h) _Pragma("unroll") for (int _i = 0; _i < 2; ++_i) { const int _row = _h * HALF + RA[_i]; \
        if constexpr (GATHER) { int _t = 0; if (_row < (u).nvalid) _t = (u).tok[_row] >> 2; dst[_h][_i] = (unsigned)(_t * lda + CA[_i]) * 2u; } \
        else dst[_h][_i] = (unsigned)(_row * lda + CA[_i]) * 2u; } } while (0)
    Unit cur, nxt; int ui = 0;
    if (!S.next(0, cur)) return;
    Acc acc;
#pragma unroll
    for (int a = 0; a < 2; ++a)
#pragma unroll
        for (int b = 0; b < 2; ++b)
#pragma unroll
            for (int m = 0; m < 4; ++m)
#pragma unroll
                for (int n = 0; n < 2; ++n) acc[a][b][m][n] = (f32x4){0.f, 0.f, 0.f, 0.f};
    bf16x8 At[4][2], B0[2][2], B1[2][2];
    unsigned vA[2][2], vN[2][2], vA2[2][2];
    PG8_VOFFA(vA, cur);
#pragma unroll
    for (int h = 0; h < 2; ++h)
#pragma unroll
        for (int i = 0; i < 2; ++i) { vN[h][i] = vA[h][i]; vA2[h][i] = vA[h][i]; }
    const char* cA = cur.a; const char* cB = cur.b;
    if constexpr (SP2) {
        PG8_STAGE(PG8_SB(0, 0), cB, voffB); PG8_STAGE(PG8_SB(0, 1), cB + hstepB, voffB); PG8_STAGE(PG8_SA(0, 0), cA, vA[0]); PG8_STAGE(PG8_SA(0, 1), cA, vA[1]);
        if (wr == 1) PG8_BAR;
        PG8_WAIT_V(2); PG8_BAR;
        PG8_STAGE(PG8_SB(1, 0), cB + kstep, voffB); PG8_STAGE(PG8_SA(1, 0), cA + kstep, vA[0]); PG8_STAGE(PG8_SB(1, 1), cB + hstepB + kstep, voffB);
        PG8_WAIT_V(6); PG8_BAR;
    } else {
        PG8_STAGE(PG8_SB(0, 0), cB, voffB); PG8_STAGE(PG8_SA(0, 0), cA, vA[0]); PG8_STAGE(PG8_SB(0, 1), cB + hstepB, voffB); PG8_STAGE(PG8_SA(0, 1), cA, vA[1]);
        if (wr == 1) PG8_BAR;
        PG8_WAIT_V(4); PG8_BAR;
        PG8_STAGE(PG8_SB(1, 0), cB + kstep, voffB); PG8_STAGE(PG8_SA(1, 0), cA + kstep, vA[0]); PG8_STAGE(PG8_SB(1, 1), cB + hstepB + kstep, voffB);
        PG8_WAIT_V(6); PG8_BAR;
    }
    for (;;) {
        const bool has_next = S.next(ui + 1, nxt);
        const char* nA = has_next ? nxt.a : cA; const char* nB = has_next ? nxt.b : cB;
        if (has_next) { PG8_VOFFA(vN, nxt); }
        for (int t = 0; t < nt; t += 2) {
            const bool last = (t == nt - 2);
            const char* a1 = cA + (size_t)(t + 1) * kstep;
            const char* a2 = last ? nA : cA + (size_t)(t + 2) * kstep; const char* b2 = last ? nB : cB + (size_t)(t + 2) * kstep;
            const char* a3 = a2 + kstep; const char* b3 = b2 + kstep;
            if (last) {
#pragma unroll
                for (int h = 0; h < 2; ++h)
#pragma unroll
                    for (int i = 0; i < 2; ++i) vA2[h][i] = vN[h][i];
            }
            if constexpr (SP2) {
            PG8_LDB(B0, 0, 0); PG8_LDB(B1, 0, 1); PG8_SCHED; PG8_LDA(At, 0, 0); PG8_STAGE(PG8_SA(1, 1), a1, vA[1]);
            PG8_WAIT_V(8); PG8_WAIT_L(0); PG8_BAR; PG8_MMA(0, 0, At, B0); PG8_MMA(0, 1, At, B1); PG8_BAR; PG8_SCHED;
            PG8_LDA(At, 0, 1); PG8_STAGE(PG8_SB(0, 0), b2, voffB); PG8_STAGE(PG8_SB(0, 1), b2 + hstepB, voffB); PG8_STAGE(PG8_SA(0, 0), a2, vA2[0]);
            PG8_WAIT_V(8); PG8_WAIT_L(0); PG8_BAR; PG8_MMA(1, 0, At, B0); PG8_MMA(1, 1, At, B1); PG8_BAR; PG8_SCHED;
            PG8_LDB(B0, 1, 0); PG8_LDB(B1, 1, 1); PG8_SCHED; PG8_LDA(At, 1, 0); PG8_STAGE(PG8_SA(0, 1), a2, vA2[1]);
            PG8_WAIT_V(8); PG8_WAIT_L(0); PG8_BAR; PG8_MMA(0, 0, At, B0); PG8_MMA(0, 1, At, B1); PG8_BAR; PG8_SCHED;
            PG8_LDA(At, 1, 1); PG8_STAGE(PG8_SB(1, 0), b3, voffB); PG8_STAGE(PG8_SB(1, 1), b3 + hstepB, voffB); PG8_STAGE(PG8_SA(1, 0), a3, vA2[0]);
            PG8_WAIT_V(8); PG8_WAIT_L(0); PG8_BAR; PG8_MMA(1, 0, At, B0); PG8_MMA(1, 1, At, B1); PG8_BAR; PG8_SCHED;
            } else {
            PG8_LDB(B0, 0, 0); PG8_SCHED; PG8_LDA(At, 0, 0); PG8_STAGE(PG8_SA(1, 1), a1, vA[1]);
            PG8_WAIT_L(8); PG8_BAR; PG8_WAIT_L(0); PG8_MMA(0, 0, At, B0); PG8_BAR; PG8_SCHED;
            PG8_LDB(B1, 0, 1); PG8_STAGE(PG8_SB(0, 0), b2, voffB);
            PG8_BAR; PG8_WAIT_L(0); PG8_MMA(0, 1, At, B1); PG8_BAR;
            PG8_LDA(At, 0, 1); PG8_STAGE(PG8_SA(0, 0), a2, vA2[0]);
            PG8_BAR; PG8_WAIT_L(0); PG8_MMA(1, 0, At, B0); PG8_BAR; PG8_SCHED;
            PG8_STAGE(PG8_SB(0, 1), b2 + hstepB, voffB);
            PG8_WAIT_V(6); PG8_BAR; PG8_MMA(1, 1, At, B1); PG8_BAR;
            PG8_LDB(B0, 1, 0); PG8_SCHED; PG8_LDA(At, 1, 0); PG8_STAGE(PG8_SA(0, 1), a2, vA2[1]);
            PG8_WAIT_L(8); PG8_BAR; PG8_WAIT_L(0); PG8_MMA(0, 0, At, B0); PG8_BAR; PG8_SCHED;
            PG8_LDB(B1, 1, 1); PG8_STAGE(PG8_SB(1, 0), b3, voffB);
            PG8_BAR; PG8_WAIT_L(0); PG8_MMA(0, 1, At, B1); PG8_BAR;
            PG8_LDA(At, 1, 1); PG8_STAGE(PG8_SA(1, 0), a3, vA2[0]);
            PG8_BAR; PG8_WAIT_L(0); PG8_MMA(1, 0, At, B0); PG8_BAR; PG8_SCHED;
            PG8_STAGE(PG8_SB(1, 1), b3 + hstepB, voffB);
            PG8_WAIT_V(6); PG8_BAR; PG8_MMA(1, 1, At, B1); PG8_BAR;
            }
        }
        if constexpr (ALIGN_EPI) { if (wr == 0) PG8_BAR; }
        if constexpr (!Epi::AFTER_DRAIN) { E(acc, cur, wr, wc, fr, fq); }
        if (!has_next) break;
#pragma unroll
        for (int a = 0; a < 2; ++a)
#pragma unroll
            for (int b = 0; b < 2; ++b)
#pragma unroll
                for (int m = 0; m < 4; ++m)
#pragma unroll
                    for (int n = 0; n < 2; ++n) acc[a][b][m][n] = (f32x4){0.f, 0.f, 0.f, 0.f};
        cur = nxt; cA = nA; cB = nB; ++ui;
#pragma unroll
        for (int h = 0; h < 2; ++h)
#pragma unroll
            for (int i = 0; i < 2; ++i) { vA[h][i] = vN[h][i]; vA2[h][i] = vN[h][i]; }
        if constexpr (ALIGN_EPI) { if (wr == 1) PG8_BAR; }
    }
    PG8_WAIT_V(0);
    if constexpr (!ALIGN_EPI) { if (wr == 0) PG8_BAR; }
    PG8_BAR;
    if constexpr (Epi::AFTER_DRAIN) { E.fused(acc, cur, wr, wc, fr, fq, lds, wid, lane); }
#undef PG8_SA
#undef PG8_SB
#undef PG8_STAGE
#undef PG8_LDA
#undef PG8_LDB
#undef PG8_MMA
#undef PG8_WAIT_V
#undef PG8_WAIT_L
#undef PG8_BAR
#undef PG8_SCHED
#undef PG8_VOFFA
}

struct OrderP1 {
    const char *xn, *win_t, *memn, *wkv_t; int G, c; GridOrder g0;
    __device__ __forceinline__ void init(const void* xn_, const void* win_t_, const void* memn_, const void* wkv_t_, int G_, int c_) {
        xn = (const char*)xn_; win_t = (const char*)win_t_; memn = (const char*)memn_; wkv_t = (const char*)wkv_t_; G = G_; c = c_; g0.init(M / 256, NPROJ / 256); }
    __device__ __forceinline__ bool next(int i, Unit& u) const {
        const int L = i * G + c; u.tok = nullptr; u.nvalid = 256; u.e = 0; u.rowoff = 0;
        if (L < g0.nwg) { g0.map(L, u.pm, u.pn); u.kind = 0; u.a = xn + (size_t)u.pm * 256 * D * 2; u.b = win_t + (size_t)u.pn * 256 * D * 2; return true; }
        int r = L - g0.nwg;
        if (r < 32) { u.kind = 1; u.pm = r >> 2; u.pn = r & 3; u.a = memn + (size_t)u.pm * 256 * D * 2; u.b = wkv_t + (size_t)u.pn * 256 * D * 2; return true; }
        r -= 32;
        if (r < 32) { u.kind = 2; u.pm = r >> 3; u.pn = r & 7; u.a = wkv_t + (size_t)(D + u.pm * 256) * D * 2; u.b = memn + (size_t)u.pn * 256 * D * 2; return true; }
        return false;
    }
};
struct OrderPlain {
    const char *A, *Bt; int lda, ldb, G, c; GridOrder g0;
    __device__ __forceinline__ void init(const void* A_, const void* Bt_, int lda_, int ldb_, int nM, int nN, int G_, int c_) { A = (const char*)A_; Bt = (const char*)Bt_; lda = lda_; ldb = ldb_; G = G_; c = c_; g0.init(nM, nN); }
    __device__ __forceinline__ bool next(int i, Unit& u) const {
        const int L = i * G + c; if (L >= g0.nwg) return false;
        g0.map(L, u.pm, u.pn); u.kind = 0; u.tok = nullptr; u.nvalid = 256; u.e = 0; u.rowoff = 0;
        u.a = A + (size_t)u.pm * 256 * lda * 2; u.b = Bt + (size_t)u.pn * 256 * ldb * 2; return true;
    }
};
template <int MODE> struct OrderX {
    const char *A, *Bt; int G, c;
    __device__ __forceinline__ void init(const void* A_, const void* Bt_, int G_, int c_) { A = (const char*)A_; Bt = (const char*)Bt_; G = G_; c = c_; }
    __device__ __forceinline__ bool next(int i, Unit& u) const {
        const int L = i * G + c; if (L >= (M / 256) * XH) return false;
        const int xcd = L & 7, j = L >> 3; u.pm = xcd * 8 + (j >> 2); u.pn = j & 3;
        const int b = u.pm >> 3; u.kind = 0; u.tok = nullptr; u.nvalid = 256; u.e = 0; u.rowoff = 0;
        u.a = A + ((size_t)u.pm * 256 * D + (size_t)u.pn * XHD) * 2;
        if (MODE == 0) u.b = Bt + ((size_t)b * MEMLEN * D + (size_t)u.pn * XHD) * 2;
        else u.b = Bt + ((size_t)u.pn * XHD * MROWS + (size_t)b * MEMLEN) * 2;
        return true;
    }
};
template <int NTN, bool G1> struct OrderMoe {
    const unsigned* cnt; const int* ltok; const char* A; const char* Bt; int G, c;
    __device__ __forceinline__ void init(const unsigned* cnt_, const int* ltok_, const void* A_, const void* Bt_, int G_, int c_) { cnt = cnt_; ltok = ltok_; A = (const char*)A_; Bt = (const char*)Bt_; G = G_; c = c_; }
    __device__ __forceinline__ bool next(int i, Unit& u) const {
        const int xcd = c & 7, slot = c >> 3, nslot = G >> 3; int j = i * nslot + slot;
        int seg[4], til[4]; int run = 0;
#pragma unroll 1
        for (int e = 0; e < NE; ++e) { const int t = (int)((cnt[64 * e] + 255u) >> 8); if ((e & 7) == xcd) { seg[e >> 3] = run; til[e >> 3] = t; } run += t; }
#pragma unroll
        for (int q = 0; q < 4; ++q) {
            const int nu = til[q] * NTN;
            if (j < nu) { const int e = xcd + 8 * q, mt = j / NTN, nt = j % NTN, cn = (int)cnt[64 * e];
                u.e = e; u.pm = mt; u.pn = nt; u.kind = 0; u.rowoff = (seg[q] + mt) * 256; u.nvalid = cn - mt * 256 < 256 ? cn - mt * 256 : 256; u.tok = ltok + (size_t)e * LISTCAP + mt * 256;
                if (G1) { u.a = A; u.b = Bt + ((size_t)e * 2048 + (size_t)nt * 256) * D * 2; }
                else { u.a = A + (size_t)u.rowoff * DEXP * 2; u.b = Bt + ((size_t)e * 1024 + (size_t)nt * 256) * DEXP * 2; }
                return true; }
            j -= nu;
        }
        return false;
    }
};

struct EpiP1 {
    static constexpr bool PERM = true, AFTER_DRAIN = false;
    bf16_t *proj, *kmem, *vt;
    __device__ __forceinline__ void operator()(const Acc& acc, const Unit& u, int wr, int wc, int fr, int fq) const {
        bf16_t* base; int ldc; float sc = 1.f;
        if (u.kind == 0) { base = proj; ldc = NPROJ; if (u.pn >= 6 && u.pn < 8) sc = C2Q; } else if (u.kind == 1) { base = kmem; ldc = D; } else { base = vt; ldc = MROWS; }
        const int row0 = u.pm * BM + wr * 64 + fr, col0 = u.pn * BM + wc * 32 + 8 * fq;
#pragma unroll
        for (int ai = 0; ai < 2; ++ai)
#pragma unroll
            for (int m = 0; m < 4; ++m) { bf16_t* rowp = base + (size_t)(row0 + ai * HALF + m * 16) * ldc + col0;
#pragma unroll
                for (int bj = 0; bj < 2; ++bj) { const f32x4 v0 = acc[ai][bj][m][0] * sc, v1 = acc[ai][bj][m][1] * sc;
                    u32x4 w; w.x = cvt_pk_bf16(v0[0], v0[1]); w.y = cvt_pk_bf16(v0[2], v0[3]); w.z = cvt_pk_bf16(v1[0], v1[1]); w.w = cvt_pk_bf16(v1[2], v1[3]);
                    *(u32x4*)(rowp + bj * HALF) = w; } }
    }
};
struct EpiRes {
    static constexpr bool PERM = false, AFTER_DRAIN = false;
    const float* base; float* xo; bf16_t* xb; float* ss;
    __device__ __forceinline__ void operator()(const Acc& acc, const Unit& u, int wr, int wc, int fr, int fq) const {
        const int col0 = u.pn * BM + wc * 32 + 4 * fq;
#pragma unroll
        for (int ai = 0; ai < 2; ++ai)
#pragma unroll
            for (int m = 0; m < 4; ++m) { const int row = u.pm * BM + ai * HALF + wr * 64 + m * 16 + fr; const size_t off = (size_t)row * D + col0; float s = 0.f;
#pragma unroll
                for (int bj = 0; bj < 2; ++bj)
#pragma unroll
                    for (int n = 0; n < 2; ++n) { const f32x4 bs = *(const f32x4*)(base + off + bj * HALF + n * 16); const f32x4 o = bs + acc[ai][bj][m][n];
                        *(f32x4*)(xo + off + bj * HALF + n * 16) = o; u32x2 w; w.x = cvt_pk_bf16(o[0], o[1]); w.y = cvt_pk_bf16(o[2], o[3]); *(u32x2*)(xb + off + bj * HALF + n * 16) = w;
                        s += (o[0] * o[0] + o[1] * o[1]) + (o[2] * o[2] + o[3] * o[3]); }
                s += __shfl_xor(s, 16); s += __shfl_xor(s, 32);
                if (fq == 0) ss[(size_t)row * 16 + u.pn * 4 + wc] = s; }
    }
};
__device__ __forceinline__ float rstd_from_ss(const float* ss, int row) {
    const f32x4* p = (const f32x4*)(ss + (size_t)row * 16); const f32x4 a = p[0], b = p[1], c = p[2], d = p[3];
    const float s = ((a[0] + a[1]) + (a[2] + a[3])) + ((b[0] + b[1]) + (b[2] + b[3])) + ((c[0] + c[1]) + (c[2] + c[3])) + ((d[0] + d[1]) + (d[2] + d[3]));
    return __builtin_amdgcn_rsqf(s * (1.0f / D) + EPS);
}
struct EpiQm {
    static constexpr bool PERM = true, AFTER_DRAIN = false;
    bf16_t* qm; const float* ss;
    __device__ __forceinline__ void operator()(const Acc& acc, const Unit& u, int wr, int wc, int fr, int fq) const {
        const int row0 = u.pm * BM + wr * 64 + fr, col0 = u.pn * BM + wc * 32 + 8 * fq;
#pragma unroll
        for (int ai = 0; ai < 2; ++ai)
#pragma unroll
            for (int m = 0; m < 4; ++m) { const int row = row0 + ai * HALF + m * 16; const float sc = rstd_from_ss(ss, row) * C2X; bf16_t* rowp = qm + (size_t)row * D + col0;
#pragma unroll
                for (int bj = 0; bj < 2; ++bj) { const f32x4 v0 = acc[ai][bj][m][0] * sc, v1 = acc[ai][bj][m][1] * sc;
                    u32x4 w; w.x = cvt_pk_bf16(v0[0], v0[1]); w.y = cvt_pk_bf16(v0[2], v0[3]); w.z = cvt_pk_bf16(v1[0], v1[1]); w.w = cvt_pk_bf16(v1[2], v1[3]);
                    *(u32x4*)(rowp + bj * HALF) = w; } }
    }
};
struct EpiSoftmax {
    static constexpr bool PERM = true, AFTER_DRAIN = true;
    bf16_t* pb;
    __device__ __forceinline__ void fused(Acc& acc, const Unit& u, int wr, int wc, int fr, int fq, LAS unsigned char* lds, int wid, int lane) const {
        LAS float* PM = (LAS float*)lds;
        LAS float* PS = (LAS float*)(lds + 4096);
#pragma unroll
        for (int ai = 0; ai < 2; ++ai)
#pragma unroll
            for (int m = 0; m < 4; ++m) { float mx = -INFINITY;
#pragma unroll
                for (int bj = 0; bj < 2; ++bj)
#pragma unroll
                    for (int n = 0; n < 2; ++n) { const f32x4 x = acc[ai][bj][m][n]; mx = fmaxf(mx, fmaxf(fmaxf(x[0], x[1]), fmaxf(x[2], x[3]))); }
                mx = fmaxf(mx, __shfl_xor(mx, 16)); mx = fmaxf(mx, __shfl_xor(mx, 32));
                if (fq == 0) PM[(ai * HALF + wr * 64 + m * 16 + fr) * 4 + wc] = mx; }
        __syncthreads();
#pragma unroll
        for (int ai = 0; ai < 2; ++ai)
#pragma unroll
            for (int m = 0; m < 4; ++m) { const int r = ai * HALF + wr * 64 + m * 16 + fr; const f32x4 pm4 = *(const LAS f32x4*)(PM + r * 4);
                const float mx = fmaxf(fmaxf(pm4[0], pm4[1]), fmaxf(pm4[2], pm4[3])); float s = 0.f;
#pragma unroll
                for (int bj = 0; bj < 2; ++bj)
#pragma unroll
                    for (int n = 0; n < 2; ++n) { f32x4 x = acc[ai][bj][m][n];
#pragma unroll
                        for (int j = 0; j < 4; ++j) { x[j] = __builtin_amdgcn_exp2f(x[j] - mx); s += x[j]; }
                        acc[ai][bj][m][n] = x; }
                s += __shfl_xor(s, 16); s += __shfl_xor(s, 32);
                if (fq == 0) PS[r * 4 + wc] = s; }
        __syncthreads();
        const int row0 = u.pm * BM + wr * 64 + fr, col0 = u.pn * XHD + wc * 32 + 8 * fq;
#pragma unroll
        for (int ai = 0; ai < 2; ++ai)
#pragma unroll
            for (int m = 0; m < 4; ++m) { const int r = ai * HALF + wr * 64 + m * 16 + fr; const f32x4 ps4 = *(const LAS f32x4*)(PS + r * 4);
                const float inv = 1.0f / ((ps4[0] + ps4[1]) + (ps4[2] + ps4[3])); bf16_t* rowp = pb + (size_t)(row0 + ai * HALF + m * 16) * D + col0;
#pragma unroll
                for (int bj = 0; bj < 2; ++bj) { const f32x4 v0 = acc[ai][bj][m][0] * inv, v1 = acc[ai][bj][m][1] * inv;
                    u32x4 w; w.x = cvt_pk_bf16(v0[0], v0[1]); w.y = cvt_pk_bf16(v0[2], v0[3]); w.z = cvt_pk_bf16(v1[0], v1[1]); w.w = cvt_pk_bf16(v1[2], v1[3]);
                    *(u32x4*)(rowp + bj * HALF) = w; } }
        __syncthreads();
    }
};
struct EpiO {
    static constexpr bool PERM = true, AFTER_DRAIN = false;
    bf16_t* ob;
    __device__ __forceinline__ void operator()(const Acc& acc, const Unit& u, int wr, int wc, int fr, int fq) const {
        const int row0 = u.pm * BM + wr * 64 + fr, col0 = u.pn * BM + wc * 32 + 8 * fq;
#pragma unroll
        for (int ai = 0; ai < 2; ++ai)
#pragma unroll
            for (int m = 0; m < 4; ++m) { bf16_t* rowp = ob + (size_t)(row0 + ai * HALF + m * 16) * D + col0;
#pragma unroll
                for (int bj = 0; bj < 2; ++bj) { const f32x4 v0 = acc[ai][bj][m][0], v1 = acc[ai][bj][m][1];
                    u32x4 w; w.x = cvt_pk_bf16(v0[0], v0[1]); w.y = cvt_pk_bf16(v0[2], v0[3]); w.z = cvt_pk_bf16(v1[0], v1[1]); w.w = cvt_pk_bf16(v1[2], v1[3]);
                    *(u32x4*)(rowp + bj * HALF) = w; } }
    }
};
struct EpiAct {
    static constexpr bool PERM = true, AFTER_DRAIN = false;
    bf16_t* act; const float* rstd3; const float* b1;
    __device__ __forceinline__ void operator()(const Acc& acc, const Unit& u, int wr, int wc, int fr, int fq) const {
        const int cl = wc * 32 + 8 * fq, gcol = u.pn * 128 + cl; const float* bg = b1 + (size_t)u.e * 2048 + gcol; const float* bl = bg + 1024;
        const f32x4 bg0 = *(const f32x4*)bg, bg1 = *(const f32x4*)(bg + 4), bl0 = *(const f32x4*)bl, bl1 = *(const f32x4*)(bl + 4);
#pragma unroll
        for (int ai = 0; ai < 2; ++ai)
#pragma unroll
            for (int m = 0; m < 4; ++m) { const int r = ai * HALF + wr * 64 + m * 16 + fr; float rs = 0.f; if (r < u.nvalid) rs = rstd3[u.tok[r] >> 2];
                float o[8];
#pragma unroll
                for (int n = 0; n < 2; ++n) { const f32x4 g4 = acc[ai][0][m][n] * rs + (n ? bg1 : bg0), l4 = acc[ai][1][m][n] * rs + (n ? bl1 : bl0);
#pragma unroll
                    for (int j = 0; j < 4; ++j) { const float g = fminf(g4[j], 7.0f), l = fminf(fmaxf(l4[j], -7.0f), 7.0f);
                        const float sg = __builtin_amdgcn_rcpf(1.0f + __builtin_amdgcn_exp2f(g * (-1.702f * LOG2E))); o[n * 4 + j] = g * sg * (l + 1.0f); } }
                u32x4 w; w.x = cvt_pk_bf16(o[0], o[1]); w.y = cvt_pk_bf16(o[2], o[3]); w.z = cvt_pk_bf16(o[4], o[5]); w.w = cvt_pk_bf16(o[6], o[7]);
                *(u32x4*)(act + (size_t)(u.rowoff + r) * DEXP + gcol) = w; }
    }
};
struct EpiY {
    static constexpr bool PERM = true, AFTER_DRAIN = false;
    bf16_t* y; const float* lgate; const float* b2;
    __device__ __forceinline__ void operator()(const Acc& acc, const Unit& u, int wr, int wc, int fr, int fq) const {
        const int col0 = u.pn * BM + wc * 32 + 8 * fq; const float* bb = b2 + (size_t)u.e * D + col0;
        f32x4 bv[2][2];
#pragma unroll
        for (int bj = 0; bj < 2; ++bj)
#pragma unroll
            for (int n = 0; n < 2; ++n) bv[bj][n] = *(const f32x4*)(bb + bj * HALF + 4 * n);
        const float* gt = lgate + (size_t)u.e * LISTCAP + u.pm * 256;
#pragma unroll
        for (int ai = 0; ai < 2; ++ai)
#pragma unroll
            for (int m = 0; m < 4; ++m) { const int r = ai * HALF + wr * 64 + m * 16 + fr;
                if (r < u.nvalid) { const int ent = u.tok[r]; const float gw = gt[r]; bf16_t* rowp = y + (size_t)ent * D + col0;
#pragma unroll
                    for (int bj = 0; bj < 2; ++bj) { const f32x4 v0 = (acc[ai][bj][m][0] + bv[bj][0]) * gw, v1 = (acc[ai][bj][m][1] + bv[bj][1]) * gw;
                        u32x4 w; w.x = cvt_pk_bf16(v0[0], v0[1]); w.y = cvt_pk_bf16(v0[2], v0[3]); w.z = cvt_pk_bf16(v1[0], v1[1]); w.w = cvt_pk_bf16(v1[2], v1[3]);
                        *(u32x4*)(rowp + bj * HALF) = w; } } }
    }
};
}

#define XB_TMO      128
#define XB_XCNT(j)  (256  + 64 * (j))
#define XB_XSUB(j)  (1280 + 64 * (j))
#define XB_XGEN(j)  (2304 + 64 * (j))
#define XB_TOP      3328
#define XB_TOPGEN   3392
#define XCD_BAR_WORDS 3456
#define XB_SPIN_CAP (1u << 18)
__device__ __forceinline__ unsigned xb_ld(unsigned* p)              { return __hip_atomic_load(p, __ATOMIC_RELAXED, __HIP_MEMORY_SCOPE_AGENT); }
__device__ __forceinline__ unsigned xb_add(unsigned* p, unsigned v) { return __hip_atomic_fetch_add(p, v, __ATOMIC_RELAXED, __HIP_MEMORY_SCOPE_AGENT); }
__device__ __forceinline__ unsigned xb_xcc_id() { return (unsigned)__builtin_amdgcn_s_getreg((3 << 11) | 20) & 0xFu; }
#define XB_SPIN(cond, bar) do { unsigned _sp = 0; while (cond) { __builtin_amdgcn_s_sleep(1); \
    if ((++_sp & 255u) == 0u) { if (xb_ld(&(bar)[XB_TMO])) break; if (_sp > XB_SPIN_CAP) { atomicAdd(&(bar)[XB_TMO], 1u); break; } } } } while (0)
struct XcdBarrier { unsigned* bar; unsigned x; volatile LAS unsigned* st; };
__device__ __forceinline__ XcdBarrier xcd_barrier_post(unsigned* bar, volatile LAS unsigned* st) {
    XcdBarrier b; b.bar = bar; b.x = xb_xcc_id(); b.st = st;
    if (threadIdx.x == 0) (void)xb_add(&bar[XB_XCNT(b.x)], 1u);
    return b;
}
__device__ __forceinline__ void xcd_barrier_complete(unsigned* bar, unsigned x, unsigned& nloc, unsigned& nx) {
    const unsigned G = gridDim.x * gridDim.y * gridDim.z;
    unsigned sum, cnt, mine, sp = 0u;
    for (;;) {
        sum = 0u; cnt = 0u; mine = 0u;
#pragma unroll
        for (unsigned j = 0; j < 16; ++j) { const unsigned c = xb_ld(&bar[XB_XCNT(j)]); sum += c; cnt += (c > 0u) ? 1u : 0u; mine = (j == x) ? c : mine; }
        if (sum == G) break;
        __builtin_amdgcn_s_sleep(1);
        if ((++sp & 255u) == 0u) { if (xb_ld(&bar[XB_TMO])) break; if (sp > XB_SPIN_CAP) { atomicAdd(&bar[XB_TMO], 1u); break; } }
    }
    nloc = mine > 0u ? mine : 1u; nx = cnt > 0u ? cnt : 1u;
}
__device__ __forceinline__ void xcd_barrier(const XcdBarrier& b) {
    asm volatile("s_waitcnt vmcnt(0)" ::: "memory");
    __syncthreads();
    if (threadIdx.x == 0) {
        unsigned* bar = b.bar;
        __builtin_amdgcn_s_waitcnt(0);
        unsigned nloc = b.st[0], nx = b.st[1];
        if (nloc == 0u) { xcd_barrier_complete(bar, b.x, nloc, nx); b.st[0] = nloc; b.st[1] = nx; }
        const unsigned old = xb_add(&bar[XB_XSUB(b.x)], 1u);
        const unsigned gen = old / nloc;
        if (old + 1u == (gen + 1u) * nloc) {
            __builtin_amdgcn_fence(__ATOMIC_RELEASE, "agent");
            asm volatile("s_waitcnt vmcnt(0)" ::: "memory");
            const unsigned og = xb_add(&bar[XB_TOP], 1u);
            const unsigned tg = og / nx;
            if (og + 1u == (tg + 1u) * nx) xb_add(&bar[XB_TOPGEN], 1u);
            else XB_SPIN(xb_ld(&bar[XB_TOPGEN]) == tg, bar);
            __builtin_amdgcn_fence(__ATOMIC_ACQUIRE, "agent");
            xb_add(&bar[XB_XGEN(b.x)], 1u);
            asm volatile("s_waitcnt vmcnt(0)" ::: "memory");
        } else {
            XB_SPIN(xb_ld(&bar[XB_XGEN(b.x)]) == gen, bar);
            __builtin_amdgcn_fence(__ATOMIC_ACQUIRE, "agent");
            asm volatile("s_waitcnt vmcnt(0)" ::: "memory");
        }
    }
    __syncthreads();
}

constexpr int NWAVES = 8;
constexpr int RING_OFF = 0, RING_BYTES = 131072;
constexpr int LDSCTL_OFF = RING_BYTES + 8192, MISC_OFF = LDSCTL_OFF + 320;
constexpr int LDS_BYTES = 147456;
static_assert(MISC_OFF + 128 <= LDS_BYTES, "LDS map");

struct Frame {
    LAS unsigned char* lds; volatile LAS unsigned* MISC; unsigned* ctl; unsigned char* ws;
    int tid, lane, wave, vcu, G;
    const float* const* in; float* out;
};

template <int NMAP> __device__ __forceinline__ int nmap(int n) {
    if (NMAP == 0) return n;
    return n < 1024 ? (n >> 7) * 256 + (n & 127) : ((n - 1024) >> 7) * 256 + 128 + ((n - 1024) & 127);
}
template <int NMAP> __device__ __forceinline__ void transpose_item(const float* W, int ldw, int K, bf16_t* WT, const float* g, LAS unsigned* scr, int k0, int n0, int lane) {
    const int nq = lane & 15, kp = lane >> 4;
    f32x4 va[8], vb[8];
#pragma unroll
    for (int it = 0; it < 8; ++it) { const int k = k0 + 2 * (kp + 4 * it); va[it] = *(const f32x4*)(W + (size_t)k * ldw + n0 + 4 * nq); vb[it] = *(const f32x4*)(W + (size_t)(k + 1) * ldw + n0 + 4 * nq); }
#pragma unroll
    for (int it = 0; it < 8; ++it) { const int kk2 = kp + 4 * it; f32x4 a = va[it], b = vb[it];
        if (g) { const float g0 = g[k0 + 2 * kk2], g1 = g[k0 + 2 * kk2 + 1]; a = a * g0; b = b * g1; }
#pragma unroll
        for (int j = 0; j < 4; ++j) scr[(4 * nq + j) * 33 + kk2] = cvtpk_s(a[j], b[j]); }
    LDS_WAIT(); asm volatile("" ::: "memory");
    const int c = lane & 7;
#pragma unroll
    for (int it = 0; it < 8; ++it) { const int n = (lane >> 3) + 8 * it; const LAS unsigned* s = scr + n * 33 + 4 * c;
        u32x4 o; o.x = s[0]; o.y = s[1]; o.z = s[2]; o.w = s[3];
        *(u32x4*)(WT + (size_t)nmap<NMAP>(n0 + n) * K + k0 + 8 * c) = o; }
    LDS_WAIT(); asm volatile("" ::: "memory");
}
__device__ __forceinline__ void rms_row_to_bf16(const float* xrow, const float* g, bf16_t* orow, int lane) {
    const f32x4* xr = (const f32x4*)xrow + lane; const f32x4* gr = (const f32x4*)g + lane;
    f32x4 v[4]; float s = 0.f;
#pragma unroll
    for (int j = 0; j < 4; ++j) { v[j] = xr[64 * j]; s += (v[j][0] * v[j][0] + v[j][1] * v[j][1]) + (v[j][2] * v[j][2] + v[j][3] * v[j][3]); }
    const float rstd = __builtin_amdgcn_rsqf(wave_sum(s) * (1.f / D) + EPS);
    u32x2* o8 = (u32x2*)orow + lane;
#pragma unroll
    for (int j = 0; j < 4; ++j) { const f32x4 gg = gr[64 * j]; u32x2 w; w.x = cvtpk_s(v[j][0] * rstd * gg[0], v[j][1] * rstd * gg[1]); w.y = cvtpk_s(v[j][2] * rstd * gg[2], v[j][3] * rstd * gg[3]); o8[64 * j] = w; }
}
__device__ __forceinline__ void p0_prologue(Frame& F) {
    LAS unsigned* scr = (LAS unsigned*)(F.lds + RING_OFF + F.wave * 16384);
    const int gw = F.vcu * NWAVES + F.wave, NGW = F.G * NWAVES;
    const float *x = F.in[0], *mem = F.in[1], *g_mix = F.in[2], *w_in = F.in[3], *w_out = F.in[7], *g_xattn = F.in[8], *g_mem = F.in[9], *w_q = F.in[10], *w_kv = F.in[11], *w_o = F.in[12], *g_moe = F.in[13],
                *w_router = F.in[14], *w1 = F.in[16], *w2 = F.in[18];
    bf16_t *win_t = (bf16_t*)(F.ws + WS_WIN_T), *wout_t = (bf16_t*)(F.ws + WS_WOUT_T), *wq_t = (bf16_t*)(F.ws + WS_WQ_T), *wkv_t = (bf16_t*)(F.ws + WS_WKV_T), *wo_t = (bf16_t*)(F.ws + WS_WO_T),
           *w1_t = (bf16_t*)(F.ws + WS_W1_T), *w2_t = (bf16_t*)(F.ws + WS_W2_T), *xn = (bf16_t*)(F.ws + WS_XN), *memn = (bf16_t*)(F.ws + WS_MEMN);
    float* wr = (float*)(F.ws + WS_WR);
    for (int m = gw; m < M; m += NGW) rms_row_to_bf16(x + (size_t)m * D, g_mix, xn + (size_t)m * D, F.lane);
    for (int m = gw; m < MROWS; m += NGW) rms_row_to_bf16(mem + (size_t)m * D, g_mem, memn + (size_t)m * D, F.lane);
    for (int i = gw * 64 + F.lane; i < D * NE; i += NGW * 64) wr[i] = w_router[i] * g_moe[i >> 5];
    constexpr int I_IN = 16 * 48, I_OUT = 16 * 16, I_Q = 16 * 16, I_KV = 16 * 32, I_O = 16 * 16, I_1 = NE * 16 * 32, I_2 = NE * 16 * 16;
    constexpr int NITEMS = I_IN + I_OUT + I_Q + I_KV + I_O + I_1 + I_2;
    for (int it = gw; it < NITEMS; it += NGW) {
        int r = it;
        if (r < I_IN) { transpose_item<0>(w_in, NPROJ, D, win_t, nullptr, scr, (r / 48) * 64, (r % 48) * 64, F.lane); continue; } r -= I_IN;
        if (r < I_OUT) { transpose_item<0>(w_out, D, D, wout_t, nullptr, scr, (r / 16) * 64, (r % 16) * 64, F.lane); continue; } r -= I_OUT;
        if (r < I_Q) { transpose_item<0>(w_q, D, D, wq_t, g_xattn, scr, (r / 16) * 64, (r % 16) * 64, F.lane); continue; } r -= I_Q;
        if (r < I_KV) { transpose_item<0>(w_kv, 2 * D, D, wkv_t, nullptr, scr, (r / 32) * 64, (r % 32) * 64, F.lane); continue; } r -= I_KV;
        if (r < I_O) { transpose_item<0>(w_o, D, D, wo_t, nullptr, scr, (r / 16) * 64, (r % 16) * 64, F.lane); continue; } r -= I_O;
        if (r < I_1) { const int e = r / 512, q = r % 512; transpose_item<1>(w1 + (size_t)e * D * 2048, 2048, D, w1_t + (size_t)e * 2048 * D, g_moe, scr, (q / 32) * 64, (q % 32) * 64, F.lane); continue; } r -= I_1;
        { const int e = r / 256, q = r % 256; transpose_item<0>(w2 + (size_t)e * DEXP * D, D, DEXP, w2_t + (size_t)e * D * DEXP, nullptr, scr, (q / 16) * 64, (q % 16) * 64, F.lane); }
    }
}

__device__ __forceinline__ void conv_rows(Frame& F) {
    const bf16_t* proj = (const bf16_t*)(F.ws + WS_PROJ); bf16_t* ymix = (bf16_t*)(F.ws + WS_YMIX);
    const float* conv_w = F.in[4]; const float* g_conv = F.in[5];
    const int gw = F.vcu * NWAVES + F.wave, NGW = F.G * NWAVES, c0 = 8 * F.lane;
    float w0[8], w1[8], w2[8], gg[8];
#pragma unroll
    for (int j = 0; j < 8; ++j) { w0[j] = conv_w[c0 + j]; w1[j] = conv_w[512 + c0 + j]; w2[j] = conv_w[1024 + c0 + j]; gg[j] = g_conv[c0 + j]; }
    for (int m = gw; m < M; m += NGW) {
        const int t = m & (SEQ - 1); const bf16_t* row = proj + (size_t)m * NPROJ + c0;
        const u32x4 bg = *(const u32x4*)row, cg0 = *(const u32x4*)(row + 512), xv0 = *(const u32x4*)(row + 1024);
        u32x4 cg1 = {0, 0, 0, 0}, xv1 = {0, 0, 0, 0}, cg2 = {0, 0, 0, 0}, xv2 = {0, 0, 0, 0};
        if (t >= 1) { cg1 = *(const u32x4*)(row - NPROJ + 512); xv1 = *(const u32x4*)(row - NPROJ + 1024); }
        if (t >= 2) { cg2 = *(const u32x4*)(row - 2 * NPROJ + 512); xv2 = *(const u32x4*)(row - 2 * NPROJ + 1024); }
        float y[8]; float ss = 0.f;
#pragma unroll
        for (int j = 0; j < 4; ++j) {
            const float u0l = bf_lo(cg0[j]) * bf_lo(xv0[j]), u0h = bf_hi(cg0[j]) * bf_hi(xv0[j]);
            const float u1l = bf_lo(cg1[j]) * bf_lo(xv1[j]), u1h = bf_hi(cg1[j]) * bf_hi(xv1[j]);
            const float u2l = bf_lo(cg2[j]) * bf_lo(xv2[j]), u2h = bf_hi(cg2[j]) * bf_hi(xv2[j]);
            y[2 * j] = bf_lo(bg[j]) * (w0[2 * j] * u2l + w1[2 * j] * u1l + w2[2 * j] * u0l);
            y[2 * j + 1] = bf_hi(bg[j]) * (w0[2 * j + 1] * u2h + w1[2 * j + 1] * u1h + w2[2 * j + 1] * u0h);
            ss += y[2 * j] * y[2 * j] + y[2 * j + 1] * y[2 * j + 1];
        }
        ss += __shfl_xor(ss, 1); ss += __shfl_xor(ss, 2); ss += __shfl_xor(ss, 4);
        const float rstd = __builtin_amdgcn_rsqf(ss * (1.f / 64.f) + EPS);
        u32x4 o; o.x = cvtpk_s(y[0] * rstd * gg[0], y[1] * rstd * gg[1]); o.y = cvtpk_s(y[2] * rstd * gg[2], y[3] * rstd * gg[3]);
        o.z = cvtpk_s(y[4] * rstd * gg[4], y[5] * rstd * gg[5]); o.w = cvtpk_s(y[6] * rstd * gg[6], y[7] * rstd * gg[7]);
        *(u32x4*)(ymix + (size_t)m * D + c0) = o;
    }
}
constexpr int SB_K = 0, SB_V = 8192, SB_OST = 16384, SB_OSTW = 32 * 68 * 4;
static_assert(SB_OST + 8 * SB_OSTW <= RING_BYTES, "attention LDS");
__device__ __forceinline__ int crow(int r, int hi) { return (r & 3) + 8 * (r >> 2) + 4 * hi; }
__device__ __forceinline__ void sb_attn_unit(Frame& F, int b, int h, int qb) {
    const bf16_t* proj = (const bf16_t*)(F.ws + WS_PROJ); bf16_t* ymix = (bf16_t*)(F.ws + WS_YMIX); const float* g_sb = F.in[6];
    const int tid = F.tid, lane = F.lane, wid = F.wave, r32 = lane & 31, hi = lane >> 5;
    LAS unsigned char* lds = F.lds + RING_OFF;
    const int q0 = qb * 256, qlo = q0 + wid * 32, qpos = qlo + r32;
    const size_t rowbase = (size_t)b * SEQ;
    const bf16_t* Qp = proj + (rowbase + qlo) * NPROJ + 1536 + h * 64;
    const bf16_t* Kp = proj + rowbase * NPROJ + 2048 + h * 64;
    const bf16_t* Vp = proj + rowbase * NPROJ + 2560 + h * 64;
    bf16x8 qr[4];
#pragma unroll
    for (int s = 0; s < 4; ++s) qr[s] = *(const bf16x8*)(Qp + (size_t)r32 * NPROJ + 16 * s + 8 * hi);
    bf16x8 ntri[2], nones;
#pragma unroll
    for (int s = 0; s < 2; ++s)
#pragma unroll
        for (int j = 0; j < 8; ++j) { const int k = 16 * s + 8 * (j >> 2) + 4 * hi + (j & 3); ntri[s][j] = (k > r32) ? (short)0xBF80 : (short)0; }
#pragma unroll
    for (int j = 0; j < 8; ++j) nones[j] = (short)0xBF80;
    f32x16 R = {}; f32x16 o[2]; o[0] = f32x16{}; o[1] = f32x16{};
    const int skey = tid >> 3, sc = tid & 7;
    const int koff = SB_K + skey * 128 + ((sc ^ ((skey >> 1) & 7)) << 4);
    const int voff = SB_V + (sc >> 2) * 4096 + (skey >> 4) * 1024 + (skey & 15) * 64 + (sc & 3) * 16;
    const int vb = SB_V + ((lane >> 4) & 1) * 32 + (lane & 3) * 8 + (4 * hi + ((lane & 15) >> 2)) * 64;
    int kbi = 4 * qb + 3;
    u32x4 kreg = *(const u32x4*)(Kp + (size_t)(kbi * 64 + skey) * NPROJ + sc * 8), vreg = *(const u32x4*)(Vp + (size_t)(kbi * 64 + skey) * NPROJ + sc * 8);
    for (; kbi >= 0; --kbi) {
        const int k0 = kbi * 64;
        __syncthreads();
        *(LAS u32x4*)(lds + koff) = kreg; *(LAS u32x4*)(lds + voff) = vreg;
        __syncthreads();
        if (kbi > 0) { kreg = *(const u32x4*)(Kp + (size_t)(k0 - 64 + skey) * NPROJ + sc * 8); vreg = *(const u32x4*)(Vp + (size_t)(k0 - 64 + skey) * NPROJ + sc * 8); }
        if (k0 < qlo + 31) {
            f32x16 p0 = {}, p1 = {};
#pragma unroll
            for (int s = 0; s < 4; ++s) { const int c = 2 * s + hi;
                const bf16x8 ka = *(const LAS bf16x8*)(lds + SB_K + r32 * 128 + ((c ^ ((r32 >> 1) & 7)) << 4));
                const bf16x8 kb = *(const LAS bf16x8*)(lds + SB_K + (r32 + 32) * 128 + ((c ^ (((r32 + 32) >> 1) & 7)) << 4));
                p0 = __builtin_amdgcn_mfma_f32_32x32x16_bf16(ka, qr[s], p0, 0, 0, 0); p1 = __builtin_amdgcn_mfma_f32_32x32x16_bf16(kb, qr[s], p1, 0, 0, 0); }
            const bool diag = (k0 + 63 >= qlo);
            f32x16 s0, s1;
#pragma unroll
            for (int r = 0; r < 16; ++r) {
                const float z0 = p0[r], z1 = p1[r];
                float sp0 = fmaxf(z0, 0.f) + __builtin_amdgcn_logf(1.0f + __builtin_amdgcn_exp2f(-fabsf(z0)));
                float sp1 = fmaxf(z1, 0.f) + __builtin_amdgcn_logf(1.0f + __builtin_amdgcn_exp2f(-fabsf(z1)));
                if (diag) { const int key = k0 + crow(r, hi); if (key >= qpos) sp0 = 0.f; if (key + 32 >= qpos) sp1 = 0.f; }
                s0[r] = sp0; s1[r] = sp1; p0[r] = z0 - sp0; p1[r] = z1 - sp1;
            }
            u32x4 w00 = {cvtpk_s(s0[0], s0[1]), cvtpk_s(s0[2], s0[3]), cvtpk_s(s0[4], s0[5]), cvtpk_s(s0[6], s0[7])}, w01 = {cvtpk_s(s0[8], s0[9]), cvtpk_s(s0[10], s0[11]), cvtpk_s(s0[12], s0[13]), cvtpk_s(s0[14], s0[15])};
            u32x4 w10 = {cvtpk_s(s1[0], s1[1]), cvtpk_s(s1[2], s1[3]), cvtpk_s(s1[4], s1[5]), cvtpk_s(s1[6], s1[7])}, w11 = {cvtpk_s(s1[8], s1[9]), cvtpk_s(s1[10], s1[11]), cvtpk_s(s1[12], s1[13]), cvtpk_s(s1[14], s1[15])};
            const bf16x8 sb00 = __builtin_bit_cast(bf16x8, w00), sb01 = __builtin_bit_cast(bf16x8, w01), sb10 = __builtin_bit_cast(bf16x8, w10), sb11 = __builtin_bit_cast(bf16x8, w11);
            f32x16 rest1 = __builtin_amdgcn_mfma_f32_32x32x16_bf16(ntri[0], sb10, R, 0, 0, 0); rest1 = __builtin_amdgcn_mfma_f32_32x32x16_bf16(ntri[1], sb11, rest1, 0, 0, 0);
            f32x16 U = __builtin_amdgcn_mfma_f32_32x32x16_bf16(nones, sb10, R, 0, 0, 0); U = __builtin_amdgcn_mfma_f32_32x32x16_bf16(nones, sb11, U, 0, 0, 0);
            f32x16 rest0 = __builtin_amdgcn_mfma_f32_32x32x16_bf16(ntri[0], sb00, U, 0, 0, 0); rest0 = __builtin_amdgcn_mfma_f32_32x32x16_bf16(ntri[1], sb01, rest0, 0, 0, 0);
            R = __builtin_amdgcn_mfma_f32_32x32x16_bf16(nones, sb00, U, 0, 0, 0); R = __builtin_amdgcn_mfma_f32_32x32x16_bf16(nones, sb01, R, 0, 0, 0);
#pragma unroll
            for (int r = 0; r < 16; ++r) {
                float a0 = __builtin_amdgcn_exp2f(p0[r] + rest0[r]), a1 = __builtin_amdgcn_exp2f(p1[r] + rest1[r]);
                if (diag) { const int key = k0 + crow(r, hi); if (key >= qpos) a0 = 0.f; if (key + 32 >= qpos) a1 = 0.f; }
                p0[r] = a0; p1[r] = a1;
            }
            u32x4 a00 = {cvtpk_s(p0[0], p0[1]), cvtpk_s(p0[2], p0[3]), cvtpk_s(p0[4], p0[5]), cvtpk_s(p0[6], p0[7])}, a01 = {cvtpk_s(p0[8], p0[9]), cvtpk_s(p0[10], p0[11]), cvtpk_s(p0[12], p0[13]), cvtpk_s(p0[14], p0[15])};
            u32x4 a10 = {cvtpk_s(p1[0], p1[1]), cvtpk_s(p1[2], p1[3]), cvtpk_s(p1[4], p1[5]), cvtpk_s(p1[6], p1[7])}, a11 = {cvtpk_s(p1[8], p1[9]), cvtpk_s(p1[10], p1[11]), cvtpk_s(p1[12], p1[13]), cvtpk_s(p1[14], p1[15])};
            const bf16x8 pa[4] = {__builtin_bit_cast(bf16x8, a00), __builtin_bit_cast(bf16x8, a01), __builtin_bit_cast(bf16x8, a10), __builtin_bit_cast(bf16x8, a11)};
#pragma unroll
            for (int d0 = 0; d0 < 2; ++d0)
#pragma unroll
                for (int ks = 0; ks < 4; ++ks) {
                    const s16x4 lo = __builtin_bit_cast(s16x4, __builtin_amdgcn_ds_read_tr16_b64_v4i16((LAS s16x4*)(lds + vb + d0 * 4096 + ks * 1024)));
                    const s16x4 hh = __builtin_bit_cast(s16x4, __builtin_amdgcn_ds_read_tr16_b64_v4i16((LAS s16x4*)(lds + vb + d0 * 4096 + ks * 1024 + 512)));
                    const bf16x8 vf = {lo[0], lo[1], lo[2], lo[3], hh[0], hh[1], hh[2], hh[3]};
                    o[d0] = __builtin_amdgcn_mfma_f32_32x32x16_bf16(pa[ks], vf, o[d0], 0, 0, 0);
                }
        }
    }
    LAS float* stg = (LAS float*)(lds + SB_OST + wid * SB_OSTW);
#pragma unroll
    for (int r = 0; r < 16; ++r) { const int q = crow(r, hi); stg[q * 68 + r32] = o[0][r]; stg[q * 68 + 32 + r32] = o[1][r]; }
    LDS_WAIT(); asm volatile("" ::: "memory");
    { const int q = lane >> 1, half = lane & 1; const LAS f32x4* sp = (const LAS f32x4*)(stg + q * 68 + 32 * half);
      f32x4 v[8]; float ss = 0.f;
#pragma unroll
      for (int i = 0; i < 8; ++i) { v[i] = sp[i]; ss += (v[i][0] * v[i][0] + v[i][1] * v[i][1]) + (v[i][2] * v[i][2] + v[i][3] * v[i][3]); }
      ss += __shfl_xor(ss, 1);
      const float rstd = __builtin_amdgcn_rsqf(ss * (1.f / 64.f) + EPS);
      const f32x4* gp = (const f32x4*)(g_sb + h * 64 + 32 * half);
      bf16_t* op = ymix + (rowbase + qlo + q) * D + 512 + h * 64 + 32 * half;
#pragma unroll
      for (int i = 0; i < 4; ++i) { const f32x4 g0 = gp[2 * i], g1 = gp[2 * i + 1], a = v[2 * i] * rstd * g0, c = v[2 * i + 1] * rstd * g1;
          u32x4 w; w.x = cvtpk_s(a[0], a[1]); w.y = cvtpk_s(a[2], a[3]); w.z = cvtpk_s(c[0], c[1]); w.w = cvtpk_s(c[2], c[3]); *(u32x4*)(op + 8 * i) = w; } }
    LDS_WAIT();
}
__device__ __forceinline__ void p2_mix(Frame& F) {
    conv_rows(F);
    if (F.G == 256) {
        const int bh = F.vcu >> 2, s = F.vcu & 3;
        sb_attn_unit(F, bh >> 3, bh & 7, 7 - s);
        sb_attn_unit(F, bh >> 3, bh & 7, s);
    } else {
        for (int u = F.vcu; u < 512; u += F.G) sb_attn_unit(F, u >> 6, (u >> 3) & 7, u & 7);
    }
}

__device__ __forceinline__ void p8_router(Frame& F) {
    const float* x2 = (const float*)(F.ws + WS_X2); const float* wr = (const float*)(F.ws + WS_WR); const float* b_router = F.in[15];
    float* rstd3 = (float*)(F.ws + WS_RSTD3); int* ltok = (int*)(F.ws + WS_LTOK); float* lgate = (float*)(F.ws + WS_LGATE); unsigned* cnt = F.ctl + CW_CNT;
    LAS float* wl = (LAS float*)(F.lds + RING_OFF);
    for (int i = F.tid; i < D * NE / 4; i += NWAVES * 64) ((LAS f32x4*)wl)[i] = ((const f32x4*)wr)[i];
    __syncthreads();
    const int lane = F.lane, tk = lane & 15, kq = lane >> 4;
    const int gw = F.vcu * NWAVES + F.wave, NGW = F.G * NWAVES;
    for (int item = gw; item < M / 16; item += NGW) {
        const int tok = item * 16 + tk; const float* xr = x2 + (size_t)tok * D + 4 * kq;
        f32x4 acc0 = {0.f, 0.f, 0.f, 0.f}, acc1 = {0.f, 0.f, 0.f, 0.f}; float ss = 0.f;
#pragma unroll 4
        for (int s = 0; s < 64; ++s) {
            const f32x4 xv = *(const f32x4*)(xr + 16 * s); ss += (xv[0] * xv[0] + xv[1] * xv[1]) + (xv[2] * xv[2] + xv[3] * xv[3]);
#pragma unroll
            for (int j = 0; j < 4; ++j) { const LAS float* wp = wl + (16 * s + 4 * kq + j) * 32 + tk;
                acc0 = __builtin_amdgcn_mfma_f32_16x16x4f32(wp[0], xv[j], acc0, 0, 0, 0); acc1 = __builtin_amdgcn_mfma_f32_16x16x4f32(wp[16], xv[j], acc1, 0, 0, 0); }
        }
        ss += __shfl_xor(ss, 16); ss += __shfl_xor(ss, 32);
        const float rstd = __builtin_amdgcn_rsqf(ss * (1.f / D) + EPS);
        if (kq == 0) rstd3[tok] = rstd;
        float lg[32];
#pragma unroll
        for (int q = 0; q < 4; ++q)
#pragma unroll
            for (int j = 0; j < 4; ++j) { const int src = tk + 16 * q; lg[4 * q + j] = __shfl(acc0[j], src) * rstd + b_router[4 * q + j]; lg[16 + 4 * q + j] = __shfl(acc1[j], src) * rstd + b_router[16 + 4 * q + j]; }
        float tv[4]; int ti[4]; unsigned used = 0u;
#pragma unroll
        for (int k = 0; k < 4; ++k) { float bv = -INFINITY; int bi = 0;
#pragma unroll
            for (int e = 0; e < 32; ++e) { const bool ok = !((used >> e) & 1u) && lg[e] > bv; bv = ok ? lg[e] : bv; bi = ok ? e : bi; }
            tv[k] = bv; ti[k] = bi; used |= 1u << bi; }
        const float e1 = __expf(tv[1] - tv[0]), e2 = __expf(tv[2] - tv[0]), e3 = __expf(tv[3] - tv[0]); const float inv = 1.0f / (1.0f + e1 + e2 + e3);
        const int myE = kq == 0 ? ti[0] : kq == 1 ? ti[1] : kq == 2 ? ti[2] : ti[3];
        const float myG = (kq == 0 ? 1.0f : kq == 1 ? e1 : kq == 2 ? e2 : e3) * inv;
        int rank = 0, mycount = 0;
#pragma unroll 1
        for (int e = 0; e < NE; ++e) { const unsigned long long mk = __ballot(myE == e); const int pc = __popcll(mk);
            if (myE == e) rank = __popcll(mk & ((1ull << lane) - 1ull)); if (lane == e) mycount = pc; }
        unsigned base = 0u; if (lane < NE && mycount > 0) base = atomicAdd(cnt + 64 * lane, (unsigned)mycount);
        const unsigned mybase = (unsigned)__shfl((int)base, myE);
        const size_t pos = (size_t)myE * LISTCAP + mybase + rank;
        ltok[pos] = tok * 4 + kq; lgate[pos] = myG;
    }
}

__device__ __forceinline__ void p11_final(Frame& F) {
    const float* x2 = (const float*)(F.ws + WS_X2); const bf16_t* y = (const bf16_t*)(F.ws + WS_Y); const float* g_final = F.in[20]; float* out = F.out;
    const int gw = F.vcu * NWAVES + F.wave, NGW = F.G * NWAVES, lane = F.lane;
    for (int m = gw; m < M; m += NGW) {
        f32x4 v[4]; float ss = 0.f;
#pragma unroll
        for (int j = 0; j < 2; ++j) { const int c = 8 * lane + 512 * j; v[2 * j] = *(const f32x4*)(x2 + (size_t)m * D + c); v[2 * j + 1] = *(const f32x4*)(x2 + (size_t)m * D + c + 4);
#pragma unroll
            for (int s = 0; s < 4; ++s) { const u32x4 w = *(const u32x4*)(y + ((size_t)m * 4 + s) * D + c);
                v[2 * j][0] += bf_lo(w.x); v[2 * j][1] += bf_hi(w.x); v[2 * j][2] += bf_lo(w.y); v[2 * j][3] += bf_hi(w.y);
                v[2 * j + 1][0] += bf_lo(w.z); v[2 * j + 1][1] += bf_hi(w.z); v[2 * j + 1][2] += bf_lo(w.w); v[2 * j + 1][3] += bf_hi(w.w); } }
#pragma unroll
        for (int i = 0; i < 4; ++i) ss += (v[i][0] * v[i][0] + v[i][1] * v[i][1]) + (v[i][2] * v[i][2] + v[i][3] * v[i][3]);
        const float rstd = __builtin_amdgcn_rsqf(wave_sum(ss) * (1.f / D) + EPS);
#pragma unroll
        for (int j = 0; j < 2; ++j) { const int c = 8 * lane + 512 * j; const f32x4 g0 = *(const f32x4*)(g_final + c), g1 = *(const f32x4*)(g_final + c + 4);
            *(f32x4*)(out + (size_t)m * D + c) = v[2 * j] * rstd * g0; *(f32x4*)(out + (size_t)m * D + c + 4) = v[2 * j + 1] * rstd * g1; }
    }
}

constexpr int NPHASE = 12;
struct Args { const float* in[21]; float* out; unsigned char* ws; int ph_lo, ph_hi; };
static_assert(sizeof(Args) == 21 * 8 + 8 + 8 + 8, "Args has no padding");

__global__ void __launch_bounds__(NWAVES * 64, 2) fwd(Args args) {
    extern __shared__ __attribute__((aligned(16))) unsigned char lds[];
    Frame F;
    F.lds = (LAS unsigned char*)lds; F.MISC = (volatile LAS unsigned*)(F.lds + MISC_OFF);
    F.tid = threadIdx.x; F.lane = F.tid & 63; F.wave = __builtin_amdgcn_readfirstlane(F.tid >> 6);
    F.G = gridDim.x; { const int bx = blockIdx.x; F.vcu = (F.G % 8 == 0) ? (bx % 8) * (F.G / 8) + bx / 8 : bx; }
    F.ws = args.ws; F.ctl = (unsigned*)(args.ws + WS_CTL); F.out = args.out;
    F.in = args.in;
    for (int u = F.tid; u < (LDS_BYTES - LDSCTL_OFF) / 4; u += NWAVES * 64) ((LAS unsigned*)(F.lds + LDSCTL_OFF))[u] = 0u;
    __syncthreads();
    const int lo = args.ph_lo, hi = args.ph_hi;
    const bool single = (hi - lo) > 1;
    XcdBarrier bar; bar.bar = F.ctl + CW_BAR; bar.x = 0; bar.st = nullptr;
    if (single) bar = xcd_barrier_post(F.ctl + CW_BAR, F.MISC + 8);
#ifndef PH_MASK
#define PH_MASK 0xFFF
#endif
#define IN(k) (((PH_MASK >> (k)) & 1) && lo <= (k) && (k) < hi)
#define SEAM(k) do { if (IN(k) && IN((k) + 1)) xcd_barrier(bar); } while (0)
    unsigned char* ws = args.ws;
    const int bx = (int)blockIdx.x;

    if (IN(0)) { p0_prologue(F); }
    if (IN(0) && IN(1)) { cg::this_grid().sync(); }
    if (IN(1)) {
        pg8::OrderP1 S; S.init(ws + WS_XN, ws + WS_WIN_T, ws + WS_MEMN, ws + WS_WKV_T, F.G, bx);
        pg8::EpiP1 E{(bf16_t*)(ws + WS_PROJ), (bf16_t*)(ws + WS_KMEM), (bf16_t*)(ws + WS_VT)};
        pg8::gemm_phase<pg8::EpiP1, pg8::OrderP1, false, true, true>(F.lds + RING_OFF, D, D, D, S, E);
    }
    SEAM(1);
    if (IN(2)) { p2_mix(F); }
    SEAM(2);
    if (IN(3)) {
        pg8::OrderPlain S; S.init(ws + WS_YMIX, ws + WS_WOUT_T, D, D, M / 256, D / 256, F.G, bx);
        pg8::EpiRes E{F.in[0], (float*)(ws + WS_X1), (bf16_t*)(ws + WS_X1B), (float*)(ws + WS_SS1)};
        pg8::gemm_phase<pg8::EpiRes, pg8::OrderPlain, false, true, true>(F.lds + RING_OFF, D, D, D, S, E);
    }
    SEAM(3);
    if (IN(4)) {
        pg8::OrderPlain S; S.init(ws + WS_X1B, ws + WS_WQ_T, D, D, M / 256, D / 256, F.G, bx);
        pg8::EpiQm E{(bf16_t*)(ws + WS_QM), (const float*)(ws + WS_SS1)};
        pg8::gemm_phase<pg8::EpiQm, pg8::OrderPlain, false, true, true>(F.lds + RING_OFF, D, D, D, S, E);
    }
    SEAM(4);
    if (IN(5)) {
        if (F.G == 256) {
            pg8::OrderX<0> S; S.init(ws + WS_QM, ws + WS_KMEM, F.G, bx);
            pg8::EpiSoftmax E{(bf16_t*)(ws + WS_PB)};
            pg8::gemm_phase<pg8::EpiSoftmax, pg8::OrderX<0>, false, false, true>(F.lds + RING_OFF, D, D, XHD, S, E);
        }
    }
    SEAM(5);
    if (IN(6)) {
        pg8::OrderX<1> S; S.init(ws + WS_PB, ws + WS_VT, F.G, bx);
        pg8::EpiO E{(bf16_t*)(ws + WS_OB)};
        pg8::gemm_phase<pg8::EpiO, pg8::OrderX<1>, false, true, true>(F.lds + RING_OFF, D, MROWS, MEMLEN, S, E);
    }
    SEAM(6);
    if (IN(7)) {
        pg8::OrderPlain S; S.init(ws + WS_OB, ws + WS_WO_T, D, D, M / 256, D / 256, F.G, bx);
        pg8::EpiRes E{(const float*)(ws + WS_X1), (float*)(ws + WS_X2), (bf16_t*)(ws + WS_X2B), (float*)(ws + WS_SS2)};
        pg8::gemm_phase<pg8::EpiRes, pg8::OrderPlain, false, true, true>(F.lds + RING_OFF, D, D, D, S, E);
    }
    SEAM(7);
    if (IN(8)) { p8_router(F); }
    SEAM(8);
    if (IN(9)) {
        pg8::OrderMoe<8, true> S; S.init(F.ctl + CW_CNT, (const int*)(ws + WS_LTOK), ws + WS_X2B, ws + WS_W1_T, F.G, bx);
        pg8::EpiAct E{(bf16_t*)(ws + WS_ACT), (const float*)(ws + WS_RSTD3), F.in[17]};
        pg8::gemm_phase<pg8::EpiAct, pg8::OrderMoe<8, true>, true, true, true>(F.lds + RING_OFF, D, D, D, S, E);
    }
    SEAM(9);
    if (IN(10)) {
        pg8::OrderMoe<4, false> S; S.init(F.ctl + CW_CNT, (const int*)(ws + WS_LTOK), ws + WS_ACT, ws + WS_W2_T, F.G, bx);
        pg8::EpiY E{(bf16_t*)(ws + WS_Y), (const float*)(ws + WS_LGATE), F.in[19]};
        pg8::gemm_phase<pg8::EpiY, pg8::OrderMoe<4, false>, false, true, true>(F.lds + RING_OFF, DEXP, DEXP, DEXP, S, E);
    }
    SEAM(10);
    if (IN(11)) { p11_final(F); }
#undef IN
#undef SEAM
}

extern "C" void kernel_launch(void* const* d_in, const int* in_sizes, int n_in, void* d_out, int out_size, void* d_ws, size_t ws_size, hipStream_t stream) {
    static int grid = 0;
    if (grid == 0) {
        if (n_in != 21 || in_sizes[0] != M * D || out_size != M * D || ws_size < WS_END) { fprintf(stderr, "kernel_launch: unexpected shapes (n_in %d, in0 %d, out %d, ws %zu)\n", n_in, n_in > 0 ? in_sizes[0] : -1, out_size, ws_size); grid = -1; return; }
        int dev = 0, cus = 0, per_cu = 0;
        if (hipGetDevice(&dev) != hipSuccess || hipDeviceGetAttribute(&cus, hipDeviceAttributeMultiprocessorCount, dev) != hipSuccess) { grid = -1; return; }
        if (hipFuncSetAttribute((const void*)fwd, hipFuncAttributeMaxDynamicSharedMemorySize, LDS_BYTES) != hipSuccess) { fprintf(stderr, "kernel_launch: hipFuncSetAttribute failed\n"); grid = -1; return; }
        if (hipOccupancyMaxActiveBlocksPerMultiprocessor(&per_cu, (const void*)fwd, NWAVES * 64, LDS_BYTES) != hipSuccess || per_cu < 1) { fprintf(stderr, "kernel_launch: occupancy query says %d\n", per_cu); per_cu = 1; }
        (void)hipGetLastError();
        grid = cus;
    }
    if (grid < 0) return;
    (void)hipMemsetAsync((char*)d_ws + WS_CTL, 0, CTL_ZERO_BYTES, stream);
    Args a{};
    for (int i = 0; i < 21; ++i) a.in[i] = (const float*)d_in[i];
    a.out = (float*)d_out; a.ws = (unsigned char*)d_ws;
    if (MK_N_LAUNCHES == 1) {
        a.ph_lo = 0; a.ph_hi = NPHASE;
        void* kargs[] = {&a};
        hipError_t e = hipLaunchCooperativeKernel((const void*)fwd, dim3(grid), dim3(NWAVES * 64), kargs, LDS_BYTES, stream);
        if (e != hipSuccess) fprintf(stderr, "kernel_launch: cooperative launch failed: %s\n", hipGetErrorString(e));
    } else {
        for (int p = 0; p < NPHASE; ++p) { a.ph_lo = p; a.ph_hi = p + 1; hipLaunchKernelGGL(fwd, dim3(grid), dim3(NWAVES * 64), LDS_BYTES, stream, a); }
    }
}
```

```cpp
#include <hip/hip_runtime.h>
#include <hip/hip_cooperative_groups.h>
#include <cstdio>
#include <cstdint>
namespace cg = cooperative_groups;

#ifndef MK_N_LAUNCHES
#define MK_N_LAUNCHES 1
#endif
#ifndef DUP_MASK
#define DUP_MASK 0
#endif
#define NREP(k) (((DUP_MASK >> (k)) & 1) ? 2 : 1)

constexpr int D = 1024, BATCH = 8, SEQ = 2048, M = BATCH * SEQ, MEMLEN = 256, MROWS = BATCH * MEMLEN;
constexpr int NPROJ = 3072, NE = 32, TOPK = 4, DEXP = 1024;
constexpr int XH = 4, XHD = 256;
constexpr float EPS = 1e-5f;
constexpr float LOG2E = 1.4426950408889634f;
constexpr float C2Q = 0.125f * LOG2E;
constexpr float C2X = 0.0625f * LOG2E;
constexpr int LISTCAP = M;
constexpr int ACT_ROWS = M * TOPK + NE * 256;

#define GAS __attribute__((address_space(1)))
#define LAS __attribute__((address_space(3)))
typedef unsigned short bf16_t;
typedef short bf16x8 __attribute__((ext_vector_type(8)));
typedef short s16x4 __attribute__((ext_vector_type(4)));
typedef float f32x4 __attribute__((ext_vector_type(4)));
typedef float f32x2 __attribute__((ext_vector_type(2)));
typedef float f32x16 __attribute__((ext_vector_type(16)));
typedef unsigned u32x4 __attribute__((ext_vector_type(4)));
typedef unsigned u32x2 __attribute__((ext_vector_type(2)));
typedef GAS unsigned gu32;

constexpr size_t MiB = 1u << 20;
constexpr size_t WS_CTL = 0, CTL_ZERO_BYTES = 1 * MiB;
constexpr size_t WS_WIN_T = 2 * MiB, WS_WOUT_T = 8 * MiB, WS_WQ_T = 10 * MiB, WS_WKV_T = 12 * MiB, WS_WO_T = 16 * MiB, WS_WR = 18 * MiB;
constexpr size_t WS_MEMN = 19 * MiB, WS_KMEM = 23 * MiB, WS_VT = 27 * MiB, WS_SS1 = 31 * MiB, WS_SS2 = 32 * MiB, WS_RSTD3 = 33 * MiB, WS_LTOK = 34 * MiB, WS_LGATE = 36 * MiB, WS_LRSTD = 38 * MiB;
constexpr size_t WS_W1_T = 40 * MiB, WS_W2_T = 168 * MiB;
constexpr size_t WS_XN = 232 * MiB, WS_PROJ = 264 * MiB, WS_YMIX = 360 * MiB;
constexpr size_t WS_X1 = 392 * MiB, WS_X1B = 456 * MiB, WS_QM = 488 * MiB, WS_PB = 520 * MiB, WS_OB = 552 * MiB, WS_X2 = 584 * MiB, WS_X2B = 648 * MiB;
constexpr size_t WS_ACT = 232 * MiB;
constexpr size_t WS_Y = 392 * MiB;
constexpr size_t WS_END = 680 * MiB;
static_assert(WS_ACT + (size_t)ACT_ROWS * DEXP * 2 <= WS_X1 && WS_Y + (size_t)M * TOPK * D * 2 <= WS_PB, "overlays");
constexpr int CW_TMO = 0, CW_CODE = 1, CW_BAR = 4096, CW_CNT = 8192;

__device__ __forceinline__ unsigned cvt_pk_bf16(float lo, float hi) { unsigned r; asm volatile("v_cvt_pk_bf16_f32 %0, %1, %2" : "=v"(r) : "v"(lo), "v"(hi)); return r; }
__device__ __forceinline__ unsigned cvtpk_s(float lo, float hi) { typedef __bf16 bf16x2_t __attribute__((ext_vector_type(2))); f32x2 v = {lo, hi}; bf16x2_t b = __builtin_convertvector(v, bf16x2_t); return __builtin_bit_cast(unsigned, b); }
__device__ __forceinline__ float bf_lo(unsigned w) { return __uint_as_float(w << 16); }
__device__ __forceinline__ float bf_hi(unsigned w) { return __uint_as_float(w & 0xffff0000u); }
__device__ __forceinline__ float wave_sum(float v) {
#pragma unroll
    for (int o = 1; o < 64; o <<= 1) v += __shfl_xor(v, o);
    return v;
}
#define LDS_WAIT() asm volatile("s_waitcnt lgkmcnt(0)" ::: "memory")
#define VM_WAIT() asm volatile("s_waitcnt vmcnt(0)" ::: "memory")

namespace pg8 {
constexpr int BM = 256, BK = 64, HALF = 128, HTB = HALF * BK * 2, STAGE_BYTES = 8 * HTB, NXCD = 8, WGM = 8;
__host__ __device__ __forceinline__ int lds_byte(int r, int c) { const int st = (r >> 4) * 2 + (c >> 5), rr = r & 15, cc = c & 31, ob = rr * 64 + cc * 2; return st * 1024 + (ob ^ (((ob >> 9) & 1) << 5)); }
__host__ __device__ __forceinline__ void stage_rc(int b, int& R, int& C) { const int st = b / 1024, sb = b % 1024, swz = sb ^ (((sb >> 9) & 1) << 5); R = (st >> 1) * 16 + swz / 64; C = (st & 1) * 32 + (swz % 64) / 2; }
__host__ __device__ __forceinline__ int perm32(int rho) { const int n = rho >> 4, i = rho & 15; return 8 * (i >> 2) + 4 * n + (i & 3); }

struct Unit { const char* a; const char* b; int pm, pn; };
struct UnitK { const char* a; const char* b; int pm, pn, kind; };
struct UnitM { const char* a; const char* b; const int* tok; int pm, pn, nvalid, e, rowoff; };

struct GridOrder {
    int nM, nN, nwg;
    __device__ __forceinline__ void init(int nM_, int nN_) { nM = nM_; nN = nN_; nwg = nM * nN; }
    __device__ __forceinline__ void map(int L, int& pm, int& pn) const {
        int wgid = L; { const int q = nwg / NXCD, r = nwg % NXCD, xcd = wgid % NXCD, off = wgid / NXCD; wgid = (xcd < r ? xcd * (q + 1) : r * (q + 1) + (xcd - r) * q) + off; }
        const int nig = WGM * nN, gid = wgid / nig, fm = gid * WGM, gsz = (nM - fm) < WGM ? (nM - fm) : WGM;
        pm = fm + ((wgid % nig) % gsz); pn = (wgid % nig) / gsz;
    }
};

typedef f32x4 Acc[2][2][4][2];

template <class Epi, class Sched, bool GATHER, bool ALIGN_EPI, bool SP2>
__device__ __forceinline__ void gemm_phase(LAS unsigned char* lds, const int lda, const int ldb, const int K, const Sched& S, const Epi& E) {
    const int tid = threadIdx.x, wid = __builtin_amdgcn_readfirstlane(tid >> 6), lane = tid & 63, wr = wid >> 2, wc = wid & 3, fr = lane & 15, fq = lane >> 4;
    int nt = K / BK; asm volatile("" : "+s"(nt));
    int RA[2], CA[2]; unsigned voffB[2];
#pragma unroll
    for (int i = 0; i < 2; ++i) { int R, C; stage_rc(tid * 16 + i * 8192, R, C); const int Rb = Epi::PERM ? ((R & ~31) + perm32(R & 31)) : R;
        RA[i] = R; CA[i] = C; voffB[i] = (unsigned)(Rb * ldb + C) * 2u; }
    const size_t kstep = (size_t)(BK * 2);
    const size_t hstepB = (size_t)HALF * ldb * 2;
    const unsigned ldsw = (unsigned)wid * 1024u;
    const int aoff = lds_byte(wr * 64 + fr, fq * 8), boff = lds_byte(wc * 32 + fr, fq * 8);
#define PG8_SA(b, h) (((b) * 2 + (h)) * HTB)
#define PG8_SB(b, h) ((4 + (b) * 2 + (h)) * HTB)
#define PG8_STAGE(bufoff, gbase, voff) do { _Pragma("unroll") for (int _i = 0; _i < 2; ++_i) \
        __builtin_amdgcn_global_load_lds((const unsigned*)((const char*)(gbase) + (voff)[_i]), (LAS unsigned*)(lds + (bufoff) + ldsw + _i * 8192), 16, 0, 0); } while (0)
#define PG8_LDA(dst, b, h) do { _Pragma("unroll") for (int m = 0; m < 4; ++m) _Pragma("unroll") for (int k = 0; k < 2; ++k) dst[m][k] = *(const LAS bf16x8*)(lds + PG8_SA(b, h) + aoff + m * 2048 + k * 1024); } while (0)
#define PG8_LDB(dst, b, h) do { _Pragma("unroll") for (int n = 0; n < 2; ++n) _Pragma("unroll") for (int k = 0; k < 2; ++k) dst[n][k] = *(const LAS bf16x8*)(lds + PG8_SB(b, h) + boff + n * 2048 + k * 1024); } while (0)
#define PG8_MMA(ai, bj, At, Bt) do { __builtin_amdgcn_s_setprio(1); _Pragma("unroll") for (int m = 0; m < 4; ++m) _Pragma("unroll") for (int n = 0; n < 2; ++n) _Pragma("unroll") for (int k = 0; k < 2; ++k) \
        acc[ai][bj][m][n] = __builtin_amdgcn_mfma_f32_16x16x32_bf16(Bt[n][k], At[m][k], acc[ai][bj][m][n], 0, 0, 0); __builtin_amdgcn_s_setprio(0); } while (0)
#define PG8_WAIT_V(n) asm volatile("s_waitcnt vmcnt(" #n ")" ::: "memory")
#define PG8_WAIT_L(n) asm volatile("s_waitcnt lgkmcnt(" #n ")" ::: "memory")
#define PG8_BAR __builtin_amdgcn_s_barrier()
#define PG8_SCHED __builtin_amdgcn_sched_barrier(0)
#define PG8_VOFFA(dst, u) do { if constexpr (GATHER) { int _t[2][2]; _Pragma("unroll") for (int _h = 0; _h < 2; ++_h) _Pragma("unroll") for (int _i = 0; _i < 2; ++_i) _t[_h][_i] = (u).tok[_h * HALF + RA[_i]]; \
        _Pragma("unroll") for (int _h = 0; _h < 2; ++_h) _Pragma("unroll") for (int _i = 0; _i < 2; ++_i) { const int _row = _h * HALF + RA[_i]; const int _tt = (_row < (u).nvalid) ? (_t[_h][_i] >> 2) : 0; dst[_h][_i] = (unsigned)(_tt * lda + CA[_i]) * 2u; } } \
        else { _Pragma("unroll") for (int _h = 0; _h < 2; ++_h) _Pragma("unroll") for (int _i = 0; _i < 2; ++_i) dst[_h][_i] = (unsigned)((_h * HALF + RA[_i]) * lda + CA[_i]) * 2u; } } while (0)
#define PG8_VOFFA_LDS(dst, u, slot) do { const LAS int* _mt = (const LAS int*)(lds + 131072 + (slot) * 3072 + 1024); _Pragma("unroll") for (int _h = 0; _h < 2; ++_h) _Pragma("unroll") for (int _i = 0; _i < 2; ++_i) { \
        const int _row = _h * HALF + RA[_i]; const int _tt = (_row < (u).nvalid) ? (_mt[_row] >> 2) : 0; dst[_h][_i] = (unsigned)(_tt * lda + CA[_i]) * 2u; } } while (0)
    typename Sched::U cur, nxt; int ui = 0;
    if (!S.next(0, cur)) return;
    Acc acc;
#pragma unroll
    for (int a = 0; a < 2; ++a)
#pragma unroll
        for (int b = 0; b < 2; ++b)
#pragma unroll
            for (int m = 0; m < 4; ++m)
#pragma unroll
                for (int n = 0; n < 2; ++n) acc[a][b][m][n] = (f32x4){0.f, 0.f, 0.f, 0.f};
    bf16x8 At[4][2], B0[2][2], B1[2][2];
    unsigned vA[2][2];
    PG8_VOFFA(vA, cur);
    const char* cA = cur.a; const char* cB = cur.b;
    E.prefetch(cur, 0, lds, wid, lane);
    if constexpr (SP2) {
        PG8_STAGE(PG8_SB(0, 0), cB, voffB); PG8_STAGE(PG8_SB(0, 1), cB + hstepB, voffB); PG8_STAGE(PG8_SA(0, 0), cA, vA[0]); PG8_STAGE(PG8_SA(0, 1), cA, vA[1]);
        if (wr == 1) PG8_BAR;
        PG8_WAIT_V(2); PG8_BAR;
        PG8_STAGE(PG8_SB(1, 0), cB + kstep, voffB); PG8_STAGE(PG8_SA(1, 0), cA + kstep, vA[0]); PG8_STAGE(PG8_SB(1, 1), cB + hstepB + kstep, voffB);
        PG8_WAIT_V(6); PG8_BAR;
    } else {
        PG8_STAGE(PG8_SB(0, 0), cB, voffB); PG8_STAGE(PG8_SA(0, 0), cA, vA[0]); PG8_STAGE(PG8_SB(0, 1), cB + hstepB, voffB); PG8_STAGE(PG8_SA(0, 1), cA, vA[1]);
        if (wr == 1) PG8_BAR;
        PG8_WAIT_V(4); PG8_BAR;
        PG8_STAGE(PG8_SB(1, 0), cB + kstep, voffB); PG8_STAGE(PG8_SA(1, 0), cA + kstep, vA[0]); PG8_STAGE(PG8_SB(1, 1), cB + hstepB + kstep, voffB);
        PG8_WAIT_V(6); PG8_BAR;
    }
    for (;;) {
        const bool has_next = S.next(ui + 1, nxt);
        const char* nA = has_next ? nxt.a : cA; const char* nB = has_next ? nxt.b : cB;
        if (has_next) E.prefetch(nxt, ui + 1, lds, wid, lane);
        for (int t = 0; t < nt; t += 2) {
            const bool last = (t == nt - 2);
            const char* a1 = cA + (size_t)(t + 1) * kstep;
            const char* a2 = last ? nA : cA + (size_t)(t + 2) * kstep; const char* b2 = last ? nB : cB + (size_t)(t + 2) * kstep;
            const char* a3 = a2 + kstep; const char* b3 = b2 + kstep;
            if constexpr (SP2) {
            PG8_LDB(B0, 0, 0); PG8_LDB(B1, 0, 1); PG8_SCHED; PG8_LDA(At, 0, 0); PG8_STAGE(PG8_SA(1, 1), a1, vA[1]); if constexpr (GATHER) { if (last && has_next) { PG8_VOFFA_LDS(vA, nxt, (ui + 1) % 3); } }
            PG8_WAIT_V(8); PG8_WAIT_L(0); PG8_BAR; PG8_MMA(0, 0, At, B0); PG8_MMA(0, 1, At, B1); PG8_BAR; PG8_SCHED;
            PG8_LDA(At, 0, 1); PG8_STAGE(PG8_SB(0, 0), b2, voffB); PG8_STAGE(PG8_SB(0, 1), b2 + hstepB, voffB); PG8_STAGE(PG8_SA(0, 0), a2, vA[0]);
            PG8_WAIT_V(8); PG8_WAIT_L(0); PG8_BAR; PG8_MMA(1, 0, At, B0); PG8_MMA(1, 1, At, B1); PG8_BAR; PG8_SCHED;
            PG8_LDB(B0, 1, 0); PG8_LDB(B1, 1, 1); PG8_SCHED; PG8_LDA(At, 1, 0); PG8_STAGE(PG8_SA(0, 1), a2, vA[1]);
            PG8_WAIT_V(8); PG8_WAIT_L(0); PG8_BAR; PG8_MMA(0, 0, At, B0); PG8_MMA(0, 1, At, B1); PG8_BAR; PG8_SCHED;
            PG8_LDA(At, 1, 1); PG8_STAGE(PG8_SB(1, 0), b3, voffB); PG8_STAGE(PG8_SB(1, 1), b3 + hstepB, voffB); PG8_STAGE(PG8_SA(1, 0), a3, vA[0]);
            PG8_WAIT_V(8); PG8_WAIT_L(0); PG8_BAR; PG8_MMA(1, 0, At, B0); PG8_MMA(1, 1, At, B1); PG8_BAR; PG8_SCHED;
            } else {
            PG8_LDB(B0, 0, 0); PG8_SCHED; PG8_LDA(At, 0, 0); PG8_STAGE(PG8_SA(1, 1), a1, vA[1]); if constexpr (GATHER) { if (last && has_next) { PG8_VOFFA_LDS(vA, nxt, (ui + 1) % 3); } }
            PG8_WAIT_L(8); PG8_BAR; PG8_WAIT_L(0); PG8_MMA(0, 0, At, B0); PG8_BAR; PG8_SCHED;
            PG8_LDB(B1, 0, 1); PG8_STAGE(PG8_SB(0, 0), b2, voffB);
            PG8_BAR; PG8_WAIT_L(0); PG8_MMA(0, 1, At, B1); PG8_BAR;
            PG8_LDA(At, 0, 1); PG8_STAGE(PG8_SA(0, 0), a2, vA[0]);
            PG8_BAR; PG8_WAIT_L(0); PG8_MMA(1, 0, At, B0); PG8_BAR; PG8_SCHED;
            PG8_STAGE(PG8_SB(0, 1), b2 + hstepB, voffB);
            PG8_WAIT_V(6); PG8_BAR; PG8_MMA(1, 1, At, B1); PG8_BAR;
            PG8_LDB(B0, 1, 0); PG8_SCHED; PG8_LDA(At, 1, 0); PG8_STAGE(PG8_SA(0, 1), a2, vA[1]);
            PG8_WAIT_L(8); PG8_BAR; PG8_WAIT_L(0); PG8_MMA(0, 0, At, B0); PG8_BAR; PG8_SCHED;
            PG8_LDB(B1, 1, 1); PG8_STAGE(PG8_SB(1, 0), b3, voffB);
            PG8_BAR; PG8_WAIT_L(0); PG8_MMA(0, 1, At, B1); PG8_BAR;
            PG8_LDA(At, 1, 1); PG8_STAGE(PG8_SA(1, 0), a3, vA[0]);
            PG8_BAR; PG8_WAIT_L(0); PG8_MMA(1, 0, At, B0); PG8_BAR; PG8_SCHED;
            PG8_STAGE(PG8_SB(1, 1), b3 + hstepB, voffB);
            PG8_WAIT_V(6); PG8_BAR; PG8_MMA(1, 1, At, B1); PG8_BAR;
            }
        }
        if constexpr (ALIGN_EPI) { if (wr == 0) PG8_BAR; }
        if constexpr (!Epi::AFTER_DRAIN) { E(acc, cur, ui, lds, wr, wc, fr, fq); }
        if (!has_next) break;
#pragma unroll
        for (int a = 0; a < 2; ++a)
#pragma unroll
            for (int b = 0; b < 2; ++b)
#pragma unroll
                for (int m = 0; m < 4; ++m)
#pragma unroll
                    for (int n = 0; n < 2; ++n) acc[a][b][m][n] = (f32x4){0.f, 0.f, 0.f, 0.f};
        cur = nxt; cA = nA; cB = nB; ++ui;
        if constexpr (ALIGN_EPI) { if (wr == 1) PG8_BAR; }
    }
    PG8_WAIT_V(0);
    if constexpr (!ALIGN_EPI) { if (wr == 0) PG8_BAR; }
    PG8_BAR;
    if constexpr (Epi::AFTER_DRAIN) { E.fused(acc, cur, wr, wc, fr, fq, lds, wid, lane); }
#undef PG8_SA
#undef PG8_SB
#undef PG8_STAGE
#undef PG8_LDA
#undef PG8_LDB
#undef PG8_MMA
#undef PG8_WAIT_V
#undef PG8_WAIT_L
#undef PG8_BAR
#undef PG8_SCHED
#undef PG8_VOFFA
#undef PG8_VOFFA_LDS
}

struct OrderP1 {
    typedef UnitK U;
    const char *xn, *win_t, *memn, *wkv_t; int G, c; GridOrder g0;
    __device__ __forceinline__ void init(const void* xn_, const void* win_t_, const void* memn_, const void* wkv_t_, int G_, int c_) {
        xn = (const char*)xn_; win_t = (const char*)win_t_; memn = (const char*)memn_; wkv_t = (const char*)wkv_t_; G = G_; c = c_; g0.init(M / 256, NPROJ / 256); }
    __device__ __forceinline__ bool next(int i, UnitK& u) const {
        const int L = i * G + c;
        if (L < g0.nwg) { g0.map(L, u.pm, u.pn); u.kind = 0; u.a = xn + (size_t)u.pm * 256 * D * 2; u.b = win_t + (size_t)u.pn * 256 * D * 2; return true; }
        int r = L - g0.nwg;
        if (r < 32) { u.kind = 1; u.pm = r >> 2; u.pn = r & 3; u.a = memn + (size_t)u.pm * 256 * D * 2; u.b = wkv_t + (size_t)u.pn * 256 * D * 2; return true; }
        r -= 32;
        if (r < 32) { u.kind = 2; u.pm = r >> 3; u.pn = r & 7; u.a = wkv_t + (size_t)(D + u.pm * 256) * D * 2; u.b = memn + (size_t)u.pn * 256 * D * 2; return true; }
        return false;
    }
};
struct OrderPlain {
    typedef Unit U;
    const char *A, *Bt; int lda, ldb, G, c; GridOrder g0;
    __device__ __forceinline__ void init(const void* A_, const void* Bt_, int lda_, int ldb_, int nM, int nN, int G_, int c_) { A = (const char*)A_; Bt = (const char*)Bt_; lda = lda_; ldb = ldb_; G = G_; c = c_; g0.init(nM, nN); }
    __device__ __forceinline__ bool next(int i, Unit& u) const {
        const int L = i * G + c; if (L >= g0.nwg) return false;
        g0.map(L, u.pm, u.pn);
        u.a = A + (size_t)u.pm * 256 * lda * 2; u.b = Bt + (size_t)u.pn * 256 * ldb * 2; return true;
    }
};
template <int MODE> struct OrderX {
    typedef Unit U;
    const char *A, *Bt; int G, c;
    __device__ __forceinline__ void init(const void* A_, const void* Bt_, int G_, int c_) { A = (const char*)A_; Bt = (const char*)Bt_; G = G_; c = c_; }
    __device__ __forceinline__ bool next(int i, Unit& u) const {
        const int L = i * G + c; if (L >= (M / 256) * XH) return false;
        const int xcd = L & 7, j = L >> 3; u.pm = xcd * 8 + (j >> 2); u.pn = j & 3;
        const int b = u.pm >> 3;
        u.a = A + ((size_t)u.pm * 256 * D + (size_t)u.pn * XHD) * 2;
        if (MODE == 0) u.b = Bt + ((size_t)b * MEMLEN * D + (size_t)u.pn * XHD) * 2;
        else u.b = Bt + ((size_t)u.pn * XHD * MROWS + (size_t)b * MEMLEN) * 2;
        return true;
    }
};
template <int NTN, bool G1> struct OrderMoe {
    typedef UnitM U;
    const int* ltok; const char* A; const char* Bt; int G, c; int seg[4], til[4], cn[4];
    __device__ __forceinline__ void init(const unsigned* cnt, const int* ltok_, const void* A_, const void* Bt_, int G_, int c_) {
        ltok = ltok_; A = (const char*)A_; Bt = (const char*)Bt_; G = G_; c = c_;
        const int lane = threadIdx.x & 63; const int cv = (lane < NE) ? (int)__hip_atomic_load(cnt + 64 * lane, __ATOMIC_RELAXED, __HIP_MEMORY_SCOPE_AGENT) : 0;
        const int t = (cv + 255) >> 8; int incl = t;
#pragma unroll
        for (int o = 1; o < 32; o <<= 1) { const int v = __shfl_up(incl, o); if (lane >= o) incl += v; }
        const int excl = incl - t, xcd = c & 7;
#pragma unroll
        for (int q = 0; q < 4; ++q) { seg[q] = __builtin_amdgcn_readlane(excl, xcd + 8 * q); til[q] = __builtin_amdgcn_readlane(t, xcd + 8 * q); cn[q] = __builtin_amdgcn_readlane(cv, xcd + 8 * q); }
    }
    __device__ __forceinline__ bool next(int i, UnitM& u) const {
        const int xcd = c & 7, slot = c >> 3, nslot = G >> 3; int j = i * nslot + slot;
#pragma unroll
        for (int q = 0; q < 4; ++q) {
            const int nu = til[q] * NTN;
            if (j < nu) { const int e = xcd + 8 * q, mt = j / NTN, nt = j % NTN;
                u.e = e; u.pm = mt; u.pn = nt; u.rowoff = (seg[q] + mt) * 256; u.nvalid = cn[q] - mt * 256 < 256 ? cn[q] - mt * 256 : 256; u.tok = ltok + (size_t)e * LISTCAP + mt * 256;
                if (G1) { u.a = A; u.b = Bt + ((size_t)e * 2048 + (size_t)nt * 256) * D * 2; }
                else { u.a = A + (size_t)u.rowoff * DEXP * 2; u.b = Bt + ((size_t)e * 1024 + (size_t)nt * 256) * DEXP * 2; }
                return true; }
            j -= nu;
        }
        return false;
    }
};

struct EpiP1 {
    static constexpr bool PERM = true, AFTER_DRAIN = false;
    bf16_t *proj, *kmem, *vt;
    __device__ __forceinline__ void prefetch(const UnitK&, int, LAS unsigned char*, int, int) const {}
    __device__ __forceinline__ void operator()(const Acc& acc, const UnitK& u, int, LAS unsigned char*, int wr, int wc, int fr, int fq) const {
        bf16_t* base; int ldc; float sc = 1.f;
        if (u.kind == 0) { base = proj; ldc = NPROJ; if (u.pn >= 6 && u.pn < 8) sc = C2Q; } else if (u.kind == 1) { base = kmem; ldc = D; } else { base = vt; ldc = MROWS; }
        const int row0 = u.pm * BM + wr * 64 + fr, col0 = u.pn * BM + wc * 32 + 8 * fq;
#pragma unroll
        for (int ai = 0; ai < 2; ++ai)
#pragma unroll
            for (int m = 0; m < 4; ++m) { bf16_t* rowp = base + (size_t)(row0 + ai * HALF + m * 16) * ldc + col0;
#pragma unroll
                for (int bj = 0; bj < 2; ++bj) { const f32x4 v0 = acc[ai][bj][m][0] * sc, v1 = acc[ai][bj][m][1] * sc;
                    u32x4 w; w.x = cvt_pk_bf16(v0[0], v0[1]); w.y = cvt_pk_bf16(v0[2], v0[3]); w.z = cvt_pk_bf16(v1[0], v1[1]); w.w = cvt_pk_bf16(v1[2], v1[3]);
                    *(u32x4*)(rowp + bj * HALF) = w; } }
    }
};
struct EpiRes {
    static constexpr bool PERM = false, AFTER_DRAIN = true;
    const float* base; float* xo; bf16_t* xb; float* ss;
    __device__ __forceinline__ void prefetch(const Unit&, int, LAS unsigned char*, int, int) const {}
    __device__ __forceinline__ void fused(Acc& acc, const Unit& u, int wr, int wc, int fr, int fq, LAS unsigned char* lds, int wid, int lane) const {
        LAS float* PSS = (LAS float*)lds;
        const int col0 = u.pn * BM + wc * 32 + 4 * fq;
#pragma unroll
        for (int ai = 0; ai < 2; ++ai)
#pragma unroll
            for (int m = 0; m < 4; ++m) { const int r = ai * HALF + wr * 64 + m * 16 + fr; const size_t off = (size_t)(u.pm * BM + r) * D + col0; float s = 0.f;
#pragma unroll
                for (int bj = 0; bj < 2; ++bj)
#pragma unroll
                    for (int n = 0; n < 2; ++n) { const f32x4 bs = *(const f32x4*)(base + off + bj * HALF + n * 16); const f32x4 o = bs + acc[ai][bj][m][n];
                        *(f32x4*)(xo + off + bj * HALF + n * 16) = o; u32x2 w; w.x = cvt_pk_bf16(o[0], o[1]); w.y = cvt_pk_bf16(o[2], o[3]); *(u32x2*)(xb + off + bj * HALF + n * 16) = w;
                        s += (o[0] * o[0] + o[1] * o[1]) + (o[2] * o[2] + o[3] * o[3]); }
                s += __shfl_xor(s, 16); s += __shfl_xor(s, 32);
                if (fq == 0) PSS[r * 4 + wc] = s; }
        __syncthreads();
        if (threadIdx.x < 256) { const f32x4 p = *(const LAS f32x4*)(PSS + threadIdx.x * 4); ss[(size_t)(u.pm * BM + threadIdx.x) * 4 + u.pn] = (p[0] + p[1]) + (p[2] + p[3]); }
        __syncthreads();
    }
};
__device__ __forceinline__ float rstd_from_ss(const float* ss, int row) {
    const f32x4 a = *(const f32x4*)(ss + (size_t)row * 4);
    return __builtin_amdgcn_rsqf(((a[0] + a[1]) + (a[2] + a[3])) * (1.0f / D) + EPS);
}
struct EpiQm {
    static constexpr bool PERM = true, AFTER_DRAIN = true;
    bf16_t* qm; const float* ss;
    __device__ __forceinline__ void prefetch(const Unit&, int, LAS unsigned char*, int, int) const {}
    __device__ __forceinline__ void fused(Acc& acc, const Unit& u, int wr, int wc, int fr, int fq, LAS unsigned char* lds, int wid, int lane) const {
        const int row0 = u.pm * BM + wr * 64 + fr, col0 = u.pn * BM + wc * 32 + 8 * fq;
        float sc[2][4];
#pragma unroll
        for (int ai = 0; ai < 2; ++ai)
#pragma unroll
            for (int m = 0; m < 4; ++m) sc[ai][m] = rstd_from_ss(ss, row0 + ai * HALF + m * 16) * C2X;
#pragma unroll
        for (int ai = 0; ai < 2; ++ai)
#pragma unroll
            for (int m = 0; m < 4; ++m) { const int row = row0 + ai * HALF + m * 16; bf16_t* rowp = qm + (size_t)row * D + col0;
#pragma unroll
                for (int bj = 0; bj < 2; ++bj) { const f32x4 v0 = acc[ai][bj][m][0] * sc[ai][m], v1 = acc[ai][bj][m][1] * sc[ai][m];
                    u32x4 w; w.x = cvt_pk_bf16(v0[0], v0[1]); w.y = cvt_pk_bf16(v0[2], v0[3]); w.z = cvt_pk_bf16(v1[0], v1[1]); w.w = cvt_pk_bf16(v1[2], v1[3]);
                    *(u32x4*)(rowp + bj * HALF) = w; } }
    }
};
struct EpiSoftmax {
    static constexpr bool PERM = true, AFTER_DRAIN = true;
    bf16_t* pb;
    __device__ __forceinline__ void prefetch(const Unit&, int, LAS unsigned char*, int, int) const {}
    __device__ __forceinline__ void fused(Acc& acc, const Unit& u, int wr, int wc, int fr, int fq, LAS unsigned char* lds, int wid, int lane) const {
        LAS float* PM = (LAS float*)lds;
        LAS float* PS = (LAS float*)(lds + 4096);
#pragma unroll
        for (int ai = 0; ai < 2; ++ai)
#pragma unroll
            for (int m = 0; m < 4; ++m) { float mx = -INFINITY;
#pragma unroll
                for (int bj = 0; bj < 2; ++bj)
#pragma unroll
                    for (int n = 0; n < 2; ++n) { const f32x4 x = acc[ai][bj][m][n]; mx = fmaxf(mx, fmaxf(fmaxf(x[0], x[1]), fmaxf(x[2], x[3]))); }
                mx = fmaxf(mx, __shfl_xor(mx, 16)); mx = fmaxf(mx, __shfl_xor(mx, 32));
                if (fq == 0) PM[(ai * HALF + wr * 64 + m * 16 + fr) * 4 + wc] = mx; }
        __syncthreads();
#pragma unroll
        for (int ai = 0; ai < 2; ++ai)
#pragma unroll
            for (int m = 0; m < 4; ++m) { const int r = ai * HALF + wr * 64 + m * 16 + fr; const f32x4 pm4 = *(const LAS f32x4*)(PM + r * 4);
                const float mx = fmaxf(fmaxf(pm4[0], pm4[1]), fmaxf(pm4[2], pm4[3])); float s = 0.f;
#pragma unroll
                for (int bj = 0; bj < 2; ++bj)
#pragma unroll
                    for (int n = 0; n < 2; ++n) { f32x4 x = acc[ai][bj][m][n];
#pragma unroll
                        for (int j = 0; j < 4; ++j) { x[j] = __builtin_amdgcn_exp2f(x[j] - mx); s += x[j]; }
                        acc[ai][bj][m][n] = x; }
                s += __shfl_xor(s, 16); s += __shfl_xor(s, 32);
                if (fq == 0) PS[r * 4 + wc] = s; }
        __syncthreads();
        const int row0 = u.pm * BM + wr * 64 + fr, col0 = u.pn * XHD + wc * 32 + 8 * fq;
#pragma unroll
        for (int ai = 0; ai < 2; ++ai)
#pragma unroll
            for (int m = 0; m < 4; ++m) { const int r = ai * HALF + wr * 64 + m * 16 + fr; const f32x4 ps4 = *(const LAS f32x4*)(PS + r * 4);
                const float inv = 1.0f / ((ps4[0] + ps4[1]) + (ps4[2] + ps4[3])); bf16_t* rowp = pb + (size_t)(row0 + ai * HALF + m * 16) * D + col0;
#pragma unroll
                for (int bj = 0; bj < 2; ++bj) { const f32x4 v0 = acc[ai][bj][m][0] * inv, v1 = acc[ai][bj][m][1] * inv;
                    u32x4 w; w.x = cvt_pk_bf16(v0[0], v0[1]); w.y = cvt_pk_bf16(v0[2], v0[3]); w.z = cvt_pk_bf16(v1[0], v1[1]); w.w = cvt_pk_bf16(v1[2], v1[3]);
                    *(u32x4*)(rowp + bj * HALF) = w; } }
        __syncthreads();
    }
};
struct EpiO {
    static constexpr bool PERM = true, AFTER_DRAIN = false;
    bf16_t* ob;
    __device__ __forceinline__ void prefetch(const Unit&, int, LAS unsigned char*, int, int) const {}
    __device__ __forceinline__ void operator()(const Acc& acc, const Unit& u, int, LAS unsigned char*, int wr, int wc, int fr, int fq) const {
        const int row0 = u.pm * BM + wr * 64 + fr, col0 = u.pn * BM + wc * 32 + 8 * fq;
#pragma unroll
        for (int ai = 0; ai < 2; ++ai)
#pragma unroll
            for (int m = 0; m < 4; ++m) { bf16_t* rowp = ob + (size_t)(row0 + ai * HALF + m * 16) * D + col0;
#pragma unroll
                for (int bj = 0; bj < 2; ++bj) { const f32x4 v0 = acc[ai][bj][m][0], v1 = acc[ai][bj][m][1];
                    u32x4 w; w.x = cvt_pk_bf16(v0[0], v0[1]); w.y = cvt_pk_bf16(v0[2], v0[3]); w.z = cvt_pk_bf16(v1[0], v1[1]); w.w = cvt_pk_bf16(v1[2], v1[3]);
                    *(u32x4*)(rowp + bj * HALF) = w; } }
    }
};
constexpr int META_OFF = 131072, META_BYTES = 3072;
__device__ __forceinline__ void dma4(const void* g, LAS unsigned char* l) { __builtin_amdgcn_global_load_lds((const unsigned*)g, (LAS unsigned*)l, 4, 0, 0); }
__device__ __forceinline__ void dma16(const void* g, LAS unsigned char* l) { __builtin_amdgcn_global_load_lds((const unsigned*)g, (LAS unsigned*)l, 16, 0, 0); }
struct EpiAct {
    static constexpr bool PERM = true, AFTER_DRAIN = false;
    bf16_t* act; const float* lrstd; const float* b1;
    __device__ __forceinline__ void prefetch(const UnitM& u, int ui, LAS unsigned char* lds, int wid, int lane) const {
        LAS unsigned char* mb = lds + META_OFF + (ui % 3) * META_BYTES;
        if (wid < 4) dma4(lrstd + (size_t)u.e * LISTCAP + u.pm * 256 + wid * 64 + lane, mb + wid * 256);
        else dma4(u.tok + (wid - 4) * 64 + lane, mb + 1024 + (wid - 4) * 256);
        if (wid == 4) dma16(b1 + (size_t)u.e * 2048 + (lane >> 5) * 1024 + u.pn * 128 + (lane & 31) * 4, mb + 2048);
    }
    __device__ __forceinline__ void operator()(const Acc& acc, const UnitM& u, int ui, LAS unsigned char* lds, int wr, int wc, int fr, int fq) const {
        const LAS unsigned char* mb = lds + META_OFF + (ui % 3) * META_BYTES;
        const int cl = wc * 32 + 8 * fq, gcol = u.pn * 128 + cl; const LAS float* bg = (const LAS float*)(mb + 2048) + cl; const LAS float* bl = bg + 128;
        const f32x4 bg0 = *(const LAS f32x4*)bg, bg1 = *(const LAS f32x4*)(bg + 4), bl0 = *(const LAS f32x4*)bl, bl1 = *(const LAS f32x4*)(bl + 4);
#pragma unroll
        for (int ai = 0; ai < 2; ++ai)
#pragma unroll
            for (int m = 0; m < 4; ++m) { const int r = ai * HALF + wr * 64 + m * 16 + fr; const float rs = ((const LAS float*)mb)[r];
                float o[8];
#pragma unroll
                for (int n = 0; n < 2; ++n) { const f32x4 g4 = acc[ai][0][m][n] * rs + (n ? bg1 : bg0), l4 = acc[ai][1][m][n] * rs + (n ? bl1 : bl0);
#pragma unroll
                    for (int j = 0; j < 4; ++j) { const float g = fminf(g4[j], 7.0f), l = fminf(fmaxf(l4[j], -7.0f), 7.0f);
                        const float sg = __builtin_amdgcn_rcpf(1.0f + __builtin_amdgcn_exp2f(g * (-1.702f * LOG2E))); o[n * 4 + j] = g * sg * (l + 1.0f); } }
                u32x4 w; w.x = cvt_pk_bf16(o[0], o[1]); w.y = cvt_pk_bf16(o[2], o[3]); w.z = cvt_pk_bf16(o[4], o[5]); w.w = cvt_pk_bf16(o[6], o[7]);
                *(u32x4*)(act + (size_t)(u.rowoff + r) * DEXP + gcol) = w; }
    }
};
struct EpiY {
    static constexpr bool PERM = true, AFTER_DRAIN = false;
    bf16_t* y; const float* lgate; const int* ltok; const float* b2;
    __device__ __forceinline__ void prefetch(const UnitM& u, int ui, LAS unsigned char* lds, int wid, int lane) const {
        LAS unsigned char* mb = lds + META_OFF + (ui % 3) * META_BYTES;
        const size_t li = (size_t)u.e * LISTCAP + u.pm * 256 + (wid & 3) * 64 + lane;
        if (wid < 4) dma4(lgate + li, mb + wid * 256); else dma4(ltok + li, mb + 1024 + (wid - 4) * 256);
        if (wid == 0) dma16(b2 + (size_t)u.e * D + u.pn * 256 + lane * 4, mb + 2048);
    }
    __device__ __forceinline__ void operator()(const Acc& acc, const UnitM& u, int ui, LAS unsigned char* lds, int wr, int wc, int fr, int fq) const {
        const LAS unsigned char* mb = lds + META_OFF + (ui % 3) * META_BYTES;
        const int cl = wc * 32 + 8 * fq, col0 = u.pn * BM + cl; const LAS float* bb = (const LAS float*)(mb + 2048) + cl;
        f32x4 bv[2][2];
#pragma unroll
        for (int bj = 0; bj < 2; ++bj)
#pragma unroll
            for (int n = 0; n < 2; ++n) bv[bj][n] = *(const LAS f32x4*)(bb + bj * HALF + 4 * n);
#pragma unroll
        for (int ai = 0; ai < 2; ++ai)
#pragma unroll
            for (int m = 0; m < 4; ++m) { const int r = ai * HALF + wr * 64 + m * 16 + fr;
                if (r < u.nvalid) { const int ent = ((const LAS int*)(mb + 1024))[r]; const float gw = ((const LAS float*)mb)[r]; bf16_t* rowp = y + (size_t)ent * D + col0;
#pragma unroll
                    for (int bj = 0; bj < 2; ++bj) { const f32x4 v0 = (acc[ai][bj][m][0] + bv[bj][0]) * gw, v1 = (acc[ai][bj][m][1] + bv[bj][1]) * gw;
                        u32x4 w; w.x = cvt_pk_bf16(v0[0], v0[1]); w.y = cvt_pk_bf16(v0[2], v0[3]); w.z = cvt_pk_bf16(v1[0], v1[1]); w.w = cvt_pk_bf16(v1[2], v1[3]);
                        *(u32x4*)(rowp + bj * HALF) = w; } } }
    }
};
}

#define XB_TMO      128
#define XB_XCNT(j)  (256  + 64 * (j))
#define XB_XSUB(j)  (1280 + 64 * (j))
#define XB_XGEN(j)  (2304 + 64 * (j))
#define XB_TOP      3328
#define XB_TOPGEN   3392
#define XCD_BAR_WORDS 3456
#define XB_SPIN_CAP (1u << 18)
__device__ __forceinline__ unsigned xb_ld(unsigned* p)              { return __hip_atomic_load(p, __ATOMIC_RELAXED, __HIP_MEMORY_SCOPE_AGENT); }
__device__ __forceinline__ unsigned xb_add(unsigned* p, unsigned v) { return __hip_atomic_fetch_add(p, v, __ATOMIC_RELAXED, __HIP_MEMORY_SCOPE_AGENT); }
__device__ __forceinline__ unsigned xb_xcc_id() { return (unsigned)__builtin_amdgcn_s_getreg((3 << 11) | 20) & 0xFu; }
#define XB_SPIN(cond, bar) do { unsigned _sp = 0; while (cond) { __builtin_amdgcn_s_sleep(1); \
    if ((++_sp & 255u) == 0u) { if (xb_ld(&(bar)[XB_TMO])) break; if (_sp > XB_SPIN_CAP) { atomicAdd(&(bar)[XB_TMO], 1u); break; } } } } while (0)
struct XcdBarrier { unsigned* bar; unsigned x; volatile LAS unsigned* st; };
__device__ __forceinline__ XcdBarrier xcd_barrier_post(unsigned* bar, volatile LAS unsigned* st) {
    XcdBarrier b; b.bar = bar; b.x = xb_xcc_id(); b.st = st;
    if (threadIdx.x == 0) (void)xb_add(&bar[XB_XCNT(b.x)], 1u);
    return b;
}
__device__ __forceinline__ void xcd_barrier_complete(unsigned* bar, unsigned x, unsigned& nloc, unsigned& nx) {
    const unsigned G = gridDim.x * gridDim.y * gridDim.z;
    unsigned sum, cnt, mine, sp = 0u;
    for (;;) {
        sum = 0u; cnt = 0u; mine = 0u;
#pragma unroll
        for (unsigned j = 0; j < 16; ++j) { const unsigned c = xb_ld(&bar[XB_XCNT(j)]); sum += c; cnt += (c > 0u) ? 1u : 0u; mine = (j == x) ? c : mine; }
        if (sum == G) break;
        __builtin_amdgcn_s_sleep(1);
        if ((++sp & 255u) == 0u) { if (xb_ld(&bar[XB_TMO])) break; if (sp > XB_SPIN_CAP) { atomicAdd(&bar[XB_TMO], 1u); break; } }
    }
    nloc = mine > 0u ? mine : 1u; nx = cnt > 0u ? cnt : 1u;
}
__device__ __forceinline__ void xcd_barrier(const XcdBarrier& b) {
    asm volatile("s_waitcnt vmcnt(0)" ::: "memory");
    __syncthreads();
    if (threadIdx.x == 0) {
        unsigned* bar = b.bar;
        __builtin_amdgcn_s_waitcnt(0);
        unsigned nloc = b.st[0], nx = b.st[1];
        if (nloc == 0u) { xcd_barrier_complete(bar, b.x, nloc, nx); b.st[0] = nloc; b.st[1] = nx; }
        const unsigned old = xb_add(&bar[XB_XSUB(b.x)], 1u);
        const unsigned gen = old / nloc;
        if (old + 1u == (gen + 1u) * nloc) {
            __builtin_amdgcn_fence(__ATOMIC_RELEASE, "agent");
            asm volatile("s_waitcnt vmcnt(0)" ::: "memory");
            const unsigned og = xb_add(&bar[XB_TOP], 1u);
            const unsigned tg = og / nx;
            if (og + 1u == (tg + 1u) * nx) xb_add(&bar[XB_TOPGEN], 1u);
            else XB_SPIN(xb_ld(&bar[XB_TOPGEN]) == tg, bar);
            __builtin_amdgcn_fence(__ATOMIC_ACQUIRE, "agent");
            xb_add(&bar[XB_XGEN(b.x)], 1u);
            asm volatile("s_waitcnt vmcnt(0)" ::: "memory");
        } else {
            XB_SPIN(xb_ld(&bar[XB_XGEN(b.x)]) == gen, bar);
            __builtin_amdgcn_fence(__ATOMIC_ACQUIRE, "agent");
            asm volatile("s_waitcnt vmcnt(0)" ::: "memory");
        }
    }
    __syncthreads();
}

constexpr int NWAVES = 8;
constexpr int RING_OFF = 0, RING_BYTES = 131072;
constexpr int LDSCTL_OFF = RING_BYTES + 12288, MISC_OFF = LDSCTL_OFF + 320;
constexpr int LDS_BYTES = 147456;
static_assert(MISC_OFF + 128 <= LDS_BYTES, "LDS map");

struct Frame {
    LAS unsigned char* lds; volatile LAS unsigned* MISC; unsigned* ctl; unsigned char* ws;
    int tid, lane, wave, vcu, G;
    const float* const* in; float* out;
};

template <int NMAP> __device__ __forceinline__ int nmap(int n) {
    if (NMAP == 0) return n;
    return n < 1024 ? (n >> 7) * 256 + (n & 127) : ((n - 1024) >> 7) * 256 + 128 + ((n - 1024) & 127);
}
template <int NMAP> __device__ __forceinline__ void transpose_item(const float* W, int ldw, int K, bf16_t* WT, const float* g, LAS unsigned* scr, int k0, int n0, int lane) {
    const int nq = lane & 15, kp = lane >> 4;
    f32x4 va[8], vb[8];
#pragma unroll
    for (int it = 0; it < 8; ++it) { const int k = k0 + 2 * (kp + 4 * it); va[it] = *(const f32x4*)(W + (size_t)k * ldw + n0 + 4 * nq); vb[it] = *(const f32x4*)(W + (size_t)(k + 1) * ldw + n0 + 4 * nq); }
#pragma unroll
    for (int it = 0; it < 8; ++it) { const int kk2 = kp + 4 * it; f32x4 a = va[it], b = vb[it];
        if (g) { const float g0 = g[k0 + 2 * kk2], g1 = g[k0 + 2 * kk2 + 1]; a = a * g0; b = b * g1; }
#pragma unroll
        for (int j = 0; j < 4; ++j) scr[(4 * nq + j) * 33 + kk2] = cvtpk_s(a[j], b[j]); }
    LDS_WAIT(); asm volatile("" ::: "memory");
    const int c = lane & 7;
#pragma unroll
    for (int it = 0; it < 8; ++it) { const int n = (lane >> 3) + 8 * it; const LAS unsigned* s = scr + n * 33 + 4 * c;
        u32x4 o; o.x = s[0]; o.y = s[1]; o.z = s[2]; o.w = s[3];
        *(u32x4*)(WT + (size_t)nmap<NMAP>(n0 + n) * K + k0 + 8 * c) = o; }
    LDS_WAIT(); asm volatile("" ::: "memory");
}
__device__ __forceinline__ void rms_row_to_bf16(const float* xrow, const float* g, bf16_t* orow, int lane) {
    const f32x4* xr = (const f32x4*)xrow + lane; const f32x4* gr = (const f32x4*)g + lane;
    f32x4 v[4]; float s = 0.f;
#pragma unroll
    for (int j = 0; j < 4; ++j) { v[j] = xr[64 * j]; s += (v[j][0] * v[j][0] + v[j][1] * v[j][1]) + (v[j][2] * v[j][2] + v[j][3] * v[j][3]); }
    const float rstd = __builtin_amdgcn_rsqf(wave_sum(s) * (1.f / D) + EPS);
    u32x2* o8 = (u32x2*)orow + lane;
#pragma unroll
    for (int j = 0; j < 4; ++j) { const f32x4 gg = gr[64 * j]; u32x2 w; w.x = cvtpk_s(v[j][0] * rstd * gg[0], v[j][1] * rstd * gg[1]); w.y = cvtpk_s(v[j][2] * rstd * gg[2], v[j][3] * rstd * gg[3]); o8[64 * j] = w; }
}
__device__ __forceinline__ void p0_prologue(Frame& F) {
    LAS unsigned* scr = (LAS unsigned*)(F.lds + RING_OFF + F.wave * 16384);
    const int gw = F.vcu * NWAVES + F.wave, NGW = F.G * NWAVES;
    const float *x = F.in[0], *mem = F.in[1], *g_mix = F.in[2], *w_in = F.in[3], *w_out = F.in[7], *g_xattn = F.in[8], *g_mem = F.in[9], *w_q = F.in[10], *w_kv = F.in[11], *w_o = F.in[12], *g_moe = F.in[13],
                *w_router = F.in[14], *w1 = F.in[16], *w2 = F.in[18];
    bf16_t *win_t = (bf16_t*)(F.ws + WS_WIN_T), *wout_t = (bf16_t*)(F.ws + WS_WOUT_T), *wq_t = (bf16_t*)(F.ws + WS_WQ_T), *wkv_t = (bf16_t*)(F.ws + WS_WKV_T), *wo_t = (bf16_t*)(F.ws + WS_WO_T),
           *w1_t = (bf16_t*)(F.ws + WS_W1_T), *w2_t = (bf16_t*)(F.ws + WS_W2_T), *xn = (bf16_t*)(F.ws + WS_XN), *memn = (bf16_t*)(F.ws + WS_MEMN);
    float* wr = (float*)(F.ws + WS_WR);
    for (int m = gw; m < M; m += NGW) rms_row_to_bf16(x + (size_t)m * D, g_mix, xn + (size_t)m * D, F.lane);
    for (int m = gw; m < MROWS; m += NGW) rms_row_to_bf16(mem + (size_t)m * D, g_mem, memn + (size_t)m * D, F.lane);
    for (int i = gw * 64 + F.lane; i < D * NE; i += NGW * 64) wr[i] = w_router[i] * g_moe[i >> 5];
    constexpr int I_IN = 16 * 48, I_OUT = 16 * 16, I_Q = 16 * 16, I_KV = 16 * 32, I_O = 16 * 16, I_1 = NE * 16 * 32, I_2 = NE * 16 * 16;
    constexpr int NITEMS = I_IN + I_OUT + I_Q + I_KV + I_O + I_1 + I_2;
    for (int it = gw; it < NITEMS; it += NGW) {
        int r = it;
        if (r < I_IN) { transpose_item<0>(w_in, NPROJ, D, win_t, nullptr, scr, (r / 48) * 64, (r % 48) * 64, F.lane); continue; } r -= I_IN;
        if (r < I_OUT) { transpose_item<0>(w_out, D, D, wout_t, nullptr, scr, (r / 16) * 64, (r % 16) * 64, F.lane); continue; } r -= I_OUT;
        if (r < I_Q) { transpose_item<0>(w_q, D, D, wq_t, g_xattn, scr, (r / 16) * 64, (r % 16) * 64, F.lane); continue; } r -= I_Q;
        if (r < I_KV) { transpose_item<0>(w_kv, 2 * D, D, wkv_t, nullptr, scr, (r / 32) * 64, (r % 32) * 64, F.lane); continue; } r -= I_KV;
        if (r < I_O) { transpose_item<0>(w_o, D, D, wo_t, nullptr, scr, (r / 16) * 64, (r % 16) * 64, F.lane); continue; } r -= I_O;
        if (r < I_1) { const int e = r / 512, q = r % 512; transpose_item<1>(w1 + (size_t)e * D * 2048, 2048, D, w1_t + (size_t)e * 2048 * D, g_moe, scr, (q / 32) * 64, (q % 32) * 64, F.lane); continue; } r -= I_1;
        { const int e = r / 256, q = r % 256; transpose_item<0>(w2 + (size_t)e * DEXP * D, D, DEXP, w2_t + (size_t)e * D * DEXP, nullptr, scr, (q / 16) * 64, (q % 16) * 64, F.lane); }
    }
}

__device__ __forceinline__ void conv_rows(Frame& F) {
    const bf16_t* proj = (const bf16_t*)(F.ws + WS_PROJ); bf16_t* ymix = (bf16_t*)(F.ws + WS_YMIX);
    const float* conv_w = F.in[4]; const float* g_conv = F.in[5];
    const int gw = F.vcu * NWAVES + F.wave, NGW = F.G * NWAVES, c0 = 8 * F.lane;
    float w0[8], w1[8], w2[8], gg[8];
#pragma unroll
    for (int j = 0; j < 8; ++j) { w0[j] = conv_w[c0 + j]; w1[j] = conv_w[512 + c0 + j]; w2[j] = conv_w[1024 + c0 + j]; gg[j] = g_conv[c0 + j]; }
    for (int m = gw; m < M; m += NGW) {
        const int t = m & (SEQ - 1); const bf16_t* row = proj + (size_t)m * NPROJ + c0;
        const u32x4 bg = *(const u32x4*)row, cg0 = *(const u32x4*)(row + 512), xv0 = *(const u32x4*)(row + 1024);
        u32x4 cg1 = {0, 0, 0, 0}, xv1 = {0, 0, 0, 0}, cg2 = {0, 0, 0, 0}, xv2 = {0, 0, 0, 0};
        if (t >= 1) { cg1 = *(const u32x4*)(row - NPROJ + 512); xv1 = *(const u32x4*)(row - NPROJ + 1024); }
        if (t >= 2) { cg2 = *(const u32x4*)(row - 2 * NPROJ + 512); xv2 = *(const u32x4*)(row - 2 * NPROJ + 1024); }
        float y[8]; float ss = 0.f;
#pragma unroll
        for (int j = 0; j < 4; ++j) {
            const float u0l = bf_lo(cg0[j]) * bf_lo(xv0[j]), u0h = bf_hi(cg0[j]) * bf_hi(xv0[j]);
            const float u1l = bf_lo(cg1[j]) * bf_lo(xv1[j]), u1h = bf_hi(cg1[j]) * bf_hi(xv1[j]);
            const float u2l = bf_lo(cg2[j]) * bf_lo(xv2[j]), u2h = bf_hi(cg2[j]) * bf_hi(xv2[j]);
            y[2 * j] = bf_lo(bg[j]) * (w0[2 * j] * u2l + w1[2 * j] * u1l + w2[2 * j] * u0l);
            y[2 * j + 1] = bf_hi(bg[j]) * (w0[2 * j + 1] * u2h + w1[2 * j + 1] * u1h + w2[2 * j + 1] * u0h);
            ss += y[2 * j] * y[2 * j] + y[2 * j + 1] * y[2 * j + 1];
        }
        ss += __shfl_xor(ss, 1); ss += __shfl_xor(ss, 2); ss += __shfl_xor(ss, 4);
        const float rstd = __builtin_amdgcn_rsqf(ss * (1.f / 64.f) + EPS);
        u32x4 o; o.x = cvtpk_s(y[0] * rstd * gg[0], y[1] * rstd * gg[1]); o.y = cvtpk_s(y[2] * rstd * gg[2], y[3] * rstd * gg[3]);
        o.z = cvtpk_s(y[4] * rstd * gg[4], y[5] * rstd * gg[5]); o.w = cvtpk_s(y[6] * rstd * gg[6], y[7] * rstd * gg[7]);
        *(u32x4*)(ymix + (size_t)m * D + c0) = o;
    }
}
constexpr int SB_K = 0, SB_V = 8192, SB_OST = 16384, SB_OSTW = 32 * 68 * 4;
static_assert(SB_OST + 8 * SB_OSTW <= RING_BYTES, "attention LDS");
__device__ __forceinline__ int crow(int r, int hi) { return (r & 3) + 8 * (r >> 2) + 4 * hi; }
__device__ __forceinline__ void sb_attn_unit(Frame& F, int b, int h, int qb) {
    const bf16_t* proj = (const bf16_t*)(F.ws + WS_PROJ); bf16_t* ymix = (bf16_t*)(F.ws + WS_YMIX); const float* g_sb = F.in[6];
    const int tid = F.tid, lane = F.lane, wid = F.wave, r32 = lane & 31, hi = lane >> 5;
    LAS unsigned char* lds = F.lds + RING_OFF;
    const int q0 = qb * 256, qlo = q0 + wid * 32, qpos = qlo + r32;
    const size_t rowbase = (size_t)b * SEQ;
    const bf16_t* Qp = proj + (rowbase + qlo) * NPROJ + 1536 + h * 64;
    const bf16_t* Kp = proj + rowbase * NPROJ + 2048 + h * 64;
    const bf16_t* Vp = proj + rowbase * NPROJ + 2560 + h * 64;
    bf16x8 qr[4];
#pragma unroll
    for (int s = 0; s < 4; ++s) qr[s] = *(const bf16x8*)(Qp + (size_t)r32 * NPROJ + 16 * s + 8 * hi);
    bf16x8 ntri[2], nones;
#pragma unroll
    for (int s = 0; s < 2; ++s)
#pragma unroll
        for (int j = 0; j < 8; ++j) { const int k = 16 * s + 8 * (j >> 2) + 4 * hi + (j & 3); ntri[s][j] = (k > r32) ? (short)0xBF80 : (short)0; }
#pragma unroll
    for (int j = 0; j < 8; ++j) nones[j] = (short)0xBF80;
    f32x16 R = {}; f32x16 o[2]; o[0] = f32x16{}; o[1] = f32x16{};
    const int skey = tid >> 3, sc = tid & 7;
    const int koff = SB_K + skey * 128 + ((sc ^ ((skey >> 1) & 7)) << 4);
    const int voff = SB_V + (sc >> 2) * 4096 + (skey >> 4) * 1024 + (skey & 15) * 64 + (sc & 3) * 16;
    const int vb = SB_V + ((lane >> 4) & 1) * 32 + (lane & 3) * 8 + (4 * hi + ((lane & 15) >> 2)) * 64;
    int kbi = 4 * qb + 3;
    u32x4 kreg = *(const u32x4*)(Kp + (size_t)(kbi * 64 + skey) * NPROJ + sc * 8), vreg = *(const u32x4*)(Vp + (size_t)(kbi * 64 + skey) * NPROJ + sc * 8);
    for (; kbi >= 0; --kbi) {
        const int k0 = kbi * 64;
        __syncthreads();
        *(LAS u32x4*)(lds + koff) = kreg; *(LAS u32x4*)(lds + voff) = vreg;
        __syncthreads();
        if (kbi > 0) { kreg = *(const u32x4*)(Kp + (size_t)(k0 - 64 + skey) * NPROJ + sc * 8); vreg = *(const u32x4*)(Vp + (size_t)(k0 - 64 + skey) * NPROJ + sc * 8); }
        if (k0 < qlo + 31) {
            f32x16 p0 = {}, p1 = {};
#pragma unroll
            for (int s = 0; s < 4; ++s) { const int c = 2 * s + hi;
                const bf16x8 ka = *(const LAS bf16x8*)(lds + SB_K + r32 * 128 + ((c ^ ((r32 >> 1) & 7)) << 4));
                const bf16x8 kb = *(const LAS bf16x8*)(lds + SB_K + (r32 + 32) * 128 + ((c ^ (((r32 + 32) >> 1) & 7)) << 4));
                p0 = __builtin_amdgcn_mfma_f32_32x32x16_bf16(ka, qr[s], p0, 0, 0, 0); p1 = __builtin_amdgcn_mfma_f32_32x32x16_bf16(kb, qr[s], p1, 0, 0, 0); }
            const bool diag = (k0 + 63 >= qlo);
            f32x16 s0, s1;
#pragma unroll
            for (int r = 0; r < 16; ++r) {
                const float z0 = p0[r], z1 = p1[r];
                float sp0 = fmaxf(z0, 0.f) + __builtin_amdgcn_logf(1.0f + __builtin_amdgcn_exp2f(-fabsf(z0)));
                float sp1 = fmaxf(z1, 0.f) + __builtin_amdgcn_logf(1.0f + __builtin_amdgcn_exp2f(-fabsf(z1)));
                if (diag) { const int key = k0 + crow(r, hi); if (key >= qpos) sp0 = 0.f; if (key + 32 >= qpos) sp1 = 0.f; }
                s0[r] = sp0; s1[r] = sp1; p0[r] = z0 - sp0; p1[r] = z1 - sp1;
            }
            u32x4 w00 = {cvtpk_s(s0[0], s0[1]), cvtpk_s(s0[2], s0[3]), cvtpk_s(s0[4], s0[5]), cvtpk_s(s0[6], s0[7])}, w01 = {cvtpk_s(s0[8], s0[9]), cvtpk_s(s0[10], s0[11]), cvtpk_s(s0[12], s0[13]), cvtpk_s(s0[14], s0[15])};
            u32x4 w10 = {cvtpk_s(s1[0], s1[1]), cvtpk_s(s1[2], s1[3]), cvtpk_s(s1[4], s1[5]), cvtpk_s(s1[6], s1[7])}, w11 = {cvtpk_s(s1[8], s1[9]), cvtpk_s(s1[10], s1[11]), cvtpk_s(s1[12], s1[13]), cvtpk_s(s1[14], s1[15])};
            const bf16x8 sb00 = __builtin_bit_cast(bf16x8, w00), sb01 = __builtin_bit_cast(bf16x8, w01), sb10 = __builtin_bit_cast(bf16x8, w10), sb11 = __builtin_bit_cast(bf16x8, w11);
            f32x16 rest1 = __builtin_amdgcn_mfma_f32_32x32x16_bf16(ntri[0], sb10, R, 0, 0, 0); rest1 = __builtin_amdgcn_mfma_f32_32x32x16_bf16(ntri[1], sb11, rest1, 0, 0, 0);
            f32x16 U = __builtin_amdgcn_mfma_f32_32x32x16_bf16(nones, sb10, R, 0, 0, 0); U = __builtin_amdgcn_mfma_f32_32x32x16_bf16(nones, sb11, U, 0, 0, 0);
            f32x16 rest0 = __builtin_amdgcn_mfma_f32_32x32x16_bf16(ntri[0], sb00, U, 0, 0, 0); rest0 = __builtin_amdgcn_mfma_f32_32x32x16_bf16(ntri[1], sb01, rest0, 0, 0, 0);
            R = __builtin_amdgcn_mfma_f32_32x32x16_bf16(nones, sb00, U, 0, 0, 0); R = __builtin_amdgcn_mfma_f32_32x32x16_bf16(nones, sb01, R, 0, 0, 0);
#pragma unroll
            for (int r = 0; r < 16; ++r) {
                float a0 = __builtin_amdgcn_exp2f(p0[r] + rest0[r]), a1 = __builtin_amdgcn_exp2f(p1[r] + rest1[r]);
                if (diag) { const int key = k0 + crow(r, hi); if (key >= qpos) a0 = 0.f; if (key + 32 >= qpos) a1 = 0.f; }
                p0[r] = a0; p1[r] = a1;
            }
            u32x4 a00 = {cvtpk_s(p0[0], p0[1]), cvtpk_s(p0[2], p0[3]), cvtpk_s(p0[4], p0[5]), cvtpk_s(p0[6], p0[7])}, a01 = {cvtpk_s(p0[8], p0[9]), cvtpk_s(p0[10], p0[11]), cvtpk_s(p0[12], p0[13]), cvtpk_s(p0[14], p0[15])};
            u32x4 a10 = {cvtpk_s(p1[0], p1[1]), cvtpk_s(p1[2], p1[3]), cvtpk_s(p1[4], p1[5]), cvtpk_s(p1[6], p1[7])}, a11 = {cvtpk_s(p1[8], p1[9]), cvtpk_s(p1[10], p1[11]), cvtpk_s(p1[12], p1[13]), cvtpk_s(p1[14], p1[15])};
            const bf16x8 pa[4] = {__builtin_bit_cast(bf16x8, a00), __builtin_bit_cast(bf16x8, a01), __builtin_bit_cast(bf16x8, a10), __builtin_bit_cast(bf16x8, a11)};
#pragma unroll
            for (int d0 = 0; d0 < 2; ++d0)
#pragma unroll
                for (int ks = 0; ks < 4; ++ks) {
                    const s16x4 lo = __builtin_bit_cast(s16x4, __builtin_amdgcn_ds_read_tr16_b64_v4i16((LAS s16x4*)(lds + vb + d0 * 4096 + ks * 1024)));
                    const s16x4 hh = __builtin_bit_cast(s16x4, __builtin_amdgcn_ds_read_tr16_b64_v4i16((LAS s16x4*)(lds + vb + d0 * 4096 + ks * 1024 + 512)));
                    const bf16x8 vf = {lo[0], lo[1], lo[2], lo[3], hh[0], hh[1], hh[2], hh[3]};
                    o[d0] = __builtin_amdgcn_mfma_f32_32x32x16_bf16(pa[ks], vf, o[d0], 0, 0, 0);
                }
        }
    }
    LAS float* stg = (LAS float*)(lds + SB_OST + wid * SB_OSTW);
#pragma unroll
    for (int r = 0; r < 16; ++r) { const int q = crow(r, hi); stg[q * 68 + r32] = o[0][r]; stg[q * 68 + 32 + r32] = o[1][r]; }
    LDS_WAIT(); asm volatile("" ::: "memory");
    { const int q = lane >> 1, half = lane & 1; const LAS f32x4* sp = (const LAS f32x4*)(stg + q * 68 + 32 * half);
      f32x4 v[8]; float ss = 0.f;
#pragma unroll
      for (int i = 0; i < 8; ++i) { v[i] = sp[i]; ss += (v[i][0] * v[i][0] + v[i][1] * v[i][1]) + (v[i][2] * v[i][2] + v[i][3] * v[i][3]); }
      ss += __shfl_xor(ss, 1);
      const float rstd = __builtin_amdgcn_rsqf(ss * (1.f / 64.f) + EPS);
      const f32x4* gp = (const f32x4*)(g_sb + h * 64 + 32 * half);
      bf16_t* op = ymix + (rowbase + qlo + q) * D + 512 + h * 64 + 32 * half;
#pragma unroll
      for (int i = 0; i < 4; ++i) { const f32x4 g0 = gp[2 * i], g1 = gp[2 * i + 1], a = v[2 * i] * rstd * g0, c = v[2 * i + 1] * rstd * g1;
          u32x4 w; w.x = cvtpk_s(a[0], a[1]); w.y = cvtpk_s(a[2], a[3]); w.z = cvtpk_s(c[0], c[1]); w.w = cvtpk_s(c[2], c[3]); *(u32x4*)(op + 8 * i) = w; } }
    LDS_WAIT();
}
__device__ __forceinline__ void p2_mix(Frame& F) {
    conv_rows(F);
    if (F.G == 256) {
        const int bh = F.vcu >> 2, s = F.vcu & 3;
        sb_attn_unit(F, bh >> 3, bh & 7, 7 - s);
        sb_attn_unit(F, bh >> 3, bh & 7, s);
    } else {
        for (int u = F.vcu; u < 512; u += F.G) sb_attn_unit(F, u >> 6, (u >> 3) & 7, u & 7);
    }
}

__device__ __forceinline__ void p8_router(Frame& F) {
    const float* x2 = (const float*)(F.ws + WS_X2); const float* wr = (const float*)(F.ws + WS_WR); const float* b_router = F.in[15];
    float* lrstd = (float*)(F.ws + WS_LRSTD); int* ltok = (int*)(F.ws + WS_LTOK); float* lgate = (float*)(F.ws + WS_LGATE); unsigned* cnt = F.ctl + CW_CNT;
    LAS float* wl = (LAS float*)(F.lds + RING_OFF);
    for (int i = F.tid; i < D * NE / 4; i += NWAVES * 64) ((LAS f32x4*)wl)[i] = ((const f32x4*)wr)[i];
    __syncthreads();
    const int lane = F.lane, tk = lane & 15, kq = lane >> 4;
    const int gw = F.vcu * NWAVES + F.wave, NGW = F.G * NWAVES;
    for (int item = gw; item < M / 16; item += NGW) {
        const int tok = item * 16 + tk; const float* xr = x2 + (size_t)tok * D + 4 * kq;
        f32x4 acc0 = {0.f, 0.f, 0.f, 0.f}, acc1 = {0.f, 0.f, 0.f, 0.f}; float ss = 0.f;
#pragma unroll 4
        for (int s = 0; s < 64; ++s) {
            const f32x4 xv = *(const f32x4*)(xr + 16 * s); ss += (xv[0] * xv[0] + xv[1] * xv[1]) + (xv[2] * xv[2] + xv[3] * xv[3]);
#pragma unroll
            for (int j = 0; j < 4; ++j) { const LAS float* wp = wl + (16 * s + 4 * kq + j) * 32 + tk;
                acc0 = __builtin_amdgcn_mfma_f32_16x16x4f32(wp[0], xv[j], acc0, 0, 0, 0); acc1 = __builtin_amdgcn_mfma_f32_16x16x4f32(wp[16], xv[j], acc1, 0, 0, 0); }
        }
        ss += __shfl_xor(ss, 16); ss += __shfl_xor(ss, 32);
        const float rstd = __builtin_amdgcn_rsqf(ss * (1.f / D) + EPS);
        float lg[32];
#pragma unroll
        for (int q = 0; q < 4; ++q)
#pragma unroll
            for (int j = 0; j < 4; ++j) { const int src = tk + 16 * q; lg[4 * q + j] = __shfl(acc0[j], src) * rstd + b_router[4 * q + j]; lg[16 + 4 * q + j] = __shfl(acc1[j], src) * rstd + b_router[16 + 4 * q + j]; }
        float tv[4]; int ti[4]; unsigned used = 0u;
#pragma unroll
        for (int k = 0; k < 4; ++k) { float bv = -INFINITY; int bi = 0;
#pragma unroll
            for (int e = 0; e < 32; ++e) { const bool ok = !((used >> e) & 1u) && lg[e] > bv; bv = ok ? lg[e] : bv; bi = ok ? e : bi; }
            tv[k] = bv; ti[k] = bi; used |= 1u << bi; }
        const float e1 = __expf(tv[1] - tv[0]), e2 = __expf(tv[2] - tv[0]), e3 = __expf(tv[3] - tv[0]); const float inv = 1.0f / (1.0f + e1 + e2 + e3);
        const int myE = kq == 0 ? ti[0] : kq == 1 ? ti[1] : kq == 2 ? ti[2] : ti[3];
        const float myG = (kq == 0 ? 1.0f : kq == 1 ? e1 : kq == 2 ? e2 : e3) * inv;
        int rank = 0, mycount = 0;
#pragma unroll 1
        for (int e = 0; e < NE; ++e) { const unsigned long long mk = __ballot(myE == e); const int pc = __popcll(mk);
            if (myE == e) rank = __popcll(mk & ((1ull << lane) - 1ull)); if (lane == e) mycount = pc; }
        unsigned base = 0u; if (lane < NE && mycount > 0) base = atomicAdd(cnt + 64 * lane, (unsigned)mycount);
        const unsigned mybase = (unsigned)__shfl((int)base, myE);
        const size_t pos = (size_t)myE * LISTCAP + mybase + rank;
        ltok[pos] = tok * 4 + kq; lgate[pos] = myG; lrstd[pos] = rstd;
    }
}

__device__ __forceinline__ void p11_final(Frame& F) {
    const float* x2 = (const float*)(F.ws + WS_X2); const bf16_t* y = (const bf16_t*)(F.ws + WS_Y); const float* g_final = F.in[20]; float* out = F.out;
    const int gw = F.vcu * NWAVES + F.wave, NGW = F.G * NWAVES, lane = F.lane;
    for (int m = gw; m < M; m += NGW) {
        f32x4 v[4]; float ss = 0.f;
#pragma unroll
        for (int j = 0; j < 2; ++j) { const int c = 8 * lane + 512 * j; v[2 * j] = *(const f32x4*)(x2 + (size_t)m * D + c); v[2 * j + 1] = *(const f32x4*)(x2 + (size_t)m * D + c + 4);
#pragma unroll
            for (int s = 0; s < 4; ++s) { const u32x4 w = *(const u32x4*)(y + ((size_t)m * 4 + s) * D + c);
                v[2 * j][0] += bf_lo(w.x); v[2 * j][1] += bf_hi(w.x); v[2 * j][2] += bf_lo(w.y); v[2 * j][3] += bf_hi(w.y);
                v[2 * j + 1][0] += bf_lo(w.z); v[2 * j + 1][1] += bf_hi(w.z); v[2 * j + 1][2] += bf_lo(w.w); v[2 * j + 1][3] += bf_hi(w.w); } }
#pragma unroll
        for (int i = 0; i < 4; ++i) ss += (v[i][0] * v[i][0] + v[i][1] * v[i][1]) + (v[i][2] * v[i][2] + v[i][3] * v[i][3]);
        const float rstd = __builtin_amdgcn_rsqf(wave_sum(ss) * (1.f / D) + EPS);
#pragma unroll
        for (int j = 0; j < 2; ++j) { const int c = 8 * lane + 512 * j; const f32x4 g0 = *(const f32x4*)(g_final + c), g1 = *(const f32x4*)(g_final + c + 4);
            *(f32x4*)(out + (size_t)m * D + c) = v[2 * j] * rstd * g0; *(f32x4*)(out + (size_t)m * D + c + 4) = v[2 * j + 1] * rstd * g1; }
    }
}

constexpr int NPHASE = 12;
struct Args { const float* in[21]; float* out; unsigned char* ws; int ph_lo, ph_hi; };
static_assert(sizeof(Args) == 21 * 8 + 8 + 8 + 8, "Args has no padding");

__global__ void __launch_bounds__(NWAVES * 64, 2) fwd(Args args) {
    extern __shared__ __attribute__((aligned(16))) unsigned char lds[];
    Frame F;
    F.lds = (LAS unsigned char*)lds; F.MISC = (volatile LAS unsigned*)(F.lds + MISC_OFF);
    F.tid = threadIdx.x; F.lane = F.tid & 63; F.wave = __builtin_amdgcn_readfirstlane(F.tid >> 6);
    F.G = gridDim.x; { const int bx = blockIdx.x; F.vcu = (F.G % 8 == 0) ? (bx % 8) * (F.G / 8) + bx / 8 : bx; }
    F.ws = args.ws; F.ctl = (unsigned*)(args.ws + WS_CTL); F.out = args.out;
    F.in = args.in;
    for (int u = F.tid; u < (LDS_BYTES - LDSCTL_OFF) / 4; u += NWAVES * 64) ((LAS unsigned*)(F.lds + LDSCTL_OFF))[u] = 0u;
    __syncthreads();
    const int lo = args.ph_lo, hi = args.ph_hi;
    const bool single = (hi - lo) > 1;
    XcdBarrier bar; bar.bar = F.ctl + CW_BAR; bar.x = 0; bar.st = nullptr;
    if (single) bar = xcd_barrier_post(F.ctl + CW_BAR, F.MISC + 8);
#ifndef PH_MASK
#define PH_MASK 0xFFF
#endif
#define IN(k) (((PH_MASK >> (k)) & 1) && lo <= (k) && (k) < hi)
#define SEAM(k) do { if (IN(k) && IN((k) + 1)) xcd_barrier(bar); } while (0)
    unsigned char* ws = args.ws;
    const int bx = (int)blockIdx.x;

    if (IN(0)) { p0_prologue(F); }
    if (IN(0) && IN(1)) { cg::this_grid().sync(); }
    if (IN(1)) {
        pg8::OrderP1 S; S.init(ws + WS_XN, ws + WS_WIN_T, ws + WS_MEMN, ws + WS_WKV_T, F.G, bx);
        pg8::EpiP1 E{(bf16_t*)(ws + WS_PROJ), (bf16_t*)(ws + WS_KMEM), (bf16_t*)(ws + WS_VT)};
        pg8::gemm_phase<pg8::EpiP1, pg8::OrderP1, false, true, true>(F.lds + RING_OFF, D, D, D, S, E);
    }
    SEAM(1);
    if (IN(2)) { p2_mix(F); }
    SEAM(2);
    if (IN(3)) {
        pg8::OrderPlain S; S.init(ws + WS_YMIX, ws + WS_WOUT_T, D, D, M / 256, D / 256, F.G, bx);
        pg8::EpiRes E{F.in[0], (float*)(ws + WS_X1), (bf16_t*)(ws + WS_X1B), (float*)(ws + WS_SS1)};
        pg8::gemm_phase<pg8::EpiRes, pg8::OrderPlain, false, false, true>(F.lds + RING_OFF, D, D, D, S, E);
    }
    SEAM(3);
    if (IN(4)) {
        pg8::OrderPlain S; S.init(ws + WS_X1B, ws + WS_WQ_T, D, D, M / 256, D / 256, F.G, bx);
        pg8::EpiQm E{(bf16_t*)(ws + WS_QM), (const float*)(ws + WS_SS1)};
        pg8::gemm_phase<pg8::EpiQm, pg8::OrderPlain, false, false, true>(F.lds + RING_OFF, D, D, D, S, E);
    }
    SEAM(4);
    if (IN(5)) {
        if (F.G == 256) {
            pg8::OrderX<0> S; S.init(ws + WS_QM, ws + WS_KMEM, F.G, bx);
            pg8::EpiSoftmax E{(bf16_t*)(ws + WS_PB)};
            pg8::gemm_phase<pg8::EpiSoftmax, pg8::OrderX<0>, false, false, true>(F.lds + RING_OFF, D, D, XHD, S, E);
        }
    }
    SEAM(5);
    if (IN(6)) {
        pg8::OrderX<1> S; S.init(ws + WS_PB, ws + WS_VT, F.G, bx);
        pg8::EpiO E{(bf16_t*)(ws + WS_OB)};
        pg8::gemm_phase<pg8::EpiO, pg8::OrderX<1>, false, true, true>(F.lds + RING_OFF, D, MROWS, MEMLEN, S, E);
    }
    SEAM(6);
    if (IN(7)) {
        pg8::OrderPlain S; S.init(ws + WS_OB, ws + WS_WO_T, D, D, M / 256, D / 256, F.G, bx);
        pg8::EpiRes E{(const float*)(ws + WS_X1), (float*)(ws + WS_X2), (bf16_t*)(ws + WS_X2B), (float*)(ws + WS_SS2)};
        pg8::gemm_phase<pg8::EpiRes, pg8::OrderPlain, false, false, true>(F.lds + RING_OFF, D, D, D, S, E);
    }
    SEAM(7);
    if (IN(8)) { p8_router(F); }
    SEAM(8);
    if (IN(9)) {
        pg8::OrderMoe<8, true> S; S.init(F.ctl + CW_CNT, (const int*)(ws + WS_LTOK), ws + WS_X2B, ws + WS_W1_T, F.G, bx);
        pg8::EpiAct E{(bf16_t*)(ws + WS_ACT), (const float*)(ws + WS_LRSTD), F.in[17]};
        pg8::gemm_phase<pg8::EpiAct, pg8::OrderMoe<8, true>, true, true, true>(F.lds + RING_OFF, D, D, D, S, E);
    }
    SEAM(9);
    if (IN(10)) {
        pg8::OrderMoe<4, false> S; S.init(F.ctl + CW_CNT, (const int*)(ws + WS_LTOK), ws + WS_ACT, ws + WS_W2_T, F.G, bx);
        pg8::EpiY E{(bf16_t*)(ws + WS_Y), (const float*)(ws + WS_LGATE), (const int*)(ws + WS_LTOK), F.in[19]};
        pg8::gemm_phase<pg8::EpiY, pg8::OrderMoe<4, false>, false, true, true>(F.lds + RING_OFF, DEXP, DEXP, DEXP, S, E);
    }
    SEAM(10);
    if (IN(11)) { p11_final(F); }
#undef IN
#undef SEAM
}

extern "C" void kernel_launch(void* const* d_in, const int* in_sizes, int n_in, void* d_out, int out_size, void* d_ws, size_t ws_size, hipStream_t stream) {
    static int grid = 0;
    if (grid == 0) {
        if (n_in != 21 || in_sizes[0] != M * D || out_size != M * D || ws_size < WS_END) { fprintf(stderr, "kernel_launch: unexpected shapes (n_in %d, in0 %d, out %d, ws %zu)\n", n_in, n_in > 0 ? in_sizes[0] : -1, out_size, ws_size); grid = -1; return; }
        int dev = 0, cus = 0, per_cu = 0;
        if (hipGetDevice(&dev) != hipSuccess || hipDeviceGetAttribute(&cus, hipDeviceAttributeMultiprocessorCount, dev) != hipSuccess) { grid = -1; return; }
        if (hipFuncSetAttribute((const void*)fwd, hipFuncAttributeMaxDynamicSharedMemorySize, LDS_BYTES) != hipSuccess) { fprintf(stderr, "kernel_launch: hipFuncSetAttribute failed\n"); grid = -1; return; }
        if (hipOccupancyMaxActiveBlocksPerMultiprocessor(&per_cu, (const void*)fwd, NWAVES * 64, LDS_BYTES) != hipSuccess || per_cu < 1) { fprintf(stderr, "kernel_launch: occupancy query says %d\n", per_cu); per_cu = 1; }
        (void)hipGetLastError();
        grid = cus;
    }
    if (grid < 0) return;
    (void)hipMemsetAsync((char*)d_ws + WS_CTL, 0, CTL_ZERO_BYTES, stream);
    Args a{};
    for (int i = 0; i < 21; ++i) a.in[i] = (const float*)d_in[i];
    a.out = (float*)d_out; a.ws = (unsigned char*)d_ws;
    if (MK_N_LAUNCHES == 1) {
        a.ph_lo = 0; a.ph_hi = NPHASE;
        void* kargs[] = {&a};
        hipError_t e = hipLaunchCooperativeKernel((const void*)fwd, dim3(grid), dim3(NWAVES * 64), kargs, LDS_BYTES, stream);
        if (e != hipSuccess) fprintf(stderr, "kernel_launch: cooperative launch failed: %s\n", hipGetErrorString(e));
    } else {
        for (int p = 0; p < NPHASE; ++p) { a.ph_lo = p; a.ph_hi = p + 1; for (int rep = 0; rep < NREP(p); ++rep) hipLaunchKernelGGL(fwd, dim3(grid), dim3(NWAVES * 64), LDS_BYTES, stream, a); }
    }
}
```

```cpp
#include <hip/hip_runtime.h>
#include <hip/hip_cooperative_groups.h>
#include <cstdio>
#include <cstdint>
namespace cg = cooperative_groups;

#ifndef MK_N_LAUNCHES
#define MK_N_LAUNCHES 1
#endif
#ifndef DUP_MASK
#define DUP_MASK 0
#endif
#define NREP(k) (((DUP_MASK >> (k)) & 1) ? 2 : 1)

constexpr int D = 1024, BATCH = 8, SEQ = 2048, M = BATCH * SEQ, MEMLEN = 256, MROWS = BATCH * MEMLEN;
constexpr int NPROJ = 3072, NE = 32, TOPK = 4, DEXP = 1024;
constexpr int XH = 4, XHD = 256;
constexpr float EPS = 1e-5f;
constexpr float LOG2E = 1.4426950408889634f;
constexpr float C2Q = 0.125f * LOG2E;
constexpr float C2X = 0.0625f * LOG2E;
constexpr int LISTCAP = M;
constexpr int ACT_ROWS = M * TOPK + NE * 256;

#define GAS __attribute__((address_space(1)))
#define LAS __attribute__((address_space(3)))
typedef unsigned short bf16_t;
typedef short bf16x8 __attribute__((ext_vector_type(8)));
typedef short s16x4 __attribute__((ext_vector_type(4)));
typedef float f32x4 __attribute__((ext_vector_type(4)));
typedef float f32x2 __attribute__((ext_vector_type(2)));
typedef float f32x16 __attribute__((ext_vector_type(16)));
typedef unsigned u32x4 __attribute__((ext_vector_type(4)));
typedef unsigned u32x2 __attribute__((ext_vector_type(2)));
typedef GAS unsigned gu32;

constexpr size_t MiB = 1u << 20;
constexpr size_t WS_CTL = 0, CTL_ZERO_BYTES = 1 * MiB;
constexpr size_t WS_WIN_T = 2 * MiB, WS_WOUT_T = 8 * MiB, WS_WQ_T = 10 * MiB, WS_WKV_T = 12 * MiB, WS_WO_T = 16 * MiB, WS_WR = 18 * MiB;
constexpr size_t WS_MEMN = 19 * MiB, WS_KMEM = 23 * MiB, WS_VT = 27 * MiB, WS_SS1 = 31 * MiB, WS_SS2 = 32 * MiB, WS_RSTD3 = 33 * MiB, WS_LTOK = 34 * MiB, WS_LGATE = 36 * MiB, WS_LRSTD = 38 * MiB;
constexpr size_t WS_W1_T = 40 * MiB, WS_W2_T = 168 * MiB;
constexpr size_t WS_XN = 232 * MiB, WS_PROJ = 264 * MiB, WS_YMIX = 360 * MiB;
constexpr size_t WS_X1 = 392 * MiB, WS_X1B = 456 * MiB, WS_QM = 488 * MiB, WS_PB = 520 * MiB, WS_OB = 552 * MiB, WS_X2 = 584 * MiB, WS_X2B = 648 * MiB;
constexpr size_t WS_ACT = 232 * MiB;
constexpr size_t WS_Y = 392 * MiB;
constexpr size_t WS_END = 680 * MiB;
static_assert(WS_ACT + (size_t)ACT_ROWS * DEXP * 2 <= WS_X1 && WS_Y + (size_t)M * TOPK * D * 2 <= WS_PB, "overlays");
constexpr int CW_TMO = 0, CW_CODE = 1, CW_BAR = 4096, CW_CNT = 8192;

__device__ __forceinline__ unsigned cvt_pk_bf16(float lo, float hi) { unsigned r; asm volatile("v_cvt_pk_bf16_f32 %0, %1, %2" : "=v"(r) : "v"(lo), "v"(hi)); return r; }
__device__ __forceinline__ unsigned cvtpk_s(float lo, float hi) { typedef __bf16 bf16x2_t __attribute__((ext_vector_type(2))); f32x2 v = {lo, hi}; bf16x2_t b = __builtin_convertvector(v, bf16x2_t); return __builtin_bit_cast(unsigned, b); }
__device__ __forceinline__ float bf_lo(unsigned w) { return __uint_as_float(w << 16); }
__device__ __forceinline__ float bf_hi(unsigned w) { return __uint_as_float(w & 0xffff0000u); }
__device__ __forceinline__ float wave_sum(float v) {
#pragma unroll
    for (int o = 1; o < 64; o <<= 1) v += __shfl_xor(v, o);
    return v;
}
#define LDS_WAIT() asm volatile("s_waitcnt lgkmcnt(0)" ::: "memory")
#define VM_WAIT() asm volatile("s_waitcnt vmcnt(0)" ::: "memory")

namespace pg8 {
constexpr int BM = 256, BK = 64, HALF = 128, HTB = HALF * BK * 2, STAGE_BYTES = 8 * HTB, NXCD = 8, WGM = 8;
__host__ __device__ __forceinline__ int lds_byte(int r, int c) { const int st = (r >> 4) * 2 + (c >> 5), rr = r & 15, cc = c & 31, ob = rr * 64 + cc * 2; return st * 1024 + (ob ^ (((ob >> 9) & 1) << 5)); }
__host__ __device__ __forceinline__ void stage_rc(int b, int& R, int& C) { const int st = b / 1024, sb = b % 1024, swz = sb ^ (((sb >> 9) & 1) << 5); R = (st >> 1) * 16 + swz / 64; C = (st & 1) * 32 + (swz % 64) / 2; }
__host__ __device__ __forceinline__ int perm32(int rho) { const int n = rho >> 4, i = rho & 15; return 8 * (i >> 2) + 4 * n + (i & 3); }

struct Unit { const char* a; const char* b; int pm, pn; };
struct UnitK { const char* a; const char* b; int pm, pn, kind; };
struct UnitM { const char* a; const char* b; const int* tok; int pm, pn, nvalid, e, rowoff; };

struct GridOrder {
    int nM, nN, nwg;
    __device__ __forceinline__ void init(int nM_, int nN_) { nM = nM_; nN = nN_; nwg = nM * nN; }
    __device__ __forceinline__ void map(int L, int& pm, int& pn) const {
        int wgid = L; { const int q = nwg / NXCD, r = nwg % NXCD, xcd = wgid % NXCD, off = wgid / NXCD; wgid = (xcd < r ? xcd * (q + 1) : r * (q + 1) + (xcd - r) * q) + off; }
        const int nig = WGM * nN, gid = wgid / nig, fm = gid * WGM, gsz = (nM - fm) < WGM ? (nM - fm) : WGM;
        pm = fm + ((wgid % nig) % gsz); pn = (wgid % nig) / gsz;
    }
};

typedef f32x4 Acc[2][2][4][2];

template <class Epi, class Sched, bool GATHER, bool ALIGN_EPI, bool SP2>
__device__ __forceinline__ void gemm_phase(LAS unsigned char* lds, const int lda, const int ldb, const int K, const Sched& S, const Epi& E) {
    const int tid = threadIdx.x, wid = __builtin_amdgcn_readfirstlane(tid >> 6), lane = tid & 63, wr = wid >> 2, wc = wid & 3, fr = lane & 15, fq = lane >> 4;
    int nt = K / BK; asm volatile("" : "+s"(nt));
    int RA[2], CA[2]; unsigned voffB[2];
#pragma unroll
    for (int i = 0; i < 2; ++i) { int R, C; stage_rc(tid * 16 + i * 8192, R, C); const int Rb = Epi::PERM ? ((R & ~31) + perm32(R & 31)) : R;
        RA[i] = R; CA[i] = C; voffB[i] = (unsigned)(Rb * ldb + C) * 2u; }
    const size_t kstep = (size_t)(BK * 2);
    const size_t hstepB = (size_t)HALF * ldb * 2;
    const unsigned ldsw = (unsigned)wid * 1024u;
    const int aoff = lds_byte(wr * 64 + fr, fq * 8), boff = lds_byte(wc * 32 + fr, fq * 8);
#define PG8_SA(b, h) (((b) * 2 + (h)) * HTB)
#define PG8_SB(b, h) ((4 + (b) * 2 + (h)) * HTB)
#define PG8_STAGE(bufoff, gbase, voff) do { _Pragma("unroll") for (int _i = 0; _i < 2; ++_i) \
        __builtin_amdgcn_global_load_lds((const unsigned*)((const char*)(gbase) + (voff)[_i]), (LAS unsigned*)(lds + (bufoff) + ldsw + _i * 8192), 16, 0, 0); } while (0)
#define PG8_LDA(dst, b, h) do { _Pragma("unroll") for (int m = 0; m < 4; ++m) _Pragma("unroll") for (int k = 0; k < 2; ++k) dst[m][k] = *(const LAS bf16x8*)(lds + PG8_SA(b, h) + aoff + m * 2048 + k * 1024); } while (0)
#define PG8_LDB(dst, b, h) do { _Pragma("unroll") for (int n = 0; n < 2; ++n) _Pragma("unroll") for (int k = 0; k < 2; ++k) dst[n][k] = *(const LAS bf16x8*)(lds + PG8_SB(b, h) + boff + n * 2048 + k * 1024); } while (0)
#define PG8_MMA(ai, bj, At, Bt) do { __builtin_amdgcn_s_setprio(1); _Pragma("unroll") for (int m = 0; m < 4; ++m) _Pragma("unroll") for (int n = 0; n < 2; ++n) _Pragma("unroll") for (int k = 0; k < 2; ++k) \
        acc[ai][bj][m][n] = __builtin_amdgcn_mfma_f32_16x16x32_bf16(Bt[n][k], At[m][k], acc[ai][bj][m][n], 0, 0, 0); __builtin_amdgcn_s_setprio(0); } while (0)
#define PG8_WAIT_V(n) asm volatile("s_waitcnt vmcnt(" #n ")" ::: "memory")
#define PG8_WAIT_L(n) asm volatile("s_waitcnt lgkmcnt(" #n ")" ::: "memory")
#define PG8_BAR __builtin_amdgcn_s_barrier()
#define PG8_SCHED __builtin_amdgcn_sched_barrier(0)
#define PG8_VOFFA(dst, u) do { if constexpr (GATHER) { int _t[2][2]; _Pragma("unroll") for (int _h = 0; _h < 2; ++_h) _Pragma("unroll") for (int _i = 0; _i < 2; ++_i) _t[_h][_i] = (u).tok[_h * HALF + RA[_i]]; \
        _Pragma("unroll") for (int _h = 0; _h < 2; ++_h) _Pragma("unroll") for (int _i = 0; _i < 2; ++_i) { const int _row = _h * HALF + RA[_i]; const int _tt = (_row < (u).nvalid) ? (_t[_h][_i] >> 2) : 0; dst[_h][_i] = (unsigned)(_tt * lda + CA[_i]) * 2u; } } \
        else { _Pragma("unroll") for (int _h = 0; _h < 2; ++_h) _Pragma("unroll") for (int _i = 0; _i < 2; ++_i) dst[_h][_i] = (unsigned)((_h * HALF + RA[_i]) * lda + CA[_i]) * 2u; } } while (0)
#define PG8_VOFFA_LDS(dst, u, slot) do { const LAS int* _mt = (const LAS int*)(lds + 131072 + (slot) * 3072 + 1024); _Pragma("unroll") for (int _h = 0; _h < 2; ++_h) _Pragma("unroll") for (int _i = 0; _i < 2; ++_i) { \
        const int _row = _h * HALF + RA[_i]; const int _tt = (_row < (u).nvalid) ? (_mt[_row] >> 2) : 0; dst[_h][_i] = (unsigned)(_tt * lda + CA[_i]) * 2u; } } while (0)
    typename Sched::U cur, nxt; int ui = 0;
    if (!S.next(0, cur)) return;
    Acc acc;
#pragma unroll
    for (int a = 0; a < 2; ++a)
#pragma unroll
        for (int b = 0; b < 2; ++b)
#pragma unroll
            for (int m = 0; m < 4; ++m)
#pragma unroll
                for (int n = 0; n < 2; ++n) acc[a][b][m][n] = (f32x4){0.f, 0.f, 0.f, 0.f};
    bf16x8 At[4][2], B0[2][2], B1[2][2];
    unsigned vA[2][2];
    PG8_VOFFA(vA, cur);
    const char* cA = cur.a; const char* cB = cur.b;
    E.prefetch(cur, 0, lds, wid, lane);
    if constexpr (SP2) {
        PG8_STAGE(PG8_SB(0, 0), cB, voffB); PG8_STAGE(PG8_SB(0, 1), cB + hstepB, voffB); PG8_STAGE(PG8_SA(0, 0), cA, vA[0]); PG8_STAGE(PG8_SA(0, 1), cA, vA[1]);
        if (wr == 1) PG8_BAR;
        PG8_WAIT_V(2); PG8_BAR;
        PG8_STAGE(PG8_SB(1, 0), cB + kstep, voffB); PG8_STAGE(PG8_SA(1, 0), cA + kstep, vA[0]); PG8_STAGE(PG8_SB(1, 1), cB + hstepB + kstep, voffB);
        PG8_WAIT_V(6); PG8_BAR;
    } else {
        PG8_STAGE(PG8_SB(0, 0), cB, voffB); PG8_STAGE(PG8_SA(0, 0), cA, vA[0]); PG8_STAGE(PG8_SB(0, 1), cB + hstepB, voffB); PG8_STAGE(PG8_SA(0, 1), cA, vA[1]);
        if (wr == 1) PG8_BAR;
        PG8_WAIT_V(4); PG8_BAR;
        PG8_STAGE(PG8_SB(1, 0), cB + kstep, voffB); PG8_STAGE(PG8_SA(1, 0), cA + kstep, vA[0]); PG8_STAGE(PG8_SB(1, 1), cB + hstepB + kstep, voffB);
        PG8_WAIT_V(6); PG8_BAR;
    }
    for (;;) {
        const bool has_next = S.next(ui + 1, nxt);
        const char* nA = has_next ? nxt.a : cA; const char* nB = has_next ? nxt.b : cB;
        if (has_next) E.prefetch(nxt, ui + 1, lds, wid, lane);
        for (int t = 0; t < nt; t += 2) {
            const bool last = (t == nt - 2);
            const char* a1 = cA + (size_t)(t + 1) * kstep;
            const char* a2 = last ? nA : cA + (size_t)(t + 2) * kstep; const char* b2 = last ? nB : cB + (size_t)(t + 2) * kstep;
            const char* a3 = a2 + kstep; const char* b3 = b2 + kstep;
            if constexpr (SP2) {
            PG8_LDB(B0, 0, 0); PG8_LDB(B1, 0, 1); PG8_SCHED; PG8_LDA(At, 0, 0); PG8_STAGE(PG8_SA(1, 1), a1, vA[1]); if constexpr (GATHER) { if (last && has_next) { PG8_VOFFA_LDS(vA, nxt, (ui + 1) % 3); } }
            PG8_WAIT_V(8); PG8_WAIT_L(0); PG8_BAR; PG8_MMA(0, 0, At, B0); PG8_MMA(0, 1, At, B1); PG8_BAR; PG8_SCHED;
            PG8_LDA(At, 0, 1); PG8_STAGE(PG8_SB(0, 0), b2, voffB); PG8_STAGE(PG8_SB(0, 1), b2 + hstepB, voffB); PG8_STAGE(PG8_SA(0, 0), a2, vA[0]);
            PG8_WAIT_V(8); PG8_WAIT_L(0); PG8_BAR; PG8_MMA(1, 0, At, B0); PG8_MMA(1, 1, At, B1); PG8_BAR; PG8_SCHED;
            PG8_LDB(B0, 1, 0); PG8_LDB(B1, 1, 1); PG8_SCHED; PG8_LDA(At, 1, 0); PG8_STAGE(PG8_SA(0, 1), a2, vA[1]);
            PG8_WAIT_V(8); PG8_WAIT_L(0); PG8_BAR; PG8_MMA(0, 0, At, B0); PG8_MMA(0, 1, At, B1); PG8_BAR; PG8_SCHED;
            PG8_LDA(At, 1, 1); PG8_STAGE(PG8_SB(1, 0), b3, voffB); PG8_STAGE(PG8_SB(1, 1), b3 + hstepB, voffB); PG8_STAGE(PG8_SA(1, 0), a3, vA[0]);
            PG8_WAIT_V(8); PG8_WAIT_L(0); PG8_BAR; PG8_MMA(1, 0, At, B0); PG8_MMA(1, 1, At, B1); PG8_BAR; PG8_SCHED;
            } else {
            PG8_LDB(B0, 0, 0); PG8_SCHED; PG8_LDA(At, 0, 0); PG8_STAGE(PG8_SA(1, 1), a1, vA[1]); if constexpr (GATHER) { if (last && has_next) { PG8_VOFFA_LDS(vA, nxt, (ui + 1) % 3); } }
            PG8_WAIT_L(8); PG8_BAR; PG8_WAIT_L(0); PG8_MMA(0, 0, At, B0); PG8_BAR; PG8_SCHED;
            PG8_LDB(B1, 0, 1); PG8_STAGE(PG8_SB(0, 0), b2, voffB);
            PG8_BAR; PG8_WAIT_L(0); PG8_MMA(0, 1, At, B1); PG8_BAR;
            PG8_LDA(At, 0, 1); PG8_STAGE(PG8_SA(0, 0), a2, vA[0]);
            PG8_BAR; PG8_WAIT_L(0); PG8_MMA(1, 0, At, B0); PG8_BAR; PG8_SCHED;
            PG8_STAGE(PG8_SB(0, 1), b2 + hstepB, voffB);
            PG8_WAIT_V(6); PG8_BAR; PG8_MMA(1, 1, At, B1); PG8_BAR;
            PG8_LDB(B0, 1, 0); PG8_SCHED; PG8_LDA(At, 1, 0); PG8_STAGE(PG8_SA(0, 1), a2, vA[1]);
            PG8_WAIT_L(8); PG8_BAR; PG8_WAIT_L(0); PG8_MMA(0, 0, At, B0); PG8_BAR; PG8_SCHED;
            PG8_LDB(B1, 1, 1); PG8_STAGE(PG8_SB(1, 0), b3, voffB);
            PG8_BAR; PG8_WAIT_L(0); PG8_MMA(0, 1, At, B1); PG8_BAR;
            PG8_LDA(At, 1, 1); PG8_STAGE(PG8_SA(1, 0), a3, vA[0]);
            PG8_BAR; PG8_WAIT_L(0); PG8_MMA(1, 0, At, B0); PG8_BAR; PG8_SCHED;
            PG8_STAGE(PG8_SB(1, 1), b3 + hstepB, voffB);
            PG8_WAIT_V(6); PG8_BAR; PG8_MMA(1, 1, At, B1); PG8_BAR;
            }
        }
        if constexpr (ALIGN_EPI) { if (wr == 0) PG8_BAR; }
        if constexpr (!Epi::AFTER_DRAIN) { E(acc, cur, ui, lds, wr, wc, fr, fq); }
        if (!has_next) break;
#pragma unroll
        for (int a = 0; a < 2; ++a)
#pragma unroll
            for (int b = 0; b < 2; ++b)
#pragma unroll
                for (int m = 0; m < 4; ++m)
#pragma unroll
                    for (int n = 0; n < 2; ++n) acc[a][b][m][n] = (f32x4){0.f, 0.f, 0.f, 0.f};
        cur = nxt; cA = nA; cB = nB; ++ui;
        if constexpr (ALIGN_EPI) { if (wr == 1) PG8_BAR; }
    }
    PG8_WAIT_V(0);
    if constexpr (!ALIGN_EPI) { if (wr == 0) PG8_BAR; }
    PG8_BAR;
    if constexpr (Epi::AFTER_DRAIN) { E.fused(acc, cur, wr, wc, fr, fq, lds, wid, lane); }
#undef PG8_SA
#undef PG8_SB
#undef PG8_STAGE
#undef PG8_LDA
#undef PG8_LDB
#undef PG8_MMA
#undef PG8_WAIT_V
#undef PG8_WAIT_L
#undef PG8_BAR
#undef PG8_SCHED
#undef PG8_VOFFA
#undef PG8_VOFFA_LDS
}

struct OrderP1 {
    typedef UnitK U;
    const char *xn, *win_t, *memn, *wkv_t; int G, c; GridOrder g0;
    __device__ __forceinline__ void init(const void* xn_, const void* win_t_, const void* memn_, const void* wkv_t_, int G_, int c_) {
        xn = (const char*)xn_; win_t = (const char*)win_t_; memn = (const char*)memn_; wkv_t = (const char*)wkv_t_; G = G_; c = c_; g0.init(M / 256, NPROJ / 256); }
    __device__ __forceinline__ bool next(int i, UnitK& u) const {
        const int L = i * G + c;
        if (L < g0.nwg) { g0.map(L, u.pm, u.pn); u.kind = 0; u.a = xn + (size_t)u.pm * 256 * D * 2; u.b = win_t + (size_t)u.pn * 256 * D * 2; return true; }
        int r = L - g0.nwg;
        if (r < 32) { u.kind = 1; u.pm = r >> 2; u.pn = r & 3; u.a = memn + (size_t)u.pm * 256 * D * 2; u.b = wkv_t + (size_t)u.pn * 256 * D * 2; return true; }
        r -= 32;
        if (r < 32) { u.kind = 2; u.pm = r >> 3; u.pn = r & 7; u.a = wkv_t + (size_t)(D + u.pm * 256) * D * 2; u.b = memn + (size_t)u.pn * 256 * D * 2; return true; }
        return false;
    }
};
struct OrderPlain {
    typedef Unit U;
    const char *A, *Bt; int lda, ldb, G, c; GridOrder g0;
    __device__ __forceinline__ void init(const void* A_, const void* Bt_, int lda_, int ldb_, int nM, int nN, int G_, int c_) { A = (const char*)A_; Bt = (const char*)Bt_; lda = lda_; ldb = ldb_; G = G_; c = c_; g0.init(nM, nN); }
    __device__ __forceinline__ bool next(int i, Unit& u) const {
        const int L = i * G + c; if (L >= g0.nwg) return false;
        g0.map(L, u.pm, u.pn);
        u.a = A + (size_t)u.pm * 256 * lda * 2; u.b = Bt + (size_t)u.pn * 256 * ldb * 2; return true;
    }
};
template <int MODE> struct OrderX {
    typedef Unit U;
    const char *A, *Bt; int G, c;
    __device__ __forceinline__ void init(const void* A_, const void* Bt_, int G_, int c_) { A = (const char*)A_; Bt = (const char*)Bt_; G = G_; c = c_; }
    __device__ __forceinline__ bool next(int i, Unit& u) const {
        const int L = i * G + c; if (L >= (M / 256) * XH) return false;
        const int xcd = L & 7, j = L >> 3; u.pm = xcd * 8 + (j >> 2); u.pn = j & 3;
        const int b = u.pm >> 3;
        u.a = A + ((size_t)u.pm * 256 * D + (size_t)u.pn * XHD) * 2;
        if (MODE == 0) u.b = Bt + ((size_t)b * MEMLEN * D + (size_t)u.pn * XHD) * 2;
        else u.b = Bt + ((size_t)u.pn * XHD * MROWS + (size_t)b * MEMLEN) * 2;
        return true;
    }
};
template <int NTN, bool G1> struct OrderMoe {
    typedef UnitM U;
    const int* ltok; const char* A; const char* Bt; int G, c; int seg[4], til[4], cn[4];
    __device__ __forceinline__ void init(const unsigned* cnt, const int* ltok_, const void* A_, const void* Bt_, int G_, int c_) {
        ltok = ltok_; A = (const char*)A_; Bt = (const char*)Bt_; G = G_; c = c_;
        const int lane = threadIdx.x & 63; const int cv = (lane < NE) ? (int)__hip_atomic_load(cnt + 64 * lane, __ATOMIC_RELAXED, __HIP_MEMORY_SCOPE_AGENT) : 0;
        const int t = (cv + 255) >> 8; int incl = t;
#pragma unroll
        for (int o = 1; o < 32; o <<= 1) { const int v = __shfl_up(incl, o); if (lane >= o) incl += v; }
        const int excl = incl - t, xcd = c & 7;
#pragma unroll
        for (int q = 0; q < 4; ++q) { seg[q] = __builtin_amdgcn_readlane(excl, xcd + 8 * q); til[q] = __builtin_amdgcn_readlane(t, xcd + 8 * q); cn[q] = __builtin_amdgcn_readlane(cv, xcd + 8 * q); }
    }
    __device__ __forceinline__ bool next(int i, UnitM& u) const {
        const int xcd = c & 7, slot = c >> 3, nslot = G >> 3; int j = i * nslot + slot;
#pragma unroll
        for (int q = 0; q < 4; ++q) {
            const int nu = til[q] * NTN;
            if (j < nu) { const int e = xcd + 8 * q, mt = j / NTN, nt = j % NTN;
                u.e = e; u.pm = mt; u.pn = nt; u.rowoff = (seg[q] + mt) * 256; u.nvalid = cn[q] - mt * 256 < 256 ? cn[q] - mt * 256 : 256; u.tok = ltok + (size_t)e * LISTCAP + mt * 256;
                if (G1) { u.a = A; u.b = Bt + ((size_t)e * 2048 + (size_t)nt * 256) * D * 2; }
                else { u.a = A + (size_t)u.rowoff * DEXP * 2; u.b = Bt + ((size_t)e * 1024 + (size_t)nt * 256) * DEXP * 2; }
                return true; }
            j -= nu;
        }
        return false;
    }
};

struct EpiP1 {
    static constexpr bool PERM = true, AFTER_DRAIN = false;
    bf16_t *proj, *kmem, *vt;
    __device__ __forceinline__ void prefetch(const UnitK&, int, LAS unsigned char*, int, int) const {}
    __device__ __forceinline__ void operator()(const Acc& acc, const UnitK& u, int, LAS unsigned char*, int wr, int wc, int fr, int fq) const {
        bf16_t* base; int ldc; float sc = 1.f;
        if (u.kind == 0) { base = proj; ldc = NPROJ; if (u.pn >= 6 && u.pn < 8) sc = C2Q; } else if (u.kind == 1) { base = kmem; ldc = D; } else { base = vt; ldc = MROWS; }
        const int row0 = u.pm * BM + wr * 64 + fr, col0 = u.pn * BM + wc * 32 + 8 * fq;
#pragma unroll
        for (int ai = 0; ai < 2; ++ai)
#pragma unroll
            for (int m = 0; m < 4; ++m) { bf16_t* rowp = base + (size_t)(row0 + ai * HALF + m * 16) * ldc + col0;
#pragma unroll
                for (int bj = 0; bj < 2; ++bj) { const f32x4 v0 = acc[ai][bj][m][0] * sc, v1 = acc[ai][bj][m][1] * sc;
                    u32x4 w; w.x = cvt_pk_bf16(v0[0], v0[1]); w.y = cvt_pk_bf16(v0[2], v0[3]); w.z = cvt_pk_bf16(v1[0], v1[1]); w.w = cvt_pk_bf16(v1[2], v1[3]);
                    *(u32x4*)(rowp + bj * HALF) = w; } }
    }
};
struct EpiRes {
    static constexpr bool PERM = false, AFTER_DRAIN = true;
    const float* base; float* xo; bf16_t* xb; float* ss;
    __device__ __forceinline__ void prefetch(const Unit&, int, LAS unsigned char*, int, int) const {}
    __device__ __forceinline__ void fused(Acc& acc, const Unit& u, int wr, int wc, int fr, int fq, LAS unsigned char* lds, int wid, int lane) const {
        LAS float* PSS = (LAS float*)lds;
        const int col0 = u.pn * BM + wc * 32 + 4 * fq;
#pragma unroll
        for (int ai = 0; ai < 2; ++ai)
#pragma unroll
            for (int m = 0; m < 4; ++m) { const int r = ai * HALF + wr * 64 + m * 16 + fr; const size_t off = (size_t)(u.pm * BM + r) * D + col0; float s = 0.f;
#pragma unroll
                for (int bj = 0; bj < 2; ++bj)
#pragma unroll
                    for (int n = 0; n < 2; ++n) { const f32x4 bs = *(const f32x4*)(base + off + bj * HALF + n * 16); const f32x4 o = bs + acc[ai][bj][m][n];
                        *(f32x4*)(xo + off + bj * HALF + n * 16) = o; u32x2 w; w.x = cvt_pk_bf16(o[0], o[1]); w.y = cvt_pk_bf16(o[2], o[3]); *(u32x2*)(xb + off + bj * HALF + n * 16) = w;
                        s += (o[0] * o[0] + o[1] * o[1]) + (o[2] * o[2] + o[3] * o[3]); }
                s += __shfl_xor(s, 16); s += __shfl_xor(s, 32);
                if (fq == 0) PSS[r * 4 + wc] = s; }
        __syncthreads();
        if (threadIdx.x < 256) { const f32x4 p = *(const LAS f32x4*)(PSS + threadIdx.x * 4); ss[(size_t)(u.pm * BM + threadIdx.x) * 4 + u.pn] = (p[0] + p[1]) + (p[2] + p[3]); }
        __syncthreads();
    }
};
__device__ __forceinline__ float rstd_from_ss(const float* ss, int row) {
    const f32x4 a = *(const f32x4*)(ss + (size_t)row * 4);
    return __builtin_amdgcn_rsqf(((a[0] + a[1]) + (a[2] + a[3])) * (1.0f / D) + EPS);
}
struct EpiQm {
    static constexpr bool PERM = true, AFTER_DRAIN = true;
    bf16_t* qm; const float* ss;
    __device__ __forceinline__ void prefetch(const Unit&, int, LAS unsigned char*, int, int) const {}
    __device__ __forceinline__ void fused(Acc& acc, const Unit& u, int wr, int wc, int fr, int fq, LAS unsigned char* lds, int wid, int lane) const {
        const int row0 = u.pm * BM + wr * 64 + fr, col0 = u.pn * BM + wc * 32 + 8 * fq;
        float sc[2][4];
#pragma unroll
        for (int ai = 0; ai < 2; ++ai)
#pragma unroll
            for (int m = 0; m < 4; ++m) sc[ai][m] = rstd_from_ss(ss, row0 + ai * HALF + m * 16) * C2X;
#pragma unroll
        for (int ai = 0; ai < 2; ++ai)
#pragma unroll
            for (int m = 0; m < 4; ++m) { const int row = row0 + ai * HALF + m * 16; bf16_t* rowp = qm + (size_t)row * D + col0;
#pragma unroll
                for (int bj = 0; bj < 2; ++bj) { const f32x4 v0 = acc[ai][bj][m][0] * sc[ai][m], v1 = acc[ai][bj][m][1] * sc[ai][m];
                    u32x4 w; w.x = cvt_pk_bf16(v0[0], v0[1]); w.y = cvt_pk_bf16(v0[2], v0[3]); w.z = cvt_pk_bf16(v1[0], v1[1]); w.w = cvt_pk_bf16(v1[2], v1[3]);
                    *(u32x4*)(rowp + bj * HALF) = w; } }
    }
};
struct EpiSoftmax {
    static constexpr bool PERM = true, AFTER_DRAIN = true;
    bf16_t* pb;
    __device__ __forceinline__ void prefetch(const Unit&, int, LAS unsigned char*, int, int) const {}
    __device__ __forceinline__ void fused(Acc& acc, const Unit& u, int wr, int wc, int fr, int fq, LAS unsigned char* lds, int wid, int lane) const {
        LAS float* PM = (LAS float*)lds;
        LAS float* PS = (LAS float*)(lds + 4096);
#pragma unroll
        for (int ai = 0; ai < 2; ++ai)
#pragma unroll
            for (int m = 0; m < 4; ++m) { float mx = -INFINITY;
#pragma unroll
                for (int bj = 0; bj < 2; ++bj)
#pragma unroll
                    for (int n = 0; n < 2; ++n) { const f32x4 x = acc[ai][bj][m][n]; mx = fmaxf(mx, fmaxf(fmaxf(x[0], x[1]), fmaxf(x[2], x[3]))); }
                mx = fmaxf(mx, __shfl_xor(mx, 16)); mx = fmaxf(mx, __shfl_xor(mx, 32));
                if (fq == 0) PM[(ai * HALF + wr * 64 + m * 16 + fr) * 4 + wc] = mx; }
        __syncthreads();
#pragma unroll
        for (int ai = 0; ai < 2; ++ai)
#pragma unroll
            for (int m = 0; m < 4; ++m) { const int r = ai * HALF + wr * 64 + m * 16 + fr; const f32x4 pm4 = *(const LAS f32x4*)(PM + r * 4);
                const float mx = fmaxf(fmaxf(pm4[0], pm4[1]), fmaxf(pm4[2], pm4[3])); float s = 0.f;
#pragma unroll
                for (int bj = 0; bj < 2; ++bj)
#pragma unroll
                    for (int n = 0; n < 2; ++n) { f32x4 x = acc[ai][bj][m][n];
#pragma unroll
                        for (int j = 0; j < 4; ++j) { x[j] = __builtin_amdgcn_exp2f(x[j] - mx); s += x[j]; }
                        acc[ai][bj][m][n] = x; }
                s += __shfl_xor(s, 16); s += __shfl_xor(s, 32);
                if (fq == 0) PS[r * 4 + wc] = s; }
        __syncthreads();
        const int row0 = u.pm * BM + wr * 64 + fr, col0 = u.pn * XHD + wc * 32 + 8 * fq;
#pragma unroll
        for (int ai = 0; ai < 2; ++ai)
#pragma unroll
            for (int m = 0; m < 4; ++m) { const int r = ai * HALF + wr * 64 + m * 16 + fr; const f32x4 ps4 = *(const LAS f32x4*)(PS + r * 4);
                const float inv = 1.0f / ((ps4[0] + ps4[1]) + (ps4[2] + ps4[3])); bf16_t* rowp = pb + (size_t)(row0 + ai * HALF + m * 16) * D + col0;
#pragma unroll
                for (int bj = 0; bj < 2; ++bj) { const f32x4 v0 = acc[ai][bj][m][0] * inv, v1 = acc[ai][bj][m][1] * inv;
                    u32x4 w; w.x = cvt_pk_bf16(v0[0], v0[1]); w.y = cvt_pk_bf16(v0[2], v0[3]); w.z = cvt_pk_bf16(v1[0], v1[1]); w.w = cvt_pk_bf16(v1[2], v1[3]);
                    *(u32x4*)(rowp + bj * HALF) = w; } }
        __syncthreads();
    }
};
struct EpiO {
    static constexpr bool PERM = true, AFTER_DRAIN = false;
    bf16_t* ob;
    __device__ __forceinline__ void prefetch(const Unit&, int, LAS unsigned char*, int, int) const {}
    __device__ __forceinline__ void operator()(const Acc& acc, const Unit& u, int, LAS unsigned char*, int wr, int wc, int fr, int fq) const {
        const int row0 = u.pm * BM + wr * 64 + fr, col0 = u.pn * BM + wc * 32 + 8 * fq;
#pragma unroll
        for (int ai = 0; ai < 2; ++ai)
#pragma unroll
            for (int m = 0; m < 4; ++m) { bf16_t* rowp = ob + (size_t)(row0 + ai * HALF + m * 16) * D + col0;
#pragma unroll
                for (int bj = 0; bj < 2; ++bj) { const f32x4 v0 = acc[ai][bj][m][0], v1 = acc[ai][bj][m][1];
                    u32x4 w; w.x = cvt_pk_bf16(v0[0], v0[1]); w.y = cvt_pk_bf16(v0[2], v0[3]); w.z = cvt_pk_bf16(v1[0], v1[1]); w.w = cvt_pk_bf16(v1[2], v1[3]);
                    *(u32x4*)(rowp + bj * HALF) = w; } }
    }
};
constexpr int META_OFF = 131072, META_BYTES = 3072;
__device__ __forceinline__ void dma4(const void* g, LAS unsigned char* l) { __builtin_amdgcn_global_load_lds((const unsigned*)g, (LAS unsigned*)l, 4, 0, 0); }
__device__ __forceinline__ void dma16(const void* g, LAS unsigned char* l) { __builtin_amdgcn_global_load_lds((const unsigned*)g, (LAS unsigned*)l, 16, 0, 0); }
struct EpiAct {
    static constexpr bool PERM = true, AFTER_DRAIN = false;
    bf16_t* act; const float* lrstd; const float* b1;
    __device__ __forceinline__ void prefetch(const UnitM& u, int ui, LAS unsigned char* lds, int wid, int lane) const {
        LAS unsigned char* mb = lds + META_OFF + (ui % 3) * META_BYTES;
        if (wid < 4) dma4(lrstd + (size_t)u.e * LISTCAP + u.pm * 256 + wid * 64 + lane, mb + wid * 256);
        else dma4(u.tok + (wid - 4) * 64 + lane, mb + 1024 + (wid - 4) * 256);
        if (wid == 4) dma16(b1 + (size_t)u.e * 2048 + (lane >> 5) * 1024 + u.pn * 128 + (lane & 31) * 4, mb + 2048);
    }
    __device__ __forceinline__ void operator()(const Acc& acc, const UnitM& u, int ui, LAS unsigned char* lds, int wr, int wc, int fr, int fq) const {
        const LAS unsigned char* mb = lds + META_OFF + (ui % 3) * META_BYTES;
        const int cl = wc * 32 + 8 * fq, gcol = u.pn * 128 + cl; const LAS float* bg = (const LAS float*)(mb + 2048) + cl; const LAS float* bl = bg + 128;
        const f32x4 bg0 = *(const LAS f32x4*)bg, bg1 = *(const LAS f32x4*)(bg + 4), bl0 = *(const LAS f32x4*)bl, bl1 = *(const LAS f32x4*)(bl + 4);
#pragma unroll
        for (int ai = 0; ai < 2; ++ai)
#pragma unroll
            for (int m = 0; m < 4; ++m) { const int r = ai * HALF + wr * 64 + m * 16 + fr; const float rs = ((const LAS float*)mb)[r];
                float o[8];
#pragma unroll
                for (int n = 0; n < 2; ++n) { const f32x4 g4 = acc[ai][0][m][n] * rs + (n ? bg1 : bg0), l4 = acc[ai][1][m][n] * rs + (n ? bl1 : bl0);
#pragma unroll
                    for (int j = 0; j < 4; ++j) { const float g = fminf(g4[j], 7.0f), l = fminf(fmaxf(l4[j], -7.0f), 7.0f);
                        const float sg = __builtin_amdgcn_rcpf(1.0f + __builtin_amdgcn_exp2f(g * (-1.702f * LOG2E))); o[n * 4 + j] = g * sg * (l + 1.0f); } }
                u32x4 w; w.x = cvt_pk_bf16(o[0], o[1]); w.y = cvt_pk_bf16(o[2], o[3]); w.z = cvt_pk_bf16(o[4], o[5]); w.w = cvt_pk_bf16(o[6], o[7]);
                *(u32x4*)(act + (size_t)(u.rowoff + r) * DEXP + gcol) = w; }
    }
};
struct EpiY {
    static constexpr bool PERM = true, AFTER_DRAIN = false;
    bf16_t* y; const float* lgate; const int* ltok; const float* b2;
    __device__ __forceinline__ void prefetch(const UnitM& u, int ui, LAS unsigned char* lds, int wid, int lane) const {
        LAS unsigned char* mb = lds + META_OFF + (ui % 3) * META_BYTES;
        const size_t li = (size_t)u.e * LISTCAP + u.pm * 256 + (wid & 3) * 64 + lane;
        if (wid < 4) dma4(lgate + li, mb + wid * 256); else dma4(ltok + li, mb + 1024 + (wid - 4) * 256);
        if (wid == 0) dma16(b2 + (size_t)u.e * D + u.pn * 256 + lane * 4, mb + 2048);
    }
    __device__ __forceinline__ void operator()(const Acc& acc, const UnitM& u, int ui, LAS unsigned char* lds, int wr, int wc, int fr, int fq) const {
        const LAS unsigned char* mb = lds + META_OFF + (ui % 3) * META_BYTES;
        const int cl = wc * 32 + 8 * fq, col0 = u.pn * BM + cl; const LAS float* bb = (const LAS float*)(mb + 2048) + cl;
        f32x4 bv[2][2];
#pragma unroll
        for (int bj = 0; bj < 2; ++bj)
#pragma unroll
            for (int n = 0; n < 2; ++n) bv[bj][n] = *(const LAS f32x4*)(bb + bj * HALF + 4 * n);
#pragma unroll
        for (int ai = 0; ai < 2; ++ai)
#pragma unroll
            for (int m = 0; m < 4; ++m) { const int r = ai * HALF + wr * 64 + m * 16 + fr;
                if (r < u.nvalid) { const int ent = ((const LAS int*)(mb + 1024))[r]; const float gw = ((const LAS float*)mb)[r]; bf16_t* rowp = y + (size_t)ent * D + col0;
#pragma unroll
                    for (int bj = 0; bj < 2; ++bj) { const f32x4 v0 = (acc[ai][bj][m][0] + bv[bj][0]) * gw, v1 = (acc[ai][bj][m][1] + bv[bj][1]) * gw;
                        u32x4 w; w.x = cvt_pk_bf16(v0[0], v0[1]); w.y = cvt_pk_bf16(v0[2], v0[3]); w.z = cvt_pk_bf16(v1[0], v1[1]); w.w = cvt_pk_bf16(v1[2], v1[3]);
                        *(u32x4*)(rowp + bj * HALF) = w; } } }
    }
};
}

#define XB_TMO      128
#define XB_XCNT(j)  (256  + 64 * (j))
#define XB_XSUB(j)  (1280 + 64 * (j))
#define XB_XGEN(j)  (2304 + 64 * (j))
#define XB_TOP      3328
#define XB_TOPGEN   3392
#define XCD_BAR_WORDS 3456
#define XB_SPIN_CAP (1u << 18)
__device__ __forceinline__ unsigned xb_ld(unsigned* p)              { return __hip_atomic_load(p, __ATOMIC_RELAXED, __HIP_MEMORY_SCOPE_AGENT); }
__device__ __forceinline__ unsigned xb_add(unsigned* p, unsigned v) { return __hip_atomic_fetch_add(p, v, __ATOMIC_RELAXED, __HIP_MEMORY_SCOPE_AGENT); }
__device__ __forceinline__ unsigned xb_xcc_id() { return (unsigned)__builtin_amdgcn_s_getreg((3 << 11) | 20) & 0xFu; }
#define XB_SPIN(cond, bar) do { unsigned _sp = 0; while (cond) { __builtin_amdgcn_s_sleep(1); \
    if ((++_sp & 255u) == 0u) { if (xb_ld(&(bar)[XB_TMO])) break; if (_sp > XB_SPIN_CAP) { atomicAdd(&(bar)[XB_TMO], 1u); break; } } } } while (0)
struct XcdBarrier { unsigned* bar; unsigned x; volatile LAS unsigned* st; };
__device__ __forceinline__ XcdBarrier xcd_barrier_post(unsigned* bar, volatile LAS unsigned* st) {
    XcdBarrier b; b.bar = bar; b.x = xb_xcc_id(); b.st = st;
    if (threadIdx.x == 0) (void)xb_add(&bar[XB_XCNT(b.x)], 1u);
    return b;
}
__device__ __forceinline__ void xcd_barrier_complete(unsigned* bar, unsigned x, unsigned& nloc, unsigned& nx) {
    const unsigned G = gridDim.x * gridDim.y * gridDim.z;
    unsigned sum, cnt, mine, sp = 0u;
    for (;;) {
        sum = 0u; cnt = 0u; mine = 0u;
#pragma unroll
        for (unsigned j = 0; j < 16; ++j) { const unsigned c = xb_ld(&bar[XB_XCNT(j)]); sum += c; cnt += (c > 0u) ? 1u : 0u; mine = (j == x) ? c : mine; }
        if (sum == G) break;
        __builtin_amdgcn_s_sleep(1);
        if ((++sp & 255u) == 0u) { if (xb_ld(&bar[XB_TMO])) break; if (sp > XB_SPIN_CAP) { atomicAdd(&bar[XB_TMO], 1u); break; } }
    }
    nloc = mine > 0u ? mine : 1u; nx = cnt > 0u ? cnt : 1u;
}
__device__ __forceinline__ void xcd_barrier(const XcdBarrier& b) {
    asm volatile("s_waitcnt vmcnt(0)" ::: "memory");
    __syncthreads();
    if (threadIdx.x == 0) {
        unsigned* bar = b.bar;
        __builtin_amdgcn_s_waitcnt(0);
        unsigned nloc = b.st[0], nx = b.st[1];
        if (nloc == 0u) { xcd_barrier_complete(bar, b.x, nloc, nx); b.st[0] = nloc; b.st[1] = nx; }
        const unsigned old = xb_add(&bar[XB_XSUB(b.x)], 1u);
        const unsigned gen = old / nloc;
        if (old + 1u == (gen + 1u) * nloc) {
            __builtin_amdgcn_fence(__ATOMIC_RELEASE, "agent");
            asm volatile("s_waitcnt vmcnt(0)" ::: "memory");
            const unsigned og = xb_add(&bar[XB_TOP], 1u);
            const unsigned tg = og / nx;
            if (og + 1u == (tg + 1u) * nx) xb_add(&bar[XB_TOPGEN], 1u);
            else XB_SPIN(xb_ld(&bar[XB_TOPGEN]) == tg, bar);
            __builtin_amdgcn_fence(__ATOMIC_ACQUIRE, "agent");
            xb_add(&bar[XB_XGEN(b.x)], 1u);
            asm volatile("s_waitcnt vmcnt(0)" ::: "memory");
        } else {
            XB_SPIN(xb_ld(&bar[XB_XGEN(b.x)]) == gen, bar);
            __builtin_amdgcn_fence(__ATOMIC_ACQUIRE, "agent");
            asm volatile("s_waitcnt vmcnt(0)" ::: "memory");
        }
    }
    __syncthreads();
}

constexpr int NWAVES = 8;
constexpr int RING_OFF = 0, RING_BYTES = 131072;
constexpr int LDSCTL_OFF = RING_BYTES + 12288, MISC_OFF = LDSCTL_OFF + 320;
constexpr int LDS_BYTES = 147456;
static_assert(MISC_OFF + 128 <= LDS_BYTES, "LDS map");

struct Frame {
    LAS unsigned char* lds; volatile LAS unsigned* MISC; unsigned* ctl; unsigned char* ws;
    int tid, lane, wave, vcu, G;
    const float* const* in; float* out;
};

template <int NMAP> __device__ __forceinline__ int nmap(int n) {
    if (NMAP == 0) return n;
    return n < 1024 ? (n >> 7) * 256 + (n & 127) : ((n - 1024) >> 7) * 256 + 128 + ((n - 1024) & 127);
}
template <int NMAP> __device__ __forceinline__ void transpose_item(const float* W, int ldw, int K, bf16_t* WT, const float* g, LAS unsigned* scr, int k0, int n0, int lane) {
    const int nq = lane & 15, kp = lane >> 4;
    f32x4 va[8], vb[8];
#pragma unroll
    for (int it = 0; it < 8; ++it) { const int k = k0 + 2 * (kp + 4 * it); va[it] = *(const f32x4*)(W + (size_t)k * ldw + n0 + 4 * nq); vb[it] = *(const f32x4*)(W + (size_t)(k + 1) * ldw + n0 + 4 * nq); }
#pragma unroll
    for (int it = 0; it < 8; ++it) { const int kk2 = kp + 4 * it; f32x4 a = va[it], b = vb[it];
        if (g) { const float g0 = g[k0 + 2 * kk2], g1 = g[k0 + 2 * kk2 + 1]; a = a * g0; b = b * g1; }
#pragma unroll
        for (int j = 0; j < 4; ++j) scr[(4 * nq + j) * 33 + kk2] = cvtpk_s(a[j], b[j]); }
    LDS_WAIT(); asm volatile("" ::: "memory");
    const int c = lane & 7;
#pragma unroll
    for (int it = 0; it < 8; ++it) { const int n = (lane >> 3) + 8 * it; const LAS unsigned* s = scr + n * 33 + 4 * c;
        u32x4 o; o.x = s[0]; o.y = s[1]; o.z = s[2]; o.w = s[3];
        *(u32x4*)(WT + (size_t)nmap<NMAP>(n0 + n) * K + k0 + 8 * c) = o; }
    LDS_WAIT(); asm volatile("" ::: "memory");
}
__device__ __forceinline__ void rms_row_to_bf16(const float* xrow, const float* g, bf16_t* orow, int lane) {
    const f32x4* xr = (const f32x4*)xrow + lane; const f32x4* gr = (const f32x4*)g + lane;
    f32x4 v[4]; float s = 0.f;
#pragma unroll
    for (int j = 0; j < 4; ++j) { v[j] = xr[64 * j]; s += (v[j][0] * v[j][0] + v[j][1] * v[j][1]) + (v[j][2] * v[j][2] + v[j][3] * v[j][3]); }
    const float rstd = __builtin_amdgcn_rsqf(wave_sum(s) * (1.f / D) + EPS);
    u32x2* o8 = (u32x2*)orow + lane;
#pragma unroll
    for (int j = 0; j < 4; ++j) { const f32x4 gg = gr[64 * j]; u32x2 w; w.x = cvtpk_s(v[j][0] * rstd * gg[0], v[j][1] * rstd * gg[1]); w.y = cvtpk_s(v[j][2] * rstd * gg[2], v[j][3] * rstd * gg[3]); o8[64 * j] = w; }
}
__device__ __forceinline__ void p0_prologue(Frame& F) {
    LAS unsigned* scr = (LAS unsigned*)(F.lds + RING_OFF + F.wave * 16384);
    const int gw = F.vcu * NWAVES + F.wave, NGW = F.G * NWAVES;
    const float *x = F.in[0], *mem = F.in[1], *g_mix = F.in[2], *w_in = F.in[3], *w_out = F.in[7], *g_xattn = F.in[8], *g_mem = F.in[9], *w_q = F.in[10], *w_kv = F.in[11], *w_o = F.in[12], *g_moe = F.in[13],
                *w_router = F.in[14], *w1 = F.in[16], *w2 = F.in[18];
    bf16_t *win_t = (bf16_t*)(F.ws + WS_WIN_T), *wout_t = (bf16_t*)(F.ws + WS_WOUT_T), *wq_t = (bf16_t*)(F.ws + WS_WQ_T), *wkv_t = (bf16_t*)(F.ws + WS_WKV_T), *wo_t = (bf16_t*)(F.ws + WS_WO_T),
           *w1_t = (bf16_t*)(F.ws + WS_W1_T), *w2_t = (bf16_t*)(F.ws + WS_W2_T), *xn = (bf16_t*)(F.ws + WS_XN), *memn = (bf16_t*)(F.ws + WS_MEMN);
    float* wr = (float*)(F.ws + WS_WR);
    for (int m = gw; m < M; m += NGW) rms_row_to_bf16(x + (size_t)m * D, g_mix, xn + (size_t)m * D, F.lane);
    for (int m = gw; m < MROWS; m += NGW) rms_row_to_bf16(mem + (size_t)m * D, g_mem, memn + (size_t)m * D, F.lane);
    for (int i = gw * 64 + F.lane; i < D * NE; i += NGW * 64) wr[i] = w_router[i] * g_moe[i >> 5];
    constexpr int I_IN = 16 * 48, I_OUT = 16 * 16, I_Q = 16 * 16, I_KV = 16 * 32, I_O = 16 * 16, I_1 = NE * 16 * 32, I_2 = NE * 16 * 16;
    constexpr int NITEMS = I_IN + I_OUT + I_Q + I_KV + I_O + I_1 + I_2;
    for (int it = gw; it < NITEMS; it += NGW) {
        int r = it;
        if (r < I_IN) { transpose_item<0>(w_in, NPROJ, D, win_t, nullptr, scr, (r / 48) * 64, (r % 48) * 64, F.lane); continue; } r -= I_IN;
        if (r < I_OUT) { transpose_item<0>(w_out, D, D, wout_t, nullptr, scr, (r / 16) * 64, (r % 16) * 64, F.lane); continue; } r -= I_OUT;
        if (r < I_Q) { transpose_item<0>(w_q, D, D, wq_t, g_xattn, scr, (r / 16) * 64, (r % 16) * 64, F.lane); continue; } r -= I_Q;
        if (r < I_KV) { transpose_item<0>(w_kv, 2 * D, D, wkv_t, nullptr, scr, (r / 32) * 64, (r % 32) * 64, F.lane); continue; } r -= I_KV;
        if (r < I_O) { transpose_item<0>(w_o, D, D, wo_t, nullptr, scr, (r / 16) * 64, (r % 16) * 64, F.lane); continue; } r -= I_O;
        if (r < I_1) { const int e = r / 512, q = r % 512; transpose_item<1>(w1 + (size_t)e * D * 2048, 2048, D, w1_t + (size_t)e * 2048 * D, g_moe, scr, (q / 32) * 64, (q % 32) * 64, F.lane); continue; } r -= I_1;
        { const int e = r / 256, q = r % 256; transpose_item<0>(w2 + (size_t)e * DEXP * D, D, DEXP, w2_t + (size_t)e * D * DEXP, nullptr, scr, (q / 16) * 64, (q % 16) * 64, F.lane); }
    }
}

__device__ __forceinline__ void conv_rows(Frame& F) {
    const bf16_t* proj = (const bf16_t*)(F.ws + WS_PROJ); bf16_t* ymix = (bf16_t*)(F.ws + WS_YMIX);
    const float* conv_w = F.in[4]; const float* g_conv = F.in[5];
    const int gw = F.vcu * NWAVES + F.wave, NGW = F.G * NWAVES, c0 = 8 * F.lane;
    float w0[8], w1[8], w2[8], gg[8];
#pragma unroll
    for (int j = 0; j < 8; ++j) { w0[j] = conv_w[c0 + j]; w1[j] = conv_w[512 + c0 + j]; w2[j] = conv_w[1024 + c0 + j]; gg[j] = g_conv[c0 + j]; }
    for (int m = gw; m < M; m += NGW) {
        const int t = m & (SEQ - 1); const bf16_t* row = proj + (size_t)m * NPROJ + c0;
        const u32x4 bg = *(const u32x4*)row, cg0 = *(const u32x4*)(row + 512), xv0 = *(const u32x4*)(row + 1024);
        u32x4 cg1 = {0, 0, 0, 0}, xv1 = {0, 0, 0, 0}, cg2 = {0, 0, 0, 0}, xv2 = {0, 0, 0, 0};
        if (t >= 1) { cg1 = *(const u32x4*)(row - NPROJ + 512); xv1 = *(const u32x4*)(row - NPROJ + 1024); }
        if (t >= 2) { cg2 = *(const u32x4*)(row - 2 * NPROJ + 512); xv2 = *(const u32x4*)(row - 2 * NPROJ + 1024); }
        float y[8]; float ss = 0.f;
#pragma unroll
        for (int j = 0; j < 4; ++j) {
            const float u0l = bf_lo(cg0[j]) * bf_lo(xv0[j]), u0h = bf_hi(cg0[j]) * bf_hi(xv0[j]);
            const float u1l = bf_lo(cg1[j]) * bf_lo(xv1[j]), u1h = bf_hi(cg1[j]) * bf_hi(xv1[j]);
            const float u2l = bf_lo(cg2[j]) * bf_lo(xv2[j]), u2h = bf_hi(cg2[j]) * bf_hi(xv2[j]);
            y[2 * j] = bf_lo(bg[j]) * (w0[2 * j] * u2l + w1[2 * j] * u1l + w2[2 * j] * u0l);
            y[2 * j + 1] = bf_hi(bg[j]) * (w0[2 * j + 1] * u2h + w1[2 * j + 1] * u1h + w2[2 * j + 1] * u0h);
            ss += y[2 * j] * y[2 * j] + y[2 * j + 1] * y[2 * j + 1];
        }
        ss += __shfl_xor(ss, 1); ss += __shfl_xor(ss, 2); ss += __shfl_xor(ss, 4);
        const float rstd = __builtin_amdgcn_rsqf(ss * (1.f / 64.f) + EPS);
        u32x4 o; o.x = cvtpk_s(y[0] * rstd * gg[0], y[1] * rstd * gg[1]); o.y = cvtpk_s(y[2] * rstd * gg[2], y[3] * rstd * gg[3]);
        o.z = cvtpk_s(y[4] * rstd * gg[4], y[5] * rstd * gg[5]); o.w = cvtpk_s(y[6] * rstd * gg[6], y[7] * rstd * gg[7]);
        *(u32x4*)(ymix + (size_t)m * D + c0) = o;
    }
}
constexpr int SB_K = 0, SB_V = 8192, SB_OST = 16384, SB_OSTW = 32 * 68 * 4, SB_FLAG = 90112;
static_assert(SB_OST + 8 * SB_OSTW <= SB_FLAG && SB_FLAG + 32 <= RING_BYTES, "attention LDS");
__device__ __forceinline__ int crow(int r, int hi) { return (r & 3) + 8 * (r >> 2) + 4 * hi; }
__device__ __forceinline__ void sb_attn_unit(Frame& F, int b, int h, int qb) {
    const bf16_t* proj = (const bf16_t*)(F.ws + WS_PROJ); bf16_t* ymix = (bf16_t*)(F.ws + WS_YMIX); const float* g_sb = F.in[6];
    const int tid = F.tid, lane = F.lane, wid = F.wave, r32 = lane & 31, hi = lane >> 5;
    LAS unsigned char* lds = F.lds + RING_OFF;
    const int q0 = qb * 256, qlo = q0 + wid * 32, qpos = qlo + r32;
    const size_t rowbase = (size_t)b * SEQ;
    const bf16_t* Qp = proj + (rowbase + qlo) * NPROJ + 1536 + h * 64;
    const bf16_t* Kp = proj + rowbase * NPROJ + 2048 + h * 64;
    const bf16_t* Vp = proj + rowbase * NPROJ + 2560 + h * 64;
    bf16x8 qr[4];
#pragma unroll
    for (int s = 0; s < 4; ++s) qr[s] = *(const bf16x8*)(Qp + (size_t)r32 * NPROJ + 16 * s + 8 * hi);
    bf16x8 ntri[2], nones;
#pragma unroll
    for (int s = 0; s < 2; ++s)
#pragma unroll
        for (int j = 0; j < 8; ++j) { const int k = 16 * s + 8 * (j >> 2) + 4 * hi + (j & 3); ntri[s][j] = (k > r32) ? (short)0xBF80 : (short)0; }
#pragma unroll
    for (int j = 0; j < 8; ++j) nones[j] = (short)0xBF80;
    f32x16 R = {}; f32x16 o[2]; o[0] = f32x16{}; o[1] = f32x16{};
    const int skey = tid >> 3, sc = tid & 7;
    const int koff = SB_K + skey * 128 + ((sc ^ ((skey >> 1) & 7)) << 4);
    const int voff = SB_V + (sc >> 2) * 4096 + (skey >> 4) * 1024 + (skey & 15) * 64 + (sc & 3) * 16;
    const int vb = SB_V + ((lane >> 4) & 1) * 32 + (lane & 3) * 8 + (4 * hi + ((lane & 15) >> 2)) * 64;
    int kbi = 4 * qb + 3;
    u32x4 kreg = *(const u32x4*)(Kp + (size_t)(kbi * 64 + skey) * NPROJ + sc * 8), vreg = *(const u32x4*)(Vp + (size_t)(kbi * 64 + skey) * NPROJ + sc * 8);
    LAS int* dflag = (LAS int*)(lds + SB_FLAG);
    int done = 0;
    for (; kbi >= 0; --kbi) {
        const int k0 = kbi * 64;
        __syncthreads();
        *(LAS u32x4*)(lds + koff) = kreg; *(LAS u32x4*)(lds + voff) = vreg;
        if (lane == 0) dflag[wid] = done;
        __syncthreads();
        { const u32x4 f0 = *(const LAS u32x4*)dflag, f1 = *(const LAS u32x4*)(dflag + 4); if ((f0.x & f0.y & f0.z & f0.w & f1.x & f1.y & f1.z & f1.w) != 0u) break; }
        if (kbi > 0) { kreg = *(const u32x4*)(Kp + (size_t)(k0 - 64 + skey) * NPROJ + sc * 8); vreg = *(const u32x4*)(Vp + (size_t)(k0 - 64 + skey) * NPROJ + sc * 8); }
        if (!done && k0 < qlo + 31) {
            f32x16 p0 = {}, p1 = {};
#pragma unroll
            for (int s = 0; s < 4; ++s) { const int c = 2 * s + hi;
                const bf16x8 ka = *(const LAS bf16x8*)(lds + SB_K + r32 * 128 + ((c ^ ((r32 >> 1) & 7)) << 4));
                const bf16x8 kb = *(const LAS bf16x8*)(lds + SB_K + (r32 + 32) * 128 + ((c ^ (((r32 + 32) >> 1) & 7)) << 4));
                p0 = __builtin_amdgcn_mfma_f32_32x32x16_bf16(ka, qr[s], p0, 0, 0, 0); p1 = __builtin_amdgcn_mfma_f32_32x32x16_bf16(kb, qr[s], p1, 0, 0, 0); }
            const bool diag = (k0 + 63 >= qlo);
            f32x16 s0, s1;
#pragma unroll
            for (int r = 0; r < 16; ++r) {
                const float z0 = p0[r], z1 = p1[r];
                float sp0 = fmaxf(z0, 0.f) + __builtin_amdgcn_logf(1.0f + __builtin_amdgcn_exp2f(-fabsf(z0)));
                float sp1 = fmaxf(z1, 0.f) + __builtin_amdgcn_logf(1.0f + __builtin_amdgcn_exp2f(-fabsf(z1)));
                if (diag) { const int key = k0 + crow(r, hi); if (key >= qpos) sp0 = 0.f; if (key + 32 >= qpos) sp1 = 0.f; }
                s0[r] = sp0; s1[r] = sp1; p0[r] = z0 - sp0; p1[r] = z1 - sp1;
            }
            u32x4 w00 = {cvtpk_s(s0[0], s0[1]), cvtpk_s(s0[2], s0[3]), cvtpk_s(s0[4], s0[5]), cvtpk_s(s0[6], s0[7])}, w01 = {cvtpk_s(s0[8], s0[9]), cvtpk_s(s0[10], s0[11]), cvtpk_s(s0[12], s0[13]), cvtpk_s(s0[14], s0[15])};
            u32x4 w10 = {cvtpk_s(s1[0], s1[1]), cvtpk_s(s1[2], s1[3]), cvtpk_s(s1[4], s1[5]), cvtpk_s(s1[6], s1[7])}, w11 = {cvtpk_s(s1[8], s1[9]), cvtpk_s(s1[10], s1[11]), cvtpk_s(s1[12], s1[13]), cvtpk_s(s1[14], s1[15])};
            const bf16x8 sb00 = __builtin_bit_cast(bf16x8, w00), sb01 = __builtin_bit_cast(bf16x8, w01), sb10 = __builtin_bit_cast(bf16x8, w10), sb11 = __builtin_bit_cast(bf16x8, w11);
            f32x16 rest1 = __builtin_amdgcn_mfma_f32_32x32x16_bf16(ntri[0], sb10, R, 0, 0, 0); rest1 = __builtin_amdgcn_mfma_f32_32x32x16_bf16(ntri[1], sb11, rest1, 0, 0, 0);
            f32x16 U = __builtin_amdgcn_mfma_f32_32x32x16_bf16(nones, sb10, R, 0, 0, 0); U = __builtin_amdgcn_mfma_f32_32x32x16_bf16(nones, sb11, U, 0, 0, 0);
            f32x16 rest0 = __builtin_amdgcn_mfma_f32_32x32x16_bf16(ntri[0], sb00, U, 0, 0, 0); rest0 = __builtin_amdgcn_mfma_f32_32x32x16_bf16(ntri[1], sb01, rest0, 0, 0, 0);
            R = __builtin_amdgcn_mfma_f32_32x32x16_bf16(nones, sb00, U, 0, 0, 0); R = __builtin_amdgcn_mfma_f32_32x32x16_bf16(nones, sb01, R, 0, 0, 0);
            done = __all(R[0] < -150.0f) ? 1 : 0;
#pragma unroll
            for (int r = 0; r < 16; ++r) {
                float a0 = __builtin_amdgcn_exp2f(p0[r] + rest0[r]), a1 = __builtin_amdgcn_exp2f(p1[r] + rest1[r]);
                if (diag) { const int key = k0 + crow(r, hi); if (key >= qpos) a0 = 0.f; if (key + 32 >= qpos) a1 = 0.f; }
                p0[r] = a0; p1[r] = a1;
            }
            u32x4 a00 = {cvtpk_s(p0[0], p0[1]), cvtpk_s(p0[2], p0[3]), cvtpk_s(p0[4], p0[5]), cvtpk_s(p0[6], p0[7])}, a01 = {cvtpk_s(p0[8], p0[9]), cvtpk_s(p0[10], p0[11]), cvtpk_s(p0[12], p0[13]), cvtpk_s(p0[14], p0[15])};
            u32x4 a10 = {cvtpk_s(p1[0], p1[1]), cvtpk_s(p1[2], p1[3]), cvtpk_s(p1[4], p1[5]), cvtpk_s(p1[6], p1[7])}, a11 = {cvtpk_s(p1[8], p1[9]), cvtpk_s(p1[10], p1[11]), cvtpk_s(p1[12], p1[13]), cvtpk_s(p1[14], p1[15])};
            const bf16x8 pa[4] = {__builtin_bit_cast(bf16x8, a00), __builtin_bit_cast(bf16x8, a01), __builtin_bit_cast(bf16x8, a10), __builtin_bit_cast(bf16x8, a11)};
#pragma unroll
            for (int d0 = 0; d0 < 2; ++d0)
#pragma unroll
                for (int ks = 0; ks < 4; ++ks) {
                    const s16x4 lo = __builtin_bit_cast(s16x4, __builtin_amdgcn_ds_read_tr16_b64_v4i16((LAS s16x4*)(lds + vb + d0 * 4096 + ks * 1024)));
                    const s16x4 hh = __builtin_bit_cast(s16x4, __builtin_amdgcn_ds_read_tr16_b64_v4i16((LAS s16x4*)(lds + vb + d0 * 4096 + ks * 1024 + 512)));
                    const bf16x8 vf = {lo[0], lo[1], lo[2], lo[3], hh[0], hh[1], hh[2], hh[3]};
                    o[d0] = __builtin_amdgcn_mfma_f32_32x32x16_bf16(pa[ks], vf, o[d0], 0, 0, 0);
                }
        }
    }
    LAS float* stg = (LAS float*)(lds + SB_OST + wid * SB_OSTW);
#pragma unroll
    for (int r = 0; r < 16; ++r) { const int q = crow(r, hi); stg[q * 68 + r32] = o[0][r]; stg[q * 68 + 32 + r32] = o[1][r]; }
    LDS_WAIT(); asm volatile("" ::: "memory");
    { const int q = lane >> 1, half = lane & 1; const LAS f32x4* sp = (const LAS f32x4*)(stg + q * 68 + 32 * half);
      f32x4 v[8]; float ss = 0.f;
#pragma unroll
      for (int i = 0; i < 8; ++i) { v[i] = sp[i]; ss += (v[i][0] * v[i][0] + v[i][1] * v[i][1]) + (v[i][2] * v[i][2] + v[i][3] * v[i][3]); }
      ss += __shfl_xor(ss, 1);
      const float rstd = __builtin_amdgcn_rsqf(ss * (1.f / 64.f) + EPS);
      const f32x4* gp = (const f32x4*)(g_sb + h * 64 + 32 * half);
      bf16_t* op = ymix + (rowbase + qlo + q) * D + 512 + h * 64 + 32 * half;
#pragma unroll
      for (int i = 0; i < 4; ++i) { const f32x4 g0 = gp[2 * i], g1 = gp[2 * i + 1], a = v[2 * i] * rstd * g0, c = v[2 * i + 1] * rstd * g1;
          u32x4 w; w.x = cvtpk_s(a[0], a[1]); w.y = cvtpk_s(a[2], a[3]); w.z = cvtpk_s(c[0], c[1]); w.w = cvtpk_s(c[2], c[3]); *(u32x4*)(op + 8 * i) = w; } }
    LDS_WAIT();
}
__device__ __forceinline__ void p2_mix(Frame& F) {
    conv_rows(F);
    if (F.G == 256) {
        const int bh = F.vcu >> 2, s = F.vcu & 3;
        sb_attn_unit(F, bh >> 3, bh & 7, 7 - s);
        sb_attn_unit(F, bh >> 3, bh & 7, s);
    } else {
        for (int u = F.vcu; u < 512; u += F.G) sb_attn_unit(F, u >> 6, (u >> 3) & 7, u & 7);
    }
}

__device__ __forceinline__ void p8_router(Frame& F) {
    const float* x2 = (const float*)(F.ws + WS_X2); const float* wr = (const float*)(F.ws + WS_WR); const float* b_router = F.in[15];
    float* lrstd = (float*)(F.ws + WS_LRSTD); int* ltok = (int*)(F.ws + WS_LTOK); float* lgate = (float*)(F.ws + WS_LGATE); unsigned* cnt = F.ctl + CW_CNT;
    LAS float* wl = (LAS float*)(F.lds + RING_OFF);
    for (int i = F.tid; i < D * NE / 4; i += NWAVES * 64) ((LAS f32x4*)wl)[i] = ((const f32x4*)wr)[i];
    __syncthreads();
    const int lane = F.lane, tk = lane & 15, kq = lane >> 4;
    const int gw = F.vcu * NWAVES + F.wave, NGW = F.G * NWAVES;
    for (int item = gw; item < M / 16; item += NGW) {
        const int tok = item * 16 + tk; const float* xr = x2 + (size_t)tok * D + 4 * kq;
        f32x4 acc0 = {0.f, 0.f, 0.f, 0.f}, acc1 = {0.f, 0.f, 0.f, 0.f}; float ss = 0.f;
#pragma unroll 4
        for (int s = 0; s < 64; ++s) {
            const f32x4 xv = *(const f32x4*)(xr + 16 * s); ss += (xv[0] * xv[0] + xv[1] * xv[1]) + (xv[2] * xv[2] + xv[3] * xv[3]);
#pragma unroll
            for (int j = 0; j < 4; ++j) { const LAS float* wp = wl + (16 * s + 4 * kq + j) * 32 + tk;
                acc0 = __builtin_amdgcn_mfma_f32_16x16x4f32(wp[0], xv[j], acc0, 0, 0, 0); acc1 = __builtin_amdgcn_mfma_f32_16x16x4f32(wp[16], xv[j], acc1, 0, 0, 0); }
        }
        ss += __shfl_xor(ss, 16); ss += __shfl_xor(ss, 32);
        const float rstd = __builtin_amdgcn_rsqf(ss * (1.f / D) + EPS);
        float lg[32];
#pragma unroll
        for (int q = 0; q < 4; ++q)
#pragma unroll
            for (int j = 0; j < 4; ++j) { const int src = tk + 16 * q; lg[4 * q + j] = __shfl(acc0[j], src) * rstd + b_router[4 * q + j]; lg[16 + 4 * q + j] = __shfl(acc1[j], src) * rstd + b_router[16 + 4 * q + j]; }
        float tv[4]; int ti[4]; unsigned used = 0u;
#pragma unroll
        for (int k = 0; k < 4; ++k) { float bv = -INFINITY; int bi = 0;
#pragma unroll
            for (int e = 0; e < 32; ++e) { const bool ok = !((used >> e) & 1u) && lg[e] > bv; bv = ok ? lg[e] : bv; bi = ok ? e : bi; }
            tv[k] = bv; ti[k] = bi; used |= 1u << bi; }
        const float e1 = __expf(tv[1] - tv[0]), e2 = __expf(tv[2] - tv[0]), e3 = __expf(tv[3] - tv[0]); const float inv = 1.0f / (1.0f + e1 + e2 + e3);
        const int myE = kq == 0 ? ti[0] : kq == 1 ? ti[1] : kq == 2 ? ti[2] : ti[3];
        const float myG = (kq == 0 ? 1.0f : kq == 1 ? e1 : kq == 2 ? e2 : e3) * inv;
        int rank = 0, mycount = 0;
#pragma unroll 1
        for (int e = 0; e < NE; ++e) { const unsigned long long mk = __ballot(myE == e); const int pc = __popcll(mk);
            if (myE == e) rank = __popcll(mk & ((1ull << lane) - 1ull)); if (lane == e) mycount = pc; }
        unsigned base = 0u; if (lane < NE && mycount > 0) base = atomicAdd(cnt + 64 * lane, (unsigned)mycount);
        const unsigned mybase = (unsigned)__shfl((int)base, myE);
        const size_t pos = (size_t)myE * LISTCAP + mybase + rank;
        ltok[pos] = tok * 4 + kq; lgate[pos] = myG; lrstd[pos] = rstd;
    }
}

__device__ __forceinline__ void p11_final(Frame& F) {
    const float* x2 = (const float*)(F.ws + WS_X2); const bf16_t* y = (const bf16_t*)(F.ws + WS_Y); const float* g_final = F.in[20]; float* out = F.out;
    const int gw = F.vcu * NWAVES + F.wave, NGW = F.G * NWAVES, lane = F.lane;
    for (int m = gw; m < M; m += NGW) {
        f32x4 v[4]; float ss = 0.f;
#pragma unroll
        for (int j = 0; j < 2; ++j) { const int c = 8 * lane + 512 * j; v[2 * j] = *(const f32x4*)(x2 + (size_t)m * D + c); v[2 * j + 1] = *(const f32x4*)(x2 + (size_t)m * D + c + 4);
#pragma unroll
            for (int s = 0; s < 4; ++s) { const u32x4 w = *(const u32x4*)(y + ((size_t)m * 4 + s) * D + c);
                v[2 * j][0] += bf_lo(w.x); v[2 * j][1] += bf_hi(w.x); v[2 * j][2] += bf_lo(w.y); v[2 * j][3] += bf_hi(w.y);
                v[2 * j + 1][0] += bf_lo(w.z); v[2 * j + 1][1] += bf_hi(w.z); v[2 * j + 1][2] += bf_lo(w.w); v[2 * j + 1][3] += bf_hi(w.w); } }
#pragma unroll
        for (int i = 0; i < 4; ++i) ss += (v[i][0] * v[i][0] + v[i][1] * v[i][1]) + (v[i][2] * v[i][2] + v[i][3] * v[i][3]);
        const float rstd = __builtin_amdgcn_rsqf(wave_sum(ss) * (1.f / D) + EPS);
#pragma unroll
        for (int j = 0; j < 2; ++j) { const int c = 8 * lane + 512 * j; const f32x4 g0 = *(const f32x4*)(g_final + c), g1 = *(const f32x4*)(g_final + c + 4);
            *(f32x4*)(out + (size_t)m * D + c) = v[2 * j] * rstd * g0; *(f32x4*)(out + (size_t)m * D + c + 4) = v[2 * j + 1] * rstd * g1; }
    }
}

constexpr int NPHASE = 12;
struct Args { const float* in[21]; float* out; unsigned char* ws; int ph_lo, ph_hi; };
static_assert(sizeof(Args) == 21 * 8 + 8 + 8 + 8, "Args has no padding");

__global__ void __launch_bounds__(NWAVES * 64, 2) fwd(Args args) {
    extern __shared__ __attribute__((aligned(16))) unsigned char lds[];
    Frame F;
    F.lds = (LAS unsigned char*)lds; F.MISC = (volatile LAS unsigned*)(F.lds + MISC_OFF);
    F.tid = threadIdx.x; F.lane = F.tid & 63; F.wave = __builtin_amdgcn_readfirstlane(F.tid >> 6);
    F.G = gridDim.x; { const int bx = blockIdx.x; F.vcu = (F.G % 8 == 0) ? (bx % 8) * (F.G / 8) + bx / 8 : bx; }
    F.ws = args.ws; F.ctl = (unsigned*)(args.ws + WS_CTL); F.out = args.out;
    F.in = args.in;
    for (int u = F.tid; u < (LDS_BYTES - LDSCTL_OFF) / 4; u += NWAVES * 64) ((LAS unsigned*)(F.lds + LDSCTL_OFF))[u] = 0u;
    __syncthreads();
    const int lo = args.ph_lo, hi = args.ph_hi;
    const bool single = (hi - lo) > 1;
    XcdBarrier bar; bar.bar = F.ctl + CW_BAR; bar.x = 0; bar.st = nullptr;
    if (single) bar = xcd_barrier_post(F.ctl + CW_BAR, F.MISC + 8);
#ifndef PH_MASK
#define PH_MASK 0xFFF
#endif
#define IN(k) (((PH_MASK >> (k)) & 1) && lo <= (k) && (k) < hi)
#define SEAM(k) do { if (IN(k) && IN((k) + 1)) xcd_barrier(bar); } while (0)
    unsigned char* ws = args.ws;
    const int bx = (int)blockIdx.x;

    if (IN(0)) { p0_prologue(F); }
    if (IN(0) && IN(1)) { cg::this_grid().sync(); }
    if (IN(1)) {
        pg8::OrderP1 S; S.init(ws + WS_XN, ws + WS_WIN_T, ws + WS_MEMN, ws + WS_WKV_T, F.G, bx);
        pg8::EpiP1 E{(bf16_t*)(ws + WS_PROJ), (bf16_t*)(ws + WS_KMEM), (bf16_t*)(ws + WS_VT)};
        pg8::gemm_phase<pg8::EpiP1, pg8::OrderP1, false, true, true>(F.lds + RING_OFF, D, D, D, S, E);
    }
    SEAM(1);
    if (IN(2)) { p2_mix(F); }
    SEAM(2);
    if (IN(3)) {
        pg8::OrderPlain S; S.init(ws + WS_YMIX, ws + WS_WOUT_T, D, D, M / 256, D / 256, F.G, bx);
        pg8::EpiRes E{F.in[0], (float*)(ws + WS_X1), (bf16_t*)(ws + WS_X1B), (float*)(ws + WS_SS1)};
        pg8::gemm_phase<pg8::EpiRes, pg8::OrderPlain, false, false, true>(F.lds + RING_OFF, D, D, D, S, E);
    }
    SEAM(3);
    if (IN(4)) {
        pg8::OrderPlain S; S.init(ws + WS_X1B, ws + WS_WQ_T, D, D, M / 256, D / 256, F.G, bx);
        pg8::EpiQm E{(bf16_t*)(ws + WS_QM), (const float*)(ws + WS_SS1)};
        pg8::gemm_phase<pg8::EpiQm, pg8::OrderPlain, false, false, true>(F.lds + RING_OFF, D, D, D, S, E);
    }
    SEAM(4);
    if (IN(5)) {
        if (F.G == 256) {
            pg8::OrderX<0> S; S.init(ws + WS_QM, ws + WS_KMEM, F.G, bx);
            pg8::EpiSoftmax E{(bf16_t*)(ws + WS_PB)};
            pg8::gemm_phase<pg8::EpiSoftmax, pg8::OrderX<0>, false, false, true>(F.lds + RING_OFF, D, D, XHD, S, E);
        }
    }
    SEAM(5);
    if (IN(6)) {
        pg8::OrderX<1> S; S.init(ws + WS_PB, ws + WS_VT, F.G, bx);
        pg8::EpiO E{(bf16_t*)(ws + WS_OB)};
        pg8::gemm_phase<pg8::EpiO, pg8::OrderX<1>, false, true, true>(F.lds + RING_OFF, D, MROWS, MEMLEN, S, E);
    }
    SEAM(6);
    if (IN(7)) {
        pg8::OrderPlain S; S.init(ws + WS_OB, ws + WS_WO_T, D, D, M / 256, D / 256, F.G, bx);
        pg8::EpiRes E{(const float*)(ws + WS_X1), (float*)(ws + WS_X2), (bf16_t*)(ws + WS_X2B), (float*)(ws + WS_SS2)};
        pg8::gemm_phase<pg8::EpiRes, pg8::OrderPlain, false, false, true>(F.lds + RING_OFF, D, D, D, S, E);
    }
    SEAM(7);
    if (IN(8)) { p8_router(F); }
    SEAM(8);
    if (IN(9)) {
        pg8::OrderMoe<8, true> S; S.init(F.ctl + CW_CNT, (const int*)(ws + WS_LTOK), ws + WS_X2B, ws + WS_W1_T, F.G, bx);
        pg8::EpiAct E{(bf16_t*)(ws + WS_ACT), (const float*)(ws + WS_LRSTD), F.in[17]};
        pg8::gemm_phase<pg8::EpiAct, pg8::OrderMoe<8, true>, true, true, true>(F.lds + RING_OFF, D, D, D, S, E);
    }
    SEAM(9);
    if (IN(10)) {
        pg8::OrderMoe<4, false> S; S.init(F.ctl + CW_CNT, (const int*)(ws + WS_LTOK), ws + WS_ACT, ws + WS_W2_T, F.G, bx);
        pg8::EpiY E{(bf16_t*)(ws + WS_Y), (const float*)(ws + WS_LGATE), (const int*)(ws + WS_LTOK), F.in[19]};
        pg8::gemm_phase<pg8::EpiY, pg8::OrderMoe<4, false>, false, true, true>(F.lds + RING_OFF, DEXP, DEXP, DEXP, S, E);
    }
    SEAM(10);
    if (IN(11)) { p11_final(F); }
#undef IN
#undef SEAM
}

extern "C" void kernel_launch(void* const* d_in, const int* in_sizes, int n_in, void* d_out, int out_size, void* d_ws, size_t ws_size, hipStream_t stream) {
    static int grid = 0;
    if (grid == 0) {
        if (n_in != 21 || in_sizes[0] != M * D || out_size != M * D || ws_size < WS_END) { fprintf(stderr, "kernel_launch: unexpected shapes (n_in %d, in0 %d, out %d, ws %zu)\n", n_in, n_in > 0 ? in_sizes[0] : -1, out_size, ws_size); grid = -1; return; }
        int dev = 0, cus = 0, per_cu = 0;
        if (hipGetDevice(&dev) != hipSuccess || hipDeviceGetAttribute(&cus, hipDeviceAttributeMultiprocessorCount, dev) != hipSuccess) { grid = -1; return; }
        if (hipFuncSetAttribute((const void*)fwd, hipFuncAttributeMaxDynamicSharedMemorySize, LDS_BYTES) != hipSuccess) { fprintf(stderr, "kernel_launch: hipFuncSetAttribute failed\n"); grid = -1; return; }
        if (hipOccupancyMaxActiveBlocksPerMultiprocessor(&per_cu, (const void*)fwd, NWAVES * 64, LDS_BYTES) != hipSuccess || per_cu < 1) { fprintf(stderr, "kernel_launch: occupancy query says %d\n", per_cu); per_cu = 1; }
        (void)hipGetLastError();
        grid = cus;
    }
    if (grid < 0) return;
    (void)hipMemsetAsync((char*)d_ws + WS_CTL, 0, CTL_ZERO_BYTES, stream);
    Args a{};
    for (int i = 0; i < 21; ++i) a.in[i] = (const float*)d_in[i];
    a.out = (float*)d_out; a.ws = (unsigned char*)d_ws;
    if (MK_N_LAUNCHES == 1) {
        a.ph_lo = 0; a.ph_hi = NPHASE;
        void* kargs[] = {&a};
        hipError_t e = hipLaunchCooperativeKernel((const void*)fwd, dim3(grid), dim3(NWAVES * 64), kargs, LDS_BYTES, stream);
        if (e != hipSuccess) fprintf(stderr, "kernel_launch: cooperative launch failed: %s\n", hipGetErrorString(e));
    } else {
        for (int p = 0; p < NPHASE; ++p) { a.ph_lo = p; a.ph_hi = p + 1; for (int rep = 0; rep < NREP(p); ++rep) hipLaunchKernelGGL(fwd, dim3(grid), dim3(NWAVES * 64), LDS_BYTES, stream, a); }
    }
}
```

```cpp
#include <hip/hip_runtime.h>
#include <hip/hip_cooperative_groups.h>
#include <cstdio>
#include <cstdint>
namespace cg = cooperative_groups;

#ifndef MK_N_LAUNCHES
#define MK_N_LAUNCHES 1
#endif
#ifndef DUP_MASK
#define DUP_MASK 0
#endif
#define NREP(k) (((DUP_MASK >> (k)) & 1) ? 2 : 1)

constexpr int D = 1024, BATCH = 8, SEQ = 2048, M = BATCH * SEQ, MEMLEN = 256, MROWS = BATCH * MEMLEN;
constexpr int NPROJ = 3072, NE = 32, TOPK = 4, DEXP = 1024;
constexpr int XH = 4, XHD = 256;
constexpr float EPS = 1e-5f;
constexpr float LOG2E = 1.4426950408889634f;
constexpr float C2Q = 0.125f * LOG2E;
constexpr float C2X = 0.0625f * LOG2E;
constexpr int LISTCAP = M;
constexpr int ACT_ROWS = M * TOPK + NE * 256;

#define GAS __attribute__((address_space(1)))
#define LAS __attribute__((address_space(3)))
typedef unsigned short bf16_t;
typedef short bf16x8 __attribute__((ext_vector_type(8)));
typedef short s16x4 __attribute__((ext_vector_type(4)));
typedef float f32x4 __attribute__((ext_vector_type(4)));
typedef float f32x2 __attribute__((ext_vector_type(2)));
typedef float f32x16 __attribute__((ext_vector_type(16)));
typedef unsigned u32x4 __attribute__((ext_vector_type(4)));
typedef unsigned u32x2 __attribute__((ext_vector_type(2)));
typedef GAS unsigned gu32;

constexpr size_t MiB = 1u << 20;
constexpr size_t WS_CTL = 0, CTL_ZERO_BYTES = 1 * MiB;
constexpr size_t WS_WIN_T = 2 * MiB, WS_WOUT_T = 8 * MiB, WS_WQ_T = 10 * MiB, WS_WKV_T = 12 * MiB, WS_WO_T = 16 * MiB, WS_WR = 18 * MiB;
constexpr size_t WS_MEMN = 19 * MiB, WS_KMEM = 23 * MiB, WS_VT = 27 * MiB, WS_SS1 = 31 * MiB, WS_SS2 = 32 * MiB, WS_RSTD3 = 33 * MiB, WS_LTOK = 34 * MiB, WS_LGATE = 36 * MiB, WS_LRSTD = 38 * MiB;
constexpr size_t WS_W1_T = 40 * MiB, WS_W2_T = 168 * MiB;
constexpr size_t WS_XN = 232 * MiB, WS_PROJ = 264 * MiB, WS_YMIX = 360 * MiB;
constexpr size_t WS_X1 = 392 * MiB, WS_X1B = 456 * MiB, WS_QM = 488 * MiB, WS_PB = 520 * MiB, WS_OB = 552 * MiB, WS_X2 = 584 * MiB, WS_X2B = 648 * MiB;
constexpr size_t WS_ACT = 232 * MiB;
constexpr size_t WS_Y = 392 * MiB;
constexpr size_t WS_END = 680 * MiB;
static_assert(WS_ACT + (size_t)ACT_ROWS * DEXP <= WS_X1 && WS_Y + (size_t)M * TOPK * D * 2 <= WS_PB, "overlays");
constexpr int CW_TMO = 0, CW_CODE = 1, CW_BAR = 4096, CW_CNT = 8192;

__device__ __forceinline__ unsigned cvt_pk_bf16(float lo, float hi) { unsigned r; asm volatile("v_cvt_pk_bf16_f32 %0, %1, %2" : "=v"(r) : "v"(lo), "v"(hi)); return r; }
__device__ __forceinline__ unsigned cvtpk_s(float lo, float hi) { typedef __bf16 bf16x2_t __attribute__((ext_vector_type(2))); f32x2 v = {lo, hi}; bf16x2_t b = __builtin_convertvector(v, bf16x2_t); return __builtin_bit_cast(unsigned, b); }
__device__ __forceinline__ float clamp448(float v) { return fminf(fmaxf(v, -448.0f), 448.0f); }
__device__ __forceinline__ unsigned pk_fp8x4(float a, float b, float c, float d) { int w = 0; w = __builtin_amdgcn_cvt_pk_fp8_f32(clamp448(a), clamp448(b), w, false); w = __builtin_amdgcn_cvt_pk_fp8_f32(clamp448(c), clamp448(d), w, true); return (unsigned)w; }
constexpr float W8_SCALE = 64.0f, ACT8_SCALE = 4.0f;
constexpr int E8_ONE = 0x7F7F7F7F, E8_W = 0x79797979, E8_ACT = 0x7D7D7D7D;
__device__ __forceinline__ float bf_lo(unsigned w) { return __uint_as_float(w << 16); }
__device__ __forceinline__ float bf_hi(unsigned w) { return __uint_as_float(w & 0xffff0000u); }
__device__ __forceinline__ float wave_sum(float v) {
#pragma unroll
    for (int o = 1; o < 64; o <<= 1) v += __shfl_xor(v, o);
    return v;
}
#define LDS_WAIT() asm volatile("s_waitcnt lgkmcnt(0)" ::: "memory")
#define VM_WAIT() asm volatile("s_waitcnt vmcnt(0)" ::: "memory")

namespace pg8 {
constexpr int BM = 256, BK = 64, HALF = 128, HTB = HALF * BK * 2, STAGE_BYTES = 8 * HTB, NXCD = 8, WGM = 8;
__host__ __device__ __forceinline__ int lds_byte(int r, int c) { const int st = (r >> 4) * 2 + (c >> 5), rr = r & 15, cc = c & 31, ob = rr * 64 + cc * 2; return st * 1024 + (ob ^ (((ob >> 9) & 1) << 5)); }
__host__ __device__ __forceinline__ void stage_rc(int b, int& R, int& C) { const int st = b / 1024, sb = b % 1024, swz = sb ^ (((sb >> 9) & 1) << 5); R = (st >> 1) * 16 + swz / 64; C = (st & 1) * 32 + (swz % 64) / 2; }
__host__ __device__ __forceinline__ int perm32(int rho) { const int n = rho >> 4, i = rho & 15; return 8 * (i >> 2) + 4 * n + (i & 3); }

struct Unit { const char* a; const char* b; int pm, pn; };
struct UnitK { const char* a; const char* b; int pm, pn, kind; };
struct UnitM { const char* a; const char* b; const int* tok; int pm, pn, nvalid, e, rowoff; };

struct GridOrder {
    int nM, nN, nwg;
    __device__ __forceinline__ void init(int nM_, int nN_) { nM = nM_; nN = nN_; nwg = nM * nN; }
    __device__ __forceinline__ void map(int L, int& pm, int& pn) const {
        int wgid = L; { const int q = nwg / NXCD, r = nwg % NXCD, xcd = wgid % NXCD, off = wgid / NXCD; wgid = (xcd < r ? xcd * (q + 1) : r * (q + 1) + (xcd - r) * q) + off; }
        const int nig = WGM * nN, gid = wgid / nig, fm = gid * WGM, gsz = (nM - fm) < WGM ? (nM - fm) : WGM;
        pm = fm + ((wgid % nig) % gsz); pn = (wgid % nig) / gsz;
    }
};

typedef f32x4 Acc[2][2][4][2];

template <class Epi, class Sched, bool GATHER, bool ALIGN_EPI, bool SP2, bool F8 = false, int SCA = 0x7F7F7F7F, int SCB = 0x7F7F7F7F>
__device__ __forceinline__ void gemm_phase(LAS unsigned char* lds, const int lda, const int ldb, const int K, const Sched& S, const Epi& E) {
    const int tid = threadIdx.x, wid = __builtin_amdgcn_readfirstlane(tid >> 6), lane = tid & 63, wr = wid >> 2, wc = wid & 3, fr = lane & 15, fq = lane >> 4;
    int nt = K / 128; asm volatile("" : "+s"(nt));
    int RA[2], CA[2]; unsigned voffB[2];
#pragma unroll
    for (int i = 0; i < 2; ++i) { int R, C; stage_rc(tid * 16 + i * 8192, R, C); const int Rb = Epi::PERM ? ((R & ~31) + perm32(R & 31)) : R;
        RA[i] = R; CA[i] = C; voffB[i] = (unsigned)(Rb * ldb + C * 2); }
    const size_t kstep = (size_t)(BK * 2);
    const size_t hstepB = (size_t)HALF * ldb;
    const unsigned ldsw = (unsigned)wid * 1024u;
    const int aoff = lds_byte(wr * 64 + fr, fq * 8), boff = lds_byte(wc * 32 + fr, fq * 8);
#define PG8_SA(b, h) (((b) * 2 + (h)) * HTB)
#define PG8_SB(b, h) ((4 + (b) * 2 + (h)) * HTB)
#define PG8_STAGE(bufoff, gbase, voff) do { _Pragma("unroll") for (int _i = 0; _i < 2; ++_i) \
        __builtin_amdgcn_global_load_lds((const unsigned*)((const char*)(gbase) + (voff)[_i]), (LAS unsigned*)(lds + (bufoff) + ldsw + _i * 8192), 16, 0, 0); } while (0)
#define PG8_LDA(dst, b, h) do { _Pragma("unroll") for (int m = 0; m < 4; ++m) { if constexpr (F8) { \
            dst##8[m] = __builtin_shufflevector(*(const LAS i32x4_*)(lds + PG8_SA(b, h) + aoff + m * 2048), *(const LAS i32x4_*)(lds + PG8_SA(b, h) + aoff + m * 2048 + 1024), 0, 1, 2, 3, 4, 5, 6, 7); } \
        else { _Pragma("unroll") for (int k = 0; k < 2; ++k) dst[m][k] = *(const LAS bf16x8*)(lds + PG8_SA(b, h) + aoff + m * 2048 + k * 1024); } } } while (0)
#define PG8_LDB(dst, b, h) do { _Pragma("unroll") for (int n = 0; n < 2; ++n) { if constexpr (F8) { \
            dst##8[n] = __builtin_shufflevector(*(const LAS i32x4_*)(lds + PG8_SB(b, h) + boff + n * 2048), *(const LAS i32x4_*)(lds + PG8_SB(b, h) + boff + n * 2048 + 1024), 0, 1, 2, 3, 4, 5, 6, 7); } \
        else { _Pragma("unroll") for (int k = 0; k < 2; ++k) dst[n][k] = *(const LAS bf16x8*)(lds + PG8_SB(b, h) + boff + n * 2048 + k * 1024); } } } while (0)
#define PG8_MMA(ai, bj, At, Bt) do { __builtin_amdgcn_s_setprio(1); _Pragma("unroll") for (int m = 0; m < 4; ++m) _Pragma("unroll") for (int n = 0; n < 2; ++n) { \
        if constexpr (F8) { acc[ai][bj][m][n] = __builtin_amdgcn_mfma_scale_f32_16x16x128_f8f6f4(Bt##8[n], At##8[m], acc[ai][bj][m][n], 0, 0, 0, SCA, 0, SCB); } \
        else { _Pragma("unroll") for (int k = 0; k < 2; ++k) acc[ai][bj][m][n] = __builtin_amdgcn_mfma_f32_16x16x32_bf16(Bt[n][k], At[m][k], acc[ai][bj][m][n], 0, 0, 0); } } \
        __builtin_amdgcn_s_setprio(0); } while (0)
#define PG8_WAIT_V(n) asm volatile("s_waitcnt vmcnt(" #n ")" ::: "memory")
#define PG8_WAIT_L(n) asm volatile("s_waitcnt lgkmcnt(" #n ")" ::: "memory")
#define PG8_BAR __builtin_amdgcn_s_barrier()
#define PG8_SCHED __builtin_amdgcn_sched_barrier(0)
#define PG8_VOFFA(dst, u) do { if constexpr (GATHER) { int _t[2][2]; _Pragma("unroll") for (int _h = 0; _h < 2; ++_h) _Pragma("unroll") for (int _i = 0; _i < 2; ++_i) _t[_h][_i] = (u).tok[_h * HALF + RA[_i]]; \
        _Pragma("unroll") for (int _h = 0; _h < 2; ++_h) _Pragma("unroll") for (int _i = 0; _i < 2; ++_i) { const int _row = _h * HALF + RA[_i]; const int _tt = (_row < (u).nvalid) ? (_t[_h][_i] >> 2) : 0; dst[_h][_i] = (unsigned)(_tt * lda + CA[_i] * 2); } } \
        else { _Pragma("unroll") for (int _h = 0; _h < 2; ++_h) _Pragma("unroll") for (int _i = 0; _i < 2; ++_i) dst[_h][_i] = (unsigned)((_h * HALF + RA[_i]) * lda + CA[_i] * 2); } } while (0)
#define PG8_VOFFA_LDS(dst, u, slot) do { const LAS int* _mt = (const LAS int*)(lds + 131072 + (slot) * 3072 + 1024); _Pragma("unroll") for (int _h = 0; _h < 2; ++_h) _Pragma("unroll") for (int _i = 0; _i < 2; ++_i) { \
        const int _row = _h * HALF + RA[_i]; const int _tt = (_row < (u).nvalid) ? (_mt[_row] >> 2) : 0; dst[_h][_i] = (unsigned)(_tt * lda + CA[_i] * 2); } } while (0)
    typename Sched::U cur, nxt; int ui = 0;
    if (!S.next(0, cur)) return;
    Acc acc;
#pragma unroll
    for (int a = 0; a < 2; ++a)
#pragma unroll
        for (int b = 0; b < 2; ++b)
#pragma unroll
            for (int m = 0; m < 4; ++m)
#pragma unroll
                for (int n = 0; n < 2; ++n) acc[a][b][m][n] = (f32x4){0.f, 0.f, 0.f, 0.f};
    typedef int i32x4_ __attribute__((ext_vector_type(4))); typedef int i32x8_ __attribute__((ext_vector_type(8)));
    bf16x8 At[4][2], B0[2][2], B1[2][2]; i32x8_ At8[4], B08[2], B18[2];
    unsigned vA[2][2];
    PG8_VOFFA(vA, cur);
    const char* cA = cur.a; const char* cB = cur.b;
    E.prefetch(cur, 0, lds, wid, lane);
    if constexpr (SP2) {
        PG8_STAGE(PG8_SB(0, 0), cB, voffB); PG8_STAGE(PG8_SB(0, 1), cB + hstepB, voffB); PG8_STAGE(PG8_SA(0, 0), cA, vA[0]); PG8_STAGE(PG8_SA(0, 1), cA, vA[1]);
        if (wr == 1) PG8_BAR;
        PG8_WAIT_V(2); PG8_BAR;
        PG8_STAGE(PG8_SB(1, 0), cB + kstep, voffB); PG8_STAGE(PG8_SA(1, 0), cA + kstep, vA[0]); PG8_STAGE(PG8_SB(1, 1), cB + hstepB + kstep, voffB);
        PG8_WAIT_V(6); PG8_BAR;
    } else {
        PG8_STAGE(PG8_SB(0, 0), cB, voffB); PG8_STAGE(PG8_SA(0, 0), cA, vA[0]); PG8_STAGE(PG8_SB(0, 1), cB + hstepB, voffB); PG8_STAGE(PG8_SA(0, 1), cA, vA[1]);
        if (wr == 1) PG8_BAR;
        PG8_WAIT_V(4); PG8_BAR;
        PG8_STAGE(PG8_SB(1, 0), cB + kstep, voffB); PG8_STAGE(PG8_SA(1, 0), cA + kstep, vA[0]); PG8_STAGE(PG8_SB(1, 1), cB + hstepB + kstep, voffB);
        PG8_WAIT_V(6); PG8_BAR;
    }
    for (;;) {
        const bool has_next = S.next(ui + 1, nxt);
        const char* nA = has_next ? nxt.a : cA; const char* nB = has_next ? nxt.b : cB;
        if (has_next) E.prefetch(nxt, ui + 1, lds, wid, lane);
        for (int t = 0; t < nt; t += 2) {
            const bool last = (t == nt - 2);
            asm volatile("" : "+v"(vA[0][0]), "+v"(vA[0][1]), "+v"(vA[1][0]), "+v"(vA[1][1]), "+v"(voffB[0]), "+v"(voffB[1]));
            const char* a1 = cA + (size_t)(t + 1) * kstep;
            const char* a2 = last ? nA : cA + (size_t)(t + 2) * kstep; const char* b2 = last ? nB : cB + (size_t)(t + 2) * kstep;
            const char* a3 = a2 + kstep; const char* b3 = b2 + kstep;
            if constexpr (SP2) {
            PG8_LDB(B0, 0, 0); PG8_LDB(B1, 0, 1); PG8_SCHED; PG8_LDA(At, 0, 0); PG8_STAGE(PG8_SA(1, 1), a1, vA[1]); if (last && has_next) { if constexpr (GATHER) { PG8_VOFFA_LDS(vA, nxt, (ui + 1) % 3); } else { PG8_VOFFA(vA, nxt); } }
            PG8_WAIT_V(8); PG8_WAIT_L(0); PG8_BAR; PG8_MMA(0, 0, At, B0); PG8_MMA(0, 1, At, B1); PG8_BAR; PG8_SCHED;
            PG8_LDA(At, 0, 1); PG8_STAGE(PG8_SB(0, 0), b2, voffB); PG8_STAGE(PG8_SB(0, 1), b2 + hstepB, voffB); PG8_STAGE(PG8_SA(0, 0), a2, vA[0]);
            PG8_WAIT_V(8); PG8_WAIT_L(0); PG8_BAR; PG8_MMA(1, 0, At, B0); PG8_MMA(1, 1, At, B1); PG8_BAR; PG8_SCHED;
            PG8_LDB(B0, 1, 0); PG8_LDB(B1, 1, 1); PG8_SCHED; PG8_LDA(At, 1, 0); PG8_STAGE(PG8_SA(0, 1), a2, vA[1]);
            PG8_WAIT_V(8); PG8_WAIT_L(0); PG8_BAR; PG8_MMA(0, 0, At, B0); PG8_MMA(0, 1, At, B1); PG8_BAR; PG8_SCHED;
            PG8_LDA(At, 1, 1); PG8_STAGE(PG8_SB(1, 0), b3, voffB); PG8_STAGE(PG8_SB(1, 1), b3 + hstepB, voffB); PG8_STAGE(PG8_SA(1, 0), a3, vA[0]);
            PG8_WAIT_V(8); PG8_WAIT_L(0); PG8_BAR; PG8_MMA(1, 0, At, B0); PG8_MMA(1, 1, At, B1); PG8_BAR; PG8_SCHED;
            } else {
            PG8_LDB(B0, 0, 0); PG8_SCHED; PG8_LDA(At, 0, 0); PG8_STAGE(PG8_SA(1, 1), a1, vA[1]); if (last && has_next) { if constexpr (GATHER) { PG8_VOFFA_LDS(vA, nxt, (ui + 1) % 3); } else { PG8_VOFFA(vA, nxt); } }
            PG8_WAIT_L(8); PG8_BAR; PG8_WAIT_L(0); PG8_MMA(0, 0, At, B0); PG8_BAR; PG8_SCHED;
            PG8_LDB(B1, 0, 1); PG8_STAGE(PG8_SB(0, 0), b2, voffB);
            PG8_BAR; PG8_WAIT_L(0); PG8_MMA(0, 1, At, B1); PG8_BAR;
            PG8_LDA(At, 0, 1); PG8_STAGE(PG8_SA(0, 0), a2, vA[0]);
            PG8_BAR; PG8_WAIT_L(0); PG8_MMA(1, 0, At, B0); PG8_BAR; PG8_SCHED;
            PG8_STAGE(PG8_SB(0, 1), b2 + hstepB, voffB);
            PG8_WAIT_V(6); PG8_BAR; PG8_MMA(1, 1, At, B1); PG8_BAR;
            PG8_LDB(B0, 1, 0); PG8_SCHED; PG8_LDA(At, 1, 0); PG8_STAGE(PG8_SA(0, 1), a2, vA[1]);
            PG8_WAIT_L(8); PG8_BAR; PG8_WAIT_L(0); PG8_MMA(0, 0, At, B0); PG8_BAR; PG8_SCHED;
            PG8_LDB(B1, 1, 1); PG8_STAGE(PG8_SB(1, 0), b3, voffB);
            PG8_BAR; PG8_WAIT_L(0); PG8_MMA(0, 1, At, B1); PG8_BAR;
            PG8_LDA(At, 1, 1); PG8_STAGE(PG8_SA(1, 0), a3, vA[0]);
            PG8_BAR; PG8_WAIT_L(0); PG8_MMA(1, 0, At, B0); PG8_BAR; PG8_SCHED;
            PG8_STAGE(PG8_SB(1, 1), b3 + hstepB, voffB);
            PG8_WAIT_V(6); PG8_BAR; PG8_MMA(1, 1, At, B1); PG8_BAR;
            }
        }
        if constexpr (ALIGN_EPI) { if (wr == 0) PG8_BAR; }
        if constexpr (!Epi::AFTER_DRAIN) { E(acc, cur, ui, lds, wr, wc, fr, fq); }
        if (!has_next) break;
#pragma unroll
        for (int a = 0; a < 2; ++a)
#pragma unroll
            for (int b = 0; b < 2; ++b)
#pragma unroll
                for (int m = 0; m < 4; ++m)
#pragma unroll
                    for (int n = 0; n < 2; ++n) acc[a][b][m][n] = (f32x4){0.f, 0.f, 0.f, 0.f};
        cur = nxt; cA = nA; cB = nB; ++ui;
        if constexpr (ALIGN_EPI) { if (wr == 1) PG8_BAR; }
    }
    PG8_WAIT_V(0);
    if constexpr (!ALIGN_EPI) { if (wr == 0) PG8_BAR; }
    PG8_BAR;
    if constexpr (Epi::AFTER_DRAIN) { E.fused(acc, cur, wr, wc, fr, fq, lds, wid, lane); }
#undef PG8_SA
#undef PG8_SB
#undef PG8_STAGE
#undef PG8_LDA
#undef PG8_LDB
#undef PG8_MMA
#undef PG8_WAIT_V
#undef PG8_WAIT_L
#undef PG8_BAR
#undef PG8_SCHED
#undef PG8_VOFFA
#undef PG8_VOFFA_LDS
}

struct OrderKV {
    typedef UnitK U;
    const char *memn, *wkv_t; int c;
    __device__ __forceinline__ void init(const void* memn_, const void* wkv_t_, int c_) { memn = (const char*)memn_; wkv_t = (const char*)wkv_t_; c = c_; }
    __device__ __forceinline__ bool next(int i, UnitK& u) const {
        if (i > 0 || c >= 64) return false;
        int r = c;
        if (r < 32) { u.kind = 1; u.pm = r >> 2; u.pn = r & 3; u.a = memn + (size_t)u.pm * 256 * D * 2; u.b = wkv_t + (size_t)u.pn * 256 * D * 2; return true; }
        r -= 32;
        u.kind = 2; u.pm = r >> 3; u.pn = r & 7; u.a = wkv_t + (size_t)(D + u.pm * 256) * D * 2; u.b = memn + (size_t)u.pn * 256 * D * 2; return true;
    }
};
struct OrderIn {
    typedef UnitK U;
    const char *A, *Bt; int G, c; GridOrder g0;
    __device__ __forceinline__ void init(const void* A_, const void* Bt_, int G_, int c_) { A = (const char*)A_; Bt = (const char*)Bt_; G = G_; c = c_; g0.init(M / 256, NPROJ / 256); }
    __device__ __forceinline__ bool next(int i, UnitK& u) const {
        const int L = i * G + c; if (L >= g0.nwg) return false;
        g0.map(L, u.pm, u.pn); u.kind = 0; u.a = A + (size_t)u.pm * 256 * D * 2; u.b = Bt + (size_t)u.pn * 256 * D * 2; return true;
    }
};
struct OrderPlain {
    typedef Unit U;
    const char *A, *Bt; int lda, ldb, G, c; GridOrder g0;
    __device__ __forceinline__ void init(const void* A_, const void* Bt_, int lda_, int ldb_, int nM, int nN, int G_, int c_) { A = (const char*)A_; Bt = (const char*)Bt_; lda = lda_; ldb = ldb_; G = G_; c = c_; g0.init(nM, nN); }
    __device__ __forceinline__ bool next(int i, Unit& u) const {
        const int L = i * G + c; if (L >= g0.nwg) return false;
        g0.map(L, u.pm, u.pn);
        u.a = A + (size_t)u.pm * 256 * lda * 2; u.b = Bt + (size_t)u.pn * 256 * ldb * 2; return true;
    }
};
template <int MODE> struct OrderX {
    typedef Unit U;
    const char *A, *Bt; int G, c;
    __device__ __forceinline__ void init(const void* A_, const void* Bt_, int G_, int c_) { A = (const char*)A_; Bt = (const char*)Bt_; G = G_; c = c_; }
    __device__ __forceinline__ bool next(int i, Unit& u) const {
        const int L = i * G + c; if (L >= (M / 256) * XH) return false;
        const int xcd = L & 7, j = L >> 3; u.pm = xcd * 8 + (j >> 2); u.pn = j & 3;
        const int b = u.pm >> 3;
        u.a = A + ((size_t)u.pm * 256 * D + (size_t)u.pn * XHD) * 2;
        if (MODE == 0) u.b = Bt + ((size_t)b * MEMLEN * D + (size_t)u.pn * XHD) * 2;
        else u.b = Bt + ((size_t)u.pn * XHD * MROWS + (size_t)b * MEMLEN) * 2;
        return true;
    }
};
template <int NTN, bool G1> struct OrderMoe {
    typedef UnitM U;
    const int* ltok; const char* A; const char* Bt; int G, c; int seg[4], til[4], cn[4];
    __device__ __forceinline__ void init(const unsigned* cnt, const int* ltok_, const void* A_, const void* Bt_, int G_, int c_) {
        ltok = ltok_; A = (const char*)A_; Bt = (const char*)Bt_; G = G_; c = c_;
        const int lane = threadIdx.x & 63; const int cv = (lane < NE) ? (int)__hip_atomic_load(cnt + 64 * lane, __ATOMIC_RELAXED, __HIP_MEMORY_SCOPE_AGENT) : 0;
        const int t = (cv + 255) >> 8; int incl = t;
#pragma unroll
        for (int o = 1; o < 32; o <<= 1) { const int v = __shfl_up(incl, o); if (lane >= o) incl += v; }
        const int excl = incl - t, xcd = c & 7;
#pragma unroll
        for (int q = 0; q < 4; ++q) { seg[q] = __builtin_amdgcn_readlane(excl, xcd + 8 * q); til[q] = __builtin_amdgcn_readlane(t, xcd + 8 * q); cn[q] = __builtin_amdgcn_readlane(cv, xcd + 8 * q); }
    }
    __device__ __forceinline__ bool next(int i, UnitM& u) const {
        const int xcd = c & 7, slot = c >> 3, nslot = G >> 3; int j = i * nslot + slot;
#pragma unroll
        for (int q = 0; q < 4; ++q) {
            const int nu = til[q] * NTN;
            if (j < nu) { const int e = xcd + 8 * q, mt = j / NTN, nt = j % NTN;
                u.e = e; u.pm = mt; u.pn = nt; u.rowoff = (seg[q] + mt) * 256; u.nvalid = cn[q] - mt * 256 < 256 ? cn[q] - mt * 256 : 256; u.tok = ltok + (size_t)e * LISTCAP + mt * 256;
                if (G1) { u.a = A; u.b = Bt + ((size_t)e * 2048 + (size_t)nt * 256) * D; }
                else { u.a = A + (size_t)u.rowoff * DEXP; u.b = Bt + ((size_t)e * 1024 + (size_t)nt * 256) * DEXP; }
                return true; }
            j -= nu;
        }
        return false;
    }
};

struct EpiP1 {
    static constexpr bool PERM = true, AFTER_DRAIN = false;
    bf16_t *proj, *kmem, *vt;
    __device__ __forceinline__ void prefetch(const UnitK&, int, LAS unsigned char*, int, int) const {}
    __device__ __forceinline__ void operator()(const Acc& acc, const UnitK& u, int, LAS unsigned char*, int wr, int wc, int fr, int fq) const {
        bf16_t* base; int ldc; float sc = 1.f;
        if (u.kind == 0) { base = proj; ldc = NPROJ; if (u.pn >= 6 && u.pn < 8) sc = C2Q; } else if (u.kind == 1) { base = kmem; ldc = D; } else { base = vt; ldc = MROWS; }
        const int row0 = u.pm * BM + wr * 64 + fr, col0 = u.pn * BM + wc * 32 + 8 * fq;
#pragma unroll
        for (int ai = 0; ai < 2; ++ai)
#pragma unroll
            for (int m = 0; m < 4; ++m) { bf16_t* rowp = base + (size_t)(row0 + ai * HALF + m * 16) * ldc + col0;
#pragma unroll
                for (int bj = 0; bj < 2; ++bj) { const f32x4 v0 = acc[ai][bj][m][0] * sc, v1 = acc[ai][bj][m][1] * sc;
                    u32x4 w; w.x = cvt_pk_bf16(v0[0], v0[1]); w.y = cvt_pk_bf16(v0[2], v0[3]); w.z = cvt_pk_bf16(v1[0], v1[1]); w.w = cvt_pk_bf16(v1[2], v1[3]);
                    *(u32x4*)(rowp + bj * HALF) = w; } }
    }
};
template <bool OUT8> struct EpiRes {
    static constexpr bool PERM = true, AFTER_DRAIN = true;
    const float* base; float* xo; bf16_t* xb; float* ss;
    __device__ __forceinline__ void prefetch(const Unit&, int, LAS unsigned char*, int, int) const {}
    __device__ __forceinline__ void fused(Acc& acc, const Unit& u, int wr, int wc, int fr, int fq, LAS unsigned char* lds, int wid, int lane) const {
        LAS float* PSS = (LAS float*)lds;
        const int col0 = u.pn * BM + wc * 32 + 8 * fq;
#pragma unroll
        for (int ai = 0; ai < 2; ++ai)
#pragma unroll
            for (int m = 0; m < 4; ++m) { const int r = ai * HALF + wr * 64 + m * 16 + fr; const size_t off = (size_t)(u.pm * BM + r) * D + col0; float sq = 0.f;
#pragma unroll
                for (int bj = 0; bj < 2; ++bj) { const f32x4 b0 = *(const f32x4*)(base + off + bj * HALF), b1 = *(const f32x4*)(base + off + bj * HALF + 4);
                    const f32x4 o0 = b0 + acc[ai][bj][m][0], o1 = b1 + acc[ai][bj][m][1];
                    *(f32x4*)(xo + off + bj * HALF) = o0; *(f32x4*)(xo + off + bj * HALF + 4) = o1;
                    if constexpr (OUT8) { u32x2 w; w.x = pk_fp8x4(o0[0], o0[1], o0[2], o0[3]); w.y = pk_fp8x4(o1[0], o1[1], o1[2], o1[3]); *(u32x2*)((unsigned char*)xb + off + bj * HALF) = w; }
                    else { u32x4 w; w.x = cvt_pk_bf16(o0[0], o0[1]); w.y = cvt_pk_bf16(o0[2], o0[3]); w.z = cvt_pk_bf16(o1[0], o1[1]); w.w = cvt_pk_bf16(o1[2], o1[3]); *(u32x4*)(xb + off + bj * HALF) = w; }
                    sq += ((o0[0] * o0[0] + o0[1] * o0[1]) + (o0[2] * o0[2] + o0[3] * o0[3])) + ((o1[0] * o1[0] + o1[1] * o1[1]) + (o1[2] * o1[2] + o1[3] * o1[3])); }
                sq += __shfl_xor(sq, 16); sq += __shfl_xor(sq, 32);
                if (fq == 0) PSS[r * 4 + wc] = sq; }
        __syncthreads();
        if (threadIdx.x < 256) { const f32x4 p = *(const LAS f32x4*)(PSS + threadIdx.x * 4); ss[(size_t)(u.pm * BM + threadIdx.x) * 4 + u.pn] = (p[0] + p[1]) + (p[2] + p[3]); }
        __syncthreads();
    }
};
__device__ __forceinline__ float rstd_from_ss(const float* ss, int row) {
    const f32x4 a = *(const f32x4*)(ss + (size_t)row * 4);
    return __builtin_amdgcn_rsqf(((a[0] + a[1]) + (a[2] + a[3])) * (1.0f / D) + EPS);
}
struct EpiQm {
    static constexpr bool PERM = true, AFTER_DRAIN = true;
    bf16_t* qm; const float* ss;
    __device__ __forceinline__ void prefetch(const Unit&, int, LAS unsigned char*, int, int) const {}
    __device__ __forceinline__ void fused(Acc& acc, const Unit& u, int wr, int wc, int fr, int fq, LAS unsigned char* lds, int wid, int lane) const {
        const int row0 = u.pm * BM + wr * 64 + fr, col0 = u.pn * BM + wc * 32 + 8 * fq;
        float sc[2][4];
#pragma unroll
        for (int ai = 0; ai < 2; ++ai)
#pragma unroll
            for (int m = 0; m < 4; ++m) sc[ai][m] = rstd_from_ss(ss, row0 + ai * HALF + m * 16) * C2X;
#pragma unroll
        for (int ai = 0; ai < 2; ++ai)
#pragma unroll
            for (int m = 0; m < 4; ++m) { const int row = row0 + ai * HALF + m * 16; bf16_t* rowp = qm + (size_t)row * D + col0;
#pragma unroll
                for (int bj = 0; bj < 2; ++bj) { const f32x4 v0 = acc[ai][bj][m][0] * sc[ai][m], v1 = acc[ai][bj][m][1] * sc[ai][m];
                    u32x4 w; w.x = cvt_pk_bf16(v0[0], v0[1]); w.y = cvt_pk_bf16(v0[2], v0[3]); w.z = cvt_pk_bf16(v1[0], v1[1]); w.w = cvt_pk_bf16(v1[2], v1[3]);
                    *(u32x4*)(rowp + bj * HALF) = w; } }
    }
};
struct EpiSoftmax {
    static constexpr bool PERM = true, AFTER_DRAIN = true;
    bf16_t* pb;
    __device__ __forceinline__ void prefetch(const Unit&, int, LAS unsigned char*, int, int) const {}
    __device__ __forceinline__ void fused(Acc& acc, const Unit& u, int wr, int wc, int fr, int fq, LAS unsigned char* lds, int wid, int lane) const {
        LAS float* PM = (LAS float*)lds;
        LAS float* PS = (LAS float*)(lds + 4096);
#pragma unroll
        for (int ai = 0; ai < 2; ++ai)
#pragma unroll
            for (int m = 0; m < 4; ++m) { float mx = -INFINITY;
#pragma unroll
                for (int bj = 0; bj < 2; ++bj)
#pragma unroll
                    for (int n = 0; n < 2; ++n) { const f32x4 x = acc[ai][bj][m][n]; mx = fmaxf(mx, fmaxf(fmaxf(x[0], x[1]), fmaxf(x[2], x[3]))); }
                mx = fmaxf(mx, __shfl_xor(mx, 16)); mx = fmaxf(mx, __shfl_xor(mx, 32));
                if (fq == 0) PM[(ai * HALF + wr * 64 + m * 16 + fr) * 4 + wc] = mx; }
        __syncthreads();
#pragma unroll
        for (int ai = 0; ai < 2; ++ai)
#pragma unroll
            for (int m = 0; m < 4; ++m) { const int r = ai * HALF + wr * 64 + m * 16 + fr; const f32x4 pm4 = *(const LAS f32x4*)(PM + r * 4);
                const float mx = fmaxf(fmaxf(pm4[0], pm4[1]), fmaxf(pm4[2], pm4[3])); float s = 0.f;
#pragma unroll
                for (int bj = 0; bj < 2; ++bj)
#pragma unroll
                    for (int n = 0; n < 2; ++n) { f32x4 x = acc[ai][bj][m][n];
#pragma unroll
                        for (int j = 0; j < 4; ++j) { x[j] = __builtin_amdgcn_exp2f(x[j] - mx); s += x[j]; }
                        acc[ai][bj][m][n] = x; }
                s += __shfl_xor(s, 16); s += __shfl_xor(s, 32);
                if (fq == 0) PS[r * 4 + wc] = s; }
        __syncthreads();
        const int row0 = u.pm * BM + wr * 64 + fr, col0 = u.pn * XHD + wc * 32 + 8 * fq;
#pragma unroll
        for (int ai = 0; ai < 2; ++ai)
#pragma unroll
            for (int m = 0; m < 4; ++m) { const int r = ai * HALF + wr * 64 + m * 16 + fr; const f32x4 ps4 = *(const LAS f32x4*)(PS + r * 4);
                const float inv = 1.0f / ((ps4[0] + ps4[1]) + (ps4[2] + ps4[3])); bf16_t* rowp = pb + (size_t)(row0 + ai * HALF + m * 16) * D + col0;
#pragma unroll
                for (int bj = 0; bj < 2; ++bj) { const f32x4 v0 = acc[ai][bj][m][0] * inv, v1 = acc[ai][bj][m][1] * inv;
                    u32x4 w; w.x = cvt_pk_bf16(v0[0], v0[1]); w.y = cvt_pk_bf16(v0[2], v0[3]); w.z = cvt_pk_bf16(v1[0], v1[1]); w.w = cvt_pk_bf16(v1[2], v1[3]);
                    *(u32x4*)(rowp + bj * HALF) = w; } }
        __syncthreads();
    }
};
struct EpiO {
    static constexpr bool PERM = true, AFTER_DRAIN = false;
    bf16_t* ob;
    __device__ __forceinline__ void prefetch(const Unit&, int, LAS unsigned char*, int, int) const {}
    __device__ __forceinline__ void operator()(const Acc& acc, const Unit& u, int, LAS unsigned char*, int wr, int wc, int fr, int fq) const {
        const int row0 = u.pm * BM + wr * 64 + fr, col0 = u.pn * BM + wc * 32 + 8 * fq;
#pragma unroll
        for (int ai = 0; ai < 2; ++ai)
#pragma unroll
            for (int m = 0; m < 4; ++m) { bf16_t* rowp = ob + (size_t)(row0 + ai * HALF + m * 16) * D + col0;
#pragma unroll
                for (int bj = 0; bj < 2; ++bj) { const f32x4 v0 = acc[ai][bj][m][0], v1 = acc[ai][bj][m][1];
                    u32x4 w; w.x = cvt_pk_bf16(v0[0], v0[1]); w.y = cvt_pk_bf16(v0[2], v0[3]); w.z = cvt_pk_bf16(v1[0], v1[1]); w.w = cvt_pk_bf16(v1[2], v1[3]);
                    *(u32x4*)(rowp + bj * HALF) = w; } }
    }
};
constexpr int META_OFF = 131072, META_BYTES = 3072;
__device__ __forceinline__ void dma4(const void* g, LAS unsigned char* l) { __builtin_amdgcn_global_load_lds((const unsigned*)g, (LAS unsigned*)l, 4, 0, 0); }
__device__ __forceinline__ void dma16(const void* g, LAS unsigned char* l) { __builtin_amdgcn_global_load_lds((const unsigned*)g, (LAS unsigned*)l, 16, 0, 0); }
struct EpiAct {
    static constexpr bool PERM = true, AFTER_DRAIN = false;
    bf16_t* act; const float* lrstd; const float* b1;
    __device__ __forceinline__ void prefetch(const UnitM& u, int ui, LAS unsigned char* lds, int wid, int lane) const {
        LAS unsigned char* mb = lds + META_OFF + (ui % 3) * META_BYTES;
        if (wid < 4) dma4(lrstd + (size_t)u.e * LISTCAP + u.pm * 256 + wid * 64 + lane, mb + wid * 256);
        else dma4(u.tok + (wid - 4) * 64 + lane, mb + 1024 + (wid - 4) * 256);
        if (wid == 4) dma16(b1 + (size_t)u.e * 2048 + (lane >> 5) * 1024 + u.pn * 128 + (lane & 31) * 4, mb + 2048);
    }
    __device__ __forceinline__ void operator()(const Acc& acc, const UnitM& u, int ui, LAS unsigned char* lds, int wr, int wc, int fr, int fq) const {
        const LAS unsigned char* mb = lds + META_OFF + (ui % 3) * META_BYTES;
        const int cl = wc * 32 + 8 * fq, gcol = u.pn * 128 + cl; const LAS float* bg = (const LAS float*)(mb + 2048) + cl; const LAS float* bl = bg + 128;
        const f32x4 bg0 = *(const LAS f32x4*)bg, bg1 = *(const LAS f32x4*)(bg + 4), bl0 = *(const LAS f32x4*)bl, bl1 = *(const LAS f32x4*)(bl + 4);
        int rb = wr * 64 + fr; asm volatile("" : "+v"(rb));
#pragma unroll
        for (int ai = 0; ai < 2; ++ai)
#pragma unroll
            for (int m = 0; m < 4; ++m) { const int r = ai * HALF + m * 16 + rb; const float rs = ((const LAS float*)mb)[r] * (1.0f / W8_SCALE);
                float o[8];
#pragma unroll
                for (int n = 0; n < 2; ++n) { const f32x4 g4 = acc[ai][0][m][n] * rs + (n ? bg1 : bg0), l4 = acc[ai][1][m][n] * rs + (n ? bl1 : bl0);
#pragma unroll
                    for (int j = 0; j < 4; ++j) { const float g = fminf(g4[j], 7.0f), l = fminf(fmaxf(l4[j], -7.0f), 7.0f);
                        const float sg = __builtin_amdgcn_rcpf(1.0f + __builtin_amdgcn_exp2f(g * (-1.702f * LOG2E))); o[n * 4 + j] = g * sg * (l + 1.0f); } }
                u32x2 w; w.x = pk_fp8x4(o[0] * ACT8_SCALE, o[1] * ACT8_SCALE, o[2] * ACT8_SCALE, o[3] * ACT8_SCALE); w.y = pk_fp8x4(o[4] * ACT8_SCALE, o[5] * ACT8_SCALE, o[6] * ACT8_SCALE, o[7] * ACT8_SCALE);
                *(u32x2*)((unsigned char*)act + (size_t)(u.rowoff + r) * DEXP + gcol) = w; }
    }
};
struct EpiY {
    static constexpr bool PERM = true, AFTER_DRAIN = false;
    bf16_t* y; const float* lgate; const int* ltok; const float* b2;
    __device__ __forceinline__ void prefetch(const UnitM& u, int ui, LAS unsigned char* lds, int wid, int lane) const {
        LAS unsigned char* mb = lds + META_OFF + (ui % 3) * META_BYTES;
        const size_t li = (size_t)u.e * LISTCAP + u.pm * 256 + (wid & 3) * 64 + lane;
        if (wid < 4) dma4(lgate + li, mb + wid * 256); else dma4(ltok + li, mb + 1024 + (wid - 4) * 256);
        if (wid == 0) dma16(b2 + (size_t)u.e * D + u.pn * 256 + lane * 4, mb + 2048);
    }
    __device__ __forceinline__ void operator()(const Acc& acc, const UnitM& u, int ui, LAS unsigned char* lds, int wr, int wc, int fr, int fq) const {
        const LAS unsigned char* mb = lds + META_OFF + (ui % 3) * META_BYTES;
        const int cl = wc * 32 + 8 * fq, col0 = u.pn * BM + cl; const LAS float* bb = (const LAS float*)(mb + 2048) + cl;
        int rb = wr * 64 + fr; asm volatile("" : "+v"(rb));
#pragma unroll
        for (int bj = 0; bj < 2; ++bj) {
            const f32x4 bv0 = *(const LAS f32x4*)(bb + bj * HALF), bv1 = *(const LAS f32x4*)(bb + bj * HALF + 4);
#pragma unroll
            for (int ai = 0; ai < 2; ++ai)
#pragma unroll
                for (int m = 0; m < 4; ++m) { const int r = ai * HALF + m * 16 + rb;
                    if (r < u.nvalid) { const int ent = ((const LAS int*)(mb + 1024))[r]; const float gw = ((const LAS float*)mb)[r]; bf16_t* rowp = y + (size_t)ent * D + col0;
                        const f32x4 v0 = (acc[ai][bj][m][0] * (1.0f / (W8_SCALE * ACT8_SCALE)) + bv0) * gw, v1 = (acc[ai][bj][m][1] * (1.0f / (W8_SCALE * ACT8_SCALE)) + bv1) * gw;
                        u32x4 w; w.x = cvt_pk_bf16(v0[0], v0[1]); w.y = cvt_pk_bf16(v0[2], v0[3]); w.z = cvt_pk_bf16(v1[0], v1[1]); w.w = cvt_pk_bf16(v1[2], v1[3]);
                        *(u32x4*)(rowp + bj * HALF) = w; } }
        }
    }
};
}

#define XB_TMO      128
#define XB_XCNT(j)  (256  + 64 * (j))
#define XB_XSUB(j)  (1280 + 64 * (j))
#define XB_XGEN(j)  (2304 + 64 * (j))
#define XB_TOP      3328
#define XB_TOPGEN   3392
#define XCD_BAR_WORDS 3456
#define XB_SPIN_CAP (1u << 18)
__device__ __forceinline__ unsigned xb_ld(unsigned* p)              { return __hip_atomic_load(p, __ATOMIC_RELAXED, __HIP_MEMORY_SCOPE_AGENT); }
__device__ __forceinline__ unsigned xb_add(unsigned* p, unsigned v) { return __hip_atomic_fetch_add(p, v, __ATOMIC_RELAXED, __HIP_MEMORY_SCOPE_AGENT); }
__device__ __forceinline__ unsigned xb_xcc_id() { return (unsigned)__builtin_amdgcn_s_getreg((3 << 11) | 20) & 0xFu; }
#define XB_SPIN(cond, bar) do { unsigned _sp = 0; while (cond) { __builtin_amdgcn_s_sleep(1); \
    if ((++_sp & 255u) == 0u) { if (xb_ld(&(bar)[XB_TMO])) break; if (_sp > XB_SPIN_CAP) { atomicAdd(&(bar)[XB_TMO], 1u); break; } } } } while (0)
struct XcdBarrier { unsigned* bar; unsigned x; volatile LAS unsigned* st; };
__device__ __forceinline__ XcdBarrier xcd_barrier_post(unsigned* bar, volatile LAS unsigned* st) {
    XcdBarrier b; b.bar = bar; b.x = xb_xcc_id(); b.st = st;
    if (threadIdx.x == 0) (void)xb_add(&bar[XB_XCNT(b.x)], 1u);
    return b;
}
__device__ __forceinline__ void xcd_barrier_complete(unsigned* bar, unsigned x, unsigned& nloc, unsigned& nx) {
    const unsigned G = gridDim.x * gridDim.y * gridDim.z;
    unsigned sum, cnt, mine, sp = 0u;
    for (;;) {
        sum = 0u; cnt = 0u; mine = 0u;
#pragma unroll
        for (unsigned j = 0; j < 16; ++j) { const unsigned c = xb_ld(&bar[XB_XCNT(j)]); sum += c; cnt += (c > 0u) ? 1u : 0u; mine = (j == x) ? c : mine; }
        if (sum == G) break;
        __builtin_amdgcn_s_sleep(1);
        if ((++sp & 255u) == 0u) { if (xb_ld(&bar[XB_TMO])) break; if (sp > XB_SPIN_CAP) { atomicAdd(&bar[XB_TMO], 1u); break; } }
    }
    nloc = mine > 0u ? mine : 1u; nx = cnt > 0u ? cnt : 1u;
}
__device__ __forceinline__ void xcd_barrier(const XcdBarrier& b) {
    asm volatile("s_waitcnt vmcnt(0)" ::: "memory");
    __syncthreads();
    if (threadIdx.x == 0) {
        unsigned* bar = b.bar;
        __builtin_amdgcn_s_waitcnt(0);
        unsigned nloc = b.st[0], nx = b.st[1];
        if (nloc == 0u) { xcd_barrier_complete(bar, b.x, nloc, nx); b.st[0] = nloc; b.st[1] = nx; }
        const unsigned old = xb_add(&bar[XB_XSUB(b.x)], 1u);
        const unsigned gen = old / nloc;
        if (old + 1u == (gen + 1u) * nloc) {
            __builtin_amdgcn_fence(__ATOMIC_RELEASE, "agent");
            asm volatile("s_waitcnt vmcnt(0)" ::: "memory");
            const unsigned og = xb_add(&bar[XB_TOP], 1u);
            const unsigned tg = og / nx;
            if (og + 1u == (tg + 1u) * nx) xb_add(&bar[XB_TOPGEN], 1u);
            else XB_SPIN(xb_ld(&bar[XB_TOPGEN]) == tg, bar);
            __builtin_amdgcn_fence(__ATOMIC_ACQUIRE, "agent");
            xb_add(&bar[XB_XGEN(b.x)], 1u);
            asm volatile("s_waitcnt vmcnt(0)" ::: "memory");
        } else {
            XB_SPIN(xb_ld(&bar[XB_XGEN(b.x)]) == gen, bar);
            __builtin_amdgcn_fence(__ATOMIC_ACQUIRE, "agent");
            asm volatile("s_waitcnt vmcnt(0)" ::: "memory");
        }
    }
    __syncthreads();
}

constexpr int NWAVES = 8;
constexpr int RING_OFF = 0, RING_BYTES = 131072;
constexpr int LDSCTL_OFF = RING_BYTES + 12288, MISC_OFF = LDSCTL_OFF + 320;
constexpr int LDS_BYTES = 147456;
static_assert(MISC_OFF + 128 <= LDS_BYTES, "LDS map");

struct Frame {
    LAS unsigned char* lds; volatile LAS unsigned* MISC; unsigned* ctl; unsigned char* ws;
    int tid, lane, wave, vcu, G;
    const float* const* in; float* out;
};

__device__ __forceinline__ int nmap1(int n) { return n < 1024 ? (n >> 7) * 256 + (n & 127) : ((n - 1024) >> 7) * 256 + 128 + ((n - 1024) & 127); }
struct TItem { const float* W; bf16_t* WT; const float* g; int ldw, K, k0, n0, perm; };
__device__ __forceinline__ void titem_load(const TItem& t, f32x4 (&va)[8], f32x4 (&vb)[8], int lane) {
    const int nq = lane & 15, kp = lane >> 4;
#pragma unroll
    for (int it = 0; it < 8; ++it) { const int k = t.k0 + 2 * (kp + 4 * it); va[it] = *(const f32x4*)(t.W + (size_t)k * t.ldw + t.n0 + 4 * nq); vb[it] = *(const f32x4*)(t.W + (size_t)(k + 1) * t.ldw + t.n0 + 4 * nq); }
}
__device__ __forceinline__ void titem_store(const TItem& t, const f32x4 (&va)[8], const f32x4 (&vb)[8], LAS unsigned* scr, int lane) {
    const int nq = lane & 15, kp = lane >> 4;
#pragma unroll
    for (int it = 0; it < 8; ++it) { const int kk2 = kp + 4 * it; f32x4 a = va[it], b = vb[it];
        if (t.g) { const float g0 = t.g[t.k0 + 2 * kk2], g1 = t.g[t.k0 + 2 * kk2 + 1]; a = a * g0; b = b * g1; }
#pragma unroll
        for (int j = 0; j < 4; ++j) scr[(4 * nq + j) * 33 + kk2] = cvtpk_s(a[j], b[j]); }
    LDS_WAIT(); asm volatile("" ::: "memory");
    const int c = lane & 7;
#pragma unroll
    for (int it = 0; it < 8; ++it) { const int n = (lane >> 3) + 8 * it; const LAS unsigned* sp = scr + n * 33 + 4 * c;
        u32x4 o; o.x = sp[0]; o.y = sp[1]; o.z = sp[2]; o.w = sp[3];
        const int nn = t.n0 + n, nr = t.perm ? nmap1(nn) : nn;
        *(u32x4*)(t.WT + (size_t)nr * t.K + t.k0 + 8 * c) = o; }
    LDS_WAIT(); asm volatile("" ::: "memory");
}
__device__ __forceinline__ void titem8_load(const TItem& t, f32x4 (&va)[8], f32x4 (&vb)[8], int lane) {
    const int nq = lane & 7, kg = lane >> 3;
#pragma unroll
    for (int it = 0; it < 4; ++it) { const int k = t.k0 + 4 * (kg + 8 * it); const float* p = t.W + (size_t)k * t.ldw + t.n0 + 4 * nq;
        va[2 * it] = *(const f32x4*)p; va[2 * it + 1] = *(const f32x4*)(p + t.ldw); vb[2 * it] = *(const f32x4*)(p + 2 * (size_t)t.ldw); vb[2 * it + 1] = *(const f32x4*)(p + 3 * (size_t)t.ldw); }
}
__device__ __forceinline__ void titem8_store(const TItem& t, const f32x4 (&va)[8], const f32x4 (&vb)[8], LAS unsigned* scr, int lane) {
    const int nq = lane & 7, kg = lane >> 3;
#pragma unroll
    for (int it = 0; it < 4; ++it) { const int kq = kg + 8 * it; f32x4 a = va[2 * it], b = va[2 * it + 1], c = vb[2 * it], d = vb[2 * it + 1];
        float g0 = W8_SCALE, g1 = W8_SCALE, g2 = W8_SCALE, g3 = W8_SCALE;
        if (t.g) { const f32x4 gv = *(const f32x4*)(t.g + t.k0 + 4 * kq); g0 *= gv[0]; g1 *= gv[1]; g2 *= gv[2]; g3 *= gv[3]; }
#pragma unroll
        for (int j = 0; j < 4; ++j) scr[(4 * nq + j) * 33 + kq] = pk_fp8x4(a[j] * g0, b[j] * g1, c[j] * g2, d[j] * g3); }
    LDS_WAIT(); asm volatile("" ::: "memory");
    const int c = lane & 7;
#pragma unroll
    for (int it = 0; it < 4; ++it) { const int n = (lane >> 3) + 8 * it; const LAS unsigned* sp = scr + n * 33 + 4 * c;
        u32x4 o; o.x = sp[0]; o.y = sp[1]; o.z = sp[2]; o.w = sp[3];
        const int nn = t.n0 + n, nr = t.perm ? nmap1(nn) : nn;
        *(u32x4*)((unsigned char*)t.WT + (size_t)nr * t.K + t.k0 + 16 * c) = o; }
    LDS_WAIT(); asm volatile("" ::: "memory");
}
template <bool F8, class Dec> __device__ __forceinline__ void titem_loop(int first, int stride, int n, LAS unsigned* scr, int lane, const Dec& dec) {
    if (first >= n) return;
    TItem A, B; f32x4 a0[8], a1[8], b0[8], b1[8];
    int ia = first; dec(ia, A); if (F8) titem8_load(A, a0, a1, lane); else titem_load(A, a0, a1, lane);
    for (;;) {
        const int ib = ia + stride; const bool hb = ib < n;
        if (hb) { dec(ib, B); if (F8) titem8_load(B, b0, b1, lane); else titem_load(B, b0, b1, lane); }
        if (F8) titem8_store(A, a0, a1, scr, lane); else titem_store(A, a0, a1, scr, lane);
        if (!hb) break;
        ia = ib + stride; const bool ha = ia < n;
        if (ha) { dec(ia, A); if (F8) titem8_load(A, a0, a1, lane); else titem_load(A, a0, a1, lane); }
        if (F8) titem8_store(B, b0, b1, scr, lane); else titem_store(B, b0, b1, scr, lane);
        if (!ha) break;
    }
}
__device__ __forceinline__ void rms_rows_to_bf16(const float* x, const float* g, bf16_t* o, int first, int stride, int n, int lane) {
    if (first >= n) return;
    const f32x4* gr = (const f32x4*)g + lane; f32x4 gg[4];
#pragma unroll
    for (int j = 0; j < 4; ++j) gg[j] = gr[64 * j];
    f32x4 v[4], w[4];
#pragma unroll
    for (int j = 0; j < 4; ++j) v[j] = ((const f32x4*)(x + (size_t)first * D) + lane)[64 * j];
    for (int m = first; m < n; m += stride) {
        const int mn = m + stride;
        if (mn < n) {
#pragma unroll
            for (int j = 0; j < 4; ++j) w[j] = ((const f32x4*)(x + (size_t)mn * D) + lane)[64 * j];
        }
        float sq = 0.f;
#pragma unroll
        for (int j = 0; j < 4; ++j) sq += (v[j][0] * v[j][0] + v[j][1] * v[j][1]) + (v[j][2] * v[j][2] + v[j][3] * v[j][3]);
        const float rstd = __builtin_amdgcn_rsqf(wave_sum(sq) * (1.f / D) + EPS);
        u32x2* o8 = (u32x2*)(o + (size_t)m * D) + lane;
#pragma unroll
        for (int j = 0; j < 4; ++j) { u32x2 q; q.x = cvtpk_s(v[j][0] * rstd * gg[j][0], v[j][1] * rstd * gg[j][1]); q.y = cvtpk_s(v[j][2] * rstd * gg[j][2], v[j][3] * rstd * gg[j][3]); o8[64 * j] = q; }
#pragma unroll
        for (int j = 0; j < 4; ++j) v[j] = w[j];
    }
}
__device__ __forceinline__ void p0a_prologue(Frame& F) {
    LAS unsigned* scr = (LAS unsigned*)(F.lds + RING_OFF + F.wave * 16384);
    const int gw = F.vcu * NWAVES + F.wave, NGW = F.G * NWAVES;
    const float *mem = F.in[1], *g_mem = F.in[9], *w_kv = F.in[11];
    bf16_t *wkv_t = (bf16_t*)(F.ws + WS_WKV_T), *memn = (bf16_t*)(F.ws + WS_MEMN);
    rms_rows_to_bf16(mem, g_mem, memn, gw, NGW, MROWS, F.lane);
    titem_loop<false>(gw, NGW, 16 * 32, scr, F.lane, [=](int r, TItem& t) { t.W = w_kv; t.WT = wkv_t; t.g = nullptr; t.ldw = 2 * D; t.K = D; t.k0 = (r / 32) * 64; t.n0 = (r % 32) * 64; t.perm = 0; });
}
__device__ __forceinline__ void p0b_prologue(Frame& F, int wv, int nwv, int lo_frac_num, int lo_frac_den, bool low) {
    LAS unsigned* scr = (LAS unsigned*)(F.lds + RING_OFF + F.wave * 16384);
    const float *x = F.in[0], *g_mix = F.in[2], *w_in = F.in[3], *w_out = F.in[7], *g_xattn = F.in[8], *w_q = F.in[10], *w_o = F.in[12], *g_moe = F.in[13], *w_router = F.in[14], *w1 = F.in[16], *w2 = F.in[18];
    bf16_t *win_t = (bf16_t*)(F.ws + WS_WIN_T), *wout_t = (bf16_t*)(F.ws + WS_WOUT_T), *wq_t = (bf16_t*)(F.ws + WS_WQ_T), *wo_t = (bf16_t*)(F.ws + WS_WO_T),
           *w1_t = (bf16_t*)(F.ws + WS_W1_T), *w2_t = (bf16_t*)(F.ws + WS_W2_T), *xn = (bf16_t*)(F.ws + WS_XN);
    float* wr = (float*)(F.ws + WS_WR);
    auto range = [&](int n, int& first, int& end) { const int cut = (int)((long)n * lo_frac_num / lo_frac_den); if (low) { first = wv; end = cut; } else { first = cut + wv; end = n; } };
    int f, e;
    range(D * NE / 64, f, e); for (int i = f; i < e; i += nwv) { const int idx = i * 64 + F.lane; wr[idx] = w_router[idx] * g_moe[idx >> 5]; }
    constexpr int I_1 = NE * 8 * 64, I_2 = NE * 8 * 32;
    range(I_1 + I_2, f, e);
    titem_loop<true>(f, nwv, e, scr, F.lane, [=](int r, TItem& t) {
        t.g = nullptr; t.perm = 0; t.K = D;
        if (r < I_2) { const int ex = r / 256, q = r % 256; t.W = w2 + (size_t)ex * DEXP * D; t.WT = (bf16_t*)((unsigned char*)w2_t + (size_t)ex * D * DEXP); t.ldw = D; t.k0 = (q / 32) * 128; t.n0 = (q % 32) * 32; return; } r -= I_2;
        { const int ex = r / 512, q = r % 512; t.W = w1 + (size_t)ex * D * 2048; t.WT = (bf16_t*)((unsigned char*)w1_t + (size_t)ex * 2048 * D); t.g = g_moe; t.ldw = 2048; t.perm = 1; t.k0 = (q / 64) * 128; t.n0 = (q % 64) * 32; }
    });
    constexpr int I_IN = 16 * 48, I_OUT = 16 * 16, I_Q = 16 * 16, I_O = 16 * 16;
    range(I_IN + I_OUT + I_Q + I_O, f, e);
    titem_loop<false>(f, nwv, e, scr, F.lane, [=](int r, TItem& t) {
        t.g = nullptr; t.perm = 0; t.K = D; t.ldw = D;
        if (r < I_O) { t.W = w_o; t.WT = wo_t; t.k0 = (r / 16) * 64; t.n0 = (r % 16) * 64; return; } r -= I_O;
        if (r < I_Q) { t.W = w_q; t.WT = wq_t; t.g = g_xattn; t.k0 = (r / 16) * 64; t.n0 = (r % 16) * 64; return; } r -= I_Q;
        if (r < I_OUT) { t.W = w_out; t.WT = wout_t; t.k0 = (r / 16) * 64; t.n0 = (r % 16) * 64; return; } r -= I_OUT;
        { t.W = w_in; t.WT = win_t; t.ldw = NPROJ; t.k0 = (r / 48) * 64; t.n0 = (r % 48) * 64; }
    });
    range(M, f, e); rms_rows_to_bf16(x, g_mix, xn, f, nwv, e, F.lane);
}

__device__ __forceinline__ void conv_rows(Frame& F) {
    const bf16_t* proj = (const bf16_t*)(F.ws + WS_PROJ); bf16_t* ymix = (bf16_t*)(F.ws + WS_YMIX);
    const float* conv_w = F.in[4]; const float* g_conv = F.in[5];
    const int gw = F.vcu * NWAVES + F.wave, NGW = F.G * NWAVES, c0 = 8 * F.lane;
    float w0[8], w1[8], w2[8], gg[8];
#pragma unroll
    for (int j = 0; j < 8; ++j) { w0[j] = conv_w[c0 + j]; w1[j] = conv_w[512 + c0 + j]; w2[j] = conv_w[1024 + c0 + j]; gg[j] = g_conv[c0 + j]; }
    for (int m = gw; m < M; m += NGW) {
        const int t = m & (SEQ - 1); const bf16_t* row = proj + (size_t)m * NPROJ + c0;
        const u32x4 bg = *(const u32x4*)row, cg0 = *(const u32x4*)(row + 512), xv0 = *(const u32x4*)(row + 1024);
        u32x4 cg1 = {0, 0, 0, 0}, xv1 = {0, 0, 0, 0}, cg2 = {0, 0, 0, 0}, xv2 = {0, 0, 0, 0};
        if (t >= 1) { cg1 = *(const u32x4*)(row - NPROJ + 512); xv1 = *(const u32x4*)(row - NPROJ + 1024); }
        if (t >= 2) { cg2 = *(const u32x4*)(row - 2 * NPROJ + 512); xv2 = *(const u32x4*)(row - 2 * NPROJ + 1024); }
        float y[8]; float ss = 0.f;
#pragma unroll
        for (int j = 0; j < 4; ++j) {
            const float u0l = bf_lo(cg0[j]) * bf_lo(xv0[j]), u0h = bf_hi(cg0[j]) * bf_hi(xv0[j]);
            const float u1l = bf_lo(cg1[j]) * bf_lo(xv1[j]), u1h = bf_hi(cg1[j]) * bf_hi(xv1[j]);
            const float u2l = bf_lo(cg2[j]) * bf_lo(xv2[j]), u2h = bf_hi(cg2[j]) * bf_hi(xv2[j]);
            y[2 * j] = bf_lo(bg[j]) * (w0[2 * j] * u2l + w1[2 * j] * u1l + w2[2 * j] * u0l);
            y[2 * j + 1] = bf_hi(bg[j]) * (w0[2 * j + 1] * u2h + w1[2 * j + 1] * u1h + w2[2 * j + 1] * u0h);
            ss += y[2 * j] * y[2 * j] + y[2 * j + 1] * y[2 * j + 1];
        }
        ss += __shfl_xor(ss, 1); ss += __shfl_xor(ss, 2); ss += __shfl_xor(ss, 4);
        const float rstd = __builtin_amdgcn_rsqf(ss * (1.f / 64.f) + EPS);
        u32x4 o; o.x = cvtpk_s(y[0] * rstd * gg[0], y[1] * rstd * gg[1]); o.y = cvtpk_s(y[2] * rstd * gg[2], y[3] * rstd * gg[3]);
        o.z = cvtpk_s(y[4] * rstd * gg[4], y[5] * rstd * gg[5]); o.w = cvtpk_s(y[6] * rstd * gg[6], y[7] * rstd * gg[7]);
        *(u32x4*)(ymix + (size_t)m * D + c0) = o;
    }
}
constexpr int SB_K = 0, SB_V = 8192, SB_OST = 16384, SB_OSTW = 32 * 68 * 4, SB_FLAG = 90112;
static_assert(SB_OST + 8 * SB_OSTW <= SB_FLAG && SB_FLAG + 32 <= RING_BYTES, "attention LDS");
__device__ __forceinline__ int crow(int r, int hi) { return (r & 3) + 8 * (r >> 2) + 4 * hi; }
__device__ __forceinline__ void sb_attn_unit(Frame& F, int b, int h, int qb) {
    const bf16_t* proj = (const bf16_t*)(F.ws + WS_PROJ); bf16_t* ymix = (bf16_t*)(F.ws + WS_YMIX); const float* g_sb = F.in[6];
    const int tid = F.tid, lane = F.lane, wid = F.wave, r32 = lane & 31, hi = lane >> 5;
    LAS unsigned char* lds = F.lds + RING_OFF;
    const int q0 = qb * 256, qlo = q0 + wid * 32, qpos = qlo + r32;
    const size_t rowbase = (size_t)b * SEQ;
    const bf16_t* Qp = proj + (rowbase + qlo) * NPROJ + 1536 + h * 64;
    const bf16_t* Kp = proj + rowbase * NPROJ + 2048 + h * 64;
    const bf16_t* Vp = proj + rowbase * NPROJ + 2560 + h * 64;
    bf16x8 qr[4];
#pragma unroll
    for (int s = 0; s < 4; ++s) qr[s] = *(const bf16x8*)(Qp + (size_t)r32 * NPROJ + 16 * s + 8 * hi);
    bf16x8 ntri[2], nones;
#pragma unroll
    for (int s = 0; s < 2; ++s)
#pragma unroll
        for (int j = 0; j < 8; ++j) { const int k = 16 * s + 8 * (j >> 2) + 4 * hi + (j & 3); ntri[s][j] = (k > r32) ? (short)0xBF80 : (short)0; }
#pragma unroll
    for (int j = 0; j < 8; ++j) nones[j] = (short)0xBF80;
    f32x16 R = {}; f32x16 o[2]; o[0] = f32x16{}; o[1] = f32x16{};
    const int skey = tid >> 3, sc = tid & 7;
    const int koff = SB_K + skey * 128 + ((sc ^ ((skey >> 1) & 7)) << 4);
    const int voff = SB_V + (sc >> 2) * 4096 + (skey >> 4) * 1024 + (skey & 15) * 64 + (sc & 3) * 16;
    const int vb = SB_V + ((lane >> 4) & 1) * 32 + (lane & 3) * 8 + (4 * hi + ((lane & 15) >> 2)) * 64;
    int kbi = 4 * qb + 3;
    u32x4 kreg = *(const u32x4*)(Kp + (size_t)(kbi * 64 + skey) * NPROJ + sc * 8), vreg = *(const u32x4*)(Vp + (size_t)(kbi * 64 + skey) * NPROJ + sc * 8);
    LAS int* dflag = (LAS int*)(lds + SB_FLAG);
    int done = 0;
    for (; kbi >= 0; --kbi) {
        const int k0 = kbi * 64;
        __syncthreads();
        *(LAS u32x4*)(lds + koff) = kreg; *(LAS u32x4*)(lds + voff) = vreg;
        if (lane == 0) dflag[wid] = done;
        __syncthreads();
        { const u32x4 f0 = *(const LAS u32x4*)dflag, f1 = *(const LAS u32x4*)(dflag + 4); if ((f0.x & f0.y & f0.z & f0.w & f1.x & f1.y & f1.z & f1.w) != 0u) break; }
        if (kbi > 0) { kreg = *(const u32x4*)(Kp + (size_t)(k0 - 64 + skey) * NPROJ + sc * 8); vreg = *(const u32x4*)(Vp + (size_t)(k0 - 64 + skey) * NPROJ + sc * 8); }
        if (!done && k0 < qlo + 31) {
            f32x16 p0 = {}, p1 = {};
#pragma unroll
            for (int s = 0; s < 4; ++s) { const int c = 2 * s + hi;
                const bf16x8 ka = *(const LAS bf16x8*)(lds + SB_K + r32 * 128 + ((c ^ ((r32 >> 1) & 7)) << 4));
                const bf16x8 kb = *(const LAS bf16x8*)(lds + SB_K + (r32 + 32) * 128 + ((c ^ (((r32 + 32) >> 1) & 7)) << 4));
                p0 = __builtin_amdgcn_mfma_f32_32x32x16_bf16(ka, qr[s], p0, 0, 0, 0); p1 = __builtin_amdgcn_mfma_f32_32x32x16_bf16(kb, qr[s], p1, 0, 0, 0); }
            const bool diag = (k0 + 63 >= qlo);
            f32x16 s0, s1;
#pragma unroll
            for (int r = 0; r < 16; ++r) {
                const float z0 = p0[r], z1 = p1[r];
                float sp0 = fmaxf(z0, 0.f) + __builtin_amdgcn_logf(1.0f + __builtin_amdgcn_exp2f(-fabsf(z0)));
                float sp1 = fmaxf(z1, 0.f) + __builtin_amdgcn_logf(1.0f + __builtin_amdgcn_exp2f(-fabsf(z1)));
                if (diag) { const int key = k0 + crow(r, hi); if (key >= qpos) sp0 = 0.f; if (key + 32 >= qpos) sp1 = 0.f; }
                s0[r] = sp0; s1[r] = sp1; p0[r] = z0 - sp0; p1[r] = z1 - sp1;
            }
            u32x4 w00 = {cvtpk_s(s0[0], s0[1]), cvtpk_s(s0[2], s0[3]), cvtpk_s(s0[4], s0[5]), cvtpk_s(s0[6], s0[7])}, w01 = {cvtpk_s(s0[8], s0[9]), cvtpk_s(s0[10], s0[11]), cvtpk_s(s0[12], s0[13]), cvtpk_s(s0[14], s0[15])};
            u32x4 w10 = {cvtpk_s(s1[0], s1[1]), cvtpk_s(s1[2], s1[3]), cvtpk_s(s1[4], s1[5]), cvtpk_s(s1[6], s1[7])}, w11 = {cvtpk_s(s1[8], s1[9]), cvtpk_s(s1[10], s1[11]), cvtpk_s(s1[12], s1[13]), cvtpk_s(s1[14], s1[15])};
            const bf16x8 sb00 = __builtin_bit_cast(bf16x8, w00), sb01 = __builtin_bit_cast(bf16x8, w01), sb10 = __builtin_bit_cast(bf16x8, w10), sb11 = __builtin_bit_cast(bf16x8, w11);
            f32x16 rest1 = __builtin_amdgcn_mfma_f32_32x32x16_bf16(ntri[0], sb10, R, 0, 0, 0); rest1 = __builtin_amdgcn_mfma_f32_32x32x16_bf16(ntri[1], sb11, rest1, 0, 0, 0);
            f32x16 U = __builtin_amdgcn_mfma_f32_32x32x16_bf16(nones, sb10, R, 0, 0, 0); U = __builtin_amdgcn_mfma_f32_32x32x16_bf16(nones, sb11, U, 0, 0, 0);
            f32x16 rest0 = __builtin_amdgcn_mfma_f32_32x32x16_bf16(ntri[0], sb00, U, 0, 0, 0); rest0 = __builtin_amdgcn_mfma_f32_32x32x16_bf16(ntri[1], sb01, rest0, 0, 0, 0);
            R = __builtin_amdgcn_mfma_f32_32x32x16_bf16(nones, sb00, U, 0, 0, 0); R = __builtin_amdgcn_mfma_f32_32x32x16_bf16(nones, sb01, R, 0, 0, 0);
            done = __all(R[0] < -150.0f) ? 1 : 0;
#pragma unroll
            for (int r = 0; r < 16; ++r) {
                float a0 = __builtin_amdgcn_exp2f(p0[r] + rest0[r]), a1 = __builtin_amdgcn_exp2f(p1[r] + rest1[r]);
                if (diag) { const int key = k0 + crow(r, hi); if (key >= qpos) a0 = 0.f; if (key + 32 >= qpos) a1 = 0.f; }
                p0[r] = a0; p1[r] = a1;
            }
            u32x4 a00 = {cvtpk_s(p0[0], p0[1]), cvtpk_s(p0[2], p0[3]), cvtpk_s(p0[4], p0[5]), cvtpk_s(p0[6], p0[7])}, a01 = {cvtpk_s(p0[8], p0[9]), cvtpk_s(p0[10], p0[11]), cvtpk_s(p0[12], p0[13]), cvtpk_s(p0[14], p0[15])};
            u32x4 a10 = {cvtpk_s(p1[0], p1[1]), cvtpk_s(p1[2], p1[3]), cvtpk_s(p1[4], p1[5]), cvtpk_s(p1[6], p1[7])}, a11 = {cvtpk_s(p1[8], p1[9]), cvtpk_s(p1[10], p1[11]), cvtpk_s(p1[12], p1[13]), cvtpk_s(p1[14], p1[15])};
            const bf16x8 pa[4] = {__builtin_bit_cast(bf16x8, a00), __builtin_bit_cast(bf16x8, a01), __builtin_bit_cast(bf16x8, a10), __builtin_bit_cast(bf16x8, a11)};
#pragma unroll
            for (int d0 = 0; d0 < 2; ++d0)
#pragma unroll
                for (int ks = 0; ks < 4; ++ks) {
                    const s16x4 lo = __builtin_bit_cast(s16x4, __builtin_amdgcn_ds_read_tr16_b64_v4i16((LAS s16x4*)(lds + vb + d0 * 4096 + ks * 1024)));
                    const s16x4 hh = __builtin_bit_cast(s16x4, __builtin_amdgcn_ds_read_tr16_b64_v4i16((LAS s16x4*)(lds + vb + d0 * 4096 + ks * 1024 + 512)));
                    const bf16x8 vf = {lo[0], lo[1], lo[2], lo[3], hh[0], hh[1], hh[2], hh[3]};
                    o[d0] = __builtin_amdgcn_mfma_f32_32x32x16_bf16(pa[ks], vf, o[d0], 0, 0, 0);
                }
        }
    }
    LAS float* stg = (LAS float*)(lds + SB_OST + wid * SB_OSTW);
#pragma unroll
    for (int r = 0; r < 16; ++r) { const int q = crow(r, hi); stg[q * 68 + r32] = o[0][r]; stg[q * 68 + 32 + r32] = o[1][r]; }
    LDS_WAIT(); asm volatile("" ::: "memory");
    { const int q = lane >> 1, half = lane & 1; const LAS f32x4* sp = (const LAS f32x4*)(stg + q * 68 + 32 * half);
      f32x4 v[8]; float ss = 0.f;
#pragma unroll
      for (int i = 0; i < 8; ++i) { v[i] = sp[i]; ss += (v[i][0] * v[i][0] + v[i][1] * v[i][1]) + (v[i][2] * v[i][2] + v[i][3] * v[i][3]); }
      ss += __shfl_xor(ss, 1);
      const float rstd = __builtin_amdgcn_rsqf(ss * (1.f / 64.f) + EPS);
      const f32x4* gp = (const f32x4*)(g_sb + h * 64 + 32 * half);
      bf16_t* op = ymix + (rowbase + qlo + q) * D + 512 + h * 64 + 32 * half;
#pragma unroll
      for (int i = 0; i < 4; ++i) { const f32x4 g0 = gp[2 * i], g1 = gp[2 * i + 1], a = v[2 * i] * rstd * g0, c = v[2 * i + 1] * rstd * g1;
          u32x4 w; w.x = cvtpk_s(a[0], a[1]); w.y = cvtpk_s(a[2], a[3]); w.z = cvtpk_s(c[0], c[1]); w.w = cvtpk_s(c[2], c[3]); *(u32x4*)(op + 8 * i) = w; } }
    LDS_WAIT();
}
__device__ __forceinline__ void p2_mix(Frame& F) {
    conv_rows(F);
    if (F.G == 256) {
        const int bh = F.vcu >> 2, s = F.vcu & 3;
        sb_attn_unit(F, bh >> 3, bh & 7, 7 - s);
        sb_attn_unit(F, bh >> 3, bh & 7, s);
    } else {
        for (int u = F.vcu; u < 512; u += F.G) sb_attn_unit(F, u >> 6, (u >> 3) & 7, u & 7);
    }
}

__device__ __forceinline__ void p8_router(Frame& F) {
    const float* x2 = (const float*)(F.ws + WS_X2); const float* wr = (const float*)(F.ws + WS_WR); const float* b_router = F.in[15];
    float* lrstd = (float*)(F.ws + WS_LRSTD); int* ltok = (int*)(F.ws + WS_LTOK); float* lgate = (float*)(F.ws + WS_LGATE); unsigned* cnt = F.ctl + CW_CNT;
    LAS float* wl = (LAS float*)(F.lds + RING_OFF);
    for (int i = F.tid; i < D * NE / 4; i += NWAVES * 64) ((LAS f32x4*)wl)[i] = ((const f32x4*)wr)[i];
    __syncthreads();
    const int lane = F.lane, tk = lane & 15, kq = lane >> 4;
    const int gw = F.vcu * NWAVES + F.wave, NGW = F.G * NWAVES;
    for (int item = gw; item < M / 16; item += NGW) {
        const int tok = item * 16 + tk; const float* xr = x2 + (size_t)tok * D + 4 * kq;
        f32x4 acc0 = {0.f, 0.f, 0.f, 0.f}, acc1 = {0.f, 0.f, 0.f, 0.f}; float ss = 0.f;
#pragma unroll 4
        for (int s = 0; s < 64; ++s) {
            const f32x4 xv = *(const f32x4*)(xr + 16 * s); ss += (xv[0] * xv[0] + xv[1] * xv[1]) + (xv[2] * xv[2] + xv[3] * xv[3]);
#pragma unroll
            for (int j = 0; j < 4; ++j) { const LAS float* wp = wl + (16 * s + 4 * kq + j) * 32 + tk;
                acc0 = __builtin_amdgcn_mfma_f32_16x16x4f32(wp[0], xv[j], acc0, 0, 0, 0); acc1 = __builtin_amdgcn_mfma_f32_16x16x4f32(wp[16], xv[j], acc1, 0, 0, 0); }
        }
        ss += __shfl_xor(ss, 16); ss += __shfl_xor(ss, 32);
        const float rstd = __builtin_amdgcn_rsqf(ss * (1.f / D) + EPS);
        float lg[32];
#pragma unroll
        for (int q = 0; q < 4; ++q)
#pragma unroll
            for (int j = 0; j < 4; ++j) { const int src = tk + 16 * q; lg[4 * q + j] = __shfl(acc0[j], src) * rstd + b_router[4 * q + j]; lg[16 + 4 * q + j] = __shfl(acc1[j], src) * rstd + b_router[16 + 4 * q + j]; }
        float tv[4]; int ti[4]; unsigned used = 0u;
#pragma unroll
        for (int k = 0; k < 4; ++k) { float bv = -INFINITY; int bi = 0;
#pragma unroll
            for (int e = 0; e < 32; ++e) { const bool ok = !((used >> e) & 1u) && lg[e] > bv; bv = ok ? lg[e] : bv; bi = ok ? e : bi; }
            tv[k] = bv; ti[k] = bi; used |= 1u << bi; }
        const float e1 = __expf(tv[1] - tv[0]), e2 = __expf(tv[2] - tv[0]), e3 = __expf(tv[3] - tv[0]); const float inv = 1.0f / (1.0f + e1 + e2 + e3);
        const int myE = kq == 0 ? ti[0] : kq == 1 ? ti[1] : kq == 2 ? ti[2] : ti[3];
        const float myG = (kq == 0 ? 1.0f : kq == 1 ? e1 : kq == 2 ? e2 : e3) * inv;
        int rank = 0, mycount = 0;
#pragma unroll 1
        for (int e = 0; e < NE; ++e) { const unsigned long long mk = __ballot(myE == e); const int pc = __popcll(mk);
            if (myE == e) rank = __popcll(mk & ((1ull << lane) - 1ull)); if (lane == e) mycount = pc; }
        unsigned base = 0u; if (lane < NE && mycount > 0) base = atomicAdd(cnt + 64 * lane, (unsigned)mycount);
        const unsigned mybase = (unsigned)__shfl((int)base, myE);
        const size_t pos = (size_t)myE * LISTCAP + mybase + rank;
        ltok[pos] = tok * 4 + kq; lgate[pos] = myG; lrstd[pos] = rstd;
    }
}

__device__ __forceinline__ void p11_load(const float* x2, const bf16_t* y, int m, int lane, f32x4 (&xv)[4], u32x4 (&yv)[8]) {
#pragma unroll
    for (int j = 0; j < 2; ++j) { const int c = 8 * lane + 512 * j; xv[2 * j] = *(const f32x4*)(x2 + (size_t)m * D + c); xv[2 * j + 1] = *(const f32x4*)(x2 + (size_t)m * D + c + 4);
#pragma unroll
        for (int sl = 0; sl < 4; ++sl) yv[4 * j + sl] = *(const u32x4*)(y + ((size_t)m * 4 + sl) * D + c); }
}
__device__ __forceinline__ void p11_final(Frame& F) {
    const float* x2 = (const float*)(F.ws + WS_X2); const bf16_t* y = (const bf16_t*)(F.ws + WS_Y); const float* g_final = F.in[20]; float* out = F.out;
    const int gw = F.vcu * NWAVES + F.wave, NGW = F.G * NWAVES, lane = F.lane;
    if (gw >= M) return;
    f32x4 gg[4];
#pragma unroll
    for (int j = 0; j < 2; ++j) { const int c = 8 * lane + 512 * j; gg[2 * j] = *(const f32x4*)(g_final + c); gg[2 * j + 1] = *(const f32x4*)(g_final + c + 4); }
    f32x4 xv[4], xn_[4]; u32x4 yv[8], yn_[8];
    p11_load(x2, y, gw, lane, xv, yv);
    for (int m = gw; m < M; m += NGW) {
        if (m + NGW < M) p11_load(x2, y, m + NGW, lane, xn_, yn_);
        f32x4 v[4]; float ss = 0.f;
#pragma unroll
        for (int j = 0; j < 2; ++j) { v[2 * j] = xv[2 * j]; v[2 * j + 1] = xv[2 * j + 1];
#pragma unroll
            for (int sl = 0; sl < 4; ++sl) { const u32x4 w = yv[4 * j + sl];
                v[2 * j][0] += bf_lo(w.x); v[2 * j][1] += bf_hi(w.x); v[2 * j][2] += bf_lo(w.y); v[2 * j][3] += bf_hi(w.y);
                v[2 * j + 1][0] += bf_lo(w.z); v[2 * j + 1][1] += bf_hi(w.z); v[2 * j + 1][2] += bf_lo(w.w); v[2 * j + 1][3] += bf_hi(w.w); } }
#pragma unroll
        for (int i = 0; i < 4; ++i) ss += (v[i][0] * v[i][0] + v[i][1] * v[i][1]) + (v[i][2] * v[i][2] + v[i][3] * v[i][3]);
        const float rstd = __builtin_amdgcn_rsqf(wave_sum(ss) * (1.f / D) + EPS);
#pragma unroll
        for (int j = 0; j < 2; ++j) { const int c = 8 * lane + 512 * j;
            *(f32x4*)(out + (size_t)m * D + c) = v[2 * j] * rstd * gg[2 * j]; *(f32x4*)(out + (size_t)m * D + c + 4) = v[2 * j + 1] * rstd * gg[2 * j + 1]; }
#pragma unroll
        for (int i = 0; i < 4; ++i) xv[i] = xn_[i];
#pragma unroll
        for (int i = 0; i < 8; ++i) yv[i] = yn_[i];
    }
}

constexpr int NPHASE = 13;
struct Args { const float* in[21]; float* out; unsigned char* ws; int ph_lo, ph_hi; };
static_assert(sizeof(Args) == 21 * 8 + 8 + 8 + 8, "Args has no padding");

__global__ void __launch_bounds__(NWAVES * 64, 2) fwd(Args args) {
    extern __shared__ __attribute__((aligned(16))) unsigned char lds[];
    Frame F;
    F.lds = (LAS unsigned char*)lds; F.MISC = (volatile LAS unsigned*)(F.lds + MISC_OFF);
    F.tid = threadIdx.x; F.lane = F.tid & 63; F.wave = __builtin_amdgcn_readfirstlane(F.tid >> 6);
    F.G = gridDim.x; { const int bx = blockIdx.x; F.vcu = (F.G % 8 == 0) ? (bx % 8) * (F.G / 8) + bx / 8 : bx; }
    F.ws = args.ws; F.ctl = (unsigned*)(args.ws + WS_CTL); F.out = args.out;
    F.in = args.in;
    for (int u = F.tid; u < (LDS_BYTES - LDSCTL_OFF) / 4; u += NWAVES * 64) ((LAS unsigned*)(F.lds + LDSCTL_OFF))[u] = 0u;
    __syncthreads();
    const int lo = args.ph_lo, hi = args.ph_hi;
    const bool single = (hi - lo) > 1;
    XcdBarrier bar; bar.bar = F.ctl + CW_BAR; bar.x = 0; bar.st = nullptr;
    if (single) bar = xcd_barrier_post(F.ctl + CW_BAR, F.MISC + 8);
#ifndef PH_MASK
#define PH_MASK 0x1FFF
#endif
#define IN(k) (((PH_MASK >> (k)) & 1) && lo <= (k) && (k) < hi)
#define SEAM(k) do { if (IN(k) && IN((k) + 1)) xcd_barrier(bar); } while (0)
    unsigned char* ws = args.ws;
    const int bx = (int)blockIdx.x;

    if (IN(0)) {
        p0a_prologue(F);
        if (single) cg::this_grid().sync();
    }
    if (IN(12)) {
        const bool low = bx < 64;
        if (low) {
            pg8::OrderKV S; S.init(ws + WS_MEMN, ws + WS_WKV_T, bx);
            pg8::EpiP1 E{(bf16_t*)(ws + WS_PROJ), (bf16_t*)(ws + WS_KMEM), (bf16_t*)(ws + WS_VT)};
            pg8::gemm_phase<pg8::EpiP1, pg8::OrderKV, false, false, true>(F.lds + RING_OFF, 2 * D, 2 * D, 2 * D, S, E);
        }
        const int nlow = 64 * NWAVES, nhigh = (F.G - 64) * NWAVES;
        if (low) p0b_prologue(F, bx * NWAVES + F.wave, nlow, 4 * nlow, 4 * nlow + 5 * nhigh, true);
        else p0b_prologue(F, (bx - 64) * NWAVES + F.wave, nhigh, 4 * nlow, 4 * nlow + 5 * nhigh, false);
    }
    if (IN(12) && IN(1)) xcd_barrier(bar);
    if (IN(1)) {
        pg8::OrderIn S; S.init(ws + WS_XN, ws + WS_WIN_T, F.G, bx);
        pg8::EpiP1 E{(bf16_t*)(ws + WS_PROJ), (bf16_t*)(ws + WS_KMEM), (bf16_t*)(ws + WS_VT)};
        pg8::gemm_phase<pg8::EpiP1, pg8::OrderIn, false, true, true>(F.lds + RING_OFF, 2 * D, 2 * D, 2 * D, S, E);
    }
    SEAM(1);
    if (IN(2)) { p2_mix(F); }
    SEAM(2);
    if (IN(3)) {
        pg8::OrderPlain S; S.init(ws + WS_YMIX, ws + WS_WOUT_T, D, D, M / 256, D / 256, F.G, bx);
        pg8::EpiRes<false> E{F.in[0], (float*)(ws + WS_X1), (bf16_t*)(ws + WS_X1B), (float*)(ws + WS_SS1)};
        pg8::gemm_phase<pg8::EpiRes<false>, pg8::OrderPlain, false, false, true>(F.lds + RING_OFF, 2 * D, 2 * D, 2 * D, S, E);
    }
    SEAM(3);
    if (IN(4)) {
        pg8::OrderPlain S; S.init(ws + WS_X1B, ws + WS_WQ_T, D, D, M / 256, D / 256, F.G, bx);
        pg8::EpiQm E{(bf16_t*)(ws + WS_QM), (const float*)(ws + WS_SS1)};
        pg8::gemm_phase<pg8::EpiQm, pg8::OrderPlain, false, false, true>(F.lds + RING_OFF, 2 * D, 2 * D, 2 * D, S, E);
    }
    SEAM(4);
    if (IN(5)) {
        if (F.G == 256) {
            pg8::OrderX<0> S; S.init(ws + WS_QM, ws + WS_KMEM, F.G, bx);
            pg8::EpiSoftmax E{(bf16_t*)(ws + WS_PB)};
            pg8::gemm_phase<pg8::EpiSoftmax, pg8::OrderX<0>, false, false, true>(F.lds + RING_OFF, 2 * D, 2 * D, 2 * XHD, S, E);
        }
    }
    SEAM(5);
    if (IN(6)) {
        pg8::OrderX<1> S; S.init(ws + WS_PB, ws + WS_VT, F.G, bx);
        pg8::EpiO E{(bf16_t*)(ws + WS_OB)};
        pg8::gemm_phase<pg8::EpiO, pg8::OrderX<1>, false, true, true>(F.lds + RING_OFF, 2 * D, 2 * MROWS, 2 * MEMLEN, S, E);
    }
    SEAM(6);
    if (IN(7)) {
        pg8::OrderPlain S; S.init(ws + WS_OB, ws + WS_WO_T, D, D, M / 256, D / 256, F.G, bx);
        pg8::EpiRes<true> E{(const float*)(ws + WS_X1), (float*)(ws + WS_X2), (bf16_t*)(ws + WS_X2B), (float*)(ws + WS_SS2)};
        pg8::gemm_phase<pg8::EpiRes<true>, pg8::OrderPlain, false, false, true>(F.lds + RING_OFF, 2 * D, 2 * D, 2 * D, S, E);
    }
    SEAM(7);
    if (IN(8)) { p8_router(F); }
    SEAM(8);
    if (IN(9)) {
        pg8::OrderMoe<8, true> S; S.init(F.ctl + CW_CNT, (const int*)(ws + WS_LTOK), ws + WS_X2B, ws + WS_W1_T, F.G, bx);
        pg8::EpiAct E{(bf16_t*)(ws + WS_ACT), (const float*)(ws + WS_LRSTD), F.in[17]};
        pg8::gemm_phase<pg8::EpiAct, pg8::OrderMoe<8, true>, true, true, true, true>(F.lds + RING_OFF, D, D, D, S, E);
    }
    SEAM(9);
    if (IN(10)) {
        pg8::OrderMoe<4, false> S; S.init(F.ctl + CW_CNT, (const int*)(ws + WS_LTOK), ws + WS_ACT, ws + WS_W2_T, F.G, bx);
        pg8::EpiY E{(bf16_t*)(ws + WS_Y), (const float*)(ws + WS_LGATE), (const int*)(ws + WS_LTOK), F.in[19]};
        pg8::gemm_phase<pg8::EpiY, pg8::OrderMoe<4, false>, false, true, true, true>(F.lds + RING_OFF, DEXP, DEXP, DEXP, S, E);
    }
    SEAM(10);
    if (IN(11)) { p11_final(F); }
#undef IN
#undef SEAM
}

extern "C" void kernel_launch(void* const* d_in, const int* in_sizes, int n_in, void* d_out, int out_size, void* d_ws, size_t ws_size, hipStream_t stream) {
    static int grid = 0;
    if (grid == 0) {
        if (n_in != 21 || in_sizes[0] != M * D || out_size != M * D || ws_size < WS_END) { fprintf(stderr, "kernel_launch: unexpected shapes (n_in %d, in0 %d, out %d, ws %zu)\n", n_in, n_in > 0 ? in_sizes[0] : -1, out_size, ws_size); grid = -1; return; }
        int dev = 0, cus = 0, per_cu = 0;
        if (hipGetDevice(&dev) != hipSuccess || hipDeviceGetAttribute(&cus, hipDeviceAttributeMultiprocessorCount, dev) != hipSuccess) { grid = -1; return; }
        if (hipFuncSetAttribute((const void*)fwd, hipFuncAttributeMaxDynamicSharedMemorySize, LDS_BYTES) != hipSuccess) { fprintf(stderr, "kernel_launch: hipFuncSetAttribute failed\n"); grid = -1; return; }
        if (hipOccupancyMaxActiveBlocksPerMultiprocessor(&per_cu, (const void*)fwd, NWAVES * 64, LDS_BYTES) != hipSuccess || per_cu < 1) { fprintf(stderr, "kernel_launch: occupancy query says %d\n", per_cu); per_cu = 1; }
        (void)hipGetLastError();
        grid = cus;
    }
    if (grid < 0) return;
    (void)hipMemsetAsync((char*)d_ws + WS_CTL, 0, CTL_ZERO_BYTES, stream);
    Args a{};
    for (int i = 0; i < 21; ++i) a.in[i] = (const float*)d_in[i];
    a.out = (float*)d_out; a.ws = (unsigned char*)d_ws;
    if (MK_N_LAUNCHES == 1) {
        a.ph_lo = 0; a.ph_hi = NPHASE;
        void* kargs[] = {&a};
        hipError_t e = hipLaunchCooperativeKernel((const void*)fwd, dim3(grid), dim3(NWAVES * 64), kargs, LDS_BYTES, stream);
        if (e != hipSuccess) fprintf(stderr, "kernel_launch: cooperative launch failed: %s\n", hipGetErrorString(e));
    } else {
        for (int pi = 0; pi < NPHASE; ++pi) { const int p = pi == 0 ? 0 : pi == 1 ? 12 : pi - 1; a.ph_lo = p; a.ph_hi = p + 1; for (int rep = 0; rep < NREP(p); ++rep) hipLaunchKernelGGL(fwd, dim3(grid), dim3(NWAVES * 64), LDS_BYTES, stream, a); }
    }
}
```

```cpp
#include <hip/hip_runtime.h>
#include <hip/hip_cooperative_groups.h>
#include <cstdio>
#include <cstdint>
namespace cg = cooperative_groups;

#ifndef MK_N_LAUNCHES
#define MK_N_LAUNCHES 1
#endif
#ifndef DUP_MASK
#define DUP_MASK 0
#endif
#define NREP(k) (((DUP_MASK >> (k)) & 1) ? 2 : 1)

constexpr int D = 1024, BATCH = 8, SEQ = 2048, M = BATCH * SEQ, MEMLEN = 256, MROWS = BATCH * MEMLEN;
constexpr int NPROJ = 3072, NE = 32, TOPK = 4, DEXP = 1024;
constexpr int XH = 4, XHD = 256;
constexpr float EPS = 1e-5f;
constexpr float LOG2E = 1.4426950408889634f;
constexpr float C2Q = 0.125f * LOG2E;
constexpr float C2X = 0.0625f * LOG2E;
constexpr int LISTCAP = M;
constexpr int ACT_ROWS = M * TOPK + NE * 256;

#define GAS __attribute__((address_space(1)))
#define LAS __attribute__((address_space(3)))
typedef unsigned short bf16_t;
typedef short bf16x8 __attribute__((ext_vector_type(8)));
typedef short s16x4 __attribute__((ext_vector_type(4)));
typedef float f32x4 __attribute__((ext_vector_type(4)));
typedef float f32x2 __attribute__((ext_vector_type(2)));
typedef float f32x16 __attribute__((ext_vector_type(16)));
typedef unsigned u32x4 __attribute__((ext_vector_type(4)));
typedef unsigned u32x2 __attribute__((ext_vector_type(2)));
typedef GAS unsigned gu32;

constexpr size_t MiB = 1u << 20;
constexpr size_t WS_CTL = 0, CTL_ZERO_BYTES = 1 * MiB;
constexpr size_t WS_WIN_T = 2 * MiB, WS_WOUT_T = 8 * MiB, WS_WQ_T = 10 * MiB, WS_WKV_T = 12 * MiB, WS_WO_T = 16 * MiB, WS_WR = 18 * MiB;
constexpr size_t WS_MEMN = 19 * MiB, WS_KMEM = 23 * MiB, WS_VT = 27 * MiB, WS_SS1 = 31 * MiB, WS_SS2 = 32 * MiB, WS_RSTD3 = 33 * MiB, WS_LTOK = 34 * MiB, WS_LGATE = 36 * MiB, WS_LRSTD = 38 * MiB;
constexpr size_t WS_W1_T = 40 * MiB, WS_W2_T = 168 * MiB;
constexpr size_t WS_XN = 232 * MiB, WS_PROJ = 264 * MiB, WS_YMIX = 360 * MiB;
constexpr size_t WS_X1 = 392 * MiB, WS_X1B = 456 * MiB, WS_QM = 488 * MiB, WS_PB = 520 * MiB, WS_OB = 552 * MiB, WS_X2 = 584 * MiB, WS_X2B = 648 * MiB;
constexpr size_t WS_ACT = 232 * MiB;
constexpr size_t WS_Y = 392 * MiB;
constexpr size_t WS_END = 680 * MiB;
static_assert(WS_ACT + (size_t)ACT_ROWS * DEXP <= WS_X1 && WS_Y + (size_t)M * TOPK * D * 2 <= WS_PB, "overlays");
constexpr int CW_TMO = 0, CW_CODE = 1, CW_BAR = 4096, CW_CNT = 8192;

__device__ __forceinline__ unsigned cvt_pk_bf16(float lo, float hi) { unsigned r; asm volatile("v_cvt_pk_bf16_f32 %0, %1, %2" : "=v"(r) : "v"(lo), "v"(hi)); return r; }
__device__ __forceinline__ unsigned cvtpk_s(float lo, float hi) { typedef __bf16 bf16x2_t __attribute__((ext_vector_type(2))); f32x2 v = {lo, hi}; bf16x2_t b = __builtin_convertvector(v, bf16x2_t); return __builtin_bit_cast(unsigned, b); }
__device__ __forceinline__ float clamp448(float v) { return fminf(fmaxf(v, -448.0f), 448.0f); }
__device__ __forceinline__ unsigned pk_fp8x4(float a, float b, float c, float d) { int w = 0; w = __builtin_amdgcn_cvt_pk_fp8_f32(clamp448(a), clamp448(b), w, false); w = __builtin_amdgcn_cvt_pk_fp8_f32(clamp448(c), clamp448(d), w, true); return (unsigned)w; }
constexpr float W8_SCALE = 64.0f, ACT8_SCALE = 4.0f;
constexpr int E8_ONE = 0x7F7F7F7F, E8_W = 0x79797979, E8_ACT = 0x7D7D7D7D;
__device__ __forceinline__ float bf_lo(unsigned w) { return __uint_as_float(w << 16); }
__device__ __forceinline__ float bf_hi(unsigned w) { return __uint_as_float(w & 0xffff0000u); }
__device__ __forceinline__ float wave_sum(float v) {
#pragma unroll
    for (int o = 1; o < 64; o <<= 1) v += __shfl_xor(v, o);
    return v;
}
#define LDS_WAIT() asm volatile("s_waitcnt lgkmcnt(0)" ::: "memory")
#define VM_WAIT() asm volatile("s_waitcnt vmcnt(0)" ::: "memory")

namespace pg8 {
constexpr int BM = 256, BK = 64, HALF = 128, HTB = HALF * BK * 2, STAGE_BYTES = 8 * HTB, NXCD = 8, WGM = 8;
__host__ __device__ __forceinline__ int lds_byte(int r, int c) { const int st = (r >> 4) * 2 + (c >> 5), rr = r & 15, cc = c & 31, ob = rr * 64 + cc * 2; return st * 1024 + (ob ^ (((ob >> 9) & 1) << 5)); }
__host__ __device__ __forceinline__ void stage_rc(int b, int& R, int& C) { const int st = b / 1024, sb = b % 1024, swz = sb ^ (((sb >> 9) & 1) << 5); R = (st >> 1) * 16 + swz / 64; C = (st & 1) * 32 + (swz % 64) / 2; }
__host__ __device__ __forceinline__ int perm32(int rho) { const int n = rho >> 4, i = rho & 15; return 8 * (i >> 2) + 4 * n + (i & 3); }

struct Unit { const char* a; const char* b; int pm, pn; };
struct UnitK { const char* a; const char* b; int pm, pn, kind; };
struct UnitM { const char* a; const char* b; const int* tok; int pm, pn, nvalid, e, rowoff; };

struct GridOrder {
    int nM, nN, nwg;
    __device__ __forceinline__ void init(int nM_, int nN_) { nM = nM_; nN = nN_; nwg = nM * nN; }
    __device__ __forceinline__ void map(int L, int& pm, int& pn) const {
        int wgid = L; { const int q = nwg / NXCD, r = nwg % NXCD, xcd = wgid % NXCD, off = wgid / NXCD; wgid = (xcd < r ? xcd * (q + 1) : r * (q + 1) + (xcd - r) * q) + off; }
        const int nig = WGM * nN, gid = wgid / nig, fm = gid * WGM, gsz = (nM - fm) < WGM ? (nM - fm) : WGM;
        pm = fm + ((wgid % nig) % gsz); pn = (wgid % nig) / gsz;
    }
};

typedef f32x4 Acc[2][2][4][2];

template <class Epi, class Sched, bool GATHER, bool ALIGN_EPI, bool SP2, bool F8 = false, int SCA = 0x7F7F7F7F, int SCB = 0x7F7F7F7F>
__device__ __forceinline__ void gemm_phase(LAS unsigned char* lds, const int lda, const int ldb, const int K, const Sched& S, const Epi& E) {
    const int tid = threadIdx.x, wid = __builtin_amdgcn_readfirstlane(tid >> 6), lane = tid & 63, wr = wid >> 2, wc = wid & 3, fr = lane & 15, fq = lane >> 4;
    int nt = K / 128; asm volatile("" : "+s"(nt));
    int RA[2], CA[2]; unsigned voffB[2];
#pragma unroll
    for (int i = 0; i < 2; ++i) { int R, C; stage_rc(tid * 16 + i * 8192, R, C); const int Rb = Epi::PERM ? ((R & ~31) + perm32(R & 31)) : R;
        RA[i] = R; CA[i] = C; voffB[i] = (unsigned)(Rb * ldb + C * 2); }
    const size_t kstep = (size_t)(BK * 2);
    const size_t hstepB = (size_t)HALF * ldb;
    const unsigned ldsw = (unsigned)wid * 1024u;
    const int aoff = lds_byte(wr * 64 + fr, fq * 8), boff = lds_byte(wc * 32 + fr, fq * 8);
#define PG8_SA(b, h) (((b) * 2 + (h)) * HTB)
#define PG8_SB(b, h) ((4 + (b) * 2 + (h)) * HTB)
#define PG8_STAGE(bufoff, gbase, voff) do { _Pragma("unroll") for (int _i = 0; _i < 2; ++_i) \
        __builtin_amdgcn_global_load_lds((const unsigned*)((const char*)(gbase) + (voff)[_i]), (LAS unsigned*)(lds + (bufoff) + ldsw + _i * 8192), 16, 0, 0); } while (0)
#define PG8_LDA(dst, b, h) do { _Pragma("unroll") for (int m = 0; m < 4; ++m) { if constexpr (F8) { \
            dst##8[m] = __builtin_shufflevector(*(const LAS i32x4_*)(lds + PG8_SA(b, h) + aoff + m * 2048), *(const LAS i32x4_*)(lds + PG8_SA(b, h) + aoff + m * 2048 + 1024), 0, 1, 2, 3, 4, 5, 6, 7); } \
        else { _Pragma("unroll") for (int k = 0; k < 2; ++k) dst[m][k] = *(const LAS bf16x8*)(lds + PG8_SA(b, h) + aoff + m * 2048 + k * 1024); } } } while (0)
#define PG8_LDB(dst, b, h) do { _Pragma("unroll") for (int n = 0; n < 2; ++n) { if constexpr (F8) { \
            dst##8[n] = __builtin_shufflevector(*(const LAS i32x4_*)(lds + PG8_SB(b, h) + boff + n * 2048), *(const LAS i32x4_*)(lds + PG8_SB(b, h) + boff + n * 2048 + 1024), 0, 1, 2, 3, 4, 5, 6, 7); } \
        else { _Pragma("unroll") for (int k = 0; k < 2; ++k) dst[n][k] = *(const LAS bf16x8*)(lds + PG8_SB(b, h) + boff + n * 2048 + k * 1024); } } } while (0)
#define PG8_MMA(ai, bj, At, Bt) do { __builtin_amdgcn_s_setprio(1); _Pragma("unroll") for (int m = 0; m < 4; ++m) _Pragma("unroll") for (int n = 0; n < 2; ++n) { \
        if constexpr (F8) { acc[ai][bj][m][n] = __builtin_amdgcn_mfma_scale_f32_16x16x128_f8f6f4(Bt##8[n], At##8[m], acc[ai][bj][m][n], 0, 0, 0, SCA, 0, SCB); } \
        else { _Pragma("unroll") for (int k = 0; k < 2; ++k) acc[ai][bj][m][n] = __builtin_amdgcn_mfma_f32_16x16x32_bf16(Bt[n][k], At[m][k], acc[ai][bj][m][n], 0, 0, 0); } } \
        __builtin_amdgcn_s_setprio(0); } while (0)
#define PG8_WAIT_V(n) asm volatile("s_waitcnt vmcnt(" #n ")" ::: "memory")
#define PG8_WAIT_L(n) asm volatile("s_waitcnt lgkmcnt(" #n ")" ::: "memory")
#define PG8_BAR __builtin_amdgcn_s_barrier()
#define PG8_SCHED __builtin_amdgcn_sched_barrier(0)
#define PG8_VOFFA(dst, u) do { if constexpr (GATHER) { int _t[2][2]; _Pragma("unroll") for (int _h = 0; _h < 2; ++_h) _Pragma("unroll") for (int _i = 0; _i < 2; ++_i) _t[_h][_i] = (u).tok[_h * HALF + RA[_i]]; \
        _Pragma("unroll") for (int _h = 0; _h < 2; ++_h) _Pragma("unroll") for (int _i = 0; _i < 2; ++_i) { const int _row = _h * HALF + RA[_i]; const int _tt = (_row < (u).nvalid) ? (_t[_h][_i] >> 2) : 0; dst[_h][_i] = (unsigned)(_tt * lda + CA[_i] * 2); } } \
        else { _Pragma("unroll") for (int _h = 0; _h < 2; ++_h) _Pragma("unroll") for (int _i = 0; _i < 2; ++_i) dst[_h][_i] = (unsigned)((_h * HALF + RA[_i]) * lda + CA[_i] * 2); } } while (0)
#define PG8_VOFFA_LDS(dst, u, slot) do { const LAS int* _mt = (const LAS int*)(lds + 131072 + (slot) * 3072 + 1024); _Pragma("unroll") for (int _h = 0; _h < 2; ++_h) _Pragma("unroll") for (int _i = 0; _i < 2; ++_i) { \
        const int _row = _h * HALF + RA[_i]; const int _tt = (_row < (u).nvalid) ? (_mt[_row] >> 2) : 0; dst[_h][_i] = (unsigned)(_tt * lda + CA[_i] * 2); } } while (0)
    typename Sched::U cur, nxt; int ui = 0;
    if (!S.next(0, cur)) return;
    Acc acc;
#pragma unroll
    for (int a = 0; a < 2; ++a)
#pragma unroll
        for (int b = 0; b < 2; ++b)
#pragma unroll
            for (int m = 0; m < 4; ++m)
#pragma unroll
                for (int n = 0; n < 2; ++n) acc[a][b][m][n] = (f32x4){0.f, 0.f, 0.f, 0.f};
    typedef int i32x4_ __attribute__((ext_vector_type(4))); typedef int i32x8_ __attribute__((ext_vector_type(8)));
    bf16x8 At[4][2], B0[2][2], B1[2][2]; i32x8_ At8[4], B08[2], B18[2];
    unsigned vA[2][2];
    PG8_VOFFA(vA, cur);
    const char* cA = cur.a; const char* cB = cur.b;
    E.prefetch(cur, 0, lds, wid, lane);
    if constexpr (SP2) {
        PG8_STAGE(PG8_SB(0, 0), cB, voffB); PG8_STAGE(PG8_SB(0, 1), cB + hstepB, voffB); PG8_STAGE(PG8_SA(0, 0), cA, vA[0]); PG8_STAGE(PG8_SA(0, 1), cA, vA[1]);
        if (wr == 1) PG8_BAR;
        PG8_WAIT_V(2); PG8_BAR;
        PG8_STAGE(PG8_SB(1, 0), cB + kstep, voffB); PG8_STAGE(PG8_SA(1, 0), cA + kstep, vA[0]); PG8_STAGE(PG8_SB(1, 1), cB + hstepB + kstep, voffB);
        PG8_WAIT_V(6); PG8_BAR;
    } else {
        PG8_STAGE(PG8_SB(0, 0), cB, voffB); PG8_STAGE(PG8_SA(0, 0), cA, vA[0]); PG8_STAGE(PG8_SB(0, 1), cB + hstepB, voffB); PG8_STAGE(PG8_SA(0, 1), cA, vA[1]);
        if (wr == 1) PG8_BAR;
        PG8_WAIT_V(4); PG8_BAR;
        PG8_STAGE(PG8_SB(1, 0), cB + kstep, voffB); PG8_STAGE(PG8_SA(1, 0), cA + kstep, vA[0]); PG8_STAGE(PG8_SB(1, 1), cB + hstepB + kstep, voffB);
        PG8_WAIT_V(6); PG8_BAR;
    }
    for (;;) {
        const bool has_next = S.next(ui + 1, nxt);
        const char* nA = has_next ? nxt.a : cA; const char* nB = has_next ? nxt.b : cB;
        if (has_next) E.prefetch(nxt, ui + 1, lds, wid, lane);
        for (int t = 0; t < nt; t += 2) {
            const bool last = (t == nt - 2);
            asm volatile("" : "+v"(vA[0][0]), "+v"(vA[0][1]), "+v"(vA[1][0]), "+v"(vA[1][1]), "+v"(voffB[0]), "+v"(voffB[1]));
            const char* a1 = cA + (size_t)(t + 1) * kstep;
            const char* a2 = last ? nA : cA + (size_t)(t + 2) * kstep; const char* b2 = last ? nB : cB + (size_t)(t + 2) * kstep;
            const char* a3 = a2 + kstep; const char* b3 = b2 + kstep;
            if constexpr (SP2) {
            PG8_LDB(B0, 0, 0); PG8_LDB(B1, 0, 1); PG8_SCHED; PG8_LDA(At, 0, 0); PG8_STAGE(PG8_SA(1, 1), a1, vA[1]); if (last && has_next) { if constexpr (GATHER) { PG8_VOFFA_LDS(vA, nxt, (ui + 1) % 3); } else { PG8_VOFFA(vA, nxt); } }
            PG8_WAIT_V(8); PG8_WAIT_L(0); PG8_BAR; PG8_MMA(0, 0, At, B0); PG8_MMA(0, 1, At, B1); PG8_BAR; PG8_SCHED;
            PG8_LDA(At, 0, 1); PG8_STAGE(PG8_SB(0, 0), b2, voffB); PG8_STAGE(PG8_SB(0, 1), b2 + hstepB, voffB); PG8_STAGE(PG8_SA(0, 0), a2, vA[0]);
            PG8_WAIT_V(8); PG8_WAIT_L(0); PG8_BAR; PG8_MMA(1, 0, At, B0); PG8_MMA(1, 1, At, B1); PG8_BAR; PG8_SCHED;
            PG8_LDB(B0, 1, 0); PG8_LDB(B1, 1, 1); PG8_SCHED; PG8_LDA(At, 1, 0); PG8_STAGE(PG8_SA(0, 1), a2, vA[1]);
            PG8_WAIT_V(8); PG8_WAIT_L(0); PG8_BAR; PG8_MMA(0, 0, At, B0); PG8_MMA(0, 1, At, B1); PG8_BAR; PG8_SCHED;
            PG8_LDA(At, 1, 1); PG8_STAGE(PG8_SB(1, 0), b3, voffB); PG8_STAGE(PG8_SB(1, 1), b3 + hstepB, voffB); PG8_STAGE(PG8_SA(1, 0), a3, vA[0]);
            PG8_WAIT_V(8); PG8_WAIT_L(0); PG8_BAR; PG8_MMA(1, 0, At, B0); PG8_MMA(1, 1, At, B1); PG8_BAR; PG8_SCHED;
            } else {
            PG8_LDB(B0, 0, 0); PG8_SCHED; PG8_LDA(At, 0, 0); PG8_STAGE(PG8_SA(1, 1), a1, vA[1]); if (last && has_next) { if constexpr (GATHER) { PG8_VOFFA_LDS(vA, nxt, (ui + 1) % 3); } else { PG8_VOFFA(vA, nxt); } }
            PG8_WAIT_L(8); PG8_BAR; PG8_WAIT_L(0); PG8_MMA(0, 0, At, B0); PG8_BAR; PG8_SCHED;
            PG8_LDB(B1, 0, 1); PG8_STAGE(PG8_SB(0, 0), b2, voffB);
            PG8_BAR; PG8_WAIT_L(0); PG8_MMA(0, 1, At, B1); PG8_BAR;
            PG8_LDA(At, 0, 1); PG8_STAGE(PG8_SA(0, 0), a2, vA[0]);
            PG8_BAR; PG8_WAIT_L(0); PG8_MMA(1, 0, At, B0); PG8_BAR; PG8_SCHED;
            PG8_STAGE(PG8_SB(0, 1), b2 + hstepB, voffB);
            PG8_WAIT_V(6); PG8_BAR; PG8_MMA(1, 1, At, B1); PG8_BAR;
            PG8_LDB(B0, 1, 0); PG8_SCHED; PG8_LDA(At, 1, 0); PG8_STAGE(PG8_SA(0, 1), a2, vA[1]);
            PG8_WAIT_L(8); PG8_BAR; PG8_WAIT_L(0); PG8_MMA(0, 0, At, B0); PG8_BAR; PG8_SCHED;
            PG8_LDB(B1, 1, 1); PG8_STAGE(PG8_SB(1, 0), b3, voffB);
            PG8_BAR; PG8_WAIT_L(0); PG8_MMA(0, 1, At, B1); PG8_BAR;
            PG8_LDA(At, 1, 1); PG8_STAGE(PG8_SA(1, 0), a3, vA[0]);
            PG8_BAR; PG8_WAIT_L(0); PG8_MMA(1, 0, At, B0); PG8_BAR; PG8_SCHED;
            PG8_STAGE(PG8_SB(1, 1), b3 + hstepB, voffB);
            PG8_WAIT_V(6); PG8_BAR; PG8_MMA(1, 1, At, B1); PG8_BAR;
            }
        }
        if constexpr (ALIGN_EPI) { if (wr == 0) PG8_BAR; }
        if constexpr (!Epi::AFTER_DRAIN) { E(acc, cur, ui, lds, wr, wc, fr, fq); }
        if (!has_next) break;
#pragma unroll
        for (int a = 0; a < 2; ++a)
#pragma unroll
            for (int b = 0; b < 2; ++b)
#pragma unroll
                for (int m = 0; m < 4; ++m)
#pragma unroll
                    for (int n = 0; n < 2; ++n) acc[a][b][m][n] = (f32x4){0.f, 0.f, 0.f, 0.f};
        cur = nxt; cA = nA; cB = nB; ++ui;
        if constexpr (ALIGN_EPI) { if (wr == 1) PG8_BAR; }
    }
    PG8_WAIT_V(0);
    if constexpr (!ALIGN_EPI) { if (wr == 0) PG8_BAR; }
    PG8_BAR;
    if constexpr (Epi::AFTER_DRAIN) { E.fused(acc, cur, wr, wc, fr, fq, lds, wid, lane); }
#undef PG8_SA
#undef PG8_SB
#undef PG8_STAGE
#undef PG8_LDA
#undef PG8_LDB
#undef PG8_MMA
#undef PG8_WAIT_V
#undef PG8_WAIT_L
#undef PG8_BAR
#undef PG8_SCHED
#undef PG8_VOFFA
#undef PG8_VOFFA_LDS
}

struct OrderKV {
    typedef UnitK U;
    const char *memn, *wkv_t; int c;
    __device__ __forceinline__ void init(const void* memn_, const void* wkv_t_, int c_) { memn = (const char*)memn_; wkv_t = (const char*)wkv_t_; c = c_; }
    __device__ __forceinline__ bool next(int i, UnitK& u) const {
        if (i > 0 || c >= 64) return false;
        int r = c;
        if (r < 32) { u.kind = 1; u.pm = r >> 2; u.pn = r & 3; u.a = memn + (size_t)u.pm * 256 * D * 2; u.b = wkv_t + (size_t)u.pn * 256 * D * 2; return true; }
        r -= 32;
        u.kind = 2; u.pm = r >> 3; u.pn = r & 7; u.a = wkv_t + (size_t)(D + u.pm * 256) * D * 2; u.b = memn + (size_t)u.pn * 256 * D * 2; return true;
    }
};
struct OrderIn {
    typedef UnitK U;
    const char *A, *Bt; int G, c; GridOrder g0;
    __device__ __forceinline__ void init(const void* A_, const void* Bt_, int G_, int c_) { A = (const char*)A_; Bt = (const char*)Bt_; G = G_; c = c_; g0.init(M / 256, NPROJ / 256); }
    __device__ __forceinline__ bool next(int i, UnitK& u) const {
        const int L = i * G + c; if (L >= g0.nwg) return false;
        g0.map(L, u.pm, u.pn); u.kind = 0; u.a = A + (size_t)u.pm * 256 * D * 2; u.b = Bt + (size_t)u.pn * 256 * D * 2; return true;
    }
};
struct OrderPlain {
    typedef Unit U;
    const char *A, *Bt; int lda, ldb, G, c; GridOrder g0;
    __device__ __forceinline__ void init(const void* A_, const void* Bt_, int lda_, int ldb_, int nM, int nN, int G_, int c_) { A = (const char*)A_; Bt = (const char*)Bt_; lda = lda_; ldb = ldb_; G = G_; c = c_; g0.init(nM, nN); }
    __device__ __forceinline__ bool next(int i, Unit& u) const {
        const int L = i * G + c; if (L >= g0.nwg) return false;
        g0.map(L, u.pm, u.pn);
        u.a = A + (size_t)u.pm * 256 * lda * 2; u.b = Bt + (size_t)u.pn * 256 * ldb * 2; return true;
    }
};
struct OrderQ {
    typedef Unit U;
    const char *A, *Bt; int G, c;
    __device__ __forceinline__ void init(const void* A_, const void* Bt_, int G_, int c_) { A = (const char*)A_; Bt = (const char*)Bt_; G = G_; c = c_; }
    __device__ __forceinline__ bool next(int i, Unit& u) const {
        const int L = i * G + c; if (L >= (M / 256) * XH) return false;
        const int xcd = L & 7, j = L >> 3; u.pm = xcd * 8 + (j >> 2); u.pn = j & 3;
        u.a = A + (size_t)u.pm * 256 * D * 2; u.b = Bt + (size_t)u.pn * 256 * D * 2; return true;
    }
};
template <int MODE> struct OrderX {
    typedef Unit U;
    const char *A, *Bt; int G, c;
    __device__ __forceinline__ void init(const void* A_, const void* Bt_, int G_, int c_) { A = (const char*)A_; Bt = (const char*)Bt_; G = G_; c = c_; }
    __device__ __forceinline__ bool next(int i, Unit& u) const {
        const int L = i * G + c; if (L >= (M / 256) * XH) return false;
        const int xcd = L & 7, j = L >> 3; u.pm = xcd * 8 + (j >> 2); u.pn = j & 3;
        const int b = u.pm >> 3;
        u.a = A + ((size_t)u.pm * 256 * D + (size_t)u.pn * XHD) * 2;
        if (MODE == 0) u.b = Bt + ((size_t)b * MEMLEN * D + (size_t)u.pn * XHD) * 2;
        else u.b = Bt + ((size_t)u.pn * XHD * MROWS + (size_t)b * MEMLEN) * 2;
        return true;
    }
};
template <int NTN, bool G1> struct OrderMoe {
    typedef UnitM U;
    const int* ltok; const char* A; const char* Bt; int G, c; int seg[4], til[4], cn[4];
    __device__ __forceinline__ void init(const unsigned* cnt, const int* ltok_, const void* A_, const void* Bt_, int G_, int c_) {
        ltok = ltok_; A = (const char*)A_; Bt = (const char*)Bt_; G = G_; c = c_;
        const int lane = threadIdx.x & 63; const int cv = (lane < NE) ? (int)__hip_atomic_load(cnt + 64 * lane, __ATOMIC_RELAXED, __HIP_MEMORY_SCOPE_AGENT) : 0;
        const int t = (cv + 255) >> 8; int incl = t;
#pragma unroll
        for (int o = 1; o < 32; o <<= 1) { const int v = __shfl_up(incl, o); if (lane >= o) incl += v; }
        const int excl = incl - t, xcd = c & 7;
#pragma unroll
        for (int q = 0; q < 4; ++q) { seg[q] = __builtin_amdgcn_readlane(excl, xcd + 8 * q); til[q] = __builtin_amdgcn_readlane(t, xcd + 8 * q); cn[q] = __builtin_amdgcn_readlane(cv, xcd + 8 * q); }
    }
    __device__ __forceinline__ bool next(int i, UnitM& u) const {
        const int xcd = c & 7, slot = c >> 3, nslot = G >> 3; int j = i * nslot + slot;
#pragma unroll
        for (int q = 0; q < 4; ++q) {
            const int nu = til[q] * NTN;
            if (j < nu) { const int e = xcd + 8 * q, mt = j / NTN, nt = j % NTN;
                u.e = e; u.pm = mt; u.pn = nt; u.rowoff = (seg[q] + mt) * 256; u.nvalid = cn[q] - mt * 256 < 256 ? cn[q] - mt * 256 : 256; u.tok = ltok + (size_t)e * LISTCAP + mt * 256;
                if (G1) { u.a = A; u.b = Bt + ((size_t)e * 2048 + (size_t)nt * 256) * D; }
                else { u.a = A + (size_t)u.rowoff * DEXP; u.b = Bt + ((size_t)e * 1024 + (size_t)nt * 256) * DEXP; }
                return true; }
            j -= nu;
        }
        return false;
    }
};

struct EpiP1 {
    static constexpr bool PERM = true, AFTER_DRAIN = false;
    bf16_t *proj, *kmem, *vt;
    __device__ __forceinline__ void prefetch(const UnitK&, int, LAS unsigned char*, int, int) const {}
    __device__ __forceinline__ void operator()(const Acc& acc, const UnitK& u, int, LAS unsigned char*, int wr, int wc, int fr, int fq) const {
        bf16_t* base; int ldc; float sc = 1.f;
        if (u.kind == 0) { base = proj; ldc = NPROJ; if (u.pn >= 6 && u.pn < 8) sc = C2Q; } else if (u.kind == 1) { base = kmem; ldc = D; } else { base = vt; ldc = MROWS; }
        const int row0 = u.pm * BM + wr * 64 + fr, col0 = u.pn * BM + wc * 32 + 8 * fq;
#pragma unroll
        for (int ai = 0; ai < 2; ++ai)
#pragma unroll
            for (int m = 0; m < 4; ++m) { bf16_t* rowp = base + (size_t)(row0 + ai * HALF + m * 16) * ldc + col0;
#pragma unroll
                for (int bj = 0; bj < 2; ++bj) { const f32x4 v0 = acc[ai][bj][m][0] * sc, v1 = acc[ai][bj][m][1] * sc;
                    u32x4 w; w.x = cvt_pk_bf16(v0[0], v0[1]); w.y = cvt_pk_bf16(v0[2], v0[3]); w.z = cvt_pk_bf16(v1[0], v1[1]); w.w = cvt_pk_bf16(v1[2], v1[3]);
                    *(u32x4*)(rowp + bj * HALF) = w; } }
    }
};
template <bool OUT8> struct EpiRes {
    static constexpr bool PERM = true, AFTER_DRAIN = true;
    const float* base; float* xo; bf16_t* xb; float* ss;
    __device__ __forceinline__ void prefetch(const Unit&, int, LAS unsigned char*, int, int) const {}
    __device__ __forceinline__ void fused(Acc& acc, const Unit& u, int wr, int wc, int fr, int fq, LAS unsigned char* lds, int wid, int lane) const {
        LAS float* PSS = (LAS float*)lds;
        const int col0 = u.pn * BM + wc * 32 + 8 * fq;
#pragma unroll
        for (int ai = 0; ai < 2; ++ai)
#pragma unroll
            for (int m = 0; m < 4; ++m) { const int r = ai * HALF + wr * 64 + m * 16 + fr; const size_t off = (size_t)(u.pm * BM + r) * D + col0; float sq = 0.f;
#pragma unroll
                for (int bj = 0; bj < 2; ++bj) { const f32x4 b0 = *(const f32x4*)(base + off + bj * HALF), b1 = *(const f32x4*)(base + off + bj * HALF + 4);
                    const f32x4 o0 = b0 + acc[ai][bj][m][0], o1 = b1 + acc[ai][bj][m][1];
                    *(f32x4*)(xo + off + bj * HALF) = o0; *(f32x4*)(xo + off + bj * HALF + 4) = o1;
                    if constexpr (OUT8) { u32x2 w; w.x = pk_fp8x4(o0[0], o0[1], o0[2], o0[3]); w.y = pk_fp8x4(o1[0], o1[1], o1[2], o1[3]); *(u32x2*)((unsigned char*)xb + off + bj * HALF) = w; }
                    else { u32x4 w; w.x = cvt_pk_bf16(o0[0], o0[1]); w.y = cvt_pk_bf16(o0[2], o0[3]); w.z = cvt_pk_bf16(o1[0], o1[1]); w.w = cvt_pk_bf16(o1[2], o1[3]); *(u32x4*)(xb + off + bj * HALF) = w; }
                    sq += ((o0[0] * o0[0] + o0[1] * o0[1]) + (o0[2] * o0[2] + o0[3] * o0[3])) + ((o1[0] * o1[0] + o1[1] * o1[1]) + (o1[2] * o1[2] + o1[3] * o1[3])); }
                sq += __shfl_xor(sq, 16); sq += __shfl_xor(sq, 32);
                if (fq == 0) PSS[r * 4 + wc] = sq; }
        __syncthreads();
        if (threadIdx.x < 256) { const f32x4 p = *(const LAS f32x4*)(PSS + threadIdx.x * 4); ss[(size_t)(u.pm * BM + threadIdx.x) * 4 + u.pn] = (p[0] + p[1]) + (p[2] + p[3]); }
        __syncthreads();
    }
};
__device__ __forceinline__ float rstd_from_ss(const float* ss, int row) {
    const f32x4 a = *(const f32x4*)(ss + (size_t)row * 4);
    return __builtin_amdgcn_rsqf(((a[0] + a[1]) + (a[2] + a[3])) * (1.0f / D) + EPS);
}
struct EpiQm {
    static constexpr bool PERM = true, AFTER_DRAIN = true;
    bf16_t* qm; const float* ss;
    __device__ __forceinline__ void prefetch(const Unit&, int, LAS unsigned char*, int, int) const {}
    __device__ __forceinline__ void fused(Acc& acc, const Unit& u, int wr, int wc, int fr, int fq, LAS unsigned char* lds, int wid, int lane) const {
        const int row0 = u.pm * BM + wr * 64 + fr, col0 = u.pn * BM + wc * 32 + 8 * fq;
        float sc[2][4];
#pragma unroll
        for (int ai = 0; ai < 2; ++ai)
#pragma unroll
            for (int m = 0; m < 4; ++m) sc[ai][m] = rstd_from_ss(ss, row0 + ai * HALF + m * 16) * C2X;
#pragma unroll
        for (int ai = 0; ai < 2; ++ai)
#pragma unroll
            for (int m = 0; m < 4; ++m) { const int row = row0 + ai * HALF + m * 16; bf16_t* rowp = qm + (size_t)row * D + col0;
#pragma unroll
                for (int bj = 0; bj < 2; ++bj) { const f32x4 v0 = acc[ai][bj][m][0] * sc[ai][m], v1 = acc[ai][bj][m][1] * sc[ai][m];
                    u32x4 w; w.x = cvt_pk_bf16(v0[0], v0[1]); w.y = cvt_pk_bf16(v0[2], v0[3]); w.z = cvt_pk_bf16(v1[0], v1[1]); w.w = cvt_pk_bf16(v1[2], v1[3]);
                    *(u32x4*)(rowp + bj * HALF) = w; } }
    }
};
struct EpiSoftmax {
    static constexpr bool PERM = true, AFTER_DRAIN = true;
    bf16_t* pb;
    __device__ __forceinline__ void prefetch(const Unit&, int, LAS unsigned char*, int, int) const {}
    __device__ __forceinline__ void fused(Acc& acc, const Unit& u, int wr, int wc, int fr, int fq, LAS unsigned char* lds, int wid, int lane) const {
        LAS float* PM = (LAS float*)lds;
        LAS float* PS = (LAS float*)(lds + 4096);
#pragma unroll
        for (int ai = 0; ai < 2; ++ai)
#pragma unroll
            for (int m = 0; m < 4; ++m) { float mx = -INFINITY;
#pragma unroll
                for (int bj = 0; bj < 2; ++bj)
#pragma unroll
                    for (int n = 0; n < 2; ++n) { const f32x4 x = acc[ai][bj][m][n]; mx = fmaxf(mx, fmaxf(fmaxf(x[0], x[1]), fmaxf(x[2], x[3]))); }
                mx = fmaxf(mx, __shfl_xor(mx, 16)); mx = fmaxf(mx, __shfl_xor(mx, 32));
                if (fq == 0) PM[(ai * HALF + wr * 64 + m * 16 + fr) * 4 + wc] = mx; }
        __syncthreads();
#pragma unroll
        for (int ai = 0; ai < 2; ++ai)
#pragma unroll
            for (int m = 0; m < 4; ++m) { const int r = ai * HALF + wr * 64 + m * 16 + fr; const f32x4 pm4 = *(const LAS f32x4*)(PM + r * 4);
                const float mx = fmaxf(fmaxf(pm4[0], pm4[1]), fmaxf(pm4[2], pm4[3])); float s = 0.f;
#pragma unroll
                for (int bj = 0; bj < 2; ++bj)
#pragma unroll
                    for (int n = 0; n < 2; ++n) { f32x4 x = acc[ai][bj][m][n];
#pragma unroll
                        for (int j = 0; j < 4; ++j) { x[j] = __builtin_amdgcn_exp2f(x[j] - mx); s += x[j]; }
                        acc[ai][bj][m][n] = x; }
                s += __shfl_xor(s, 16); s += __shfl_xor(s, 32);
                if (fq == 0) PS[r * 4 + wc] = s; }
        __syncthreads();
        const int row0 = u.pm * BM + wr * 64 + fr, col0 = u.pn * XHD + wc * 32 + 8 * fq;
#pragma unroll
        for (int ai = 0; ai < 2; ++ai)
#pragma unroll
            for (int m = 0; m < 4; ++m) { const int r = ai * HALF + wr * 64 + m * 16 + fr; const f32x4 ps4 = *(const LAS f32x4*)(PS + r * 4);
                const float inv = 1.0f / ((ps4[0] + ps4[1]) + (ps4[2] + ps4[3])); bf16_t* rowp = pb + (size_t)(row0 + ai * HALF + m * 16) * D + col0;
#pragma unroll
                for (int bj = 0; bj < 2; ++bj) { const f32x4 v0 = acc[ai][bj][m][0] * inv, v1 = acc[ai][bj][m][1] * inv;
                    u32x4 w; w.x = cvt_pk_bf16(v0[0], v0[1]); w.y = cvt_pk_bf16(v0[2], v0[3]); w.z = cvt_pk_bf16(v1[0], v1[1]); w.w = cvt_pk_bf16(v1[2], v1[3]);
                    *(u32x4*)(rowp + bj * HALF) = w; } }
        __syncthreads();
    }
};
struct EpiO {
    static constexpr bool PERM = true, AFTER_DRAIN = false;
    bf16_t* ob;
    __device__ __forceinline__ void prefetch(const Unit&, int, LAS unsigned char*, int, int) const {}
    __device__ __forceinline__ void operator()(const Acc& acc, const Unit& u, int, LAS unsigned char*, int wr, int wc, int fr, int fq) const {
        const int row0 = u.pm * BM + wr * 64 + fr, col0 = u.pn * BM + wc * 32 + 8 * fq;
#pragma unroll
        for (int ai = 0; ai < 2; ++ai)
#pragma unroll
            for (int m = 0; m < 4; ++m) { bf16_t* rowp = ob + (size_t)(row0 + ai * HALF + m * 16) * D + col0;
#pragma unroll
                for (int bj = 0; bj < 2; ++bj) { const f32x4 v0 = acc[ai][bj][m][0], v1 = acc[ai][bj][m][1];
                    u32x4 w; w.x = cvt_pk_bf16(v0[0], v0[1]); w.y = cvt_pk_bf16(v0[2], v0[3]); w.z = cvt_pk_bf16(v1[0], v1[1]); w.w = cvt_pk_bf16(v1[2], v1[3]);
                    *(u32x4*)(rowp + bj * HALF) = w; } }
    }
};
constexpr int META_OFF = 131072, META_BYTES = 3072;
__device__ __forceinline__ void dma4(const void* g, LAS unsigned char* l) { __builtin_amdgcn_global_load_lds((const unsigned*)g, (LAS unsigned*)l, 4, 0, 0); }
__device__ __forceinline__ void dma16(const void* g, LAS unsigned char* l) { __builtin_amdgcn_global_load_lds((const unsigned*)g, (LAS unsigned*)l, 16, 0, 0); }
struct EpiAct {
    static constexpr bool PERM = true, AFTER_DRAIN = false;
    bf16_t* act; const float* lrstd; const float* b1;
    __device__ __forceinline__ void prefetch(const UnitM& u, int ui, LAS unsigned char* lds, int wid, int lane) const {
        LAS unsigned char* mb = lds + META_OFF + (ui % 3) * META_BYTES;
        if (wid < 4) dma4(lrstd + (size_t)u.e * LISTCAP + u.pm * 256 + wid * 64 + lane, mb + wid * 256);
        else dma4(u.tok + (wid - 4) * 64 + lane, mb + 1024 + (wid - 4) * 256);
        if (wid == 4) dma16(b1 + (size_t)u.e * 2048 + (lane >> 5) * 1024 + u.pn * 128 + (lane & 31) * 4, mb + 2048);
    }
    __device__ __forceinline__ void operator()(const Acc& acc, const UnitM& u, int ui, LAS unsigned char* lds, int wr, int wc, int fr, int fq) const {
        const LAS unsigned char* mb = lds + META_OFF + (ui % 3) * META_BYTES;
        const int cl = wc * 32 + 8 * fq, gcol = u.pn * 128 + cl; const LAS float* bg = (const LAS float*)(mb + 2048) + cl; const LAS float* bl = bg + 128;
        const f32x4 bg0 = *(const LAS f32x4*)bg, bg1 = *(const LAS f32x4*)(bg + 4), bl0 = *(const LAS f32x4*)bl, bl1 = *(const LAS f32x4*)(bl + 4);
        int rb = wr * 64 + fr; asm volatile("" : "+v"(rb));
#pragma unroll
        for (int ai = 0; ai < 2; ++ai)
#pragma unroll
            for (int m = 0; m < 4; ++m) { const int r = ai * HALF + m * 16 + rb; const float rs = ((const LAS float*)mb)[r] * (1.0f / W8_SCALE);
                float o[8];
#pragma unroll
                for (int n = 0; n < 2; ++n) { const f32x4 g4 = acc[ai][0][m][n] * rs + (n ? bg1 : bg0), l4 = acc[ai][1][m][n] * rs + (n ? bl1 : bl0);
#pragma unroll
                    for (int j = 0; j < 4; ++j) { const float g = fminf(g4[j], 7.0f), l = fminf(fmaxf(l4[j], -7.0f), 7.0f);
                        const float sg = __builtin_amdgcn_rcpf(1.0f + __builtin_amdgcn_exp2f(g * (-1.702f * LOG2E))); o[n * 4 + j] = g * sg * (l + 1.0f); } }
                u32x2 w; w.x = pk_fp8x4(o[0] * ACT8_SCALE, o[1] * ACT8_SCALE, o[2] * ACT8_SCALE, o[3] * ACT8_SCALE); w.y = pk_fp8x4(o[4] * ACT8_SCALE, o[5] * ACT8_SCALE, o[6] * ACT8_SCALE, o[7] * ACT8_SCALE);
                *(u32x2*)((unsigned char*)act + (size_t)(u.rowoff + r) * DEXP + gcol) = w; }
    }
};
struct EpiY {
    static constexpr bool PERM = true, AFTER_DRAIN = false;
    bf16_t* y; const float* lgate; const int* ltok; const float* b2;
    __device__ __forceinline__ void prefetch(const UnitM& u, int ui, LAS unsigned char* lds, int wid, int lane) const {
        LAS unsigned char* mb = lds + META_OFF + (ui % 3) * META_BYTES;
        const size_t li = (size_t)u.e * LISTCAP + u.pm * 256 + (wid & 3) * 64 + lane;
        if (wid < 4) dma4(lgate + li, mb + wid * 256); else dma4(ltok + li, mb + 1024 + (wid - 4) * 256);
        if (wid == 0) dma16(b2 + (size_t)u.e * D + u.pn * 256 + lane * 4, mb + 2048);
    }
    __device__ __forceinline__ void operator()(const Acc& acc, const UnitM& u, int ui, LAS unsigned char* lds, int wr, int wc, int fr, int fq) const {
        const LAS unsigned char* mb = lds + META_OFF + (ui % 3) * META_BYTES;
        const int cl = wc * 32 + 8 * fq, col0 = u.pn * BM + cl; const LAS float* bb = (const LAS float*)(mb + 2048) + cl;
        int rb = wr * 64 + fr; asm volatile("" : "+v"(rb));
#pragma unroll
        for (int bj = 0; bj < 2; ++bj) {
            const f32x4 bv0 = *(const LAS f32x4*)(bb + bj * HALF), bv1 = *(const LAS f32x4*)(bb + bj * HALF + 4);
#pragma unroll
            for (int ai = 0; ai < 2; ++ai)
#pragma unroll
                for (int m = 0; m < 4; ++m) { const int r = ai * HALF + m * 16 + rb;
                    if (r < u.nvalid) { const int ent = ((const LAS int*)(mb + 1024))[r]; const float gw = ((const LAS float*)mb)[r]; bf16_t* rowp = y + (size_t)ent * D + col0;
                        const f32x4 v0 = (acc[ai][bj][m][0] * (1.0f / (W8_SCALE * ACT8_SCALE)) + bv0) * gw, v1 = (acc[ai][bj][m][1] * (1.0f / (W8_SCALE * ACT8_SCALE)) + bv1) * gw;
                        u32x4 w; w.x = cvt_pk_bf16(v0[0], v0[1]); w.y = cvt_pk_bf16(v0[2], v0[3]); w.z = cvt_pk_bf16(v1[0], v1[1]); w.w = cvt_pk_bf16(v1[2], v1[3]);
                        *(u32x4*)(rowp + bj * HALF) = w; } }
        }
    }
};
}

#define XB_TMO      128
#define XB_XCNT(j)  (256  + 64 * (j))
#define XB_XSUB(j)  (1280 + 64 * (j))
#define XB_XGEN(j)  (2304 + 64 * (j))
#define XB_TOP      3328
#define XB_TOPGEN   3392
#define XCD_BAR_WORDS 3456
#define XB_SPIN_CAP (1u << 18)
__device__ __forceinline__ unsigned xb_ld(unsigned* p)              { return __hip_atomic_load(p, __ATOMIC_RELAXED, __HIP_MEMORY_SCOPE_AGENT); }
__device__ __forceinline__ unsigned xb_add(unsigned* p, unsigned v) { return __hip_atomic_fetch_add(p, v, __ATOMIC_RELAXED, __HIP_MEMORY_SCOPE_AGENT); }
__device__ __forceinline__ unsigned xb_xcc_id() { return (unsigned)__builtin_amdgcn_s_getreg((3 << 11) | 20) & 0xFu; }
#define XB_SPIN(cond, bar) do { unsigned _sp = 0; while (cond) { __builtin_amdgcn_s_sleep(1); \
    if ((++_sp & 255u) == 0u) { if (xb_ld(&(bar)[XB_TMO])) break; if (_sp > XB_SPIN_CAP) { atomicAdd(&(bar)[XB_TMO], 1u); break; } } } } while (0)
struct XcdBarrier { unsigned* bar; unsigned x; volatile LAS unsigned* st; };
__device__ __forceinline__ XcdBarrier xcd_barrier_post(unsigned* bar, volatile LAS unsigned* st) {
    XcdBarrier b; b.bar = bar; b.x = xb_xcc_id(); b.st = st;
    if (threadIdx.x == 0) (void)xb_add(&bar[XB_XCNT(b.x)], 1u);
    return b;
}
__device__ __forceinline__ void xcd_barrier_complete(unsigned* bar, unsigned x, unsigned& nloc, unsigned& nx) {
    const unsigned G = gridDim.x * gridDim.y * gridDim.z;
    unsigned sum, cnt, mine, sp = 0u;
    for (;;) {
        sum = 0u; cnt = 0u; mine = 0u;
#pragma unroll
        for (unsigned j = 0; j < 16; ++j) { const unsigned c = xb_ld(&bar[XB_XCNT(j)]); sum += c; cnt += (c > 0u) ? 1u : 0u; mine = (j == x) ? c : mine; }
        if (sum == G) break;
        __builtin_amdgcn_s_sleep(1);
        if ((++sp & 255u) == 0u) { if (xb_ld(&bar[XB_TMO])) break; if (sp > XB_SPIN_CAP) { atomicAdd(&bar[XB_TMO], 1u); break; } }
    }
    nloc = mine > 0u ? mine : 1u; nx = cnt > 0u ? cnt : 1u;
}
__device__ __forceinline__ void xcd_barrier(const XcdBarrier& b) {
    asm volatile("s_waitcnt vmcnt(0)" ::: "memory");
    __syncthreads();
    if (threadIdx.x == 0) {
        unsigned* bar = b.bar;
        __builtin_amdgcn_s_waitcnt(0);
        unsigned nloc = b.st[0], nx = b.st[1];
        if (nloc == 0u) { xcd_barrier_complete(bar, b.x, nloc, nx); b.st[0] = nloc; b.st[1] = nx; }
        const unsigned old = xb_add(&bar[XB_XSUB(b.x)], 1u);
        const unsigned gen = old / nloc;
        if (old + 1u == (gen + 1u) * nloc) {
            __builtin_amdgcn_fence(__ATOMIC_RELEASE, "agent");
            asm volatile("s_waitcnt vmcnt(0)" ::: "memory");
            const unsigned og = xb_add(&bar[XB_TOP], 1u);
            const unsigned tg = og / nx;
            if (og + 1u == (tg + 1u) * nx) xb_add(&bar[XB_TOPGEN], 1u);
            else XB_SPIN(xb_ld(&bar[XB_TOPGEN]) == tg, bar);
            __builtin_amdgcn_fence(__ATOMIC_ACQUIRE, "agent");
            xb_add(&bar[XB_XGEN(b.x)], 1u);
            asm volatile("s_waitcnt vmcnt(0)" ::: "memory");
        } else {
            XB_SPIN(xb_ld(&bar[XB_XGEN(b.x)]) == gen, bar);
            __builtin_amdgcn_fence(__ATOMIC_ACQUIRE, "agent");
            asm volatile("s_waitcnt vmcnt(0)" ::: "memory");
        }
    }
    __syncthreads();
}

__device__ __forceinline__ void local_seam() {
    asm volatile("s_waitcnt vmcnt(0)" ::: "memory");
    __syncthreads();
    if (threadIdx.x == 0) { __builtin_amdgcn_fence(__ATOMIC_ACQUIRE, "agent"); asm volatile("s_waitcnt vmcnt(0)" ::: "memory"); }
    __syncthreads();
}

constexpr int NWAVES = 8;
constexpr int RING_OFF = 0, RING_BYTES = 131072;
constexpr int LDSCTL_OFF = RING_BYTES + 12288, MISC_OFF = LDSCTL_OFF + 320;
constexpr int LDS_BYTES = 147456;
static_assert(MISC_OFF + 128 <= LDS_BYTES, "LDS map");

struct Frame {
    LAS unsigned char* lds; volatile LAS unsigned* MISC; unsigned* ctl; unsigned char* ws;
    int tid, lane, wave, vcu, G;
    const float* const* in; float* out;
};

__device__ __forceinline__ int nmap1(int n) { return n < 1024 ? (n >> 7) * 256 + (n & 127) : ((n - 1024) >> 7) * 256 + 128 + ((n - 1024) & 127); }
struct TItem { const float* W; bf16_t* WT; const float* g; int ldw, K, k0, n0, perm; };
__device__ __forceinline__ void titem_load(const TItem& t, f32x4 (&va)[8], f32x4 (&vb)[8], int lane) {
    const int nq = lane & 15, kp = lane >> 4;
#pragma unroll
    for (int it = 0; it < 8; ++it) { const int k = t.k0 + 2 * (kp + 4 * it); va[it] = *(const f32x4*)(t.W + (size_t)k * t.ldw + t.n0 + 4 * nq); vb[it] = *(const f32x4*)(t.W + (size_t)(k + 1) * t.ldw + t.n0 + 4 * nq); }
}
__device__ __forceinline__ void titem_store(const TItem& t, const f32x4 (&va)[8], const f32x4 (&vb)[8], LAS unsigned* scr, int lane) {
    const int nq = lane & 15, kp = lane >> 4;
#pragma unroll
    for (int it = 0; it < 8; ++it) { const int kk2 = kp + 4 * it; f32x4 a = va[it], b = vb[it];
        if (t.g) { const float g0 = t.g[t.k0 + 2 * kk2], g1 = t.g[t.k0 + 2 * kk2 + 1]; a = a * g0; b = b * g1; }
#pragma unroll
        for (int j = 0; j < 4; ++j) scr[(4 * nq + j) * 33 + kk2] = cvtpk_s(a[j], b[j]); }
    LDS_WAIT(); asm volatile("" ::: "memory");
    const int c = lane & 7;
#pragma unroll
    for (int it = 0; it < 8; ++it) { const int n = (lane >> 3) + 8 * it; const LAS unsigned* sp = scr + n * 33 + 4 * c;
        u32x4 o; o.x = sp[0]; o.y = sp[1]; o.z = sp[2]; o.w = sp[3];
        const int nn = t.n0 + n, nr = t.perm ? nmap1(nn) : nn;
        *(u32x4*)(t.WT + (size_t)nr * t.K + t.k0 + 8 * c) = o; }
    LDS_WAIT(); asm volatile("" ::: "memory");
}
__device__ __forceinline__ void titem8_load(const TItem& t, f32x4 (&va)[8], f32x4 (&vb)[8], int lane) {
    const int nq = lane & 7, kg = lane >> 3;
#pragma unroll
    for (int it = 0; it < 4; ++it) { const int k = t.k0 + 4 * (kg + 8 * it); const float* p = t.W + (size_t)k * t.ldw + t.n0 + 4 * nq;
        va[2 * it] = *(const f32x4*)p; va[2 * it + 1] = *(const f32x4*)(p + t.ldw); vb[2 * it] = *(const f32x4*)(p + 2 * (size_t)t.ldw); vb[2 * it + 1] = *(const f32x4*)(p + 3 * (size_t)t.ldw); }
}
__device__ __forceinline__ void titem8_store(const TItem& t, const f32x4 (&va)[8], const f32x4 (&vb)[8], LAS unsigned* scr, int lane) {
    const int nq = lane & 7, kg = lane >> 3;
#pragma unroll
    for (int it = 0; it < 4; ++it) { const int kq = kg + 8 * it; f32x4 a = va[2 * it], b = va[2 * it + 1], c = vb[2 * it], d = vb[2 * it + 1];
        float g0 = W8_SCALE, g1 = W8_SCALE, g2 = W8_SCALE, g3 = W8_SCALE;
        if (t.g) { const f32x4 gv = *(const f32x4*)(t.g + t.k0 + 4 * kq); g0 *= gv[0]; g1 *= gv[1]; g2 *= gv[2]; g3 *= gv[3]; }
#pragma unroll
        for (int j = 0; j < 4; ++j) scr[(4 * nq + j) * 33 + kq] = pk_fp8x4(a[j] * g0, b[j] * g1, c[j] * g2, d[j] * g3); }
    LDS_WAIT(); asm volatile("" ::: "memory");
    const int c = lane & 7;
#pragma unroll
    for (int it = 0; it < 4; ++it) { const int n = (lane >> 3) + 8 * it; const LAS unsigned* sp = scr + n * 33 + 4 * c;
        u32x4 o; o.x = sp[0]; o.y = sp[1]; o.z = sp[2]; o.w = sp[3];
        const int nn = t.n0 + n, nr = t.perm ? nmap1(nn) : nn;
        *(u32x4*)((unsigned char*)t.WT + (size_t)nr * t.K + t.k0 + 16 * c) = o; }
    LDS_WAIT(); asm volatile("" ::: "memory");
}
template <bool F8, class Dec> __device__ __forceinline__ void titem_loop(int first, int stride, int n, LAS unsigned* scr, int lane, const Dec& dec) {
    if (first >= n) return;
    TItem A, B; f32x4 a0[8], a1[8], b0[8], b1[8];
    int ia = first; dec(ia, A); if (F8) titem8_load(A, a0, a1, lane); else titem_load(A, a0, a1, lane);
    for (;;) {
        const int ib = ia + stride; const bool hb = ib < n;
        if (hb) { dec(ib, B); if (F8) titem8_load(B, b0, b1, lane); else titem_load(B, b0, b1, lane); }
        if (F8) titem8_store(A, a0, a1, scr, lane); else titem_store(A, a0, a1, scr, lane);
        if (!hb) break;
        ia = ib + stride; const bool ha = ia < n;
        if (ha) { dec(ia, A); if (F8) titem8_load(A, a0, a1, lane); else titem_load(A, a0, a1, lane); }
        if (F8) titem8_store(B, b0, b1, scr, lane); else titem_store(B, b0, b1, scr, lane);
        if (!ha) break;
    }
}
__device__ __forceinline__ void rms_rows_to_bf16(const float* x, const float* g, bf16_t* o, int first, int stride, int n, int lane) {
    if (first >= n) return;
    const f32x4* gr = (const f32x4*)g + lane; f32x4 gg[4];
#pragma unroll
    for (int j = 0; j < 4; ++j) gg[j] = gr[64 * j];
    f32x4 v[4], w[4];
#pragma unroll
    for (int j = 0; j < 4; ++j) v[j] = ((const f32x4*)(x + (size_t)first * D) + lane)[64 * j];
    for (int m = first; m < n; m += stride) {
        const int mn = m + stride;
        if (mn < n) {
#pragma unroll
            for (int j = 0; j < 4; ++j) w[j] = ((const f32x4*)(x + (size_t)mn * D) + lane)[64 * j];
        }
        float sq = 0.f;
#pragma unroll
        for (int j = 0; j < 4; ++j) sq += (v[j][0] * v[j][0] + v[j][1] * v[j][1]) + (v[j][2] * v[j][2] + v[j][3] * v[j][3]);
        const float rstd = __builtin_amdgcn_rsqf(wave_sum(sq) * (1.f / D) + EPS);
        u32x2* o8 = (u32x2*)(o + (size_t)m * D) + lane;
#pragma unroll
        for (int j = 0; j < 4; ++j) { u32x2 q; q.x = cvtpk_s(v[j][0] * rstd * gg[j][0], v[j][1] * rstd * gg[j][1]); q.y = cvtpk_s(v[j][2] * rstd * gg[j][2], v[j][3] * rstd * gg[j][3]); o8[64 * j] = q; }
#pragma unroll
        for (int j = 0; j < 4; ++j) v[j] = w[j];
    }
}
__device__ __forceinline__ void p0a_prologue(Frame& F) {
    LAS unsigned* scr = (LAS unsigned*)(F.lds + RING_OFF + F.wave * 16384);
    const int gw = F.vcu * NWAVES + F.wave, NGW = F.G * NWAVES;
    const float *mem = F.in[1], *g_mem = F.in[9], *w_kv = F.in[11];
    bf16_t *wkv_t = (bf16_t*)(F.ws + WS_WKV_T), *memn = (bf16_t*)(F.ws + WS_MEMN);
    rms_rows_to_bf16(mem, g_mem, memn, gw, NGW, MROWS, F.lane);
    titem_loop<false>(gw, NGW, 16 * 32, scr, F.lane, [=](int r, TItem& t) { t.W = w_kv; t.WT = wkv_t; t.g = nullptr; t.ldw = 2 * D; t.K = D; t.k0 = (r / 32) * 64; t.n0 = (r % 32) * 64; t.perm = 0; });
}
__device__ __forceinline__ void p0b_prologue(Frame& F, int wv, int nwv, int lo_frac_num, int lo_frac_den, bool low) {
    LAS unsigned* scr = (LAS unsigned*)(F.lds + RING_OFF + F.wave * 16384);
    const float *x = F.in[0], *g_mix = F.in[2], *w_in = F.in[3], *w_out = F.in[7], *g_xattn = F.in[8], *w_q = F.in[10], *w_o = F.in[12], *g_moe = F.in[13], *w_router = F.in[14], *w1 = F.in[16], *w2 = F.in[18];
    bf16_t *win_t = (bf16_t*)(F.ws + WS_WIN_T), *wout_t = (bf16_t*)(F.ws + WS_WOUT_T), *wq_t = (bf16_t*)(F.ws + WS_WQ_T), *wo_t = (bf16_t*)(F.ws + WS_WO_T),
           *w1_t = (bf16_t*)(F.ws + WS_W1_T), *w2_t = (bf16_t*)(F.ws + WS_W2_T), *xn = (bf16_t*)(F.ws + WS_XN);
    float* wr = (float*)(F.ws + WS_WR);
    auto range = [&](int n, int& first, int& end) { const int cut = (int)((long)n * lo_frac_num / lo_frac_den); if (low) { first = wv; end = cut; } else { first = cut + wv; end = n; } };
    int f, e;
    range(D * NE / 64, f, e); for (int i = f; i < e; i += nwv) { const int idx = i * 64 + F.lane; wr[idx] = w_router[idx] * g_moe[idx >> 5]; }
    constexpr int I_1 = NE * 8 * 64, I_2 = NE * 8 * 32;
    range(I_1 + I_2, f, e);
    titem_loop<true>(f, nwv, e, scr, F.lane, [=](int r, TItem& t) {
        t.g = nullptr; t.perm = 0; t.K = D;
        if (r < I_2) { const int ex = r / 256, q = r % 256; t.W = w2 + (size_t)ex * DEXP * D; t.WT = (bf16_t*)((unsigned char*)w2_t + (size_t)ex * D * DEXP); t.ldw = D; t.k0 = (q / 32) * 128; t.n0 = (q % 32) * 32; return; } r -= I_2;
        { const int ex = r / 512, q = r % 512; t.W = w1 + (size_t)ex * D * 2048; t.WT = (bf16_t*)((unsigned char*)w1_t + (size_t)ex * 2048 * D); t.g = g_moe; t.ldw = 2048; t.perm = 1; t.k0 = (q / 64) * 128; t.n0 = (q % 64) * 32; }
    });
    constexpr int I_IN = 16 * 48, I_OUT = 16 * 16, I_Q = 16 * 16, I_O = 16 * 16;
    range(I_IN + I_OUT + I_Q + I_O, f, e);
    titem_loop<false>(f, nwv, e, scr, F.lane, [=](int r, TItem& t) {
        t.g = nullptr; t.perm = 0; t.K = D; t.ldw = D;
        if (r < I_O) { t.W = w_o; t.WT = wo_t; t.k0 = (r / 16) * 64; t.n0 = (r % 16) * 64; return; } r -= I_O;
        if (r < I_Q) { t.W = w_q; t.WT = wq_t; t.g = g_xattn; t.k0 = (r / 16) * 64; t.n0 = (r % 16) * 64; return; } r -= I_Q;
        if (r < I_OUT) { t.W = w_out; t.WT = wout_t; t.k0 = (r / 16) * 64; t.n0 = (r % 16) * 64; return; } r -= I_OUT;
        { t.W = w_in; t.WT = win_t; t.ldw = NPROJ; t.k0 = (r / 48) * 64; t.n0 = (r % 48) * 64; }
    });
    range(M, f, e); rms_rows_to_bf16(x, g_mix, xn, f, nwv, e, F.lane);
}

__device__ __forceinline__ void conv_rows(Frame& F) {
    const bf16_t* proj = (const bf16_t*)(F.ws + WS_PROJ); bf16_t* ymix = (bf16_t*)(F.ws + WS_YMIX);
    const float* conv_w = F.in[4]; const float* g_conv = F.in[5];
    const int gw = F.vcu * NWAVES + F.wave, NGW = F.G * NWAVES, c0 = 8 * F.lane;
    float w0[8], w1[8], w2[8], gg[8];
#pragma unroll
    for (int j = 0; j < 8; ++j) { w0[j] = conv_w[c0 + j]; w1[j] = conv_w[512 + c0 + j]; w2[j] = conv_w[1024 + c0 + j]; gg[j] = g_conv[c0 + j]; }
    auto ld = [&](int m, u32x4 (&v)[7]) {
        const int t = m & (SEQ - 1); const bf16_t* row = proj + (size_t)m * NPROJ + c0;
        v[0] = *(const u32x4*)row; v[1] = *(const u32x4*)(row + 512); v[2] = *(const u32x4*)(row + 1024);
        v[3] = (u32x4){0, 0, 0, 0}; v[4] = v[3]; v[5] = v[3]; v[6] = v[3];
        if (t >= 1) { v[3] = *(const u32x4*)(row - NPROJ + 512); v[4] = *(const u32x4*)(row - NPROJ + 1024); }
        if (t >= 2) { v[5] = *(const u32x4*)(row - 2 * NPROJ + 512); v[6] = *(const u32x4*)(row - 2 * NPROJ + 1024); }
    };
    if (gw >= M) return;
    u32x4 cur[7], nx[7];
    ld(gw, cur);
    for (int m = gw; m < M; m += NGW) {
        if (m + NGW < M) ld(m + NGW, nx);
        const u32x4 bg = cur[0], cg0 = cur[1], xv0 = cur[2], cg1 = cur[3], xv1 = cur[4], cg2 = cur[5], xv2 = cur[6];
        float y[8]; float ss = 0.f;
#pragma unroll
        for (int j = 0; j < 4; ++j) {
            const float u0l = bf_lo(cg0[j]) * bf_lo(xv0[j]), u0h = bf_hi(cg0[j]) * bf_hi(xv0[j]);
            const float u1l = bf_lo(cg1[j]) * bf_lo(xv1[j]), u1h = bf_hi(cg1[j]) * bf_hi(xv1[j]);
            const float u2l = bf_lo(cg2[j]) * bf_lo(xv2[j]), u2h = bf_hi(cg2[j]) * bf_hi(xv2[j]);
            y[2 * j] = bf_lo(bg[j]) * (w0[2 * j] * u2l + w1[2 * j] * u1l + w2[2 * j] * u0l);
            y[2 * j + 1] = bf_hi(bg[j]) * (w0[2 * j + 1] * u2h + w1[2 * j + 1] * u1h + w2[2 * j + 1] * u0h);
            ss += y[2 * j] * y[2 * j] + y[2 * j + 1] * y[2 * j + 1];
        }
        ss += __shfl_xor(ss, 1); ss += __shfl_xor(ss, 2); ss += __shfl_xor(ss, 4);
        const float rstd = __builtin_amdgcn_rsqf(ss * (1.f / 64.f) + EPS);
        u32x4 o; o.x = cvtpk_s(y[0] * rstd * gg[0], y[1] * rstd * gg[1]); o.y = cvtpk_s(y[2] * rstd * gg[2], y[3] * rstd * gg[3]);
        o.z = cvtpk_s(y[4] * rstd * gg[4], y[5] * rstd * gg[5]); o.w = cvtpk_s(y[6] * rstd * gg[6], y[7] * rstd * gg[7]);
        *(u32x4*)(ymix + (size_t)m * D + c0) = o;
#pragma unroll
        for (int i = 0; i < 7; ++i) cur[i] = nx[i];
    }
}
constexpr int SB_K = 0, SB_V = 8192, SB_OST = 16384, SB_OSTW = 32 * 68 * 4, SB_FLAG = 90112;
static_assert(SB_OST + 8 * SB_OSTW <= SB_FLAG && SB_FLAG + 32 <= RING_BYTES, "attention LDS");
__device__ __forceinline__ int crow(int r, int hi) { return (r & 3) + 8 * (r >> 2) + 4 * hi; }
__device__ __forceinline__ void sb_attn_unit(Frame& F, int b, int h, int qb) {
    const bf16_t* proj = (const bf16_t*)(F.ws + WS_PROJ); bf16_t* ymix = (bf16_t*)(F.ws + WS_YMIX); const float* g_sb = F.in[6];
    const int tid = F.tid, lane = F.lane, wid = F.wave, r32 = lane & 31, hi = lane >> 5;
    LAS unsigned char* lds = F.lds + RING_OFF;
    const int q0 = qb * 256, qlo = q0 + wid * 32, qpos = qlo + r32;
    const size_t rowbase = (size_t)b * SEQ;
    const bf16_t* Qp = proj + (rowbase + qlo) * NPROJ + 1536 + h * 64;
    const bf16_t* Kp = proj + rowbase * NPROJ + 2048 + h * 64;
    const bf16_t* Vp = proj + rowbase * NPROJ + 2560 + h * 64;
    bf16x8 qr[4];
#pragma unroll
    for (int s = 0; s < 4; ++s) qr[s] = *(const bf16x8*)(Qp + (size_t)r32 * NPROJ + 16 * s + 8 * hi);
    bf16x8 ntri[2], nones;
#pragma unroll
    for (int s = 0; s < 2; ++s)
#pragma unroll
        for (int j = 0; j < 8; ++j) { const int k = 16 * s + 8 * (j >> 2) + 4 * hi + (j & 3); ntri[s][j] = (k > r32) ? (short)0xBF80 : (short)0; }
#pragma unroll
    for (int j = 0; j < 8; ++j) nones[j] = (short)0xBF80;
    f32x16 R = {}; f32x16 o[2]; o[0] = f32x16{}; o[1] = f32x16{};
    const int skey = tid >> 3, sc = tid & 7;
    const int koff = SB_K + skey * 128 + ((sc ^ ((skey >> 1) & 7)) << 4);
    const int voff = SB_V + (sc >> 2) * 4096 + (skey >> 4) * 1024 + (skey & 15) * 64 + (sc & 3) * 16;
    const int vb = SB_V + ((lane >> 4) & 1) * 32 + (lane & 3) * 8 + (4 * hi + ((lane & 15) >> 2)) * 64;
    int kbi = 4 * qb + 3;
    u32x4 kreg = *(const u32x4*)(Kp + (size_t)(kbi * 64 + skey) * NPROJ + sc * 8), vreg = *(const u32x4*)(Vp + (size_t)(kbi * 64 + skey) * NPROJ + sc * 8);
    LAS int* dflag = (LAS int*)(lds + SB_FLAG);
    int done = 0;
    for (; kbi >= 0; --kbi) {
        const int k0 = kbi * 64;
        __syncthreads();
        *(LAS u32x4*)(lds + koff) = kreg; *(LAS u32x4*)(lds + voff) = vreg;
        if (lane == 0) dflag[wid] = done;
        __syncthreads();
        { const u32x4 f0 = *(const LAS u32x4*)dflag, f1 = *(const LAS u32x4*)(dflag + 4); if ((f0.x & f0.y & f0.z & f0.w & f1.x & f1.y & f1.z & f1.w) != 0u) break; }
        if (kbi > 0) { kreg = *(const u32x4*)(Kp + (size_t)(k0 - 64 + skey) * NPROJ + sc * 8); vreg = *(const u32x4*)(Vp + (size_t)(k0 - 64 + skey) * NPROJ + sc * 8); }
        if (!done && k0 < qlo + 31) {
            f32x16 p0 = {}, p1 = {};
#pragma unroll
            for (int s = 0; s < 4; ++s) { const int c = 2 * s + hi;
                const bf16x8 ka = *(const LAS bf16x8*)(lds + SB_K + r32 * 128 + ((c ^ ((r32 >> 1) & 7)) << 4));
                const bf16x8 kb = *(const LAS bf16x8*)(lds + SB_K + (r32 + 32) * 128 + ((c ^ (((r32 + 32) >> 1) & 7)) << 4));
                p0 = __builtin_amdgcn_mfma_f32_32x32x16_bf16(ka, qr[s], p0, 0, 0, 0); p1 = __builtin_amdgcn_mfma_f32_32x32x16_bf16(kb, qr[s], p1, 0, 0, 0); }
            const bool diag = (k0 + 63 >= qlo);
            f32x16 s0, s1;
#pragma unroll
            for (int r = 0; r < 16; ++r) {
                const float z0 = p0[r], z1 = p1[r];
                float sp0 = fmaxf(z0, 0.f) + __builtin_amdgcn_logf(1.0f + __builtin_amdgcn_exp2f(-fabsf(z0)));
                float sp1 = fmaxf(z1, 0.f) + __builtin_amdgcn_logf(1.0f + __builtin_amdgcn_exp2f(-fabsf(z1)));
                if (diag) { const int key = k0 + crow(r, hi); if (key >= qpos) sp0 = 0.f; if (key + 32 >= qpos) sp1 = 0.f; }
                s0[r] = sp0; s1[r] = sp1; p0[r] = z0 - sp0; p1[r] = z1 - sp1;
            }
            u32x4 w00 = {cvtpk_s(s0[0], s0[1]), cvtpk_s(s0[2], s0[3]), cvtpk_s(s0[4], s0[5]), cvtpk_s(s0[6], s0[7])}, w01 = {cvtpk_s(s0[8], s0[9]), cvtpk_s(s0[10], s0[11]), cvtpk_s(s0[12], s0[13]), cvtpk_s(s0[14], s0[15])};
            u32x4 w10 = {cvtpk_s(s1[0], s1[1]), cvtpk_s(s1[2], s1[3]), cvtpk_s(s1[4], s1[5]), cvtpk_s(s1[6], s1[7])}, w11 = {cvtpk_s(s1[8], s1[9]), cvtpk_s(s1[10], s1[11]), cvtpk_s(s1[12], s1[13]), cvtpk_s(s1[14], s1[15])};
            const bf16x8 sb00 = __builtin_bit_cast(bf16x8, w00), sb01 = __builtin_bit_cast(bf16x8, w01), sb10 = __builtin_bit_cast(bf16x8, w10), sb11 = __builtin_bit_cast(bf16x8, w11);
            f32x16 rest1 = __builtin_amdgcn_mfma_f32_32x32x16_bf16(ntri[0], sb10, R, 0, 0, 0); rest1 = __builtin_amdgcn_mfma_f32_32x32x16_bf16(ntri[1], sb11, rest1, 0, 0, 0);
            f32x16 U = __builtin_amdgcn_mfma_f32_32x32x16_bf16(nones, sb10, R, 0, 0, 0); U = __builtin_amdgcn_mfma_f32_32x32x16_bf16(nones, sb11, U, 0, 0, 0);
            f32x16 rest0 = __builtin_amdgcn_mfma_f32_32x32x16_bf16(ntri[0], sb00, U, 0, 0, 0); rest0 = __builtin_amdgcn_mfma_f32_32x32x16_bf16(ntri[1], sb01, rest0, 0, 0, 0);
            R = __builtin_amdgcn_mfma_f32_32x32x16_bf16(nones, sb00, U, 0, 0, 0); R = __builtin_amdgcn_mfma_f32_32x32x16_bf16(nones, sb01, R, 0, 0, 0);
            done = __all(R[0] < -150.0f) ? 1 : 0;
#pragma unroll
            for (int r = 0; r < 16; ++r) {
                float a0 = __builtin_amdgcn_exp2f(p0[r] + rest0[r]), a1 = __builtin_amdgcn_exp2f(p1[r] + rest1[r]);
                if (diag) { const int key = k0 + crow(r, hi); if (key >= qpos) a0 = 0.f; if (key + 32 >= qpos) a1 = 0.f; }
                p0[r] = a0; p1[r] = a1;
            }
            u32x4 a00 = {cvtpk_s(p0[0], p0[1]), cvtpk_s(p0[2], p0[3]), cvtpk_s(p0[4], p0[5]), cvtpk_s(p0[6], p0[7])}, a01 = {cvtpk_s(p0[8], p0[9]), cvtpk_s(p0[10], p0[11]), cvtpk_s(p0[12], p0[13]), cvtpk_s(p0[14], p0[15])};
            u32x4 a10 = {cvtpk_s(p1[0], p1[1]), cvtpk_s(p1[2], p1[3]), cvtpk_s(p1[4], p1[5]), cvtpk_s(p1[6], p1[7])}, a11 = {cvtpk_s(p1[8], p1[9]), cvtpk_s(p1[10], p1[11]), cvtpk_s(p1[12], p1[13]), cvtpk_s(p1[14], p1[15])};
            const bf16x8 pa[4] = {__builtin_bit_cast(bf16x8, a00), __builtin_bit_cast(bf16x8, a01), __builtin_bit_cast(bf16x8, a10), __builtin_bit_cast(bf16x8, a11)};
#pragma unroll
            for (int d0 = 0; d0 < 2; ++d0)
#pragma unroll
                for (int ks = 0; ks < 4; ++ks) {
                    const s16x4 lo = __builtin_bit_cast(s16x4, __builtin_amdgcn_ds_read_tr16_b64_v4i16((LAS s16x4*)(lds + vb + d0 * 4096 + ks * 1024)));
                    const s16x4 hh = __builtin_bit_cast(s16x4, __builtin_amdgcn_ds_read_tr16_b64_v4i16((LAS s16x4*)(lds + vb + d0 * 4096 + ks * 1024 + 512)));
                    const bf16x8 vf = {lo[0], lo[1], lo[2], lo[3], hh[0], hh[1], hh[2], hh[3]};
                    o[d0] = __builtin_amdgcn_mfma_f32_32x32x16_bf16(pa[ks], vf, o[d0], 0, 0, 0);
                }
        }
    }
    LAS float* stg = (LAS float*)(lds + SB_OST + wid * SB_OSTW);
#pragma unroll
    for (int r = 0; r < 16; ++r) { const int q = crow(r, hi); stg[q * 68 + r32] = o[0][r]; stg[q * 68 + 32 + r32] = o[1][r]; }
    LDS_WAIT(); asm volatile("" ::: "memory");
    { const int q = lane >> 1, half = lane & 1; const LAS f32x4* sp = (const LAS f32x4*)(stg + q * 68 + 32 * half);
      f32x4 v[8]; float ss = 0.f;
#pragma unroll
      for (int i = 0; i < 8; ++i) { v[i] = sp[i]; ss += (v[i][0] * v[i][0] + v[i][1] * v[i][1]) + (v[i][2] * v[i][2] + v[i][3] * v[i][3]); }
      ss += __shfl_xor(ss, 1);
      const float rstd = __builtin_amdgcn_rsqf(ss * (1.f / 64.f) + EPS);
      const f32x4* gp = (const f32x4*)(g_sb + h * 64 + 32 * half);
      bf16_t* op = ymix + (rowbase + qlo + q) * D + 512 + h * 64 + 32 * half;
#pragma unroll
      for (int i = 0; i < 4; ++i) { const f32x4 g0 = gp[2 * i], g1 = gp[2 * i + 1], a = v[2 * i] * rstd * g0, c = v[2 * i + 1] * rstd * g1;
          u32x4 w; w.x = cvtpk_s(a[0], a[1]); w.y = cvtpk_s(a[2], a[3]); w.z = cvtpk_s(c[0], c[1]); w.w = cvtpk_s(c[2], c[3]); *(u32x4*)(op + 8 * i) = w; } }
    LDS_WAIT();
}
__device__ __forceinline__ void p2_mix(Frame& F) {
    conv_rows(F);
    if (F.G == 256) {
        const int bh = F.vcu >> 2, s = F.vcu & 3;
        sb_attn_unit(F, bh >> 3, bh & 7, 7 - s);
        sb_attn_unit(F, bh >> 3, bh & 7, s);
    } else {
        for (int u = F.vcu; u < 512; u += F.G) sb_attn_unit(F, u >> 6, (u >> 3) & 7, u & 7);
    }
}

__device__ __forceinline__ void p8_router(Frame& F) {
    const float* x2 = (const float*)(F.ws + WS_X2); const float* wr = (const float*)(F.ws + WS_WR); const float* b_router = F.in[15];
    float* lrstd = (float*)(F.ws + WS_LRSTD); int* ltok = (int*)(F.ws + WS_LTOK); float* lgate = (float*)(F.ws + WS_LGATE); unsigned* cnt = F.ctl + CW_CNT;
    LAS float* wl = (LAS float*)(F.lds + RING_OFF);
    for (int i = F.tid; i < D * NE / 4; i += NWAVES * 64) ((LAS f32x4*)wl)[i] = ((const f32x4*)wr)[i];
    __syncthreads();
    const int lane = F.lane, tk = lane & 15, kq = lane >> 4;
    const int gw = F.vcu * NWAVES + F.wave, NGW = F.G * NWAVES;
    for (int item = gw; item < M / 16; item += NGW) {
        const int tok = item * 16 + tk; const float* xr = x2 + (size_t)tok * D + 4 * kq;
        f32x4 acc0 = {0.f, 0.f, 0.f, 0.f}, acc1 = {0.f, 0.f, 0.f, 0.f}; float ss = 0.f;
#pragma unroll 4
        for (int s = 0; s < 64; ++s) {
            const f32x4 xv = *(const f32x4*)(xr + 16 * s); ss += (xv[0] * xv[0] + xv[1] * xv[1]) + (xv[2] * xv[2] + xv[3] * xv[3]);
#pragma unroll
            for (int j = 0; j < 4; ++j) { const LAS float* wp = wl + (16 * s + 4 * kq + j) * 32 + tk;
                acc0 = __builtin_amdgcn_mfma_f32_16x16x4f32(wp[0], xv[j], acc0, 0, 0, 0); acc1 = __builtin_amdgcn_mfma_f32_16x16x4f32(wp[16], xv[j], acc1, 0, 0, 0); }
        }
        ss += __shfl_xor(ss, 16); ss += __shfl_xor(ss, 32);
        const float rstd = __builtin_amdgcn_rsqf(ss * (1.f / D) + EPS);
        float lg[32];
#pragma unroll
        for (int q = 0; q < 4; ++q)
#pragma unroll
            for (int j = 0; j < 4; ++j) { const int src = tk + 16 * q; lg[4 * q + j] = __shfl(acc0[j], src) * rstd + b_router[4 * q + j]; lg[16 + 4 * q + j] = __shfl(acc1[j], src) * rstd + b_router[16 + 4 * q + j]; }
        float tv[4]; int ti[4]; unsigned used = 0u;
#pragma unroll
        for (int k = 0; k < 4; ++k) { float bv = -INFINITY; int bi = 0;
#pragma unroll
            for (int e = 0; e < 32; ++e) { const bool ok = !((used >> e) & 1u) && lg[e] > bv; bv = ok ? lg[e] : bv; bi = ok ? e : bi; }
            tv[k] = bv; ti[k] = bi; used |= 1u << bi; }
        const float e1 = __expf(tv[1] - tv[0]), e2 = __expf(tv[2] - tv[0]), e3 = __expf(tv[3] - tv[0]); const float inv = 1.0f / (1.0f + e1 + e2 + e3);
        const int myE = kq == 0 ? ti[0] : kq == 1 ? ti[1] : kq == 2 ? ti[2] : ti[3];
        const float myG = (kq == 0 ? 1.0f : kq == 1 ? e1 : kq == 2 ? e2 : e3) * inv;
        int rank = 0, mycount = 0;
#pragma unroll 1
        for (int e = 0; e < NE; ++e) { const unsigned long long mk = __ballot(myE == e); const int pc = __popcll(mk);
            if (myE == e) rank = __popcll(mk & ((1ull << lane) - 1ull)); if (lane == e) mycount = pc; }
        unsigned base = 0u; if (lane < NE && mycount > 0) base = atomicAdd(cnt + 64 * lane, (unsigned)mycount);
        const unsigned mybase = (unsigned)__shfl((int)base, myE);
        const size_t pos = (size_t)myE * LISTCAP + mybase + rank;
        ltok[pos] = tok * 4 + kq; lgate[pos] = myG; lrstd[pos] = rstd;
    }
}

__device__ __forceinline__ void p11_load(const float* x2, const bf16_t* y, int m, int lane, f32x4 (&xv)[4], u32x4 (&yv)[8]) {
#pragma unroll
    for (int j = 0; j < 2; ++j) { const int c = 8 * lane + 512 * j; xv[2 * j] = *(const f32x4*)(x2 + (size_t)m * D + c); xv[2 * j + 1] = *(const f32x4*)(x2 + (size_t)m * D + c + 4);
#pragma unroll
        for (int sl = 0; sl < 4; ++sl) yv[4 * j + sl] = *(const u32x4*)(y + ((size_t)m * 4 + sl) * D + c); }
}
__device__ __forceinline__ void p11_final(Frame& F) {
    const float* x2 = (const float*)(F.ws + WS_X2); const bf16_t* y = (const bf16_t*)(F.ws + WS_Y); const float* g_final = F.in[20]; float* out = F.out;
    const int gw = F.vcu * NWAVES + F.wave, NGW = F.G * NWAVES, lane = F.lane;
    if (gw >= M) return;
    f32x4 gg[4];
#pragma unroll
    for (int j = 0; j < 2; ++j) { const int c = 8 * lane + 512 * j; gg[2 * j] = *(const f32x4*)(g_final + c); gg[2 * j + 1] = *(const f32x4*)(g_final + c + 4); }
    f32x4 xv[4], xn_[4]; u32x4 yv[8], yn_[8];
    p11_load(x2, y, gw, lane, xv, yv);
    for (int m = gw; m < M; m += NGW) {
        if (m + NGW < M) p11_load(x2, y, m + NGW, lane, xn_, yn_);
        f32x4 v[4]; float ss = 0.f;
#pragma unroll
        for (int j = 0; j < 2; ++j) { v[2 * j] = xv[2 * j]; v[2 * j + 1] = xv[2 * j + 1];
#pragma unroll
            for (int sl = 0; sl < 4; ++sl) { const u32x4 w = yv[4 * j + sl];
                v[2 * j][0] += bf_lo(w.x); v[2 * j][1] += bf_hi(w.x); v[2 * j][2] += bf_lo(w.y); v[2 * j][3] += bf_hi(w.y);
                v[2 * j + 1][0] += bf_lo(w.z); v[2 * j + 1][1] += bf_hi(w.z); v[2 * j + 1][2] += bf_lo(w.w); v[2 * j + 1][3] += bf_hi(w.w); } }
#pragma unroll
        for (int i = 0; i < 4; ++i) ss += (v[i][0] * v[i][0] + v[i][1] * v[i][1]) + (v[i][2] * v[i][2] + v[i][3] * v[i][3]);
        const float rstd = __builtin_amdgcn_rsqf(wave_sum(ss) * (1.f / D) + EPS);
#pragma unroll
        for (int j = 0; j < 2; ++j) { const int c = 8 * lane + 512 * j;
            *(f32x4*)(out + (size_t)m * D + c) = v[2 * j] * rstd * gg[2 * j]; *(f32x4*)(out + (size_t)m * D + c + 4) = v[2 * j + 1] * rstd * gg[2 * j + 1]; }
#pragma unroll
        for (int i = 0; i < 4; ++i) xv[i] = xn_[i];
#pragma unroll
        for (int i = 0; i < 8; ++i) yv[i] = yn_[i];
    }
}

constexpr int NPHASE = 13;
struct Args { const float* in[21]; float* out; unsigned char* ws; int ph_lo, ph_hi; };
static_assert(sizeof(Args) == 21 * 8 + 8 + 8 + 8, "Args has no padding");

__global__ void __launch_bounds__(NWAVES * 64, 2) fwd(Args args) {
    extern __shared__ __attribute__((aligned(16))) unsigned char lds[];
    Frame F;
    F.lds = (LAS unsigned char*)lds; F.MISC = (volatile LAS unsigned*)(F.lds + MISC_OFF);
    F.tid = threadIdx.x; F.lane = F.tid & 63; F.wave = __builtin_amdgcn_readfirstlane(F.tid >> 6);
    F.G = gridDim.x; { const int bx = blockIdx.x; F.vcu = (F.G % 8 == 0) ? (bx % 8) * (F.G / 8) + bx / 8 : bx; }
    F.ws = args.ws; F.ctl = (unsigned*)(args.ws + WS_CTL); F.out = args.out;
    F.in = args.in;
    for (int u = F.tid; u < (LDS_BYTES - LDSCTL_OFF) / 4; u += NWAVES * 64) ((LAS unsigned*)(F.lds + LDSCTL_OFF))[u] = 0u;
    __syncthreads();
    const int lo = args.ph_lo, hi = args.ph_hi;
    const bool single = (hi - lo) > 1;
    XcdBarrier bar; bar.bar = F.ctl + CW_BAR; bar.x = 0; bar.st = nullptr;
    if (single) bar = xcd_barrier_post(F.ctl + CW_BAR, F.MISC + 8);
#ifndef PH_MASK
#define PH_MASK 0x1FFF
#endif
#define IN(k) (((PH_MASK >> (k)) & 1) && lo <= (k) && (k) < hi)
#define SEAM(k) do { if (IN(k) && IN((k) + 1)) xcd_barrier(bar); } while (0)
    unsigned char* ws = args.ws;
    const int bx = (int)blockIdx.x;

    if (IN(0)) {
        p0a_prologue(F);
        if (single) xcd_barrier(bar);
    }
    if (IN(12)) {
        const bool low = bx < 64;
        if (low) {
            pg8::OrderKV S; S.init(ws + WS_MEMN, ws + WS_WKV_T, bx);
            pg8::EpiP1 E{(bf16_t*)(ws + WS_PROJ), (bf16_t*)(ws + WS_KMEM), (bf16_t*)(ws + WS_VT)};
            pg8::gemm_phase<pg8::EpiP1, pg8::OrderKV, false, false, true>(F.lds + RING_OFF, 2 * D, 2 * D, 2 * D, S, E);
        }
        const int nlow = 64 * NWAVES, nhigh = (F.G - 64) * NWAVES;
        if (low) p0b_prologue(F, bx * NWAVES + F.wave, nlow, 4 * nlow, 4 * nlow + 5 * nhigh, true);
        else p0b_prologue(F, (bx - 64) * NWAVES + F.wave, nhigh, 4 * nlow, 4 * nlow + 5 * nhigh, false);
    }
    if (IN(12) && IN(1)) xcd_barrier(bar);
    if (IN(1)) {
        pg8::OrderIn S; S.init(ws + WS_XN, ws + WS_WIN_T, F.G, bx);
        pg8::EpiP1 E{(bf16_t*)(ws + WS_PROJ), (bf16_t*)(ws + WS_KMEM), (bf16_t*)(ws + WS_VT)};
        pg8::gemm_phase<pg8::EpiP1, pg8::OrderIn, false, true, true>(F.lds + RING_OFF, 2 * D, 2 * D, 2 * D, S, E);
    }
    SEAM(1);
    if (IN(2)) { p2_mix(F); }
    SEAM(2);
    if (IN(3)) {
        pg8::OrderPlain S; S.init(ws + WS_YMIX, ws + WS_WOUT_T, D, D, M / 256, D / 256, F.G, bx);
        pg8::EpiRes<false> E{F.in[0], (float*)(ws + WS_X1), (bf16_t*)(ws + WS_X1B), (float*)(ws + WS_SS1)};
        pg8::gemm_phase<pg8::EpiRes<false>, pg8::OrderPlain, false, false, true>(F.lds + RING_OFF, 2 * D, 2 * D, 2 * D, S, E);
    }
    SEAM(3);
    if (IN(4)) {
        pg8::OrderQ S; S.init(ws + WS_X1B, ws + WS_WQ_T, F.G, bx);
        pg8::EpiQm E{(bf16_t*)(ws + WS_QM), (const float*)(ws + WS_SS1)};
        pg8::gemm_phase<pg8::EpiQm, pg8::OrderQ, false, false, true>(F.lds + RING_OFF, 2 * D, 2 * D, 2 * D, S, E);
    }
    if (single && IN(4) && IN(5)) local_seam();
    if (IN(5)) {
        if (F.G == 256) {
            pg8::OrderX<0> S; S.init(ws + WS_QM, ws + WS_KMEM, F.G, bx);
            pg8::EpiSoftmax E{(bf16_t*)(ws + WS_PB)};
            pg8::gemm_phase<pg8::EpiSoftmax, pg8::OrderX<0>, false, false, true>(F.lds + RING_OFF, 2 * D, 2 * D, 2 * XHD, S, E);
        }
    }
    if (single && IN(5) && IN(6)) local_seam();
    if (IN(6)) {
        pg8::OrderX<1> S; S.init(ws + WS_PB, ws + WS_VT, F.G, bx);
        pg8::EpiO E{(bf16_t*)(ws + WS_OB)};
        pg8::gemm_phase<pg8::EpiO, pg8::OrderX<1>, false, true, true>(F.lds + RING_OFF, 2 * D, 2 * MROWS, 2 * MEMLEN, S, E);
    }
    SEAM(6);
    if (IN(7)) {
        pg8::OrderPlain S; S.init(ws + WS_OB, ws + WS_WO_T, D, D, M / 256, D / 256, F.G, bx);
        pg8::EpiRes<true> E{(const float*)(ws + WS_X1), (float*)(ws + WS_X2), (bf16_t*)(ws + WS_X2B), (float*)(ws + WS_SS2)};
        pg8::gemm_phase<pg8::EpiRes<true>, pg8::OrderPlain, false, false, true>(F.lds + RING_OFF, 2 * D, 2 * D, 2 * D, S, E);
    }
    SEAM(7);
    if (IN(8)) { p8_router(F); }
    SEAM(8);
    if (IN(9)) {
        pg8::OrderMoe<8, true> S; S.init(F.ctl + CW_CNT, (const int*)(ws + WS_LTOK), ws + WS_X2B, ws + WS_W1_T, F.G, bx);
        pg8::EpiAct E{(bf16_t*)(ws + WS_ACT), (const float*)(ws + WS_LRSTD), F.in[17]};
        pg8::gemm_phase<pg8::EpiAct, pg8::OrderMoe<8, true>, true, true, true, true>(F.lds + RING_OFF, D, D, D, S, E);
    }
    SEAM(9);
    if (IN(10)) {
        pg8::OrderMoe<4, false> S; S.init(F.ctl + CW_CNT, (const int*)(ws + WS_LTOK), ws + WS_ACT, ws + WS_W2_T, F.G, bx);
        pg8::EpiY E{(bf16_t*)(ws + WS_Y), (const float*)(ws + WS_LGATE), (const int*)(ws + WS_LTOK), F.in[19]};
        pg8::gemm_phase<pg8::EpiY, pg8::OrderMoe<4, false>, false, true, true, true>(F.lds + RING_OFF, DEXP, DEXP, DEXP, S, E);
    }
    SEAM(10);
    if (IN(11)) { p11_final(F); }
#undef IN
#undef SEAM
}

extern "C" void kernel_launch(void* const* d_in, const int* in_sizes, int n_in, void* d_out, int out_size, void* d_ws, size_t ws_size, hipStream_t stream) {
    static int grid = 0;
    if (grid == 0) {
        if (n_in != 21 || in_sizes[0] != M * D || out_size != M * D || ws_size < WS_END) { fprintf(stderr, "kernel_launch: unexpected shapes (n_in %d, in0 %d, out %d, ws %zu)\n", n_in, n_in > 0 ? in_sizes[0] : -1, out_size, ws_size); grid = -1; return; }
        int dev = 0, cus = 0, per_cu = 0;
        if (hipGetDevice(&dev) != hipSuccess || hipDeviceGetAttribute(&cus, hipDeviceAttributeMultiprocessorCount, dev) != hipSuccess) { grid = -1; return; }
        if (hipFuncSetAttribute((const void*)fwd, hipFuncAttributeMaxDynamicSharedMemorySize, LDS_BYTES) != hipSuccess) { fprintf(stderr, "kernel_launch: hipFuncSetAttribute failed\n"); grid = -1; return; }
        if (hipOccupancyMaxActiveBlocksPerMultiprocessor(&per_cu, (const void*)fwd, NWAVES * 64, LDS_BYTES) != hipSuccess || per_cu < 1) { fprintf(stderr, "kernel_launch: occupancy query says %d\n", per_cu); per_cu = 1; }
        (void)hipGetLastError();
        grid = cus;
    }
    if (grid < 0) return;
    (void)hipMemsetAsync((char*)d_ws + WS_CTL, 0, CTL_ZERO_BYTES, stream);
    Args a{};
    for (int i = 0; i < 21; ++i) a.in[i] = (const float*)d_in[i];
    a.out = (float*)d_out; a.ws = (unsigned char*)d_ws;
    if (MK_N_LAUNCHES == 1) {
        a.ph_lo = 0; a.ph_hi = NPHASE;
        void* kargs[] = {&a};
        hipError_t e = hipLaunchCooperativeKernel((const void*)fwd, dim3(grid), dim3(NWAVES * 64), kargs, LDS_BYTES, stream);
        if (e != hipSuccess) fprintf(stderr, "kernel_launch: cooperative launch failed: %s\n", hipGetErrorString(e));
    } else {
        for (int pi = 0; pi < NPHASE; ++pi) { const int p = pi == 0 ? 0 : pi == 1 ? 12 : pi - 1; a.ph_lo = p; a.ph_hi = p + 1; for (int rep = 0; rep < NREP(p); ++rep) hipLaunchKernelGGL(fwd, dim3(grid), dim3(NWAVES * 64), LDS_BYTES, stream, a); }
    }
}
```

```cpp
#include <hip/hip_runtime.h>
#include <hip/hip_cooperative_groups.h>
#include <cstdio>
#include <cstdint>
namespace cg = cooperative_groups;

#ifndef MK_N_LAUNCHES
#define MK_N_LAUNCHES 1
#endif
#ifndef DUP_MASK
#define DUP_MASK 0
#endif
#define NREP(k) (((DUP_MASK >> (k)) & 1) ? 2 : 1)

constexpr int D = 1024, BATCH = 8, SEQ = 2048, M = BATCH * SEQ, MEMLEN = 256, MROWS = BATCH * MEMLEN;
constexpr int NPROJ = 3072, NE = 32, TOPK = 4, DEXP = 1024;
constexpr int XH = 4, XHD = 256;
constexpr float EPS = 1e-5f;
constexpr float LOG2E = 1.4426950408889634f;
constexpr float C2Q = 0.125f * LOG2E;
constexpr float C2X = 0.0625f * LOG2E;
constexpr int LISTCAP = M;
constexpr int ACT_ROWS = M * TOPK + NE * 256;

#define GAS __attribute__((address_space(1)))
#define LAS __attribute__((address_space(3)))
typedef unsigned short bf16_t;
typedef short bf16x8 __attribute__((ext_vector_type(8)));
typedef short s16x4 __attribute__((ext_vector_type(4)));
typedef float f32x4 __attribute__((ext_vector_type(4)));
typedef float f32x2 __attribute__((ext_vector_type(2)));
typedef float f32x16 __attribute__((ext_vector_type(16)));
typedef unsigned u32x4 __attribute__((ext_vector_type(4)));
typedef unsigned u32x2 __attribute__((ext_vector_type(2)));
typedef GAS unsigned gu32;

constexpr size_t MiB = 1u << 20;
constexpr size_t WS_CTL = 0, CTL_ZERO_BYTES = 1 * MiB;
constexpr size_t WS_WIN_T = 2 * MiB, WS_WOUT_T = 8 * MiB, WS_WQ_T = 10 * MiB, WS_WKV_T = 12 * MiB, WS_WO_T = 16 * MiB, WS_WR = 18 * MiB;
constexpr size_t WS_MEMN = 19 * MiB, WS_KMEM = 23 * MiB, WS_VT = 27 * MiB, WS_SS1 = 31 * MiB, WS_SS2 = 32 * MiB, WS_RSTD3 = 33 * MiB, WS_LTOK = 34 * MiB, WS_LGATE = 36 * MiB, WS_LRSTD = 38 * MiB;
constexpr size_t WS_W1_T = 40 * MiB, WS_W2_T = 168 * MiB;
constexpr size_t WS_XN = 232 * MiB, WS_PROJ = 264 * MiB, WS_YMIX = 360 * MiB;
constexpr size_t WS_X1 = 392 * MiB, WS_X1B = 456 * MiB, WS_QM = 488 * MiB, WS_PB = 520 * MiB, WS_OB = 552 * MiB, WS_X2 = 584 * MiB, WS_X2B = 648 * MiB;
constexpr size_t WS_ACT = 232 * MiB;
constexpr size_t WS_Y = 392 * MiB;
constexpr size_t WS_END = 680 * MiB;
static_assert(WS_ACT + (size_t)ACT_ROWS * DEXP <= WS_X1 && WS_Y + (size_t)M * TOPK * D * 2 <= WS_PB, "overlays");
constexpr int CW_TMO = 0, CW_CODE = 1, CW_BAR = 4096, CW_CNT = 8192;

__device__ __forceinline__ unsigned cvt_pk_bf16(float lo, float hi) { unsigned r; asm volatile("v_cvt_pk_bf16_f32 %0, %1, %2" : "=v"(r) : "v"(lo), "v"(hi)); return r; }
__device__ __forceinline__ unsigned cvtpk_s(float lo, float hi) { typedef __bf16 bf16x2_t __attribute__((ext_vector_type(2))); f32x2 v = {lo, hi}; bf16x2_t b = __builtin_convertvector(v, bf16x2_t); return __builtin_bit_cast(unsigned, b); }
__device__ __forceinline__ float clamp448(float v) { return fminf(fmaxf(v, -448.0f), 448.0f); }
__device__ __forceinline__ unsigned pk_fp8x4(float a, float b, float c, float d) { int w = 0; w = __builtin_amdgcn_cvt_pk_fp8_f32(clamp448(a), clamp448(b), w, false); w = __builtin_amdgcn_cvt_pk_fp8_f32(clamp448(c), clamp448(d), w, true); return (unsigned)w; }
constexpr float W8_SCALE = 64.0f, ACT8_SCALE = 4.0f, Y8_SCALE = 16.0f;
constexpr int E8_ONE = 0x7F7F7F7F, E8_W = 0x79797979, E8_ACT = 0x7D7D7D7D;
__device__ __forceinline__ float bf_lo(unsigned w) { return __uint_as_float(w << 16); }
__device__ __forceinline__ float bf_hi(unsigned w) { return __uint_as_float(w & 0xffff0000u); }
__device__ __forceinline__ float wave_sum(float v) {
#pragma unroll
    for (int o = 1; o < 64; o <<= 1) v += __shfl_xor(v, o);
    return v;
}
#define LDS_WAIT() asm volatile("s_waitcnt lgkmcnt(0)" ::: "memory")
#define VM_WAIT() asm volatile("s_waitcnt vmcnt(0)" ::: "memory")

namespace pg8 {
constexpr int BM = 256, BK = 64, HALF = 128, HTB = HALF * BK * 2, STAGE_BYTES = 8 * HTB, NXCD = 8, WGM = 8;
__host__ __device__ __forceinline__ int lds_byte(int r, int c) { const int st = (r >> 4) * 2 + (c >> 5), rr = r & 15, cc = c & 31, ob = rr * 64 + cc * 2; return st * 1024 + (ob ^ (((ob >> 9) & 1) << 5)); }
__host__ __device__ __forceinline__ void stage_rc(int b, int& R, int& C) { const int st = b / 1024, sb = b % 1024, swz = sb ^ (((sb >> 9) & 1) << 5); R = (st >> 1) * 16 + swz / 64; C = (st & 1) * 32 + (swz % 64) / 2; }
__host__ __device__ __forceinline__ int perm32(int rho) { const int n = rho >> 4, i = rho & 15; return 8 * (i >> 2) + 4 * n + (i & 3); }

struct Unit { const char* a; const char* b; int pm, pn; };
struct UnitK { const char* a; const char* b; int pm, pn, kind; };
struct UnitM { const char* a; const char* b; const int* tok; int pm, pn, nvalid, e, rowoff; };

struct GridOrder {
    int nM, nN, nwg;
    __device__ __forceinline__ void init(int nM_, int nN_) { nM = nM_; nN = nN_; nwg = nM * nN; }
    __device__ __forceinline__ void map(int L, int& pm, int& pn) const {
        int wgid = L; { const int q = nwg / NXCD, r = nwg % NXCD, xcd = wgid % NXCD, off = wgid / NXCD; wgid = (xcd < r ? xcd * (q + 1) : r * (q + 1) + (xcd - r) * q) + off; }
        const int nig = WGM * nN, gid = wgid / nig, fm = gid * WGM, gsz = (nM - fm) < WGM ? (nM - fm) : WGM;
        pm = fm + ((wgid % nig) % gsz); pn = (wgid % nig) / gsz;
    }
};

typedef f32x4 Acc[2][2][4][2];

template <class Epi, class Sched, bool GATHER, bool ALIGN_EPI, bool SP2, bool F8 = false, int SCA = 0x7F7F7F7F, int SCB = 0x7F7F7F7F>
__device__ __forceinline__ void gemm_phase(LAS unsigned char* lds, const int lda, const int ldb, const int K, const Sched& S, const Epi& E) {
    const int tid = threadIdx.x, wid = __builtin_amdgcn_readfirstlane(tid >> 6), lane = tid & 63, wr = wid >> 2, wc = wid & 3, fr = lane & 15, fq = lane >> 4;
    int nt = K / 128; asm volatile("" : "+s"(nt));
    int RA[2], CA[2]; unsigned voffB[2];
#pragma unroll
    for (int i = 0; i < 2; ++i) { int R, C; stage_rc(tid * 16 + i * 8192, R, C); const int Rb = Epi::PERM ? ((R & ~31) + perm32(R & 31)) : R;
        RA[i] = R; CA[i] = C; voffB[i] = (unsigned)(Rb * ldb + C * 2); }
    const size_t kstep = (size_t)(BK * 2);
    const size_t hstepB = (size_t)HALF * ldb;
    const unsigned ldsw = (unsigned)wid * 1024u;
    const int aoff = lds_byte(wr * 64 + fr, fq * 8), boff = lds_byte(wc * 32 + fr, fq * 8);
#define PG8_SA(b, h) (((b) * 2 + (h)) * HTB)
#define PG8_SB(b, h) ((4 + (b) * 2 + (h)) * HTB)
#define PG8_STAGE(bufoff, gbase, voff) do { _Pragma("unroll") for (int _i = 0; _i < 2; ++_i) \
        __builtin_amdgcn_global_load_lds((const unsigned*)((const char*)(gbase) + (voff)[_i]), (LAS unsigned*)(lds + (bufoff) + ldsw + _i * 8192), 16, 0, 0); } while (0)
#define PG8_LDA(dst, b, h) do { _Pragma("unroll") for (int m = 0; m < 4; ++m) { if constexpr (F8) { \
            dst##8[m] = __builtin_shufflevector(*(const LAS i32x4_*)(lds + PG8_SA(b, h) + aoff + m * 2048), *(const LAS i32x4_*)(lds + PG8_SA(b, h) + aoff + m * 2048 + 1024), 0, 1, 2, 3, 4, 5, 6, 7); } \
        else { _Pragma("unroll") for (int k = 0; k < 2; ++k) dst[m][k] = *(const LAS bf16x8*)(lds + PG8_SA(b, h) + aoff + m * 2048 + k * 1024); } } } while (0)
#define PG8_LDB(dst, b, h) do { _Pragma("unroll") for (int n = 0; n < 2; ++n) { if constexpr (F8) { \
            dst##8[n] = __builtin_shufflevector(*(const LAS i32x4_*)(lds + PG8_SB(b, h) + boff + n * 2048), *(const LAS i32x4_*)(lds + PG8_SB(b, h) + boff + n * 2048 + 1024), 0, 1, 2, 3, 4, 5, 6, 7); } \
        else { _Pragma("unroll") for (int k = 0; k < 2; ++k) dst[n][k] = *(const LAS bf16x8*)(lds + PG8_SB(b, h) + boff + n * 2048 + k * 1024); } } } while (0)
#define PG8_MMA(ai, bj, At, Bt) do { __builtin_amdgcn_s_setprio(1); _Pragma("unroll") for (int m = 0; m < 4; ++m) _Pragma("unroll") for (int n = 0; n < 2; ++n) { \
        if constexpr (F8) { acc[ai][bj][m][n] = __builtin_amdgcn_mfma_scale_f32_16x16x128_f8f6f4(Bt##8[n], At##8[m], acc[ai][bj][m][n], 0, 0, 0, SCA, 0, SCB); } \
        else { _Pragma("unroll") for (int k = 0; k < 2; ++k) acc[ai][bj][m][n] = __builtin_amdgcn_mfma_f32_16x16x32_bf16(Bt[n][k], At[m][k], acc[ai][bj][m][n], 0, 0, 0); } } \
        __builtin_amdgcn_s_setprio(0); } while (0)
#define PG8_WAIT_V(n) asm volatile("s_waitcnt vmcnt(" #n ")" ::: "memory")
#define PG8_WAIT_L(n) asm volatile("s_waitcnt lgkmcnt(" #n ")" ::: "memory")
#define PG8_BAR __builtin_amdgcn_s_barrier()
#define PG8_SCHED __builtin_amdgcn_sched_barrier(0)
#define PG8_VOFFA(dst, u) do { if constexpr (GATHER) { int _t[2][2]; _Pragma("unroll") for (int _h = 0; _h < 2; ++_h) _Pragma("unroll") for (int _i = 0; _i < 2; ++_i) _t[_h][_i] = (u).tok[_h * HALF + RA[_i]]; \
        _Pragma("unroll") for (int _h = 0; _h < 2; ++_h) _Pragma("unroll") for (int _i = 0; _i < 2; ++_i) { const int _row = _h * HALF + RA[_i]; const int _tt = (_row < (u).nvalid) ? (_t[_h][_i] >> 2) : 0; dst[_h][_i] = (unsigned)(_tt * lda + CA[_i] * 2); } } \
        else { _Pragma("unroll") for (int _h = 0; _h < 2; ++_h) _Pragma("unroll") for (int _i = 0; _i < 2; ++_i) dst[_h][_i] = (unsigned)((_h * HALF + RA[_i]) * lda + CA[_i] * 2); } } while (0)
#define PG8_VOFFA_LDS(dst, u, slot) do { const LAS int* _mt = (const LAS int*)(lds + 131072 + (slot) * 3072 + 1024); _Pragma("unroll") for (int _h = 0; _h < 2; ++_h) _Pragma("unroll") for (int _i = 0; _i < 2; ++_i) { \
        const int _row = _h * HALF + RA[_i]; const int _tt = (_row < (u).nvalid) ? (_mt[_row] >> 2) : 0; dst[_h][_i] = (unsigned)(_tt * lda + CA[_i] * 2); } } while (0)
    typename Sched::U cur, nxt; int ui = 0;
    if (!S.next(0, cur)) return;
    Acc acc;
#pragma unroll
    for (int a = 0; a < 2; ++a)
#pragma unroll
        for (int b = 0; b < 2; ++b)
#pragma unroll
            for (int m = 0; m < 4; ++m)
#pragma unroll
                for (int n = 0; n < 2; ++n) acc[a][b][m][n] = (f32x4){0.f, 0.f, 0.f, 0.f};
    typedef int i32x4_ __attribute__((ext_vector_type(4))); typedef int i32x8_ __attribute__((ext_vector_type(8)));
    bf16x8 At[4][2], B0[2][2], B1[2][2]; i32x8_ At8[4], B08[2], B18[2];
    unsigned vA[2][2];
    PG8_VOFFA(vA, cur);
    const char* cA = cur.a; const char* cB = cur.b;
    E.prefetch(cur, 0, lds, wid, lane);
    if constexpr (SP2) {
        PG8_STAGE(PG8_SB(0, 0), cB, voffB); PG8_STAGE(PG8_SB(0, 1), cB + hstepB, voffB); PG8_STAGE(PG8_SA(0, 0), cA, vA[0]); PG8_STAGE(PG8_SA(0, 1), cA, vA[1]);
        if (wr == 1) PG8_BAR;
        PG8_WAIT_V(2); PG8_BAR;
        PG8_STAGE(PG8_SB(1, 0), cB + kstep, voffB); PG8_STAGE(PG8_SA(1, 0), cA + kstep, vA[0]); PG8_STAGE(PG8_SB(1, 1), cB + hstepB + kstep, voffB);
        PG8_WAIT_V(6); PG8_BAR;
    } else {
        PG8_STAGE(PG8_SB(0, 0), cB, voffB); PG8_STAGE(PG8_SA(0, 0), cA, vA[0]); PG8_STAGE(PG8_SB(0, 1), cB + hstepB, voffB); PG8_STAGE(PG8_SA(0, 1), cA, vA[1]);
        if (wr == 1) PG8_BAR;
        PG8_WAIT_V(4); PG8_BAR;
        PG8_STAGE(PG8_SB(1, 0), cB + kstep, voffB); PG8_STAGE(PG8_SA(1, 0), cA + kstep, vA[0]); PG8_STAGE(PG8_SB(1, 1), cB + hstepB + kstep, voffB);
        PG8_WAIT_V(6); PG8_BAR;
    }
    for (;;) {
        const bool has_next = S.next(ui + 1, nxt);
        const char* nA = has_next ? nxt.a : cA; const char* nB = has_next ? nxt.b : cB;
        if (has_next) E.prefetch(nxt, ui + 1, lds, wid, lane);
        for (int t = 0; t < nt; t += 2) {
            const bool last = (t == nt - 2);
            asm volatile("" : "+v"(vA[0][0]), "+v"(vA[0][1]), "+v"(vA[1][0]), "+v"(vA[1][1]), "+v"(voffB[0]), "+v"(voffB[1]));
            const char* a1 = cA + (size_t)(t + 1) * kstep;
            const char* a2 = last ? nA : cA + (size_t)(t + 2) * kstep; const char* b2 = last ? nB : cB + (size_t)(t + 2) * kstep;
            const char* a3 = a2 + kstep; const char* b3 = b2 + kstep;
            if constexpr (SP2) {
            PG8_LDB(B0, 0, 0); PG8_LDB(B1, 0, 1); PG8_SCHED; PG8_LDA(At, 0, 0); PG8_STAGE(PG8_SA(1, 1), a1, vA[1]); if (last && has_next) { if constexpr (GATHER) { PG8_VOFFA_LDS(vA, nxt, (ui + 1) % 3); } else { PG8_VOFFA(vA, nxt); } }
            PG8_WAIT_V(8); PG8_WAIT_L(0); PG8_BAR; PG8_MMA(0, 0, At, B0); PG8_MMA(0, 1, At, B1); PG8_BAR; PG8_SCHED;
            PG8_LDA(At, 0, 1); PG8_STAGE(PG8_SB(0, 0), b2, voffB); PG8_STAGE(PG8_SB(0, 1), b2 + hstepB, voffB); PG8_STAGE(PG8_SA(0, 0), a2, vA[0]);
            PG8_WAIT_V(8); PG8_WAIT_L(0); PG8_BAR; PG8_MMA(1, 0, At, B0); PG8_MMA(1, 1, At, B1); PG8_BAR; PG8_SCHED;
            PG8_LDB(B0, 1, 0); PG8_LDB(B1, 1, 1); PG8_SCHED; PG8_LDA(At, 1, 0); PG8_STAGE(PG8_SA(0, 1), a2, vA[1]);
            PG8_WAIT_V(8); PG8_WAIT_L(0); PG8_BAR; PG8_MMA(0, 0, At, B0); PG8_MMA(0, 1, At, B1); PG8_BAR; PG8_SCHED;
            PG8_LDA(At, 1, 1); PG8_STAGE(PG8_SB(1, 0), b3, voffB); PG8_STAGE(PG8_SB(1, 1), b3 + hstepB, voffB); PG8_STAGE(PG8_SA(1, 0), a3, vA[0]);
            PG8_WAIT_V(8); PG8_WAIT_L(0); PG8_BAR; PG8_MMA(1, 0, At, B0); PG8_MMA(1, 1, At, B1); PG8_BAR; PG8_SCHED;
            } else {
            PG8_LDB(B0, 0, 0); PG8_SCHED; PG8_LDA(At, 0, 0); PG8_STAGE(PG8_SA(1, 1), a1, vA[1]); if (last && has_next) { if constexpr (GATHER) { PG8_VOFFA_LDS(vA, nxt, (ui + 1) % 3); } else { PG8_VOFFA(vA, nxt); } }
            PG8_WAIT_L(8); PG8_BAR; PG8_WAIT_L(0); PG8_MMA(0, 0, At, B0); PG8_BAR; PG8_SCHED;
            PG8_LDB(B1, 0, 1); PG8_STAGE(PG8_SB(0, 0), b2, voffB);
            PG8_BAR; PG8_WAIT_L(0); PG8_MMA(0, 1, At, B1); PG8_BAR;
            PG8_LDA(At, 0, 1); PG8_STAGE(PG8_SA(0, 0), a2, vA[0]);
            PG8_BAR; PG8_WAIT_L(0); PG8_MMA(1, 0, At, B0); PG8_BAR; PG8_SCHED;
            PG8_STAGE(PG8_SB(0, 1), b2 + hstepB, voffB);
            PG8_WAIT_V(6); PG8_BAR; PG8_MMA(1, 1, At, B1); PG8_BAR;
            PG8_LDB(B0, 1, 0); PG8_SCHED; PG8_LDA(At, 1, 0); PG8_STAGE(PG8_SA(0, 1), a2, vA[1]);
            PG8_WAIT_L(8); PG8_BAR; PG8_WAIT_L(0); PG8_MMA(0, 0, At, B0); PG8_BAR; PG8_SCHED;
            PG8_LDB(B1, 1, 1); PG8_STAGE(PG8_SB(1, 0), b3, voffB);
            PG8_BAR; PG8_WAIT_L(0); PG8_MMA(0, 1, At, B1); PG8_BAR;
            PG8_LDA(At, 1, 1); PG8_STAGE(PG8_SA(1, 0), a3, vA[0]);
            PG8_BAR; PG8_WAIT_L(0); PG8_MMA(1, 0, At, B0); PG8_BAR; PG8_SCHED;
            PG8_STAGE(PG8_SB(1, 1), b3 + hstepB, voffB);
            PG8_WAIT_V(6); PG8_BAR; PG8_MMA(1, 1, At, B1); PG8_BAR;
            }
        }
        if constexpr (ALIGN_EPI) { if (wr == 0) PG8_BAR; }
        if constexpr (!Epi::AFTER_DRAIN) { E(acc, cur, ui, lds, wr, wc, fr, fq); }
        if (!has_next) break;
#pragma unroll
        for (int a = 0; a < 2; ++a)
#pragma unroll
            for (int b = 0; b < 2; ++b)
#pragma unroll
                for (int m = 0; m < 4; ++m)
#pragma unroll
                    for (int n = 0; n < 2; ++n) acc[a][b][m][n] = (f32x4){0.f, 0.f, 0.f, 0.f};
        cur = nxt; cA = nA; cB = nB; ++ui;
        if constexpr (ALIGN_EPI) { if (wr == 1) PG8_BAR; }
    }
    PG8_WAIT_V(0);
    if constexpr (!ALIGN_EPI) { if (wr == 0) PG8_BAR; }
    PG8_BAR;
    if constexpr (Epi::AFTER_DRAIN) { E.fused(acc, cur, wr, wc, fr, fq, lds, wid, lane); }
#undef PG8_SA
#undef PG8_SB
#undef PG8_STAGE
#undef PG8_LDA
#undef PG8_LDB
#undef PG8_MMA
#undef PG8_WAIT_V
#undef PG8_WAIT_L
#undef PG8_BAR
#undef PG8_SCHED
#undef PG8_VOFFA
#undef PG8_VOFFA_LDS
}

struct OrderKV {
    typedef UnitK U;
    const char *memn, *wkv_t; int c;
    __device__ __forceinline__ void init(const void* memn_, const void* wkv_t_, int c_) { memn = (const char*)memn_; wkv_t = (const char*)wkv_t_; c = c_; }
    __device__ __forceinline__ bool next(int i, UnitK& u) const {
        if (i > 0 || c >= 64) return false;
        int r = c;
        if (r < 32) { u.kind = 1; u.pm = r >> 2; u.pn = r & 3; u.a = memn + (size_t)u.pm * 256 * D * 2; u.b = wkv_t + (size_t)u.pn * 256 * D * 2; return true; }
        r -= 32;
        u.kind = 2; u.pm = r >> 3; u.pn = r & 7; u.a = wkv_t + (size_t)(D + u.pm * 256) * D * 2; u.b = memn + (size_t)u.pn * 256 * D * 2; return true;
    }
};
struct OrderIn {
    typedef UnitK U;
    const char *A, *Bt; int G, c; GridOrder g0;
    __device__ __forceinline__ void init(const void* A_, const void* Bt_, int G_, int c_) { A = (const char*)A_; Bt = (const char*)Bt_; G = G_; c = c_; g0.init(M / 256, NPROJ / 256); }
    __device__ __forceinline__ bool next(int i, UnitK& u) const {
        const int L = i * G + c; if (L >= g0.nwg) return false;
        g0.map(L, u.pm, u.pn); u.kind = 0; u.a = A + (size_t)u.pm * 256 * D * 2; u.b = Bt + (size_t)u.pn * 256 * D * 2; return true;
    }
};
struct OrderPlain {
    typedef Unit U;
    const char *A, *Bt; int lda, ldb, G, c; GridOrder g0;
    __device__ __forceinline__ void init(const void* A_, const void* Bt_, int lda_, int ldb_, int nM, int nN, int G_, int c_) { A = (const char*)A_; Bt = (const char*)Bt_; lda = lda_; ldb = ldb_; G = G_; c = c_; g0.init(nM, nN); }
    __device__ __forceinline__ bool next(int i, Unit& u) const {
        const int L = i * G + c; if (L >= g0.nwg) return false;
        g0.map(L, u.pm, u.pn);
        u.a = A + (size_t)u.pm * 256 * lda * 2; u.b = Bt + (size_t)u.pn * 256 * ldb * 2; return true;
    }
};
struct OrderQ {
    typedef Unit U;
    const char *A, *Bt; int G, c;
    __device__ __forceinline__ void init(const void* A_, const void* Bt_, int G_, int c_) { A = (const char*)A_; Bt = (const char*)Bt_; G = G_; c = c_; }
    __device__ __forceinline__ bool next(int i, Unit& u) const {
        const int L = i * G + c; if (L >= (M / 256) * XH) return false;
        const int xcd = L & 7, j = L >> 3; u.pm = xcd * 8 + (j >> 2); u.pn = j & 3;
        u.a = A + (size_t)u.pm * 256 * D * 2; u.b = Bt + (size_t)u.pn * 256 * D * 2; return true;
    }
};
template <int MODE> struct OrderX {
    typedef Unit U;
    const char *A, *Bt; int G, c;
    __device__ __forceinline__ void init(const void* A_, const void* Bt_, int G_, int c_) { A = (const char*)A_; Bt = (const char*)Bt_; G = G_; c = c_; }
    __device__ __forceinline__ bool next(int i, Unit& u) const {
        const int L = i * G + c; if (L >= (M / 256) * XH) return false;
        const int xcd = L & 7, j = L >> 3; u.pm = xcd * 8 + (j >> 2); u.pn = j & 3;
        const int b = u.pm >> 3;
        u.a = A + ((size_t)u.pm * 256 * D + (size_t)u.pn * XHD) * 2;
        if (MODE == 0) u.b = Bt + ((size_t)b * MEMLEN * D + (size_t)u.pn * XHD) * 2;
        else u.b = Bt + ((size_t)u.pn * XHD * MROWS + (size_t)b * MEMLEN) * 2;
        return true;
    }
};
template <int NTN, bool G1> struct OrderMoe {
    typedef UnitM U;
    const int* ltok; const char* A; const char* Bt; int G, c; int seg[4], til[4], cn[4];
    __device__ __forceinline__ void init(const unsigned* cnt, const int* ltok_, const void* A_, const void* Bt_, int G_, int c_) {
        ltok = ltok_; A = (const char*)A_; Bt = (const char*)Bt_; G = G_; c = c_;
        const int lane = threadIdx.x & 63; const int cv = (lane < NE) ? (int)__hip_atomic_load(cnt + 64 * lane, __ATOMIC_RELAXED, __HIP_MEMORY_SCOPE_AGENT) : 0;
        const int t = (cv + 255) >> 8; int incl = t;
#pragma unroll
        for (int o = 1; o < 32; o <<= 1) { const int v = __shfl_up(incl, o); if (lane >= o) incl += v; }
        const int excl = incl - t, xcd = c & 7;
#pragma unroll
        for (int q = 0; q < 4; ++q) { seg[q] = __builtin_amdgcn_readlane(excl, xcd + 8 * q); til[q] = __builtin_amdgcn_readlane(t, xcd + 8 * q); cn[q] = __builtin_amdgcn_readlane(cv, xcd + 8 * q); }
    }
    __device__ __forceinline__ bool next(int i, UnitM& u) const {
        const int xcd = c & 7, slot = c >> 3, nslot = G >> 3; int j = i * nslot + slot;
#pragma unroll
        for (int q = 0; q < 4; ++q) {
            const int nu = til[q] * NTN;
            if (j < nu) { const int e = xcd + 8 * q, mt = j / NTN, nt = j % NTN;
                u.e = e; u.pm = mt; u.pn = nt; u.rowoff = (seg[q] + mt) * 256; u.nvalid = cn[q] - mt * 256 < 256 ? cn[q] - mt * 256 : 256; u.tok = ltok + (size_t)e * LISTCAP + mt * 256;
                if (G1) { u.a = A; u.b = Bt + ((size_t)e * 2048 + (size_t)nt * 256) * D; }
                else { u.a = A + (size_t)u.rowoff * DEXP; u.b = Bt + ((size_t)e * 1024 + (size_t)nt * 256) * DEXP; }
                return true; }
            j -= nu;
        }
        return false;
    }
};

struct EpiP1 {
    static constexpr bool PERM = true, AFTER_DRAIN = false;
    bf16_t *proj, *kmem, *vt;
    __device__ __forceinline__ void prefetch(const UnitK&, int, LAS unsigned char*, int, int) const {}
    __device__ __forceinline__ void operator()(const Acc& acc, const UnitK& u, int, LAS unsigned char*, int wr, int wc, int fr, int fq) const {
        bf16_t* base; int ldc; float sc = 1.f;
        if (u.kind == 0) { base = proj; ldc = NPROJ; if (u.pn >= 6 && u.pn < 8) sc = C2Q; } else if (u.kind == 1) { base = kmem; ldc = D; } else { base = vt; ldc = MROWS; }
        const int row0 = u.pm * BM + wr * 64 + fr, col0 = u.pn * BM + wc * 32 + 8 * fq;
#pragma unroll
        for (int ai = 0; ai < 2; ++ai)
#pragma unroll
            for (int m = 0; m < 4; ++m) { bf16_t* rowp = base + (size_t)(row0 + ai * HALF + m * 16) * ldc + col0;
#pragma unroll
                for (int bj = 0; bj < 2; ++bj) { const f32x4 v0 = acc[ai][bj][m][0] * sc, v1 = acc[ai][bj][m][1] * sc;
                    u32x4 w; w.x = cvt_pk_bf16(v0[0], v0[1]); w.y = cvt_pk_bf16(v0[2], v0[3]); w.z = cvt_pk_bf16(v1[0], v1[1]); w.w = cvt_pk_bf16(v1[2], v1[3]);
                    *(u32x4*)(rowp + bj * HALF) = w; } }
    }
};
template <bool OUT8> struct EpiRes {
    static constexpr bool PERM = true, AFTER_DRAIN = true;
    const float* base; float* xo; bf16_t* xb; float* ss;
    __device__ __forceinline__ void prefetch(const Unit&, int, LAS unsigned char*, int, int) const {}
    __device__ __forceinline__ void fused(Acc& acc, const Unit& u, int wr, int wc, int fr, int fq, LAS unsigned char* lds, int wid, int lane) const {
        LAS float* PSS = (LAS float*)lds;
        const int col0 = u.pn * BM + wc * 32 + 8 * fq;
#pragma unroll
        for (int ai = 0; ai < 2; ++ai)
#pragma unroll
            for (int m = 0; m < 4; ++m) { const int r = ai * HALF + wr * 64 + m * 16 + fr; const size_t off = (size_t)(u.pm * BM + r) * D + col0; float sq = 0.f;
#pragma unroll
                for (int bj = 0; bj < 2; ++bj) { const f32x4 b0 = *(const f32x4*)(base + off + bj * HALF), b1 = *(const f32x4*)(base + off + bj * HALF + 4);
                    const f32x4 o0 = b0 + acc[ai][bj][m][0], o1 = b1 + acc[ai][bj][m][1];
                    *(f32x4*)(xo + off + bj * HALF) = o0; *(f32x4*)(xo + off + bj * HALF + 4) = o1;
                    if constexpr (OUT8) { u32x2 w; w.x = pk_fp8x4(o0[0], o0[1], o0[2], o0[3]); w.y = pk_fp8x4(o1[0], o1[1], o1[2], o1[3]); *(u32x2*)((unsigned char*)xb + off + bj * HALF) = w; }
                    else { u32x4 w; w.x = cvt_pk_bf16(o0[0], o0[1]); w.y = cvt_pk_bf16(o0[2], o0[3]); w.z = cvt_pk_bf16(o1[0], o1[1]); w.w = cvt_pk_bf16(o1[2], o1[3]); *(u32x4*)(xb + off + bj * HALF) = w; }
                    sq += ((o0[0] * o0[0] + o0[1] * o0[1]) + (o0[2] * o0[2] + o0[3] * o0[3])) + ((o1[0] * o1[0] + o1[1] * o1[1]) + (o1[2] * o1[2] + o1[3] * o1[3])); }
                sq += __shfl_xor(sq, 16); sq += __shfl_xor(sq, 32);
                if (fq == 0) PSS[r * 4 + wc] = sq; }
        __syncthreads();
        if (threadIdx.x < 256) { const f32x4 p = *(const LAS f32x4*)(PSS + threadIdx.x * 4); ss[(size_t)(u.pm * BM + threadIdx.x) * 4 + u.pn] = (p[0] + p[1]) + (p[2] + p[3]); }
        __syncthreads();
    }
};
__device__ __forceinline__ float rstd_from_ss(const float* ss, int row) {
    const f32x4 a = *(const f32x4*)(ss + (size_t)row * 4);
    return __builtin_amdgcn_rsqf(((a[0] + a[1]) + (a[2] + a[3])) * (1.0f / D) + EPS);
}
struct EpiQm {
    static constexpr bool PERM = true, AFTER_DRAIN = true;
    bf16_t* qm; const float* ss;
    __device__ __forceinline__ void prefetch(const Unit&, int, LAS unsigned char*, int, int) const {}
    __device__ __forceinline__ void fused(Acc& acc, const Unit& u, int wr, int wc, int fr, int fq, LAS unsigned char* lds, int wid, int lane) const {
        const int row0 = u.pm * BM + wr * 64 + fr, col0 = u.pn * BM + wc * 32 + 8 * fq;
        float sc[2][4];
#pragma unroll
        for (int ai = 0; ai < 2; ++ai)
#pragma unroll
            for (int m = 0; m < 4; ++m) sc[ai][m] = rstd_from_ss(ss, row0 + ai * HALF + m * 16) * C2X;
#pragma unroll
        for (int ai = 0; ai < 2; ++ai)
#pragma unroll
            for (int m = 0; m < 4; ++m) { const int row = row0 + ai * HALF + m * 16; bf16_t* rowp = qm + (size_t)row * D + col0;
#pragma unroll
                for (int bj = 0; bj < 2; ++bj) { const f32x4 v0 = acc[ai][bj][m][0] * sc[ai][m], v1 = acc[ai][bj][m][1] * sc[ai][m];
                    u32x4 w; w.x = cvt_pk_bf16(v0[0], v0[1]); w.y = cvt_pk_bf16(v0[2], v0[3]); w.z = cvt_pk_bf16(v1[0], v1[1]); w.w = cvt_pk_bf16(v1[2], v1[3]);
                    *(u32x4*)(rowp + bj * HALF) = w; } }
    }
};
struct EpiSoftmax {
    static constexpr bool PERM = true, AFTER_DRAIN = true;
    bf16_t* pb;
    __device__ __forceinline__ void prefetch(const Unit&, int, LAS unsigned char*, int, int) const {}
    __device__ __forceinline__ void fused(Acc& acc, const Unit& u, int wr, int wc, int fr, int fq, LAS unsigned char* lds, int wid, int lane) const {
        LAS float* PM = (LAS float*)lds;
        LAS float* PS = (LAS float*)(lds + 4096);
#pragma unroll
        for (int ai = 0; ai < 2; ++ai)
#pragma unroll
            for (int m = 0; m < 4; ++m) { float mx = -INFINITY;
#pragma unroll
                for (int bj = 0; bj < 2; ++bj)
#pragma unroll
                    for (int n = 0; n < 2; ++n) { const f32x4 x = acc[ai][bj][m][n]; mx = fmaxf(mx, fmaxf(fmaxf(x[0], x[1]), fmaxf(x[2], x[3]))); }
                mx = fmaxf(mx, __shfl_xor(mx, 16)); mx = fmaxf(mx, __shfl_xor(mx, 32));
                if (fq == 0) PM[(ai * HALF + wr * 64 + m * 16 + fr) * 4 + wc] = mx; }
        __syncthreads();
#pragma unroll
        for (int ai = 0; ai < 2; ++ai)
#pragma unroll
            for (int m = 0; m < 4; ++m) { const int r = ai * HALF + wr * 64 + m * 16 + fr; const f32x4 pm4 = *(const LAS f32x4*)(PM + r * 4);
                const float mx = fmaxf(fmaxf(pm4[0], pm4[1]), fmaxf(pm4[2], pm4[3])); float s = 0.f;
#pragma unroll
                for (int bj = 0; bj < 2; ++bj)
#pragma unroll
                    for (int n = 0; n < 2; ++n) { f32x4 x = acc[ai][bj][m][n];
#pragma unroll
                        for (int j = 0; j < 4; ++j) { x[j] = __builtin_amdgcn_exp2f(x[j] - mx); s += x[j]; }
                        acc[ai][bj][m][n] = x; }
                s += __shfl_xor(s, 16); s += __shfl_xor(s, 32);
                if (fq == 0) PS[r * 4 + wc] = s; }
        __syncthreads();
        const int row0 = u.pm * BM + wr * 64 + fr, col0 = u.pn * XHD + wc * 32 + 8 * fq;
#pragma unroll
        for (int ai = 0; ai < 2; ++ai)
#pragma unroll
            for (int m = 0; m < 4; ++m) { const int r = ai * HALF + wr * 64 + m * 16 + fr; const f32x4 ps4 = *(const LAS f32x4*)(PS + r * 4);
                const float inv = 1.0f / ((ps4[0] + ps4[1]) + (ps4[2] + ps4[3])); bf16_t* rowp = pb + (size_t)(row0 + ai * HALF + m * 16) * D + col0;
#pragma unroll
                for (int bj = 0; bj < 2; ++bj) { const f32x4 v0 = acc[ai][bj][m][0] * inv, v1 = acc[ai][bj][m][1] * inv;
                    u32x4 w; w.x = cvt_pk_bf16(v0[0], v0[1]); w.y = cvt_pk_bf16(v0[2], v0[3]); w.z = cvt_pk_bf16(v1[0], v1[1]); w.w = cvt_pk_bf16(v1[2], v1[3]);
                    *(u32x4*)(rowp + bj * HALF) = w; } }
        __syncthreads();
    }
};
struct EpiO {
    static constexpr bool PERM = true, AFTER_DRAIN = false;
    bf16_t* ob;
    __device__ __forceinline__ void prefetch(const Unit&, int, LAS unsigned char*, int, int) const {}
    __device__ __forceinline__ void operator()(const Acc& acc, const Unit& u, int, LAS unsigned char*, int wr, int wc, int fr, int fq) const {
        const int row0 = u.pm * BM + wr * 64 + fr, col0 = u.pn * BM + wc * 32 + 8 * fq;
#pragma unroll
        for (int ai = 0; ai < 2; ++ai)
#pragma unroll
            for (int m = 0; m < 4; ++m) { bf16_t* rowp = ob + (size_t)(row0 + ai * HALF + m * 16) * D + col0;
#pragma unroll
                for (int bj = 0; bj < 2; ++bj) { const f32x4 v0 = acc[ai][bj][m][0], v1 = acc[ai][bj][m][1];
                    u32x4 w; w.x = cvt_pk_bf16(v0[0], v0[1]); w.y = cvt_pk_bf16(v0[2], v0[3]); w.z = cvt_pk_bf16(v1[0], v1[1]); w.w = cvt_pk_bf16(v1[2], v1[3]);
                    *(u32x4*)(rowp + bj * HALF) = w; } }
    }
};
constexpr int META_OFF = 131072, META_BYTES = 3072;
__device__ __forceinline__ void dma4(const void* g, LAS unsigned char* l) { __builtin_amdgcn_global_load_lds((const unsigned*)g, (LAS unsigned*)l, 4, 0, 0); }
__device__ __forceinline__ void dma16(const void* g, LAS unsigned char* l) { __builtin_amdgcn_global_load_lds((const unsigned*)g, (LAS unsigned*)l, 16, 0, 0); }
struct EpiAct {
    static constexpr bool PERM = true, AFTER_DRAIN = false;
    bf16_t* act; const float* lrstd; const float* b1;
    __device__ __forceinline__ void prefetch(const UnitM& u, int ui, LAS unsigned char* lds, int wid, int lane) const {
        LAS unsigned char* mb = lds + META_OFF + (ui % 3) * META_BYTES;
        if (wid < 4) dma4(lrstd + (size_t)u.e * LISTCAP + u.pm * 256 + wid * 64 + lane, mb + wid * 256);
        else dma4(u.tok + (wid - 4) * 64 + lane, mb + 1024 + (wid - 4) * 256);
        if (wid == 4) dma16(b1 + (size_t)u.e * 2048 + (lane >> 5) * 1024 + u.pn * 128 + (lane & 31) * 4, mb + 2048);
    }
    __device__ __forceinline__ void operator()(const Acc& acc, const UnitM& u, int ui, LAS unsigned char* lds, int wr, int wc, int fr, int fq) const {
        const LAS unsigned char* mb = lds + META_OFF + (ui % 3) * META_BYTES;
        const int cl = wc * 32 + 8 * fq, gcol = u.pn * 128 + cl; const LAS float* bg = (const LAS float*)(mb + 2048) + cl; const LAS float* bl = bg + 128;
        const f32x4 bg0 = *(const LAS f32x4*)bg, bg1 = *(const LAS f32x4*)(bg + 4), bl0 = *(const LAS f32x4*)bl, bl1 = *(const LAS f32x4*)(bl + 4);
        int rb = wr * 64 + fr; asm volatile("" : "+v"(rb));
#pragma unroll
        for (int ai = 0; ai < 2; ++ai)
#pragma unroll
            for (int m = 0; m < 4; ++m) { const int r = ai * HALF + m * 16 + rb; const float rs = ((const LAS float*)mb)[r] * (1.0f / W8_SCALE);
                float o[8];
#pragma unroll
                for (int n = 0; n < 2; ++n) { const f32x4 g4 = acc[ai][0][m][n] * rs + (n ? bg1 : bg0), l4 = acc[ai][1][m][n] * rs + (n ? bl1 : bl0);
#pragma unroll
                    for (int j = 0; j < 4; ++j) { const float g = fminf(g4[j], 7.0f), l = fminf(fmaxf(l4[j], -7.0f), 7.0f);
                        const float sg = __builtin_amdgcn_rcpf(1.0f + __builtin_amdgcn_exp2f(g * (-1.702f * LOG2E))); o[n * 4 + j] = g * sg * (l + 1.0f); } }
                u32x2 w; w.x = pk_fp8x4(o[0] * ACT8_SCALE, o[1] * ACT8_SCALE, o[2] * ACT8_SCALE, o[3] * ACT8_SCALE); w.y = pk_fp8x4(o[4] * ACT8_SCALE, o[5] * ACT8_SCALE, o[6] * ACT8_SCALE, o[7] * ACT8_SCALE);
                *(u32x2*)((unsigned char*)act + (size_t)(u.rowoff + r) * DEXP + gcol) = w; }
    }
};
struct EpiY {
    static constexpr bool PERM = true, AFTER_DRAIN = false;
    bf16_t* y; const float* lgate; const int* ltok; const float* b2;
    __device__ __forceinline__ void prefetch(const UnitM& u, int ui, LAS unsigned char* lds, int wid, int lane) const {
        LAS unsigned char* mb = lds + META_OFF + (ui % 3) * META_BYTES;
        const size_t li = (size_t)u.e * LISTCAP + u.pm * 256 + (wid & 3) * 64 + lane;
        if (wid < 4) dma4(lgate + li, mb + wid * 256); else dma4(ltok + li, mb + 1024 + (wid - 4) * 256);
        if (wid == 0) dma16(b2 + (size_t)u.e * D + u.pn * 256 + lane * 4, mb + 2048);
    }
    __device__ __forceinline__ void operator()(const Acc& acc, const UnitM& u, int ui, LAS unsigned char* lds, int wr, int wc, int fr, int fq) const {
        const LAS unsigned char* mb = lds + META_OFF + (ui % 3) * META_BYTES;
        const int cl = wc * 32 + 8 * fq, col0 = u.pn * BM + cl; const LAS float* bb = (const LAS float*)(mb + 2048) + cl;
        int rb = wr * 64 + fr; asm volatile("" : "+v"(rb));
#pragma unroll
        for (int bj = 0; bj < 2; ++bj) {
            const f32x4 bv0 = *(const LAS f32x4*)(bb + bj * HALF), bv1 = *(const LAS f32x4*)(bb + bj * HALF + 4);
#pragma unroll
            for (int ai = 0; ai < 2; ++ai)
#pragma unroll
                for (int m = 0; m < 4; ++m) { const int r = ai * HALF + m * 16 + rb;
                    if (r < u.nvalid) { const int ent = ((const LAS int*)(mb + 1024))[r]; const float gw = ((const LAS float*)mb)[r]; unsigned char* rowp = (unsigned char*)y + (size_t)ent * D + col0;
                        const f32x4 v0 = (acc[ai][bj][m][0] * (1.0f / (W8_SCALE * ACT8_SCALE)) + bv0) * gw, v1 = (acc[ai][bj][m][1] * (1.0f / (W8_SCALE * ACT8_SCALE)) + bv1) * gw;
                        u32x2 w; w.x = pk_fp8x4(v0[0] * Y8_SCALE, v0[1] * Y8_SCALE, v0[2] * Y8_SCALE, v0[3] * Y8_SCALE); w.y = pk_fp8x4(v1[0] * Y8_SCALE, v1[1] * Y8_SCALE, v1[2] * Y8_SCALE, v1[3] * Y8_SCALE);
                        *(u32x2*)(rowp + bj * HALF) = w; } }
        }
    }
};
}

#define XB_TMO      128
#define XB_XCNT(j)  (256  + 64 * (j))
#define XB_XSUB(j)  (1280 + 64 * (j))
#define XB_XGEN(j)  (2304 + 64 * (j))
#define XB_TOP      3328
#define XB_TOPGEN   3392
#define XCD_BAR_WORDS 3456
#define XB_SPIN_CAP (1u << 18)
__device__ __forceinline__ unsigned xb_ld(unsigned* p)              { return __hip_atomic_load(p, __ATOMIC_RELAXED, __HIP_MEMORY_SCOPE_AGENT); }
__device__ __forceinline__ unsigned xb_add(unsigned* p, unsigned v) { return __hip_atomic_fetch_add(p, v, __ATOMIC_RELAXED, __HIP_MEMORY_SCOPE_AGENT); }
__device__ __forceinline__ unsigned xb_xcc_id() { return (unsigned)__builtin_amdgcn_s_getreg((3 << 11) | 20) & 0xFu; }
#define XB_SPIN(cond, bar) do { unsigned _sp = 0; while (cond) { __builtin_amdgcn_s_sleep(1); \
    if ((++_sp & 255u) == 0u) { if (xb_ld(&(bar)[XB_TMO])) break; if (_sp > XB_SPIN_CAP) { atomicAdd(&(bar)[XB_TMO], 1u); break; } } } } while (0)
struct XcdBarrier { unsigned* bar; unsigned x; volatile LAS unsigned* st; };
__device__ __forceinline__ XcdBarrier xcd_barrier_post(unsigned* bar, volatile LAS unsigned* st) {
    XcdBarrier b; b.bar = bar; b.x = xb_xcc_id(); b.st = st;
    if (threadIdx.x == 0) (void)xb_add(&bar[XB_XCNT(b.x)], 1u);
    return b;
}
__device__ __forceinline__ void xcd_barrier_complete(unsigned* bar, unsigned x, unsigned& nloc, unsigned& nx) {
    const unsigned G = gridDim.x * gridDim.y * gridDim.z;
    unsigned sum, cnt, mine, sp = 0u;
    for (;;) {
        sum = 0u; cnt = 0u; mine = 0u;
#pragma unroll
        for (unsigned j = 0; j < 16; ++j) { const unsigned c = xb_ld(&bar[XB_XCNT(j)]); sum += c; cnt += (c > 0u) ? 1u : 0u; mine = (j == x) ? c : mine; }
        if (sum == G) break;
        __builtin_amdgcn_s_sleep(1);
        if ((++sp & 255u) == 0u) { if (xb_ld(&bar[XB_TMO])) break; if (sp > XB_SPIN_CAP) { atomicAdd(&bar[XB_TMO], 1u); break; } }
    }
    nloc = mine > 0u ? mine : 1u; nx = cnt > 0u ? cnt : 1u;
}
__device__ __forceinline__ void xcd_barrier(const XcdBarrier& b) {
    asm volatile("s_waitcnt vmcnt(0)" ::: "memory");
    __syncthreads();
    if (threadIdx.x == 0) {
        unsigned* bar = b.bar;
        __builtin_amdgcn_s_waitcnt(0);
        unsigned nloc = b.st[0], nx = b.st[1];
        if (nloc == 0u) { xcd_barrier_complete(bar, b.x, nloc, nx); b.st[0] = nloc; b.st[1] = nx; }
        const unsigned old = xb_add(&bar[XB_XSUB(b.x)], 1u);
        const unsigned gen = old / nloc;
        if (old + 1u == (gen + 1u) * nloc) {
            __builtin_amdgcn_fence(__ATOMIC_RELEASE, "agent");
            asm volatile("s_waitcnt vmcnt(0)" ::: "memory");
            const unsigned og = xb_add(&bar[XB_TOP], 1u);
            const unsigned tg = og / nx;
            if (og + 1u == (tg + 1u) * nx) xb_add(&bar[XB_TOPGEN], 1u);
            else XB_SPIN(xb_ld(&bar[XB_TOPGEN]) == tg, bar);
            __builtin_amdgcn_fence(__ATOMIC_ACQUIRE, "agent");
            xb_add(&bar[XB_XGEN(b.x)], 1u);
            asm volatile("s_waitcnt vmcnt(0)" ::: "memory");
        } else {
            XB_SPIN(xb_ld(&bar[XB_XGEN(b.x)]) == gen, bar);
            __builtin_amdgcn_fence(__ATOMIC_ACQUIRE, "agent");
            asm volatile("s_waitcnt vmcnt(0)" ::: "memory");
        }
    }
    __syncthreads();
}

__device__ __forceinline__ void local_seam() {
    asm volatile("s_waitcnt vmcnt(0)" ::: "memory");
    __syncthreads();
    if (threadIdx.x == 0) { __builtin_amdgcn_fence(__ATOMIC_ACQUIRE, "agent"); asm volatile("s_waitcnt vmcnt(0)" ::: "memory"); }
    __syncthreads();
}

constexpr int NWAVES = 8;
constexpr int RING_OFF = 0, RING_BYTES = 131072;
constexpr int LDSCTL_OFF = RING_BYTES + 12288, MISC_OFF = LDSCTL_OFF + 320;
constexpr int LDS_BYTES = 147456;
static_assert(MISC_OFF + 128 <= LDS_BYTES, "LDS map");

struct Frame {
    LAS unsigned char* lds; volatile LAS unsigned* MISC; unsigned* ctl; unsigned char* ws;
    int tid, lane, wave, vcu, G;
    const float* const* in; float* out;
};

__device__ __forceinline__ int nmap1(int n) { return n < 1024 ? (n >> 7) * 256 + (n & 127) : ((n - 1024) >> 7) * 256 + 128 + ((n - 1024) & 127); }
struct TItem { const float* W; bf16_t* WT; const float* g; int ldw, K, k0, n0, perm; };
__device__ __forceinline__ void titem_load(const TItem& t, f32x4 (&va)[8], f32x4 (&vb)[8], int lane) {
    const int nq = lane & 15, kp = lane >> 4;
#pragma unroll
    for (int it = 0; it < 8; ++it) { const int k = t.k0 + 2 * (kp + 4 * it); va[it] = *(const f32x4*)(t.W + (size_t)k * t.ldw + t.n0 + 4 * nq); vb[it] = *(const f32x4*)(t.W + (size_t)(k + 1) * t.ldw + t.n0 + 4 * nq); }
}
__device__ __forceinline__ void titem_store(const TItem& t, const f32x4 (&va)[8], const f32x4 (&vb)[8], LAS unsigned* scr, int lane) {
    const int nq = lane & 15, kp = lane >> 4;
#pragma unroll
    for (int it = 0; it < 8; ++it) { const int kk2 = kp + 4 * it; f32x4 a = va[it], b = vb[it];
        if (t.g) { const float g0 = t.g[t.k0 + 2 * kk2], g1 = t.g[t.k0 + 2 * kk2 + 1]; a = a * g0; b = b * g1; }
#pragma unroll
        for (int j = 0; j < 4; ++j) scr[(4 * nq + j) * 33 + kk2] = cvtpk_s(a[j], b[j]); }
    LDS_WAIT(); asm volatile("" ::: "memory");
    const int c = lane & 7;
#pragma unroll
    for (int it = 0; it < 8; ++it) { const int n = (lane >> 3) + 8 * it; const LAS unsigned* sp = scr + n * 33 + 4 * c;
        u32x4 o; o.x = sp[0]; o.y = sp[1]; o.z = sp[2]; o.w = sp[3];
        const int nn = t.n0 + n, nr = t.perm ? nmap1(nn) : nn;
        *(u32x4*)(t.WT + (size_t)nr * t.K + t.k0 + 8 * c) = o; }
    LDS_WAIT(); asm volatile("" ::: "memory");
}
__device__ __forceinline__ void titem8_load(const TItem& t, f32x4 (&va)[8], f32x4 (&vb)[8], int lane) {
    const int nq = lane & 7, kg = lane >> 3;
#pragma unroll
    for (int it = 0; it < 4; ++it) { const int k = t.k0 + 4 * (kg + 8 * it); const float* p = t.W + (size_t)k * t.ldw + t.n0 + 4 * nq;
        va[2 * it] = *(const f32x4*)p; va[2 * it + 1] = *(const f32x4*)(p + t.ldw); vb[2 * it] = *(const f32x4*)(p + 2 * (size_t)t.ldw); vb[2 * it + 1] = *(const f32x4*)(p + 3 * (size_t)t.ldw); }
}
__device__ __forceinline__ void titem8_store(const TItem& t, const f32x4 (&va)[8], const f32x4 (&vb)[8], LAS unsigned* scr, int lane) {
    const int nq = lane & 7, kg = lane >> 3;
#pragma unroll
    for (int it = 0; it < 4; ++it) { const int kq = kg + 8 * it; f32x4 a = va[2 * it], b = va[2 * it + 1], c = vb[2 * it], d = vb[2 * it + 1];
        float g0 = W8_SCALE, g1 = W8_SCALE, g2 = W8_SCALE, g3 = W8_SCALE;
        if (t.g) { const f32x4 gv = *(const f32x4*)(t.g + t.k0 + 4 * kq); g0 *= gv[0]; g1 *= gv[1]; g2 *= gv[2]; g3 *= gv[3]; }
#pragma unroll
        for (int j = 0; j < 4; ++j) scr[(4 * nq + j) * 33 + kq] = pk_fp8x4(a[j] * g0, b[j] * g1, c[j] * g2, d[j] * g3); }
    LDS_WAIT(); asm volatile("" ::: "memory");
    const int c = lane & 7;
#pragma unroll
    for (int it = 0; it < 4; ++it) { const int n = (lane >> 3) + 8 * it; const LAS unsigned* sp = scr + n * 33 + 4 * c;
        u32x4 o; o.x = sp[0]; o.y = sp[1]; o.z = sp[2]; o.w = sp[3];
        const int nn = t.n0 + n, nr = t.perm ? nmap1(nn) : nn;
        *(u32x4*)((unsigned char*)t.WT + (size_t)nr * t.K + t.k0 + 16 * c) = o; }
    LDS_WAIT(); asm volatile("" ::: "memory");
}
template <bool F8, class Dec> __device__ __forceinline__ void titem_loop(int first, int stride, int n, LAS unsigned* scr, int lane, const Dec& dec) {
    if (first >= n) return;
    TItem A, B; f32x4 a0[8], a1[8], b0[8], b1[8];
    int ia = first; dec(ia, A); if (F8) titem8_load(A, a0, a1, lane); else titem_load(A, a0, a1, lane);
    for (;;) {
        const int ib = ia + stride; const bool hb = ib < n;
        if (hb) { dec(ib, B); if (F8) titem8_load(B, b0, b1, lane); else titem_load(B, b0, b1, lane); }
        if (F8) titem8_store(A, a0, a1, scr, lane); else titem_store(A, a0, a1, scr, lane);
        if (!hb) break;
        ia = ib + stride; const bool ha = ia < n;
        if (ha) { dec(ia, A); if (F8) titem8_load(A, a0, a1, lane); else titem_load(A, a0, a1, lane); }
        if (F8) titem8_store(B, b0, b1, scr, lane); else titem_store(B, b0, b1, scr, lane);
        if (!ha) break;
    }
}
__device__ __forceinline__ void rms_rows_to_bf16(const float* x, const float* g, bf16_t* o, int first, int stride, int n, int lane) {
    if (first >= n) return;
    const f32x4* gr = (const f32x4*)g + lane; f32x4 gg[4];
#pragma unroll
    for (int j = 0; j < 4; ++j) gg[j] = gr[64 * j];
    f32x4 v[4], w[4];
#pragma unroll
    for (int j = 0; j < 4; ++j) v[j] = ((const f32x4*)(x + (size_t)first * D) + lane)[64 * j];
    for (int m = first; m < n; m += stride) {
        const int mn = m + stride;
        if (mn < n) {
#pragma unroll
            for (int j = 0; j < 4; ++j) w[j] = ((const f32x4*)(x + (size_t)mn * D) + lane)[64 * j];
        }
        float sq = 0.f;
#pragma unroll
        for (int j = 0; j < 4; ++j) sq += (v[j][0] * v[j][0] + v[j][1] * v[j][1]) + (v[j][2] * v[j][2] + v[j][3] * v[j][3]);
        const float rstd = __builtin_amdgcn_rsqf(wave_sum(sq) * (1.f / D) + EPS);
        u32x2* o8 = (u32x2*)(o + (size_t)m * D) + lane;
#pragma unroll
        for (int j = 0; j < 4; ++j) { u32x2 q; q.x = cvtpk_s(v[j][0] * rstd * gg[j][0], v[j][1] * rstd * gg[j][1]); q.y = cvtpk_s(v[j][2] * rstd * gg[j][2], v[j][3] * rstd * gg[j][3]); o8[64 * j] = q; }
#pragma unroll
        for (int j = 0; j < 4; ++j) v[j] = w[j];
    }
}
__device__ __forceinline__ void p0a_prologue(Frame& F) {
    LAS unsigned* scr = (LAS unsigned*)(F.lds + RING_OFF + F.wave * 16384);
    const int gw = F.vcu * NWAVES + F.wave, NGW = F.G * NWAVES;
    const float *mem = F.in[1], *g_mem = F.in[9], *w_kv = F.in[11];
    bf16_t *wkv_t = (bf16_t*)(F.ws + WS_WKV_T), *memn = (bf16_t*)(F.ws + WS_MEMN);
    rms_rows_to_bf16(mem, g_mem, memn, gw, NGW, MROWS, F.lane);
    titem_loop<false>(gw, NGW, 16 * 32, scr, F.lane, [=](int r, TItem& t) { t.W = w_kv; t.WT = wkv_t; t.g = nullptr; t.ldw = 2 * D; t.K = D; t.k0 = (r / 32) * 64; t.n0 = (r % 32) * 64; t.perm = 0; });
}
__device__ __forceinline__ void p0b_prologue(Frame& F, int wv, int nwv, int lo_frac_num, int lo_frac_den, bool low) {
    LAS unsigned* scr = (LAS unsigned*)(F.lds + RING_OFF + F.wave * 16384);
    const float *x = F.in[0], *g_mix = F.in[2], *w_in = F.in[3], *w_out = F.in[7], *g_xattn = F.in[8], *w_q = F.in[10], *w_o = F.in[12], *g_moe = F.in[13], *w_router = F.in[14], *w1 = F.in[16], *w2 = F.in[18];
    bf16_t *win_t = (bf16_t*)(F.ws + WS_WIN_T), *wout_t = (bf16_t*)(F.ws + WS_WOUT_T), *wq_t = (bf16_t*)(F.ws + WS_WQ_T), *wo_t = (bf16_t*)(F.ws + WS_WO_T),
           *w1_t = (bf16_t*)(F.ws + WS_W1_T), *w2_t = (bf16_t*)(F.ws + WS_W2_T), *xn = (bf16_t*)(F.ws + WS_XN);
    float* wr = (float*)(F.ws + WS_WR);
    auto range = [&](int n, int& first, int& end) { const int cut = (int)((long)n * lo_frac_num / lo_frac_den); if (low) { first = wv; end = cut; } else { first = cut + wv; end = n; } };
    int f, e;
    range(D * NE / 64, f, e); for (int i = f; i < e; i += nwv) { const int idx = i * 64 + F.lane; wr[idx] = w_router[idx] * g_moe[idx >> 5]; }
    constexpr int I_1 = NE * 8 * 64, I_2 = NE * 8 * 32;
    range(I_1 + I_2, f, e);
    titem_loop<true>(f, nwv, e, scr, F.lane, [=](int r, TItem& t) {
        t.g = nullptr; t.perm = 0; t.K = D;
        if (r < I_2) { const int ex = r / 256, q = r % 256; t.W = w2 + (size_t)ex * DEXP * D; t.WT = (bf16_t*)((unsigned char*)w2_t + (size_t)ex * D * DEXP); t.ldw = D; t.k0 = (q / 32) * 128; t.n0 = (q % 32) * 32; return; } r -= I_2;
        { const int ex = r / 512, q = r % 512; t.W = w1 + (size_t)ex * D * 2048; t.WT = (bf16_t*)((unsigned char*)w1_t + (size_t)ex * 2048 * D); t.g = g_moe; t.ldw = 2048; t.perm = 1; t.k0 = (q / 64) * 128; t.n0 = (q % 64) * 32; }
    });
    constexpr int I_IN = 16 * 48, I_OUT = 16 * 16, I_Q = 16 * 16, I_O = 16 * 16;
    range(I_IN + I_OUT + I_Q + I_O, f, e);
    titem_loop<false>(f, nwv, e, scr, F.lane, [=](int r, TItem& t) {
        t.g = nullptr; t.perm = 0; t.K = D; t.ldw = D;
        if (r < I_O) { t.W = w_o; t.WT = wo_t; t.k0 = (r / 16) * 64; t.n0 = (r % 16) * 64; return; } r -= I_O;
        if (r < I_Q) { t.W = w_q; t.WT = wq_t; t.g = g_xattn; t.k0 = (r / 16) * 64; t.n0 = (r % 16) * 64; return; } r -= I_Q;
        if (r < I_OUT) { t.W = w_out; t.WT = wout_t; t.k0 = (r / 16) * 64; t.n0 = (r % 16) * 64; return; } r -= I_OUT;
        { t.W = w_in; t.WT = win_t; t.ldw = NPROJ; t.k0 = (r / 48) * 64; t.n0 = (r % 48) * 64; }
    });
    range(M, f, e); rms_rows_to_bf16(x, g_mix, xn, f, nwv, e, F.lane);
}

__device__ __forceinline__ void conv_rows(Frame& F) {
    const bf16_t* proj = (const bf16_t*)(F.ws + WS_PROJ); bf16_t* ymix = (bf16_t*)(F.ws + WS_YMIX);
    const float* conv_w = F.in[4]; const float* g_conv = F.in[5];
    const int gw = F.vcu * NWAVES + F.wave, NGW = F.G * NWAVES, c0 = 8 * F.lane;
    float w0[8], w1[8], w2[8], gg[8];
#pragma unroll
    for (int j = 0; j < 8; ++j) { w0[j] = conv_w[c0 + j]; w1[j] = conv_w[512 + c0 + j]; w2[j] = conv_w[1024 + c0 + j]; gg[j] = g_conv[c0 + j]; }
    auto ld = [&](int m, u32x4 (&v)[7]) {
        const int t = m & (SEQ - 1); const bf16_t* row = proj + (size_t)m * NPROJ + c0;
        v[0] = *(const u32x4*)row; v[1] = *(const u32x4*)(row + 512); v[2] = *(const u32x4*)(row + 1024);
        v[3] = (u32x4){0, 0, 0, 0}; v[4] = v[3]; v[5] = v[3]; v[6] = v[3];
        if (t >= 1) { v[3] = *(const u32x4*)(row - NPROJ + 512); v[4] = *(const u32x4*)(row - NPROJ + 1024); }
        if (t >= 2) { v[5] = *(const u32x4*)(row - 2 * NPROJ + 512); v[6] = *(const u32x4*)(row - 2 * NPROJ + 1024); }
    };
    if (gw >= M) return;
    u32x4 cur[7], nx[7];
    ld(gw, cur);
    for (int m = gw; m < M; m += NGW) {
        if (m + NGW < M) ld(m + NGW, nx);
        const u32x4 bg = cur[0], cg0 = cur[1], xv0 = cur[2], cg1 = cur[3], xv1 = cur[4], cg2 = cur[5], xv2 = cur[6];
        float y[8]; float ss = 0.f;
#pragma unroll
        for (int j = 0; j < 4; ++j) {
            const float u0l = bf_lo(cg0[j]) * bf_lo(xv0[j]), u0h = bf_hi(cg0[j]) * bf_hi(xv0[j]);
            const float u1l = bf_lo(cg1[j]) * bf_lo(xv1[j]), u1h = bf_hi(cg1[j]) * bf_hi(xv1[j]);
            const float u2l = bf_lo(cg2[j]) * bf_lo(xv2[j]), u2h = bf_hi(cg2[j]) * bf_hi(xv2[j]);
            y[2 * j] = bf_lo(bg[j]) * (w0[2 * j] * u2l + w1[2 * j] * u1l + w2[2 * j] * u0l);
            y[2 * j + 1] = bf_hi(bg[j]) * (w0[2 * j + 1] * u2h + w1[2 * j + 1] * u1h + w2[2 * j + 1] * u0h);
            ss += y[2 * j] * y[2 * j] + y[2 * j + 1] * y[2 * j + 1];
        }
        ss += __shfl_xor(ss, 1); ss += __shfl_xor(ss, 2); ss += __shfl_xor(ss, 4);
        const float rstd = __builtin_amdgcn_rsqf(ss * (1.f / 64.f) + EPS);
        u32x4 o; o.x = cvtpk_s(y[0] * rstd * gg[0], y[1] * rstd * gg[1]); o.y = cvtpk_s(y[2] * rstd * gg[2], y[3] * rstd * gg[3]);
        o.z = cvtpk_s(y[4] * rstd * gg[4], y[5] * rstd * gg[5]); o.w = cvtpk_s(y[6] * rstd * gg[6], y[7] * rstd * gg[7]);
        *(u32x4*)(ymix + (size_t)m * D + c0) = o;
#pragma unroll
        for (int i = 0; i < 7; ++i) cur[i] = nx[i];
    }
}
constexpr int SB_K = 0, SB_V = 8192, SB_OST = 16384, SB_OSTW = 32 * 68 * 4, SB_FLAG = 90112;
static_assert(SB_OST + 8 * SB_OSTW <= SB_FLAG && SB_FLAG + 32 <= RING_BYTES, "attention LDS");
__device__ __forceinline__ int crow(int r, int hi) { return (r & 3) + 8 * (r >> 2) + 4 * hi; }
__device__ __forceinline__ void sb_attn_unit(Frame& F, int b, int h, int qb) {
    const bf16_t* proj = (const bf16_t*)(F.ws + WS_PROJ); bf16_t* ymix = (bf16_t*)(F.ws + WS_YMIX); const float* g_sb = F.in[6];
    const int tid = F.tid, lane = F.lane, wid = F.wave, r32 = lane & 31, hi = lane >> 5;
    LAS unsigned char* lds = F.lds + RING_OFF;
    const int q0 = qb * 256, qlo = q0 + wid * 32, qpos = qlo + r32;
    const size_t rowbase = (size_t)b * SEQ;
    const bf16_t* Qp = proj + (rowbase + qlo) * NPROJ + 1536 + h * 64;
    const bf16_t* Kp = proj + rowbase * NPROJ + 2048 + h * 64;
    const bf16_t* Vp = proj + rowbase * NPROJ + 2560 + h * 64;
    bf16x8 qr[4];
#pragma unroll
    for (int s = 0; s < 4; ++s) qr[s] = *(const bf16x8*)(Qp + (size_t)r32 * NPROJ + 16 * s + 8 * hi);
    bf16x8 ntri[2], nones;
#pragma unroll
    for (int s = 0; s < 2; ++s)
#pragma unroll
        for (int j = 0; j < 8; ++j) { const int k = 16 * s + 8 * (j >> 2) + 4 * hi + (j & 3); ntri[s][j] = (k > r32) ? (short)0xBF80 : (short)0; }
#pragma unroll
    for (int j = 0; j < 8; ++j) nones[j] = (short)0xBF80;
    f32x16 R = {}; f32x16 o[2]; o[0] = f32x16{}; o[1] = f32x16{};
    const int skey = tid >> 3, sc = tid & 7;
    const int koff = SB_K + skey * 128 + ((sc ^ ((skey >> 1) & 7)) << 4);
    const int voff = SB_V + (sc >> 2) * 4096 + (skey >> 4) * 1024 + (skey & 15) * 64 + (sc & 3) * 16;
    const int vb = SB_V + ((lane >> 4) & 1) * 32 + (lane & 3) * 8 + (4 * hi + ((lane & 15) >> 2)) * 64;
    int kbi = 4 * qb + 3;
    u32x4 kreg = *(const u32x4*)(Kp + (size_t)(kbi * 64 + skey) * NPROJ + sc * 8), vreg = *(const u32x4*)(Vp + (size_t)(kbi * 64 + skey) * NPROJ + sc * 8);
    LAS int* dflag = (LAS int*)(lds + SB_FLAG);
    int done = 0;
    for (; kbi >= 0; --kbi) {
        const int k0 = kbi * 64;
        __syncthreads();
        *(LAS u32x4*)(lds + koff) = kreg; *(LAS u32x4*)(lds + voff) = vreg;
        if (lane == 0) dflag[wid] = done;
        __syncthreads();
        { const u32x4 f0 = *(const LAS u32x4*)dflag, f1 = *(const LAS u32x4*)(dflag + 4); if ((f0.x & f0.y & f0.z & f0.w & f1.x & f1.y & f1.z & f1.w) != 0u) break; }
        if (kbi > 0) { kreg = *(const u32x4*)(Kp + (size_t)(k0 - 64 + skey) * NPROJ + sc * 8); vreg = *(const u32x4*)(Vp + (size_t)(k0 - 64 + skey) * NPROJ + sc * 8); }
        if (!done && k0 < qlo + 31) {
            f32x16 p0 = {}, p1 = {};
#pragma unroll
            for (int s = 0; s < 4; ++s) { const int c = 2 * s + hi;
                const bf16x8 ka = *(const LAS bf16x8*)(lds + SB_K + r32 * 128 + ((c ^ ((r32 >> 1) & 7)) << 4));
                const bf16x8 kb = *(const LAS bf16x8*)(lds + SB_K + (r32 + 32) * 128 + ((c ^ (((r32 + 32) >> 1) & 7)) << 4));
                p0 = __builtin_amdgcn_mfma_f32_32x32x16_bf16(ka, qr[s], p0, 0, 0, 0); p1 = __builtin_amdgcn_mfma_f32_32x32x16_bf16(kb, qr[s], p1, 0, 0, 0); }
            const bool diag = (k0 + 63 >= qlo);
            f32x16 s0, s1;
#pragma unroll
            for (int r = 0; r < 16; ++r) {
                const float z0 = p0[r], z1 = p1[r];
                float sp0 = fmaxf(z0, 0.f) + __builtin_amdgcn_logf(1.0f + __builtin_amdgcn_exp2f(-fabsf(z0)));
                float sp1 = fmaxf(z1, 0.f) + __builtin_amdgcn_logf(1.0f + __builtin_amdgcn_exp2f(-fabsf(z1)));
                if (diag) { const int key = k0 + crow(r, hi); if (key >= qpos) sp0 = 0.f; if (key + 32 >= qpos) sp1 = 0.f; }
                s0[r] = sp0; s1[r] = sp1; p0[r] = z0 - sp0; p1[r] = z1 - sp1;
            }
            u32x4 w00 = {cvtpk_s(s0[0], s0[1]), cvtpk_s(s0[2], s0[3]), cvtpk_s(s0[4], s0[5]), cvtpk_s(s0[6], s0[7])}, w01 = {cvtpk_s(s0[8], s0[9]), cvtpk_s(s0[10], s0[11]), cvtpk_s(s0[12], s0[13]), cvtpk_s(s0[14], s0[15])};
            u32x4 w10 = {cvtpk_s(s1[0], s1[1]), cvtpk_s(s1[2], s1[3]), cvtpk_s(s1[4], s1[5]), cvtpk_s(s1[6], s1[7])}, w11 = {cvtpk_s(s1[8], s1[9]), cvtpk_s(s1[10], s1[11]), cvtpk_s(s1[12], s1[13]), cvtpk_s(s1[14], s1[15])};
            const bf16x8 sb00 = __builtin_bit_cast(bf16x8, w00), sb01 = __builtin_bit_cast(bf16x8, w01), sb10 = __builtin_bit_cast(bf16x8, w10), sb11 = __builtin_bit_cast(bf16x8, w11);
            f32x16 rest1 = __builtin_amdgcn_mfma_f32_32x32x16_bf16(ntri[0], sb10, R, 0, 0, 0); rest1 = __builtin_amdgcn_mfma_f32_32x32x16_bf16(ntri[1], sb11, rest1, 0, 0, 0);
            f32x16 U = __builtin_amdgcn_mfma_f32_32x32x16_bf16(nones, sb10, R, 0, 0, 0); U = __builtin_amdgcn_mfma_f32_32x32x16_bf16(nones, sb11, U, 0, 0, 0);
            f32x16 rest0 = __builtin_amdgcn_mfma_f32_32x32x16_bf16(ntri[0], sb00, U, 0, 0, 0); rest0 = __builtin_amdgcn_mfma_f32_32x32x16_bf16(ntri[1], sb01, rest0, 0, 0, 0);
            R = __builtin_amdgcn_mfma_f32_32x32x16_bf16(nones, sb00, U, 0, 0, 0); R = __builtin_amdgcn_mfma_f32_32x32x16_bf16(nones, sb01, R, 0, 0, 0);
            done = __all(R[0] < -150.0f) ? 1 : 0;
#pragma unroll
            for (int r = 0; r < 16; ++r) {
                float a0 = __builtin_amdgcn_exp2f(p0[r] + rest0[r]), a1 = __builtin_amdgcn_exp2f(p1[r] + rest1[r]);
                if (diag) { const int key = k0 + crow(r, hi); if (key >= qpos) a0 = 0.f; if (key + 32 >= qpos) a1 = 0.f; }
                p0[r] = a0; p1[r] = a1;
            }
            u32x4 a00 = {cvtpk_s(p0[0], p0[1]), cvtpk_s(p0[2], p0[3]), cvtpk_s(p0[4], p0[5]), cvtpk_s(p0[6], p0[7])}, a01 = {cvtpk_s(p0[8], p0[9]), cvtpk_s(p0[10], p0[11]), cvtpk_s(p0[12], p0[13]), cvtpk_s(p0[14], p0[15])};
            u32x4 a10 = {cvtpk_s(p1[0], p1[1]), cvtpk_s(p1[2], p1[3]), cvtpk_s(p1[4], p1[5]), cvtpk_s(p1[6], p1[7])}, a11 = {cvtpk_s(p1[8], p1[9]), cvtpk_s(p1[10], p1[11]), cvtpk_s(p1[12], p1[13]), cvtpk_s(p1[14], p1[15])};
            const bf16x8 pa[4] = {__builtin_bit_cast(bf16x8, a00), __builtin_bit_cast(bf16x8, a01), __builtin_bit_cast(bf16x8, a10), __builtin_bit_cast(bf16x8, a11)};
#pragma unroll
            for (int d0 = 0; d0 < 2; ++d0)
#pragma unroll
                for (int ks = 0; ks < 4; ++ks) {
                    const s16x4 lo = __builtin_bit_cast(s16x4, __builtin_amdgcn_ds_read_tr16_b64_v4i16((LAS s16x4*)(lds + vb + d0 * 4096 + ks * 1024)));
                    const s16x4 hh = __builtin_bit_cast(s16x4, __builtin_amdgcn_ds_read_tr16_b64_v4i16((LAS s16x4*)(lds + vb + d0 * 4096 + ks * 1024 + 512)));
                    const bf16x8 vf = {lo[0], lo[1], lo[2], lo[3], hh[0], hh[1], hh[2], hh[3]};
                    o[d0] = __builtin_amdgcn_mfma_f32_32x32x16_bf16(pa[ks], vf, o[d0], 0, 0, 0);
                }
        }
    }
    LAS float* stg = (LAS float*)(lds + SB_OST + wid * SB_OSTW);
#pragma unroll
    for (int r = 0; r < 16; ++r) { const int q = crow(r, hi); stg[q * 68 + r32] = o[0][r]; stg[q * 68 + 32 + r32] = o[1][r]; }
    LDS_WAIT(); asm volatile("" ::: "memory");
    { const int q = lane >> 1, half = lane & 1; const LAS f32x4* sp = (const LAS f32x4*)(stg + q * 68 + 32 * half);
      f32x4 v[8]; float ss = 0.f;
#pragma unroll
      for (int i = 0; i < 8; ++i) { v[i] = sp[i]; ss += (v[i][0] * v[i][0] + v[i][1] * v[i][1]) + (v[i][2] * v[i][2] + v[i][3] * v[i][3]); }
      ss += __shfl_xor(ss, 1);
      const float rstd = __builtin_amdgcn_rsqf(ss * (1.f / 64.f) + EPS);
      const f32x4* gp = (const f32x4*)(g_sb + h * 64 + 32 * half);
      bf16_t* op = ymix + (rowbase + qlo + q) * D + 512 + h * 64 + 32 * half;
#pragma unroll
      for (int i = 0; i < 4; ++i) { const f32x4 g0 = gp[2 * i], g1 = gp[2 * i + 1], a = v[2 * i] * rstd * g0, c = v[2 * i + 1] * rstd * g1;
          u32x4 w; w.x = cvtpk_s(a[0], a[1]); w.y = cvtpk_s(a[2], a[3]); w.z = cvtpk_s(c[0], c[1]); w.w = cvtpk_s(c[2], c[3]); *(u32x4*)(op + 8 * i) = w; } }
    LDS_WAIT();
}
__device__ __forceinline__ void p2_mix(Frame& F) {
    conv_rows(F);
    if (F.G == 256) {
        const int bh = F.vcu >> 2, s = F.vcu & 3;
        sb_attn_unit(F, bh >> 3, bh & 7, 7 - s);
        sb_attn_unit(F, bh >> 3, bh & 7, s);
    } else {
        for (int u = F.vcu; u < 512; u += F.G) sb_attn_unit(F, u >> 6, (u >> 3) & 7, u & 7);
    }
}

__device__ __forceinline__ void p8_router(Frame& F) {
    const float* x2 = (const float*)(F.ws + WS_X2); const float* wr = (const float*)(F.ws + WS_WR); const float* b_router = F.in[15];
    float* lrstd = (float*)(F.ws + WS_LRSTD); int* ltok = (int*)(F.ws + WS_LTOK); float* lgate = (float*)(F.ws + WS_LGATE); unsigned* cnt = F.ctl + CW_CNT;
    LAS float* wl = (LAS float*)(F.lds + RING_OFF);
    for (int i = F.tid; i < D * NE / 4; i += NWAVES * 64) ((LAS f32x4*)wl)[i] = ((const f32x4*)wr)[i];
    __syncthreads();
    const int lane = F.lane, tk = lane & 15, kq = lane >> 4;
    const int gw = F.vcu * NWAVES + F.wave, NGW = F.G * NWAVES;
    for (int item = gw; item < M / 16; item += NGW) {
        const int tok = item * 16 + tk; const float* xr = x2 + (size_t)tok * D + 4 * kq;
        f32x4 acc0 = {0.f, 0.f, 0.f, 0.f}, acc1 = {0.f, 0.f, 0.f, 0.f}; float ss = 0.f;
#pragma unroll 4
        for (int s = 0; s < 64; ++s) {
            const f32x4 xv = *(const f32x4*)(xr + 16 * s); ss += (xv[0] * xv[0] + xv[1] * xv[1]) + (xv[2] * xv[2] + xv[3] * xv[3]);
#pragma unroll
            for (int j = 0; j < 4; ++j) { const LAS float* wp = wl + (16 * s + 4 * kq + j) * 32 + tk;
                acc0 = __builtin_amdgcn_mfma_f32_16x16x4f32(wp[0], xv[j], acc0, 0, 0, 0); acc1 = __builtin_amdgcn_mfma_f32_16x16x4f32(wp[16], xv[j], acc1, 0, 0, 0); }
        }
        ss += __shfl_xor(ss, 16); ss += __shfl_xor(ss, 32);
        const float rstd = __builtin_amdgcn_rsqf(ss * (1.f / D) + EPS);
        float lg[32];
#pragma unroll
        for (int q = 0; q < 4; ++q)
#pragma unroll
            for (int j = 0; j < 4; ++j) { const int src = tk + 16 * q; lg[4 * q + j] = __shfl(acc0[j], src) * rstd + b_router[4 * q + j]; lg[16 + 4 * q + j] = __shfl(acc1[j], src) * rstd + b_router[16 + 4 * q + j]; }
        float tv[4]; int ti[4]; unsigned used = 0u;
#pragma unroll
        for (int k = 0; k < 4; ++k) { float bv = -INFINITY; int bi = 0;
#pragma unroll
            for (int e = 0; e < 32; ++e) { const bool ok = !((used >> e) & 1u) && lg[e] > bv; bv = ok ? lg[e] : bv; bi = ok ? e : bi; }
            tv[k] = bv; ti[k] = bi; used |= 1u << bi; }
        const float e1 = __expf(tv[1] - tv[0]), e2 = __expf(tv[2] - tv[0]), e3 = __expf(tv[3] - tv[0]); const float inv = 1.0f / (1.0f + e1 + e2 + e3);
        const int myE = kq == 0 ? ti[0] : kq == 1 ? ti[1] : kq == 2 ? ti[2] : ti[3];
        const float myG = (kq == 0 ? 1.0f : kq == 1 ? e1 : kq == 2 ? e2 : e3) * inv;
        int rank = 0, mycount = 0;
#pragma unroll 1
        for (int e = 0; e < NE; ++e) { const unsigned long long mk = __ballot(myE == e); const int pc = __popcll(mk);
            if (myE == e) rank = __popcll(mk & ((1ull << lane) - 1ull)); if (lane == e) mycount = pc; }
        unsigned base = 0u; if (lane < NE && mycount > 0) base = atomicAdd(cnt + 64 * lane, (unsigned)mycount);
        const unsigned mybase = (unsigned)__shfl((int)base, myE);
        const size_t pos = (size_t)myE * LISTCAP + mybase + rank;
        ltok[pos] = tok * 4 + kq; lgate[pos] = myG; lrstd[pos] = rstd;
    }
}

typedef float f32x2_ __attribute__((ext_vector_type(2)));
__device__ __forceinline__ void p11_load(const float* x2, const unsigned char* y, int m, int lane, f32x4 (&xv)[4], u32x2 (&yv)[8]) {
#pragma unroll
    for (int j = 0; j < 2; ++j) { const int c = 8 * lane + 512 * j; xv[2 * j] = *(const f32x4*)(x2 + (size_t)m * D + c); xv[2 * j + 1] = *(const f32x4*)(x2 + (size_t)m * D + c + 4);
#pragma unroll
        for (int sl = 0; sl < 4; ++sl) yv[4 * j + sl] = *(const u32x2*)(y + ((size_t)m * 4 + sl) * D + c); }
}
__device__ __forceinline__ void p11_final(Frame& F) {
    const float* x2 = (const float*)(F.ws + WS_X2); const unsigned char* y = (const unsigned char*)(F.ws + WS_Y); const float* g_final = F.in[20]; float* out = F.out;
    const int gw = F.vcu * NWAVES + F.wave, NGW = F.G * NWAVES, lane = F.lane;
    if (gw >= M) return;
    f32x4 gg[4];
#pragma unroll
    for (int j = 0; j < 2; ++j) { const int c = 8 * lane + 512 * j; gg[2 * j] = *(const f32x4*)(g_final + c); gg[2 * j + 1] = *(const f32x4*)(g_final + c + 4); }
    f32x4 xv[4], xn_[4]; u32x2 yv[8], yn_[8];
    p11_load(x2, y, gw, lane, xv, yv);
    for (int m = gw; m < M; m += NGW) {
        if (m + NGW < M) p11_load(x2, y, m + NGW, lane, xn_, yn_);
        f32x4 v[4]; float ss = 0.f;
#pragma unroll
        for (int j = 0; j < 2; ++j) { f32x4 s0 = {0.f, 0.f, 0.f, 0.f}, s1 = {0.f, 0.f, 0.f, 0.f};
#pragma unroll
            for (int sl = 0; sl < 4; ++sl) { const u32x2 w = yv[4 * j + sl];
                const f32x2_ a = __builtin_amdgcn_cvt_pk_f32_fp8((int)w.x, false), b = __builtin_amdgcn_cvt_pk_f32_fp8((int)w.x, true), c = __builtin_amdgcn_cvt_pk_f32_fp8((int)w.y, false), d = __builtin_amdgcn_cvt_pk_f32_fp8((int)w.y, true);
                s0[0] += a[0]; s0[1] += a[1]; s0[2] += b[0]; s0[3] += b[1]; s1[0] += c[0]; s1[1] += c[1]; s1[2] += d[0]; s1[3] += d[1]; }
            v[2 * j] = xv[2 * j] + s0 * (1.0f / Y8_SCALE); v[2 * j + 1] = xv[2 * j + 1] + s1 * (1.0f / Y8_SCALE); }
#pragma unroll
        for (int i = 0; i < 4; ++i) ss += (v[i][0] * v[i][0] + v[i][1] * v[i][1]) + (v[i][2] * v[i][2] + v[i][3] * v[i][3]);
        const float rstd = __builtin_amdgcn_rsqf(wave_sum(ss) * (1.f / D) + EPS);
#pragma unroll
        for (int j = 0; j < 2; ++j) { const int c = 8 * lane + 512 * j;
            *(f32x4*)(out + (size_t)m * D + c) = v[2 * j] * rstd * gg[2 * j]; *(f32x4*)(out + (size_t)m * D + c + 4) = v[2 * j + 1] * rstd * gg[2 * j + 1]; }
#pragma unroll
        for (int i = 0; i < 4; ++i) xv[i] = xn_[i];
#pragma unroll
        for (int i = 0; i < 8; ++i) yv[i] = yn_[i];
    }
}

constexpr int NPHASE = 13;
struct Args { const float* in[21]; float* out; unsigned char* ws; int ph_lo, ph_hi; };
static_assert(sizeof(Args) == 21 * 8 + 8 + 8 + 8, "Args has no padding");

__global__ void __launch_bounds__(NWAVES * 64, 2) fwd(Args args) {
    extern __shared__ __attribute__((aligned(16))) unsigned char lds[];
    Frame F;
    F.lds = (LAS unsigned char*)lds; F.MISC = (volatile LAS unsigned*)(F.lds + MISC_OFF);
    F.tid = threadIdx.x; F.lane = F.tid & 63; F.wave = __builtin_amdgcn_readfirstlane(F.tid >> 6);
    F.G = gridDim.x; { const int bx = blockIdx.x; F.vcu = (F.G % 8 == 0) ? (bx % 8) * (F.G / 8) + bx / 8 : bx; }
    F.ws = args.ws; F.ctl = (unsigned*)(args.ws + WS_CTL); F.out = args.out;
    F.in = args.in;
    for (int u = F.tid; u < (LDS_BYTES - LDSCTL_OFF) / 4; u += NWAVES * 64) ((LAS unsigned*)(F.lds + LDSCTL_OFF))[u] = 0u;
    __syncthreads();
    const int lo = args.ph_lo, hi = args.ph_hi;
    const bool single = (hi - lo) > 1;
    XcdBarrier bar; bar.bar = F.ctl + CW_BAR; bar.x = 0; bar.st = nullptr;
    if (single) bar = xcd_barrier_post(F.ctl + CW_BAR, F.MISC + 8);
#ifndef PH_MASK
#define PH_MASK 0x1FFF
#endif
#define IN(k) (((PH_MASK >> (k)) & 1) && lo <= (k) && (k) < hi)
#define SEAM(k) do { if (IN(k) && IN((k) + 1)) xcd_barrier(bar); } while (0)
    unsigned char* ws = args.ws;
    const int bx = (int)blockIdx.x;

    if (IN(0)) {
        p0a_prologue(F);
        if (single) xcd_barrier(bar);
    }
    if (IN(12)) {
        const bool low = bx < 64;
        if (low) {
            pg8::OrderKV S; S.init(ws + WS_MEMN, ws + WS_WKV_T, bx);
            pg8::EpiP1 E{(bf16_t*)(ws + WS_PROJ), (bf16_t*)(ws + WS_KMEM), (bf16_t*)(ws + WS_VT)};
            pg8::gemm_phase<pg8::EpiP1, pg8::OrderKV, false, false, true>(F.lds + RING_OFF, 2 * D, 2 * D, 2 * D, S, E);
        }
        const int nlow = 64 * NWAVES, nhigh = (F.G - 64) * NWAVES;
        if (low) p0b_prologue(F, bx * NWAVES + F.wave, nlow, 4 * nlow, 4 * nlow + 5 * nhigh, true);
        else p0b_prologue(F, (bx - 64) * NWAVES + F.wave, nhigh, 4 * nlow, 4 * nlow + 5 * nhigh, false);
    }
    if (IN(12) && IN(1)) xcd_barrier(bar);
    if (IN(1)) {
        pg8::OrderIn S; S.init(ws + WS_XN, ws + WS_WIN_T, F.G, bx);
        pg8::EpiP1 E{(bf16_t*)(ws + WS_PROJ), (bf16_t*)(ws + WS_KMEM), (bf16_t*)(ws + WS_VT)};
        pg8::gemm_phase<pg8::EpiP1, pg8::OrderIn, false, true, true>(F.lds + RING_OFF, 2 * D, 2 * D, 2 * D, S, E);
    }
    SEAM(1);
    if (IN(2)) { p2_mix(F); }
    SEAM(2);
    if (IN(3)) {
        pg8::OrderPlain S; S.init(ws + WS_YMIX, ws + WS_WOUT_T, D, D, M / 256, D / 256, F.G, bx);
        pg8::EpiRes<false> E{F.in[0], (float*)(ws + WS_X1), (bf16_t*)(ws + WS_X1B), (float*)(ws + WS_SS1)};
        pg8::gemm_phase<pg8::EpiRes<false>, pg8::OrderPlain, false, false, true>(F.lds + RING_OFF, 2 * D, 2 * D, 2 * D, S, E);
    }
    SEAM(3);
    if (IN(4)) {
        pg8::OrderQ S; S.init(ws + WS_X1B, ws + WS_WQ_T, F.G, bx);
        pg8::EpiQm E{(bf16_t*)(ws + WS_QM), (const float*)(ws + WS_SS1)};
        pg8::gemm_phase<pg8::EpiQm, pg8::OrderQ, false, false, true>(F.lds + RING_OFF, 2 * D, 2 * D, 2 * D, S, E);
    }
    if (single && IN(4) && IN(5)) local_seam();
    if (IN(5)) {
        if (F.G == 256) {
            pg8::OrderX<0> S; S.init(ws + WS_QM, ws + WS_KMEM, F.G, bx);
            pg8::EpiSoftmax E{(bf16_t*)(ws + WS_PB)};
            pg8::gemm_phase<pg8::EpiSoftmax, pg8::OrderX<0>, false, false, true>(F.lds + RING_OFF, 2 * D, 2 * D, 2 * XHD, S, E);
        }
    }
    if (single && IN(5) && IN(6)) local_seam();
    if (IN(6)) {
        pg8::OrderX<1> S; S.init(ws + WS_PB, ws + WS_VT, F.G, bx);
        pg8::EpiO E{(bf16_t*)(ws + WS_OB)};
        pg8::gemm_phase<pg8::EpiO, pg8::OrderX<1>, false, true, true>(F.lds + RING_OFF, 2 * D, 2 * MROWS, 2 * MEMLEN, S, E);
    }
    SEAM(6);
    if (IN(7)) {
        pg8::OrderPlain S; S.init(ws + WS_OB, ws + WS_WO_T, D, D, M / 256, D / 256, F.G, bx);
        pg8::EpiRes<true> E{(const float*)(ws + WS_X1), (float*)(ws + WS_X2), (bf16_t*)(ws + WS_X2B), (float*)(ws + WS_SS2)};
        pg8::gemm_phase<pg8::EpiRes<true>, pg8::OrderPlain, false, false, true>(F.lds + RING_OFF, 2 * D, 2 * D, 2 * D, S, E);
    }
    SEAM(7);
    if (IN(8)) { p8_router(F); }
    SEAM(8);
    if (IN(9)) {
        pg8::OrderMoe<8, true> S; S.init(F.ctl + CW_CNT, (const int*)(ws + WS_LTOK), ws + WS_X2B, ws + WS_W1_T, F.G, bx);
        pg8::EpiAct E{(bf16_t*)(ws + WS_ACT), (const float*)(ws + WS_LRSTD), F.in[17]};
        pg8::gemm_phase<pg8::EpiAct, pg8::OrderMoe<8, true>, true, true, true, true>(F.lds + RING_OFF, D, D, D, S, E);
    }
    SEAM(9);
    if (IN(10)) {
        pg8::OrderMoe<4, false> S; S.init(F.ctl + CW_CNT, (const int*)(ws + WS_LTOK), ws + WS_ACT, ws + WS_W2_T, F.G, bx);
        pg8::EpiY E{(bf16_t*)(ws + WS_Y), (const float*)(ws + WS_LGATE), (const int*)(ws + WS_LTOK), F.in[19]};
        pg8::gemm_phase<pg8::EpiY, pg8::OrderMoe<4, false>, false, true, true, true>(F.lds + RING_OFF, DEXP, DEXP, DEXP, S, E);
    }
    SEAM(10);
    if (IN(11)) { p11_final(F); }
#undef IN
#undef SEAM
}

extern "C" void kernel_launch(void* const* d_in, const int* in_sizes, int n_in, void* d_out, int out_size, void* d_ws, size_t ws_size, hipStream_t stream) {
    static int grid = 0;
    if (grid == 0) {
        if (n_in != 21 || in_sizes[0] != M * D || out_size != M * D || ws_size < WS_END) { fprintf(stderr, "kernel_launch: unexpected shapes (n_in %d, in0 %d, out %d, ws %zu)\n", n_in, n_in > 0 ? in_sizes[0] : -1, out_size, ws_size); grid = -1; return; }
        int dev = 0, cus = 0, per_cu = 0;
        if (hipGetDevice(&dev) != hipSuccess || hipDeviceGetAttribute(&cus, hipDeviceAttributeMultiprocessorCount, dev) != hipSuccess) { grid = -1; return; }
        if (hipFuncSetAttribute((const void*)fwd, hipFuncAttributeMaxDynamicSharedMemorySize, LDS_BYTES) != hipSuccess) { fprintf(stderr, "kernel_launch: hipFuncSetAttribute failed\n"); grid = -1; return; }
        if (hipOccupancyMaxActiveBlocksPerMultiprocessor(&per_cu, (const void*)fwd, NWAVES * 64, LDS_BYTES) != hipSuccess || per_cu < 1) { fprintf(stderr, "kernel_launch: occupancy query says %d\n", per_cu); per_cu = 1; }
        (void)hipGetLastError();
        grid = cus;
    }
    if (grid < 0) return;
    (void)hipMemsetAsync((char*)d_ws + WS_CTL, 0, CTL_ZERO_BYTES, stream);
    Args a{};
    for (int i = 0; i < 21; ++i) a.in[i] = (const float*)d_in[i];
    a.out = (float*)d_out; a.ws = (unsigned char*)d_ws;
    if (MK_N_LAUNCHES == 1) {
        a.ph_lo = 0; a.ph_hi = NPHASE;
        void* kargs[] = {&a};
        hipError_t e = hipLaunchCooperativeKernel((const void*)fwd, dim3(grid), dim3(NWAVES * 64), kargs, LDS_BYTES, stream);
        if (e != hipSuccess) fprintf(stderr, "kernel_launch: cooperative launch failed: %s\n", hipGetErrorString(e));
    } else {
        for (int pi = 0; pi < NPHASE; ++pi) { const int p = pi == 0 ? 0 : pi == 1 ? 12 : pi - 1; a.ph_lo = p; a.ph_hi = p + 1; for (int rep = 0; rep < NREP(p); ++rep) hipLaunchKernelGGL(fwd, dim3(grid), dim3(NWAVES * 64), LDS_BYTES, stream, a); }
    }
}
```

```cpp
#include <hip/hip_runtime.h>
#include <hip/hip_cooperative_groups.h>
#include <cstdio>
#include <cstdint>
namespace cg = cooperative_groups;

#ifndef MK_N_LAUNCHES
#define MK_N_LAUNCHES 1
#endif
#ifndef DUP_MASK
#define DUP_MASK 0
#endif
#define NREP(k) (((DUP_MASK >> (k)) & 1) ? 2 : 1)

constexpr int D = 1024, BATCH = 8, SEQ = 2048, M = BATCH * SEQ, MEMLEN = 256, MROWS = BATCH * MEMLEN;
constexpr int NPROJ = 3072, NE = 32, TOPK = 4, DEXP = 1024;
constexpr int XH = 4, XHD = 256;
constexpr float EPS = 1e-5f;
constexpr float LOG2E = 1.4426950408889634f;
constexpr float C2Q = 0.125f * LOG2E;
constexpr float C2X = 0.0625f * LOG2E;
#ifndef P1_CONV_PCT
#define P1_CONV_PCT 60
#endif
constexpr int N_XITEMS = NE * 8 * 64 + NE * 8 * 32;
constexpr int XITEMS_P1 = (int)((long)N_XITEMS * P1_CONV_PCT / 100);
constexpr int LISTCAP = M;
constexpr int ACT_ROWS = M * TOPK + NE * 256;

#define GAS __attribute__((address_space(1)))
#define LAS __attribute__((address_space(3)))
typedef unsigned short bf16_t;
typedef short bf16x8 __attribute__((ext_vector_type(8)));
typedef short s16x4 __attribute__((ext_vector_type(4)));
typedef float f32x4 __attribute__((ext_vector_type(4)));
typedef float f32x2 __attribute__((ext_vector_type(2)));
typedef float f32x16 __attribute__((ext_vector_type(16)));
typedef unsigned u32x4 __attribute__((ext_vector_type(4)));
typedef unsigned u32x2 __attribute__((ext_vector_type(2)));
typedef GAS unsigned gu32;

constexpr size_t MiB = 1u << 20;
constexpr size_t WS_CTL = 0, CTL_ZERO_BYTES = 1 * MiB;
constexpr size_t WS_WIN_T = 2 * MiB, WS_WOUT_T = 8 * MiB, WS_WQ_T = 10 * MiB, WS_WKV_T = 12 * MiB, WS_WO_T = 16 * MiB, WS_WR = 18 * MiB;
constexpr size_t WS_MEMN = 19 * MiB, WS_KMEM = 23 * MiB, WS_VT = 27 * MiB, WS_SS1 = 31 * MiB, WS_SS2 = 32 * MiB, WS_RSTD3 = 33 * MiB, WS_LTOK = 34 * MiB, WS_LGATE = 36 * MiB, WS_LRSTD = 38 * MiB;
constexpr size_t WS_W1_T = 40 * MiB, WS_W2_T = 168 * MiB;
constexpr size_t WS_XN = 232 * MiB, WS_PROJ = 264 * MiB, WS_YMIX = 360 * MiB;
constexpr size_t WS_X1 = 392 * MiB, WS_X1B = 456 * MiB, WS_QM = 488 * MiB, WS_PB = 520 * MiB, WS_OB = 552 * MiB, WS_X2 = 584 * MiB, WS_X2B = 648 * MiB;
constexpr size_t WS_ACT = 232 * MiB;
constexpr size_t WS_Y = 392 * MiB;
constexpr size_t WS_END = 680 * MiB;
static_assert(WS_ACT + (size_t)ACT_ROWS * DEXP <= WS_X1 && WS_Y + (size_t)M * TOPK * D * 2 <= WS_PB, "overlays");
constexpr int CW_TMO = 0, CW_CODE = 1, CW_BAR = 4096, CW_CNT = 8192;

__device__ __forceinline__ unsigned cvt_pk_bf16(float lo, float hi) { unsigned r; asm volatile("v_cvt_pk_bf16_f32 %0, %1, %2" : "=v"(r) : "v"(lo), "v"(hi)); return r; }
__device__ __forceinline__ unsigned cvtpk_s(float lo, float hi) { typedef __bf16 bf16x2_t __attribute__((ext_vector_type(2))); f32x2 v = {lo, hi}; bf16x2_t b = __builtin_convertvector(v, bf16x2_t); return __builtin_bit_cast(unsigned, b); }
__device__ __forceinline__ float clamp448(float v) { return fminf(fmaxf(v, -448.0f), 448.0f); }
__device__ __forceinline__ unsigned pk_fp8x4(float a, float b, float c, float d) { int w = 0; w = __builtin_amdgcn_cvt_pk_fp8_f32(clamp448(a), clamp448(b), w, false); w = __builtin_amdgcn_cvt_pk_fp8_f32(clamp448(c), clamp448(d), w, true); return (unsigned)w; }
constexpr float W8_SCALE = 64.0f, ACT8_SCALE = 4.0f, Y8_SCALE = 16.0f;
constexpr int E8_ONE = 0x7F7F7F7F, E8_W = 0x79797979, E8_ACT = 0x7D7D7D7D;
__device__ __forceinline__ float bf_lo(unsigned w) { return __uint_as_float(w << 16); }
__device__ __forceinline__ float bf_hi(unsigned w) { return __uint_as_float(w & 0xffff0000u); }
__device__ __forceinline__ float wave_sum(float v) {
#pragma unroll
    for (int o = 1; o < 64; o <<= 1) v += __shfl_xor(v, o);
    return v;
}
#define LDS_WAIT() asm volatile("s_waitcnt lgkmcnt(0)" ::: "memory")
#define VM_WAIT() asm volatile("s_waitcnt vmcnt(0)" ::: "memory")

namespace pg8 {
constexpr int BM = 256, BK = 64, HALF = 128, HTB = HALF * BK * 2, STAGE_BYTES = 8 * HTB, NXCD = 8, WGM = 8;
__host__ __device__ __forceinline__ int lds_byte(int r, int c) { const int st = (r >> 4) * 2 + (c >> 5), rr = r & 15, cc = c & 31, ob = rr * 64 + cc * 2; return st * 1024 + (ob ^ (((ob >> 9) & 1) << 5)); }
__host__ __device__ __forceinline__ void stage_rc(int b, int& R, int& C) { const int st = b / 1024, sb = b % 1024, swz = sb ^ (((sb >> 9) & 1) << 5); R = (st >> 1) * 16 + swz / 64; C = (st & 1) * 32 + (swz % 64) / 2; }
__host__ __device__ __forceinline__ int perm32(int rho) { const int n = rho >> 4, i = rho & 15; return 8 * (i >> 2) + 4 * n + (i & 3); }

struct Unit { const char* a; const char* b; int pm, pn; };
struct UnitK { const char* a; const char* b; int pm, pn, kind; };
struct UnitM { const char* a; const char* b; const int* tok; int pm, pn, nvalid, e, rowoff; };

struct GridOrder {
    int nM, nN, nwg;
    __device__ __forceinline__ void init(int nM_, int nN_) { nM = nM_; nN = nN_; nwg = nM * nN; }
    __device__ __forceinline__ void map(int L, int& pm, int& pn) const {
        int wgid = L; { const int q = nwg / NXCD, r = nwg % NXCD, xcd = wgid % NXCD, off = wgid / NXCD; wgid = (xcd < r ? xcd * (q + 1) : r * (q + 1) + (xcd - r) * q) + off; }
        const int nig = WGM * nN, gid = wgid / nig, fm = gid * WGM, gsz = (nM - fm) < WGM ? (nM - fm) : WGM;
        pm = fm + ((wgid % nig) % gsz); pn = (wgid % nig) / gsz;
    }
};

typedef f32x4 Acc[2][2][4][2];

template <class Epi, class Sched, bool GATHER, bool ALIGN_EPI, bool SP2, bool F8 = false, int SCA = 0x7F7F7F7F, int SCB = 0x7F7F7F7F>
__device__ __forceinline__ void gemm_phase(LAS unsigned char* lds, const int lda, const int ldb, const int K, const Sched& S, const Epi& E) {
    const int tid = threadIdx.x, wid = __builtin_amdgcn_readfirstlane(tid >> 6), lane = tid & 63, wr = wid >> 2, wc = wid & 3, fr = lane & 15, fq = lane >> 4;
    int nt = K / 128; asm volatile("" : "+s"(nt));
    int RA[2], CA[2]; unsigned voffB[2];
#pragma unroll
    for (int i = 0; i < 2; ++i) { int R, C; stage_rc(tid * 16 + i * 8192, R, C); const int Rb = Epi::PERM ? ((R & ~31) + perm32(R & 31)) : R;
        RA[i] = R; CA[i] = C; voffB[i] = (unsigned)(Rb * ldb + C * 2); }
    const size_t kstep = (size_t)(BK * 2);
    const size_t hstepB = (size_t)HALF * ldb;
    const unsigned ldsw = (unsigned)wid * 1024u;
    const int aoff = lds_byte(wr * 64 + fr, fq * 8), boff = lds_byte(wc * 32 + fr, fq * 8);
#define PG8_SA(b, h) (((b) * 2 + (h)) * HTB)
#define PG8_SB(b, h) ((4 + (b) * 2 + (h)) * HTB)
#define PG8_STAGE(bufoff, gbase, voff) do { _Pragma("unroll") for (int _i = 0; _i < 2; ++_i) \
        __builtin_amdgcn_global_load_lds((const unsigned*)((const char*)(gbase) + (voff)[_i]), (LAS unsigned*)(lds + (bufoff) + ldsw + _i * 8192), 16, 0, 0); } while (0)
#define PG8_LDA(dst, b, h) do { _Pragma("unroll") for (int m = 0; m < 4; ++m) { if constexpr (F8) { \
            dst##8[m] = __builtin_shufflevector(*(const LAS i32x4_*)(lds + PG8_SA(b, h) + aoff + m * 2048), *(const LAS i32x4_*)(lds + PG8_SA(b, h) + aoff + m * 2048 + 1024), 0, 1, 2, 3, 4, 5, 6, 7); } \
        else { _Pragma("unroll") for (int k = 0; k < 2; ++k) dst[m][k] = *(const LAS bf16x8*)(lds + PG8_SA(b, h) + aoff + m * 2048 + k * 1024); } } } while (0)
#define PG8_LDB(dst, b, h) do { _Pragma("unroll") for (int n = 0; n < 2; ++n) { if constexpr (F8) { \
            dst##8[n] = __builtin_shufflevector(*(const LAS i32x4_*)(lds + PG8_SB(b, h) + boff + n * 2048), *(const LAS i32x4_*)(lds + PG8_SB(b, h) + boff + n * 2048 + 1024), 0, 1, 2, 3, 4, 5, 6, 7); } \
        else { _Pragma("unroll") for (int k = 0; k < 2; ++k) dst[n][k] = *(const LAS bf16x8*)(lds + PG8_SB(b, h) + boff + n * 2048 + k * 1024); } } } while (0)
#define PG8_MMA(ai, bj, At, Bt) do { __builtin_amdgcn_s_setprio(1); _Pragma("unroll") for (int m = 0; m < 4; ++m) _Pragma("unroll") for (int n = 0; n < 2; ++n) { \
        if constexpr (F8) { acc[ai][bj][m][n] = __builtin_amdgcn_mfma_scale_f32_16x16x128_f8f6f4(Bt##8[n], At##8[m], acc[ai][bj][m][n], 0, 0, 0, SCA, 0, SCB); } \
        else { _Pragma("unroll") for (int k = 0; k < 2; ++k) acc[ai][bj][m][n] = __builtin_amdgcn_mfma_f32_16x16x32_bf16(Bt[n][k], At[m][k], acc[ai][bj][m][n], 0, 0, 0); } } \
        __builtin_amdgcn_s_setprio(0); } while (0)
#define PG8_WAIT_V(n) asm volatile("s_waitcnt vmcnt(" #n ")" ::: "memory")
#define PG8_WAIT_L(n) asm volatile("s_waitcnt lgkmcnt(" #n ")" ::: "memory")
#define PG8_BAR __builtin_amdgcn_s_barrier()
#define PG8_SCHED __builtin_amdgcn_sched_barrier(0)
#define PG8_VOFFA(dst, u) do { if constexpr (GATHER) { int _t[2][2]; _Pragma("unroll") for (int _h = 0; _h < 2; ++_h) _Pragma("unroll") for (int _i = 0; _i < 2; ++_i) _t[_h][_i] = (u).tok[_h * HALF + RA[_i]]; \
        _Pragma("unroll") for (int _h = 0; _h < 2; ++_h) _Pragma("unroll") for (int _i = 0; _i < 2; ++_i) { const int _row = _h * HALF + RA[_i]; const int _tt = (_row < (u).nvalid) ? (_t[_h][_i] >> 2) : 0; dst[_h][_i] = (unsigned)(_tt * lda + CA[_i] * 2); } } \
        else { _Pragma("unroll") for (int _h = 0; _h < 2; ++_h) _Pragma("unroll") for (int _i = 0; _i < 2; ++_i) dst[_h][_i] = (unsigned)((_h * HALF + RA[_i]) * lda + CA[_i] * 2); } } while (0)
#define PG8_VOFFA_LDS(dst, u, slot) do { const LAS int* _mt = (const LAS int*)(lds + 131072 + (slot) * 3072 + 1024); _Pragma("unroll") for (int _h = 0; _h < 2; ++_h) _Pragma("unroll") for (int _i = 0; _i < 2; ++_i) { \
        const int _row = _h * HALF + RA[_i]; const int _tt = (_row < (u).nvalid) ? (_mt[_row] >> 2) : 0; dst[_h][_i] = (unsigned)(_tt * lda + CA[_i] * 2); } } while (0)
    typename Sched::U cur, nxt; int ui = 0;
    if (!S.next(0, cur)) return;
    Acc acc;
#pragma unroll
    for (int a = 0; a < 2; ++a)
#pragma unroll
        for (int b = 0; b < 2; ++b)
#pragma unroll
            for (int m = 0; m < 4; ++m)
#pragma unroll
                for (int n = 0; n < 2; ++n) acc[a][b][m][n] = (f32x4){0.f, 0.f, 0.f, 0.f};
    typedef int i32x4_ __attribute__((ext_vector_type(4))); typedef int i32x8_ __attribute__((ext_vector_type(8)));
    bf16x8 At[4][2], B0[2][2], B1[2][2]; i32x8_ At8[4], B08[2], B18[2];
    unsigned vA[2][2];
    PG8_VOFFA(vA, cur);
    const char* cA = cur.a; const char* cB = cur.b;
    E.prefetch(cur, 0, lds, wid, lane);
    if constexpr (SP2) {
        PG8_STAGE(PG8_SB(0, 0), cB, voffB); PG8_STAGE(PG8_SB(0, 1), cB + hstepB, voffB); PG8_STAGE(PG8_SA(0, 0), cA, vA[0]); PG8_STAGE(PG8_SA(0, 1), cA, vA[1]);
        if (wr == 1) PG8_BAR;
        PG8_WAIT_V(2); PG8_BAR;
        PG8_STAGE(PG8_SB(1, 0), cB + kstep, voffB); PG8_STAGE(PG8_SA(1, 0), cA + kstep, vA[0]); PG8_STAGE(PG8_SB(1, 1), cB + hstepB + kstep, voffB);
        PG8_WAIT_V(6); PG8_BAR;
    } else {
        PG8_STAGE(PG8_SB(0, 0), cB, voffB); PG8_STAGE(PG8_SA(0, 0), cA, vA[0]); PG8_STAGE(PG8_SB(0, 1), cB + hstepB, voffB); PG8_STAGE(PG8_SA(0, 1), cA, vA[1]);
        if (wr == 1) PG8_BAR;
        PG8_WAIT_V(4); PG8_BAR;
        PG8_STAGE(PG8_SB(1, 0), cB + kstep, voffB); PG8_STAGE(PG8_SA(1, 0), cA + kstep, vA[0]); PG8_STAGE(PG8_SB(1, 1), cB + hstepB + kstep, voffB);
        PG8_WAIT_V(6); PG8_BAR;
    }
    for (;;) {
        const bool has_next = S.next(ui + 1, nxt);
        const char* nA = has_next ? nxt.a : cA; const char* nB = has_next ? nxt.b : cB;
        if (has_next) E.prefetch(nxt, ui + 1, lds, wid, lane);
        for (int t = 0; t < nt; t += 2) {
            const bool last = (t == nt - 2);
            asm volatile("" : "+v"(vA[0][0]), "+v"(vA[0][1]), "+v"(vA[1][0]), "+v"(vA[1][1]), "+v"(voffB[0]), "+v"(voffB[1]));
            const char* a1 = cA + (size_t)(t + 1) * kstep;
            const char* a2 = last ? nA : cA + (size_t)(t + 2) * kstep; const char* b2 = last ? nB : cB + (size_t)(t + 2) * kstep;
            const char* a3 = a2 + kstep; const char* b3 = b2 + kstep;
            if constexpr (SP2) {
            PG8_LDB(B0, 0, 0); PG8_LDB(B1, 0, 1); PG8_SCHED; PG8_LDA(At, 0, 0); PG8_STAGE(PG8_SA(1, 1), a1, vA[1]); if (last && has_next) { if constexpr (GATHER) { PG8_VOFFA_LDS(vA, nxt, (ui + 1) % 3); } else { PG8_VOFFA(vA, nxt); } }
            PG8_WAIT_V(8); PG8_WAIT_L(0); PG8_BAR; PG8_MMA(0, 0, At, B0); PG8_MMA(0, 1, At, B1); PG8_BAR; PG8_SCHED;
            PG8_LDA(At, 0, 1); PG8_STAGE(PG8_SB(0, 0), b2, voffB); PG8_STAGE(PG8_SB(0, 1), b2 + hstepB, voffB); PG8_STAGE(PG8_SA(0, 0), a2, vA[0]);
            PG8_WAIT_V(8); PG8_WAIT_L(0); PG8_BAR; PG8_MMA(1, 0, At, B0); PG8_MMA(1, 1, At, B1); PG8_BAR; PG8_SCHED;
            PG8_LDB(B0, 1, 0); PG8_LDB(B1, 1, 1); PG8_SCHED; PG8_LDA(At, 1, 0); PG8_STAGE(PG8_SA(0, 1), a2, vA[1]);
            PG8_WAIT_V(8); PG8_WAIT_L(0); PG8_BAR; PG8_MMA(0, 0, At, B0); PG8_MMA(0, 1, At, B1); PG8_BAR; PG8_SCHED;
            PG8_LDA(At, 1, 1); PG8_STAGE(PG8_SB(1, 0), b3, voffB); PG8_STAGE(PG8_SB(1, 1), b3 + hstepB, voffB); PG8_STAGE(PG8_SA(1, 0), a3, vA[0]);
            PG8_WAIT_V(8); PG8_WAIT_L(0); PG8_BAR; PG8_MMA(1, 0, At, B0); PG8_MMA(1, 1, At, B1); PG8_BAR; PG8_SCHED;
            } else {
            PG8_LDB(B0, 0, 0); PG8_SCHED; PG8_LDA(At, 0, 0); PG8_STAGE(PG8_SA(1, 1), a1, vA[1]); if (last && has_next) { if constexpr (GATHER) { PG8_VOFFA_LDS(vA, nxt, (ui + 1) % 3); } else { PG8_VOFFA(vA, nxt); } }
            PG8_WAIT_L(8); PG8_BAR; PG8_WAIT_L(0); PG8_MMA(0, 0, At, B0); PG8_BAR; PG8_SCHED;
            PG8_LDB(B1, 0, 1); PG8_STAGE(PG8_SB(0, 0), b2, voffB);
            PG8_BAR; PG8_WAIT_L(0); PG8_MMA(0, 1, At, B1); PG8_BAR;
            PG8_LDA(At, 0, 1); PG8_STAGE(PG8_SA(0, 0), a2, vA[0]);
            PG8_BAR; PG8_WAIT_L(0); PG8_MMA(1, 0, At, B0); PG8_BAR; PG8_SCHED;
            PG8_STAGE(PG8_SB(0, 1), b2 + hstepB, voffB);
            PG8_WAIT_V(6); PG8_BAR; PG8_MMA(1, 1, At, B1); PG8_BAR;
            PG8_LDB(B0, 1, 0); PG8_SCHED; PG8_LDA(At, 1, 0); PG8_STAGE(PG8_SA(0, 1), a2, vA[1]);
            PG8_WAIT_L(8); PG8_BAR; PG8_WAIT_L(0); PG8_MMA(0, 0, At, B0); PG8_BAR; PG8_SCHED;
            PG8_LDB(B1, 1, 1); PG8_STAGE(PG8_SB(1, 0), b3, voffB);
            PG8_BAR; PG8_WAIT_L(0); PG8_MMA(0, 1, At, B1); PG8_BAR;
            PG8_LDA(At, 1, 1); PG8_STAGE(PG8_SA(1, 0), a3, vA[0]);
            PG8_BAR; PG8_WAIT_L(0); PG8_MMA(1, 0, At, B0); PG8_BAR; PG8_SCHED;
            PG8_STAGE(PG8_SB(1, 1), b3 + hstepB, voffB);
            PG8_WAIT_V(6); PG8_BAR; PG8_MMA(1, 1, At, B1); PG8_BAR;
            }
        }
        if constexpr (ALIGN_EPI) { if (wr == 0) PG8_BAR; }
        if constexpr (!Epi::AFTER_DRAIN) { E(acc, cur, ui, lds, wr, wc, fr, fq); }
        if (!has_next) break;
#pragma unroll
        for (int a = 0; a < 2; ++a)
#pragma unroll
            for (int b = 0; b < 2; ++b)
#pragma unroll
                for (int m = 0; m < 4; ++m)
#pragma unroll
                    for (int n = 0; n < 2; ++n) acc[a][b][m][n] = (f32x4){0.f, 0.f, 0.f, 0.f};
        cur = nxt; cA = nA; cB = nB; ++ui;
        if constexpr (ALIGN_EPI) { if (wr == 1) PG8_BAR; }
    }
    PG8_WAIT_V(0);
    if constexpr (!ALIGN_EPI) { if (wr == 0) PG8_BAR; }
    PG8_BAR;
    if constexpr (Epi::AFTER_DRAIN) { E.fused(acc, cur, wr, wc, fr, fq, lds, wid, lane); }
#undef PG8_SA
#undef PG8_SB
#undef PG8_STAGE
#undef PG8_LDA
#undef PG8_LDB
#undef PG8_MMA
#undef PG8_WAIT_V
#undef PG8_WAIT_L
#undef PG8_BAR
#undef PG8_SCHED
#undef PG8_VOFFA
#undef PG8_VOFFA_LDS
}

struct OrderKV {
    typedef UnitK U;
    const char *memn, *wkv_t; int c;
    __device__ __forceinline__ void init(const void* memn_, const void* wkv_t_, int c_) { memn = (const char*)memn_; wkv_t = (const char*)wkv_t_; c = c_; }
    __device__ __forceinline__ bool next(int i, UnitK& u) const {
        if (i > 0 || c >= 64) return false;
        int r = c;
        if (r < 32) { u.kind = 1; u.pm = r >> 2; u.pn = r & 3; u.a = memn + (size_t)u.pm * 256 * D * 2; u.b = wkv_t + (size_t)u.pn * 256 * D * 2; return true; }
        r -= 32;
        u.kind = 2; u.pm = r >> 3; u.pn = r & 7; u.a = wkv_t + (size_t)(D + u.pm * 256) * D * 2; u.b = memn + (size_t)u.pn * 256 * D * 2; return true;
    }
};
struct OrderIn {
    typedef UnitK U;
    const char *A, *Bt; int G, c; GridOrder g0;
    __device__ __forceinline__ void init(const void* A_, const void* Bt_, int G_, int c_) { A = (const char*)A_; Bt = (const char*)Bt_; G = G_; c = c_; g0.init(M / 256, NPROJ / 256); }
    __device__ __forceinline__ bool next(int i, UnitK& u) const {
        const int L = i * G + c; if (L >= g0.nwg) return false;
        g0.map(L, u.pm, u.pn); u.kind = 0; u.a = A + (size_t)u.pm * 256 * D * 2; u.b = Bt + (size_t)u.pn * 256 * D * 2; return true;
    }
};
struct OrderPlain {
    typedef Unit U;
    const char *A, *Bt; int lda, ldb, G, c; GridOrder g0;
    __device__ __forceinline__ void init(const void* A_, const void* Bt_, int lda_, int ldb_, int nM, int nN, int G_, int c_) { A = (const char*)A_; Bt = (const char*)Bt_; lda = lda_; ldb = ldb_; G = G_; c = c_; g0.init(nM, nN); }
    __device__ __forceinline__ bool next(int i, Unit& u) const {
        const int L = i * G + c; if (L >= g0.nwg) return false;
        g0.map(L, u.pm, u.pn);
        u.a = A + (size_t)u.pm * 256 * lda * 2; u.b = Bt + (size_t)u.pn * 256 * ldb * 2; return true;
    }
};
struct OrderQ {
    typedef Unit U;
    const char *A, *Bt; int G, c;
    __device__ __forceinline__ void init(const void* A_, const void* Bt_, int G_, int c_) { A = (const char*)A_; Bt = (const char*)Bt_; G = G_; c = c_; }
    __device__ __forceinline__ bool next(int i, Unit& u) const {
        const int L = i * G + c; if (L >= (M / 256) * XH) return false;
        const int xcd = L & 7, j = L >> 3; u.pm = xcd * 8 + (j >> 2); u.pn = j & 3;
        u.a = A + (size_t)u.pm * 256 * D * 2; u.b = Bt + (size_t)u.pn * 256 * D * 2; return true;
    }
};
template <int MODE> struct OrderX {
    typedef Unit U;
    const char *A, *Bt; int G, c;
    __device__ __forceinline__ void init(const void* A_, const void* Bt_, int G_, int c_) { A = (const char*)A_; Bt = (const char*)Bt_; G = G_; c = c_; }
    __device__ __forceinline__ bool next(int i, Unit& u) const {
        const int L = i * G + c; if (L >= (M / 256) * XH) return false;
        const int xcd = L & 7, j = L >> 3; u.pm = xcd * 8 + (j >> 2); u.pn = j & 3;
        const int b = u.pm >> 3;
        u.a = A + ((size_t)u.pm * 256 * D + (size_t)u.pn * XHD) * 2;
        if (MODE == 0) u.b = Bt + ((size_t)b * MEMLEN * D + (size_t)u.pn * XHD) * 2;
        else u.b = Bt + ((size_t)u.pn * XHD * MROWS + (size_t)b * MEMLEN) * 2;
        return true;
    }
};
template <int NTN, bool G1> struct OrderMoe {
    typedef UnitM U;
    const int* ltok; const char* A; const char* Bt; int G, c; int seg[4], til[4], cn[4];
    __device__ __forceinline__ void init(const unsigned* cnt, const int* ltok_, const void* A_, const void* Bt_, int G_, int c_) {
        ltok = ltok_; A = (const char*)A_; Bt = (const char*)Bt_; G = G_; c = c_;
        const int lane = threadIdx.x & 63; const int cv = (lane < NE) ? (int)__hip_atomic_load(cnt + 64 * lane, __ATOMIC_RELAXED, __HIP_MEMORY_SCOPE_AGENT) : 0;
        const int t = (cv + 255) >> 8; int incl = t;
#pragma unroll
        for (int o = 1; o < 32; o <<= 1) { const int v = __shfl_up(incl, o); if (lane >= o) incl += v; }
        const int excl = incl - t, xcd = c & 7;
#pragma unroll
        for (int q = 0; q < 4; ++q) { seg[q] = __builtin_amdgcn_readlane(excl, xcd + 8 * q); til[q] = __builtin_amdgcn_readlane(t, xcd + 8 * q); cn[q] = __builtin_amdgcn_readlane(cv, xcd + 8 * q); }
    }
    __device__ __forceinline__ bool next(int i, UnitM& u) const {
        const int xcd = c & 7, slot = c >> 3, nslot = G >> 3; int j = i * nslot + slot;
#pragma unroll
        for (int q = 0; q < 4; ++q) {
            const int nu = til[q] * NTN;
            if (j < nu) { const int e = xcd + 8 * q, mt = j / NTN, nt = j % NTN;
                u.e = e; u.pm = mt; u.pn = nt; u.rowoff = (seg[q] + mt) * 256; u.nvalid = cn[q] - mt * 256 < 256 ? cn[q] - mt * 256 : 256; u.tok = ltok + (size_t)e * LISTCAP + mt * 256;
                if (G1) { u.a = A; u.b = Bt + ((size_t)e * 2048 + (size_t)nt * 256) * D; }
                else { u.a = A + (size_t)u.rowoff * DEXP; u.b = Bt + ((size_t)e * 1024 + (size_t)nt * 256) * DEXP; }
                return true; }
            j -= nu;
        }
        return false;
    }
};

struct EpiP1 {
    static constexpr bool PERM = true, AFTER_DRAIN = false;
    bf16_t *proj, *kmem, *vt;
    __device__ __forceinline__ void prefetch(const UnitK&, int, LAS unsigned char*, int, int) const {}
    __device__ __forceinline__ void operator()(const Acc& acc, const UnitK& u, int, LAS unsigned char*, int wr, int wc, int fr, int fq) const {
        bf16_t* base; int ldc; float sc = 1.f;
        if (u.kind == 0) { base = proj; ldc = NPROJ; if (u.pn >= 6 && u.pn < 8) sc = C2Q; } else if (u.kind == 1) { base = kmem; ldc = D; } else { base = vt; ldc = MROWS; }
        const int row0 = u.pm * BM + wr * 64 + fr, col0 = u.pn * BM + wc * 32 + 8 * fq;
#pragma unroll
        for (int ai = 0; ai < 2; ++ai)
#pragma unroll
            for (int m = 0; m < 4; ++m) { bf16_t* rowp = base + (size_t)(row0 + ai * HALF + m * 16) * ldc + col0;
#pragma unroll
                for (int bj = 0; bj < 2; ++bj) { const f32x4 v0 = acc[ai][bj][m][0] * sc, v1 = acc[ai][bj][m][1] * sc;
                    u32x4 w; w.x = cvt_pk_bf16(v0[0], v0[1]); w.y = cvt_pk_bf16(v0[2], v0[3]); w.z = cvt_pk_bf16(v1[0], v1[1]); w.w = cvt_pk_bf16(v1[2], v1[3]);
                    *(u32x4*)(rowp + bj * HALF) = w; } }
    }
};
template <bool BASE16, bool OUT8> struct EpiRes {
    static constexpr bool PERM = true, AFTER_DRAIN = true;
    const void* base; bf16_t* xb; unsigned char* x8; float* ss;
    __device__ __forceinline__ void prefetch(const Unit&, int, LAS unsigned char*, int, int) const {}
    __device__ __forceinline__ void fused(Acc& acc, const Unit& u, int wr, int wc, int fr, int fq, LAS unsigned char* lds, int wid, int lane) const {
        LAS float* PSS = (LAS float*)lds;
        const int col0 = u.pn * BM + wc * 32 + 8 * fq;
#pragma unroll
        for (int ai = 0; ai < 2; ++ai)
#pragma unroll
            for (int m = 0; m < 4; ++m) { const int r = ai * HALF + wr * 64 + m * 16 + fr; const size_t off = (size_t)(u.pm * BM + r) * D + col0; float sq = 0.f;
#pragma unroll
                for (int bj = 0; bj < 2; ++bj) { f32x4 b0, b1;
                    if constexpr (BASE16) { const u32x4 w = *(const u32x4*)((const bf16_t*)base + off + bj * HALF); b0 = (f32x4){bf_lo(w.x), bf_hi(w.x), bf_lo(w.y), bf_hi(w.y)}; b1 = (f32x4){bf_lo(w.z), bf_hi(w.z), bf_lo(w.w), bf_hi(w.w)}; }
                    else { b0 = *(const f32x4*)((const float*)base + off + bj * HALF); b1 = *(const f32x4*)((const float*)base + off + bj * HALF + 4); }
                    const f32x4 o0 = b0 + acc[ai][bj][m][0], o1 = b1 + acc[ai][bj][m][1];
                    { u32x4 w; w.x = cvt_pk_bf16(o0[0], o0[1]); w.y = cvt_pk_bf16(o0[2], o0[3]); w.z = cvt_pk_bf16(o1[0], o1[1]); w.w = cvt_pk_bf16(o1[2], o1[3]); *(u32x4*)(xb + off + bj * HALF) = w; }
                    if constexpr (OUT8) { u32x2 w; w.x = pk_fp8x4(o0[0], o0[1], o0[2], o0[3]); w.y = pk_fp8x4(o1[0], o1[1], o1[2], o1[3]); *(u32x2*)(x8 + off + bj * HALF) = w; }
                    sq += ((o0[0] * o0[0] + o0[1] * o0[1]) + (o0[2] * o0[2] + o0[3] * o0[3])) + ((o1[0] * o1[0] + o1[1] * o1[1]) + (o1[2] * o1[2] + o1[3] * o1[3])); }
                sq += __shfl_xor(sq, 16); sq += __shfl_xor(sq, 32);
                if (fq == 0) PSS[r * 4 + wc] = sq; }
        __syncthreads();
        if (threadIdx.x < 256) { const f32x4 p = *(const LAS f32x4*)(PSS + threadIdx.x * 4); ss[(size_t)(u.pm * BM + threadIdx.x) * 4 + u.pn] = (p[0] + p[1]) + (p[2] + p[3]); }
        __syncthreads();
    }
};
__device__ __forceinline__ float rstd_from_ss(const float* ss, int row) {
    const f32x4 a = *(const f32x4*)(ss + (size_t)row * 4);
    return __builtin_amdgcn_rsqf(((a[0] + a[1]) + (a[2] + a[3])) * (1.0f / D) + EPS);
}
struct EpiQm {
    static constexpr bool PERM = true, AFTER_DRAIN = true;
    bf16_t* qm; const float* ss;
    __device__ __forceinline__ void prefetch(const Unit&, int, LAS unsigned char*, int, int) const {}
    __device__ __forceinline__ void fused(Acc& acc, const Unit& u, int wr, int wc, int fr, int fq, LAS unsigned char* lds, int wid, int lane) const {
        const int row0 = u.pm * BM + wr * 64 + fr, col0 = u.pn * BM + wc * 32 + 8 * fq;
        float sc[2][4];
#pragma unroll
        for (int ai = 0; ai < 2; ++ai)
#pragma unroll
            for (int m = 0; m < 4; ++m) sc[ai][m] = rstd_from_ss(ss, row0 + ai * HALF + m * 16) * C2X;
#pragma unroll
        for (int ai = 0; ai < 2; ++ai)
#pragma unroll
            for (int m = 0; m < 4; ++m) { const int row = row0 + ai * HALF + m * 16; bf16_t* rowp = qm + (size_t)row * D + col0;
#pragma unroll
                for (int bj = 0; bj < 2; ++bj) { const f32x4 v0 = acc[ai][bj][m][0] * sc[ai][m], v1 = acc[ai][bj][m][1] * sc[ai][m];
                    u32x4 w; w.x = cvt_pk_bf16(v0[0], v0[1]); w.y = cvt_pk_bf16(v0[2], v0[3]); w.z = cvt_pk_bf16(v1[0], v1[1]); w.w = cvt_pk_bf16(v1[2], v1[3]);
                    *(u32x4*)(rowp + bj * HALF) = w; } }
    }
};
struct EpiSoftmax {
    static constexpr bool PERM = true, AFTER_DRAIN = true;
    bf16_t* pb;
    __device__ __forceinline__ void prefetch(const Unit&, int, LAS unsigned char*, int, int) const {}
    __device__ __forceinline__ void fused(Acc& acc, const Unit& u, int wr, int wc, int fr, int fq, LAS unsigned char* lds, int wid, int lane) const {
        LAS float* PM = (LAS float*)lds;
        LAS float* PS = (LAS float*)(lds + 4096);
#pragma unroll
        for (int ai = 0; ai < 2; ++ai)
#pragma unroll
            for (int m = 0; m < 4; ++m) { float mx = -INFINITY;
#pragma unroll
                for (int bj = 0; bj < 2; ++bj)
#pragma unroll
                    for (int n = 0; n < 2; ++n) { const f32x4 x = acc[ai][bj][m][n]; mx = fmaxf(mx, fmaxf(fmaxf(x[0], x[1]), fmaxf(x[2], x[3]))); }
                mx = fmaxf(mx, __shfl_xor(mx, 16)); mx = fmaxf(mx, __shfl_xor(mx, 32));
                if (fq == 0) PM[(ai * HALF + wr * 64 + m * 16 + fr) * 4 + wc] = mx; }
        __syncthreads();
#pragma unroll
        for (int ai = 0; ai < 2; ++ai)
#pragma unroll
            for (int m = 0; m < 4; ++m) { const int r = ai * HALF + wr * 64 + m * 16 + fr; const f32x4 pm4 = *(const LAS f32x4*)(PM + r * 4);
                const float mx = fmaxf(fmaxf(pm4[0], pm4[1]), fmaxf(pm4[2], pm4[3])); float s = 0.f;
#pragma unroll
                for (int bj = 0; bj < 2; ++bj)
#pragma unroll
                    for (int n = 0; n < 2; ++n) { f32x4 x = acc[ai][bj][m][n];
#pragma unroll
                        for (int j = 0; j < 4; ++j) { x[j] = __builtin_amdgcn_exp2f(x[j] - mx); s += x[j]; }
                        acc[ai][bj][m][n] = x; }
                s += __shfl_xor(s, 16); s += __shfl_xor(s, 32);
                if (fq == 0) PS[r * 4 + wc] = s; }
        __syncthreads();
        const int row0 = u.pm * BM + wr * 64 + fr, col0 = u.pn * XHD + wc * 32 + 8 * fq;
#pragma unroll
        for (int ai = 0; ai < 2; ++ai)
#pragma unroll
            for (int m = 0; m < 4; ++m) { const int r = ai * HALF + wr * 64 + m * 16 + fr; const f32x4 ps4 = *(const LAS f32x4*)(PS + r * 4);
                const float inv = 1.0f / ((ps4[0] + ps4[1]) + (ps4[2] + ps4[3])); bf16_t* rowp = pb + (size_t)(row0 + ai * HALF + m * 16) * D + col0;
#pragma unroll
                for (int bj = 0; bj < 2; ++bj) { const f32x4 v0 = acc[ai][bj][m][0] * inv, v1 = acc[ai][bj][m][1] * inv;
                    u32x4 w; w.x = cvt_pk_bf16(v0[0], v0[1]); w.y = cvt_pk_bf16(v0[2], v0[3]); w.z = cvt_pk_bf16(v1[0], v1[1]); w.w = cvt_pk_bf16(v1[2], v1[3]);
                    *(u32x4*)(rowp + bj * HALF) = w; } }
        __syncthreads();
    }
};
struct EpiO {
    static constexpr bool PERM = true, AFTER_DRAIN = false;
    bf16_t* ob;
    __device__ __forceinline__ void prefetch(const Unit&, int, LAS unsigned char*, int, int) const {}
    __device__ __forceinline__ void operator()(const Acc& acc, const Unit& u, int, LAS unsigned char*, int wr, int wc, int fr, int fq) const {
        const int row0 = u.pm * BM + wr * 64 + fr, col0 = u.pn * BM + wc * 32 + 8 * fq;
#pragma unroll
        for (int ai = 0; ai < 2; ++ai)
#pragma unroll
            for (int m = 0; m < 4; ++m) { bf16_t* rowp = ob + (size_t)(row0 + ai * HALF + m * 16) * D + col0;
#pragma unroll
                for (int bj = 0; bj < 2; ++bj) { const f32x4 v0 = acc[ai][bj][m][0], v1 = acc[ai][bj][m][1];
                    u32x4 w; w.x = cvt_pk_bf16(v0[0], v0[1]); w.y = cvt_pk_bf16(v0[2], v0[3]); w.z = cvt_pk_bf16(v1[0], v1[1]); w.w = cvt_pk_bf16(v1[2], v1[3]);
                    *(u32x4*)(rowp + bj * HALF) = w; } }
    }
};
constexpr int META_OFF = 131072, META_BYTES = 3072;
__device__ __forceinline__ void dma4(const void* g, LAS unsigned char* l) { __builtin_amdgcn_global_load_lds((const unsigned*)g, (LAS unsigned*)l, 4, 0, 0); }
__device__ __forceinline__ void dma16(const void* g, LAS unsigned char* l) { __builtin_amdgcn_global_load_lds((const unsigned*)g, (LAS unsigned*)l, 16, 0, 0); }
struct EpiAct {
    static constexpr bool PERM = true, AFTER_DRAIN = false;
    bf16_t* act; const float* lrstd; const float* b1;
    __device__ __forceinline__ void prefetch(const UnitM& u, int ui, LAS unsigned char* lds, int wid, int lane) const {
        LAS unsigned char* mb = lds + META_OFF + (ui % 3) * META_BYTES;
        if (wid < 4) dma4(lrstd + (size_t)u.e * LISTCAP + u.pm * 256 + wid * 64 + lane, mb + wid * 256);
        else dma4(u.tok + (wid - 4) * 64 + lane, mb + 1024 + (wid - 4) * 256);
        if (wid == 4) dma16(b1 + (size_t)u.e * 2048 + (lane >> 5) * 1024 + u.pn * 128 + (lane & 31) * 4, mb + 2048);
    }
    __device__ __forceinline__ void operator()(const Acc& acc, const UnitM& u, int ui, LAS unsigned char* lds, int wr, int wc, int fr, int fq) const {
        const LAS unsigned char* mb = lds + META_OFF + (ui % 3) * META_BYTES;
        const int cl = wc * 32 + 8 * fq, gcol = u.pn * 128 + cl; const LAS float* bg = (const LAS float*)(mb + 2048) + cl; const LAS float* bl = bg + 128;
        const f32x4 bg0 = *(const LAS f32x4*)bg, bg1 = *(const LAS f32x4*)(bg + 4), bl0 = *(const LAS f32x4*)bl, bl1 = *(const LAS f32x4*)(bl + 4);
        int rb = wr * 64 + fr; asm volatile("" : "+v"(rb));
#pragma unroll
        for (int ai = 0; ai < 2; ++ai)
#pragma unroll
            for (int m = 0; m < 4; ++m) { const int r = ai * HALF + m * 16 + rb; const float rs = ((const LAS float*)mb)[r] * (1.0f / W8_SCALE);
                float o[8];
#pragma unroll
                for (int n = 0; n < 2; ++n) { const f32x4 g4 = acc[ai][0][m][n] * rs + (n ? bg1 : bg0), l4 = acc[ai][1][m][n] * rs + (n ? bl1 : bl0);
#pragma unroll
                    for (int j = 0; j < 4; ++j) { const float g = fminf(g4[j], 7.0f), l = fminf(fmaxf(l4[j], -7.0f), 7.0f);
                        const float sg = __builtin_amdgcn_rcpf(1.0f + __builtin_amdgcn_exp2f(g * (-1.702f * LOG2E))); o[n * 4 + j] = g * sg * (l + 1.0f); } }
                u32x2 w; w.x = pk_fp8x4(o[0] * ACT8_SCALE, o[1] * ACT8_SCALE, o[2] * ACT8_SCALE, o[3] * ACT8_SCALE); w.y = pk_fp8x4(o[4] * ACT8_SCALE, o[5] * ACT8_SCALE, o[6] * ACT8_SCALE, o[7] * ACT8_SCALE);
                *(u32x2*)((unsigned char*)act + (size_t)(u.rowoff + r) * DEXP + gcol) = w; }
    }
};
struct EpiY {
    static constexpr bool PERM = true, AFTER_DRAIN = false;
    bf16_t* y; const float* lgate; const int* ltok; const float* b2;
    __device__ __forceinline__ void prefetch(const UnitM& u, int ui, LAS unsigned char* lds, int wid, int lane) const {
        LAS unsigned char* mb = lds + META_OFF + (ui % 3) * META_BYTES;
        const size_t li = (size_t)u.e * LISTCAP + u.pm * 256 + (wid & 3) * 64 + lane;
        if (wid < 4) dma4(lgate + li, mb + wid * 256); else dma4(ltok + li, mb + 1024 + (wid - 4) * 256);
        if (wid == 0) dma16(b2 + (size_t)u.e * D + u.pn * 256 + lane * 4, mb + 2048);
    }
    __device__ __forceinline__ void operator()(const Acc& acc, const UnitM& u, int ui, LAS unsigned char* lds, int wr, int wc, int fr, int fq) const {
        const LAS unsigned char* mb = lds + META_OFF + (ui % 3) * META_BYTES;
        const int cl = wc * 32 + 8 * fq, col0 = u.pn * BM + cl; const LAS float* bb = (const LAS float*)(mb + 2048) + cl;
        int rb = wr * 64 + fr; asm volatile("" : "+v"(rb));
#pragma unroll
        for (int bj = 0; bj < 2; ++bj) {
            const f32x4 bv0 = *(const LAS f32x4*)(bb + bj * HALF), bv1 = *(const LAS f32x4*)(bb + bj * HALF + 4);
#pragma unroll
            for (int ai = 0; ai < 2; ++ai)
#pragma unroll
                for (int m = 0; m < 4; ++m) { const int r = ai * HALF + m * 16 + rb;
                    if (r < u.nvalid) { const int ent = ((const LAS int*)(mb + 1024))[r]; const float gw = ((const LAS float*)mb)[r]; unsigned char* rowp = (unsigned char*)y + (size_t)ent * D + col0;
                        const f32x4 v0 = (acc[ai][bj][m][0] * (1.0f / (W8_SCALE * ACT8_SCALE)) + bv0) * gw, v1 = (acc[ai][bj][m][1] * (1.0f / (W8_SCALE * ACT8_SCALE)) + bv1) * gw;
                        u32x2 w; w.x = pk_fp8x4(v0[0] * Y8_SCALE, v0[1] * Y8_SCALE, v0[2] * Y8_SCALE, v0[3] * Y8_SCALE); w.y = pk_fp8x4(v1[0] * Y8_SCALE, v1[1] * Y8_SCALE, v1[2] * Y8_SCALE, v1[3] * Y8_SCALE);
                        *(u32x2*)(rowp + bj * HALF) = w; } }
        }
    }
};
}

#define XB_TMO      128
#define XB_XCNT(j)  (256  + 64 * (j))
#define XB_XSUB(j)  (1280 + 64 * (j))
#define XB_XGEN(j)  (2304 + 64 * (j))
#define XB_TOP      3328
#define XB_TOPGEN   3392
#define XCD_BAR_WORDS 3456
#define XB_SPIN_CAP (1u << 18)
__device__ __forceinline__ unsigned xb_ld(unsigned* p)              { return __hip_atomic_load(p, __ATOMIC_RELAXED, __HIP_MEMORY_SCOPE_AGENT); }
__device__ __forceinline__ unsigned xb_add(unsigned* p, unsigned v) { return __hip_atomic_fetch_add(p, v, __ATOMIC_RELAXED, __HIP_MEMORY_SCOPE_AGENT); }
__device__ __forceinline__ unsigned xb_xcc_id() { return (unsigned)__builtin_amdgcn_s_getreg((3 << 11) | 20) & 0xFu; }
#define XB_SPIN(cond, bar) do { unsigned _sp = 0; while (cond) { __builtin_amdgcn_s_sleep(1); \
    if ((++_sp & 255u) == 0u) { if (xb_ld(&(bar)[XB_TMO])) break; if (_sp > XB_SPIN_CAP) { atomicAdd(&(bar)[XB_TMO], 1u); break; } } } } while (0)
struct XcdBarrier { unsigned* bar; unsigned x; volatile LAS unsigned* st; };
__device__ __forceinline__ XcdBarrier xcd_barrier_post(unsigned* bar, volatile LAS unsigned* st) {
    XcdBarrier b; b.bar = bar; b.x = xb_xcc_id(); b.st = st;
    if (threadIdx.x == 0) (void)xb_add(&bar[XB_XCNT(b.x)], 1u);
    return b;
}
__device__ __forceinline__ void xcd_barrier_complete(unsigned* bar, unsigned x, unsigned& nloc, unsigned& nx) {
    const unsigned G = gridDim.x * gridDim.y * gridDim.z;
    unsigned sum, cnt, mine, sp = 0u;
    for (;;) {
        sum = 0u; cnt = 0u; mine = 0u;
#pragma unroll
        for (unsigned j = 0; j < 16; ++j) { const unsigned c = xb_ld(&bar[XB_XCNT(j)]); sum += c; cnt += (c > 0u) ? 1u : 0u; mine = (j == x) ? c : mine; }
        if (sum == G) break;
        __builtin_amdgcn_s_sleep(1);
        if ((++sp & 255u) == 0u) { if (xb_ld(&bar[XB_TMO])) break; if (sp > XB_SPIN_CAP) { atomicAdd(&bar[XB_TMO], 1u); break; } }
    }
    nloc = mine > 0u ? mine : 1u; nx = cnt > 0u ? cnt : 1u;
}
__device__ __forceinline__ void xcd_barrier(const XcdBarrier& b) {
    asm volatile("s_waitcnt vmcnt(0)" ::: "memory");
    __syncthreads();
    if (threadIdx.x == 0) {
        unsigned* bar = b.bar;
        __builtin_amdgcn_s_waitcnt(0);
        unsigned nloc = b.st[0], nx = b.st[1];
        if (nloc == 0u) { xcd_barrier_complete(bar, b.x, nloc, nx); b.st[0] = nloc; b.st[1] = nx; }
        const unsigned old = xb_add(&bar[XB_XSUB(b.x)], 1u);
        const unsigned gen = old / nloc;
        if (old + 1u == (gen + 1u) * nloc) {
            __builtin_amdgcn_fence(__ATOMIC_RELEASE, "agent");
            asm volatile("s_waitcnt vmcnt(0)" ::: "memory");
            const unsigned og = xb_add(&bar[XB_TOP], 1u);
            const unsigned tg = og / nx;
            if (og + 1u == (tg + 1u) * nx) xb_add(&bar[XB_TOPGEN], 1u);
            else XB_SPIN(xb_ld(&bar[XB_TOPGEN]) == tg, bar);
            __builtin_amdgcn_fence(__ATOMIC_ACQUIRE, "agent");
            xb_add(&bar[XB_XGEN(b.x)], 1u);
            asm volatile("s_waitcnt vmcnt(0)" ::: "memory");
        } else {
            XB_SPIN(xb_ld(&bar[XB_XGEN(b.x)]) == gen, bar);
            __builtin_amdgcn_fence(__ATOMIC_ACQUIRE, "agent");
            asm volatile("s_waitcnt vmcnt(0)" ::: "memory");
        }
    }
    __syncthreads();
}

__device__ __forceinline__ void local_seam() {
    asm volatile("s_waitcnt vmcnt(0)" ::: "memory");
    __syncthreads();
    if (threadIdx.x == 0) { __builtin_amdgcn_fence(__ATOMIC_ACQUIRE, "agent"); asm volatile("s_waitcnt vmcnt(0)" ::: "memory"); }
    __syncthreads();
}

constexpr int NWAVES = 8;
constexpr int RING_OFF = 0, RING_BYTES = 131072;
constexpr int LDSCTL_OFF = RING_BYTES + 12288, MISC_OFF = LDSCTL_OFF + 320;
constexpr int LDS_BYTES = 147456;
static_assert(MISC_OFF + 128 <= LDS_BYTES, "LDS map");

struct Frame {
    LAS unsigned char* lds; volatile LAS unsigned* MISC; unsigned* ctl; unsigned char* ws;
    int tid, lane, wave, vcu, G;
    const float* const* in; float* out;
};

__device__ __forceinline__ int nmap1(int n) { return n < 1024 ? (n >> 7) * 256 + (n & 127) : ((n - 1024) >> 7) * 256 + 128 + ((n - 1024) & 127); }
struct TItem { const float* W; bf16_t* WT; const float* g; int ldw, K, k0, n0, perm; };
__device__ __forceinline__ void titem_load(const TItem& t, f32x4 (&va)[8], f32x4 (&vb)[8], int lane) {
    const int nq = lane & 15, kp = lane >> 4;
#pragma unroll
    for (int it = 0; it < 8; ++it) { const int k = t.k0 + 2 * (kp + 4 * it); va[it] = *(const f32x4*)(t.W + (size_t)k * t.ldw + t.n0 + 4 * nq); vb[it] = *(const f32x4*)(t.W + (size_t)(k + 1) * t.ldw + t.n0 + 4 * nq); }
}
__device__ __forceinline__ void titem_store(const TItem& t, const f32x4 (&va)[8], const f32x4 (&vb)[8], LAS unsigned* scr, int lane) {
    const int nq = lane & 15, kp = lane >> 4;
#pragma unroll
    for (int it = 0; it < 8; ++it) { const int kk2 = kp + 4 * it; f32x4 a = va[it], b = vb[it];
        if (t.g) { const float g0 = t.g[t.k0 + 2 * kk2], g1 = t.g[t.k0 + 2 * kk2 + 1]; a = a * g0; b = b * g1; }
#pragma unroll
        for (int j = 0; j < 4; ++j) scr[(4 * nq + j) * 33 + kk2] = cvtpk_s(a[j], b[j]); }
    LDS_WAIT(); asm volatile("" ::: "memory");
    const int c = lane & 7;
#pragma unroll
    for (int it = 0; it < 8; ++it) { const int n = (lane >> 3) + 8 * it; const LAS unsigned* sp = scr + n * 33 + 4 * c;
        u32x4 o; o.x = sp[0]; o.y = sp[1]; o.z = sp[2]; o.w = sp[3];
        const int nn = t.n0 + n, nr = t.perm ? nmap1(nn) : nn;
        *(u32x4*)(t.WT + (size_t)nr * t.K + t.k0 + 8 * c) = o; }
    LDS_WAIT(); asm volatile("" ::: "memory");
}
__device__ __forceinline__ void titem8_load(const TItem& t, f32x4 (&va)[8], f32x4 (&vb)[8], int lane) {
    const int nq = lane & 7, kg = lane >> 3;
#pragma unroll
    for (int it = 0; it < 4; ++it) { const int k = t.k0 + 4 * (kg + 8 * it); const float* p = t.W + (size_t)k * t.ldw + t.n0 + 4 * nq;
        va[2 * it] = *(const f32x4*)p; va[2 * it + 1] = *(const f32x4*)(p + t.ldw); vb[2 * it] = *(const f32x4*)(p + 2 * (size_t)t.ldw); vb[2 * it + 1] = *(const f32x4*)(p + 3 * (size_t)t.ldw); }
}
__device__ __forceinline__ void titem8_store(const TItem& t, const f32x4 (&va)[8], const f32x4 (&vb)[8], LAS unsigned* scr, int lane) {
    const int nq = lane & 7, kg = lane >> 3;
#pragma unroll
    for (int it = 0; it < 4; ++it) { const int kq = kg + 8 * it; f32x4 a = va[2 * it], b = va[2 * it + 1], c = vb[2 * it], d = vb[2 * it + 1];
        float g0 = W8_SCALE, g1 = W8_SCALE, g2 = W8_SCALE, g3 = W8_SCALE;
        if (t.g) { const f32x4 gv = *(const f32x4*)(t.g + t.k0 + 4 * kq); g0 *= gv[0]; g1 *= gv[1]; g2 *= gv[2]; g3 *= gv[3]; }
#pragma unroll
        for (int j = 0; j < 4; ++j) scr[(4 * nq + j) * 33 + kq] = pk_fp8x4(a[j] * g0, b[j] * g1, c[j] * g2, d[j] * g3); }
    LDS_WAIT(); asm volatile("" ::: "memory");
    const int c = lane & 7;
#pragma unroll
    for (int it = 0; it < 4; ++it) { const int n = (lane >> 3) + 8 * it; const LAS unsigned* sp = scr + n * 33 + 4 * c;
        u32x4 o; o.x = sp[0]; o.y = sp[1]; o.z = sp[2]; o.w = sp[3];
        const int nn = t.n0 + n, nr = t.perm ? nmap1(nn) : nn;
        *(u32x4*)((unsigned char*)t.WT + (size_t)nr * t.K + t.k0 + 16 * c) = o; }
    LDS_WAIT(); asm volatile("" ::: "memory");
}
template <bool F8, class Dec> __device__ __forceinline__ void titem_loop(int first, int stride, int n, LAS unsigned* scr, int lane, const Dec& dec) {
    if (first >= n) return;
    TItem A, B; f32x4 a0[8], a1[8], b0[8], b1[8];
    int ia = first; dec(ia, A); if (F8) titem8_load(A, a0, a1, lane); else titem_load(A, a0, a1, lane);
    for (;;) {
        const int ib = ia + stride; const bool hb = ib < n;
        if (hb) { dec(ib, B); if (F8) titem8_load(B, b0, b1, lane); else titem_load(B, b0, b1, lane); }
        if (F8) titem8_store(A, a0, a1, scr, lane); else titem_store(A, a0, a1, scr, lane);
        if (!hb) break;
        ia = ib + stride; const bool ha = ia < n;
        if (ha) { dec(ia, A); if (F8) titem8_load(A, a0, a1, lane); else titem_load(A, a0, a1, lane); }
        if (F8) titem8_store(B, b0, b1, scr, lane); else titem_store(B, b0, b1, scr, lane);
        if (!ha) break;
    }
}
__device__ __forceinline__ void rms_rows_to_bf16(const float* x, const float* g, bf16_t* o, int first, int stride, int n, int lane) {
    if (first >= n) return;
    const f32x4* gr = (const f32x4*)g + lane; f32x4 gg[4];
#pragma unroll
    for (int j = 0; j < 4; ++j) gg[j] = gr[64 * j];
    f32x4 v[4], w[4];
#pragma unroll
    for (int j = 0; j < 4; ++j) v[j] = ((const f32x4*)(x + (size_t)first * D) + lane)[64 * j];
    for (int m = first; m < n; m += stride) {
        const int mn = m + stride;
        if (mn < n) {
#pragma unroll
            for (int j = 0; j < 4; ++j) w[j] = ((const f32x4*)(x + (size_t)mn * D) + lane)[64 * j];
        }
        float sq = 0.f;
#pragma unroll
        for (int j = 0; j < 4; ++j) sq += (v[j][0] * v[j][0] + v[j][1] * v[j][1]) + (v[j][2] * v[j][2] + v[j][3] * v[j][3]);
        const float rstd = __builtin_amdgcn_rsqf(wave_sum(sq) * (1.f / D) + EPS);
        u32x2* o8 = (u32x2*)(o + (size_t)m * D) + lane;
#pragma unroll
        for (int j = 0; j < 4; ++j) { u32x2 q; q.x = cvtpk_s(v[j][0] * rstd * gg[j][0], v[j][1] * rstd * gg[j][1]); q.y = cvtpk_s(v[j][2] * rstd * gg[j][2], v[j][3] * rstd * gg[j][3]); o8[64 * j] = q; }
#pragma unroll
        for (int j = 0; j < 4; ++j) v[j] = w[j];
    }
}
__device__ __forceinline__ void convert_experts(Frame& F, int first, int stride, int end) {
    LAS unsigned* scr = (LAS unsigned*)(F.lds + RING_OFF + F.wave * 16384);
    const float *g_moe = F.in[13], *w1 = F.in[16], *w2 = F.in[18];
    unsigned char *w1_t = F.ws + WS_W1_T, *w2_t = F.ws + WS_W2_T;
    constexpr int I_2 = NE * 8 * 32;
    titem_loop<true>(first, stride, end, scr, F.lane, [=](int r, TItem& t) {
        t.g = nullptr; t.perm = 0; t.K = D;
        if (r < I_2) { const int ex = r / 256, q = r % 256; t.W = w2 + (size_t)ex * DEXP * D; t.WT = (bf16_t*)(w2_t + (size_t)ex * D * DEXP); t.ldw = D; t.k0 = (q / 32) * 128; t.n0 = (q % 32) * 32; return; } r -= I_2;
        { const int ex = r / 512, q = r % 512; t.W = w1 + (size_t)ex * D * 2048; t.WT = (bf16_t*)(w1_t + (size_t)ex * 2048 * D); t.g = g_moe; t.ldw = 2048; t.perm = 1; t.k0 = (q / 64) * 128; t.n0 = (q % 64) * 32; }
    });
}
__device__ __forceinline__ void p0a_prologue(Frame& F) {
    LAS unsigned* scr = (LAS unsigned*)(F.lds + RING_OFF + F.wave * 16384);
    const int gw = F.vcu * NWAVES + F.wave, NGW = F.G * NWAVES;
    const float *mem = F.in[1], *g_mem = F.in[9], *w_kv = F.in[11];
    bf16_t *wkv_t = (bf16_t*)(F.ws + WS_WKV_T), *memn = (bf16_t*)(F.ws + WS_MEMN);
    rms_rows_to_bf16(mem, g_mem, memn, gw, NGW, MROWS, F.lane);
    titem_loop<false>(gw, NGW, 16 * 32, scr, F.lane, [=](int r, TItem& t) { t.W = w_kv; t.WT = wkv_t; t.g = nullptr; t.ldw = 2 * D; t.K = D; t.k0 = (r / 32) * 64; t.n0 = (r % 32) * 64; t.perm = 0; });
}
__device__ __forceinline__ void p0b_prologue(Frame& F, int wv, int nwv, int lo_frac_num, int lo_frac_den, bool low) {
    LAS unsigned* scr = (LAS unsigned*)(F.lds + RING_OFF + F.wave * 16384);
    const float *x = F.in[0], *g_mix = F.in[2], *w_in = F.in[3], *w_out = F.in[7], *g_xattn = F.in[8], *w_q = F.in[10], *w_o = F.in[12], *g_moe = F.in[13], *w_router = F.in[14], *w1 = F.in[16], *w2 = F.in[18];
    bf16_t *win_t = (bf16_t*)(F.ws + WS_WIN_T), *wout_t = (bf16_t*)(F.ws + WS_WOUT_T), *wq_t = (bf16_t*)(F.ws + WS_WQ_T), *wo_t = (bf16_t*)(F.ws + WS_WO_T),
           *w1_t = (bf16_t*)(F.ws + WS_W1_T), *w2_t = (bf16_t*)(F.ws + WS_W2_T), *xn = (bf16_t*)(F.ws + WS_XN);
    float* wr = (float*)(F.ws + WS_WR);
    auto range = [&](int n, int& first, int& end) { const int cut = (int)((long)n * lo_frac_num / lo_frac_den); if (low) { first = wv; end = cut; } else { first = cut + wv; end = n; } };
    int f, e;
    range(D * NE / 64, f, e); for (int i = f; i < e; i += nwv) { const int idx = i * 64 + F.lane; wr[idx] = w_router[idx] * g_moe[idx >> 5]; }
    { const int x0 = (F.G == 256) ? XITEMS_P1 : 0; range(N_XITEMS - x0, f, e); convert_experts(F, x0 + f, nwv, x0 + e); }
    constexpr int I_IN = 16 * 48, I_OUT = 16 * 16, I_Q = 16 * 16, I_O = 16 * 16;
    range(I_IN + I_OUT + I_Q + I_O, f, e);
    titem_loop<false>(f, nwv, e, scr, F.lane, [=](int r, TItem& t) {
        t.g = nullptr; t.perm = 0; t.K = D; t.ldw = D;
        if (r < I_O) { t.W = w_o; t.WT = wo_t; t.k0 = (r / 16) * 64; t.n0 = (r % 16) * 64; return; } r -= I_O;
        if (r < I_Q) { t.W = w_q; t.WT = wq_t; t.g = g_xattn; t.k0 = (r / 16) * 64; t.n0 = (r % 16) * 64; return; } r -= I_Q;
        if (r < I_OUT) { t.W = w_out; t.WT = wout_t; t.k0 = (r / 16) * 64; t.n0 = (r % 16) * 64; return; } r -= I_OUT;
        { t.W = w_in; t.WT = win_t; t.ldw = NPROJ; t.k0 = (r / 48) * 64; t.n0 = (r % 48) * 64; }
    });
    range(M, f, e); rms_rows_to_bf16(x, g_mix, xn, f, nwv, e, F.lane);
}

__device__ __forceinline__ void conv_rows(Frame& F) {
    const bf16_t* proj = (const bf16_t*)(F.ws + WS_PROJ); bf16_t* ymix = (bf16_t*)(F.ws + WS_YMIX);
    const float* conv_w = F.in[4]; const float* g_conv = F.in[5];
    const int gw = F.vcu * NWAVES + F.wave, NGW = F.G * NWAVES, c0 = 8 * F.lane;
    float w0[8], w1[8], w2[8], gg[8];
#pragma unroll
    for (int j = 0; j < 8; ++j) { w0[j] = conv_w[c0 + j]; w1[j] = conv_w[512 + c0 + j]; w2[j] = conv_w[1024 + c0 + j]; gg[j] = g_conv[c0 + j]; }
    auto ld = [&](int m, u32x4 (&v)[7]) {
        const int t = m & (SEQ - 1); const bf16_t* row = proj + (size_t)m * NPROJ + c0;
        v[0] = *(const u32x4*)row; v[1] = *(const u32x4*)(row + 512); v[2] = *(const u32x4*)(row + 1024);
        v[3] = (u32x4){0, 0, 0, 0}; v[4] = v[3]; v[5] = v[3]; v[6] = v[3];
        if (t >= 1) { v[3] = *(const u32x4*)(row - NPROJ + 512); v[4] = *(const u32x4*)(row - NPROJ + 1024); }
        if (t >= 2) { v[5] = *(const u32x4*)(row - 2 * NPROJ + 512); v[6] = *(const u32x4*)(row - 2 * NPROJ + 1024); }
    };
    if (gw >= M) return;
    u32x4 cur[7], nx[7];
    ld(gw, cur);
    for (int m = gw; m < M; m += NGW) {
        if (m + NGW < M) ld(m + NGW, nx);
        const u32x4 bg = cur[0], cg0 = cur[1], xv0 = cur[2], cg1 = cur[3], xv1 = cur[4], cg2 = cur[5], xv2 = cur[6];
        float y[8]; float ss = 0.f;
#pragma unroll
        for (int j = 0; j < 4; ++j) {
            const float u0l = bf_lo(cg0[j]) * bf_lo(xv0[j]), u0h = bf_hi(cg0[j]) * bf_hi(xv0[j]);
            const float u1l = bf_lo(cg1[j]) * bf_lo(xv1[j]), u1h = bf_hi(cg1[j]) * bf_hi(xv1[j]);
            const float u2l = bf_lo(cg2[j]) * bf_lo(xv2[j]), u2h = bf_hi(cg2[j]) * bf_hi(xv2[j]);
            y[2 * j] = bf_lo(bg[j]) * (w0[2 * j] * u2l + w1[2 * j] * u1l + w2[2 * j] * u0l);
            y[2 * j + 1] = bf_hi(bg[j]) * (w0[2 * j + 1] * u2h + w1[2 * j + 1] * u1h + w2[2 * j + 1] * u0h);
            ss += y[2 * j] * y[2 * j] + y[2 * j + 1] * y[2 * j + 1];
        }
        ss += __shfl_xor(ss, 1); ss += __shfl_xor(ss, 2); ss += __shfl_xor(ss, 4);
        const float rstd = __builtin_amdgcn_rsqf(ss * (1.f / 64.f) + EPS);
        u32x4 o; o.x = cvtpk_s(y[0] * rstd * gg[0], y[1] * rstd * gg[1]); o.y = cvtpk_s(y[2] * rstd * gg[2], y[3] * rstd * gg[3]);
        o.z = cvtpk_s(y[4] * rstd * gg[4], y[5] * rstd * gg[5]); o.w = cvtpk_s(y[6] * rstd * gg[6], y[7] * rstd * gg[7]);
        *(u32x4*)(ymix + (size_t)m * D + c0) = o;
#pragma unroll
        for (int i = 0; i < 7; ++i) cur[i] = nx[i];
    }
}
constexpr int SB_K = 0, SB_V = 8192, SB_OST = 16384, SB_OSTW = 32 * 68 * 4, SB_FLAG = 90112;
static_assert(SB_OST + 8 * SB_OSTW <= SB_FLAG && SB_FLAG + 32 <= RING_BYTES, "attention LDS");
__device__ __forceinline__ int crow(int r, int hi) { return (r & 3) + 8 * (r >> 2) + 4 * hi; }
__device__ __forceinline__ void sb_attn_unit(Frame& F, int b, int h, int qb) {
    const bf16_t* proj = (const bf16_t*)(F.ws + WS_PROJ); bf16_t* ymix = (bf16_t*)(F.ws + WS_YMIX); const float* g_sb = F.in[6];
    const int tid = F.tid, lane = F.lane, wid = F.wave, r32 = lane & 31, hi = lane >> 5;
    LAS unsigned char* lds = F.lds + RING_OFF;
    const int q0 = qb * 256, qlo = q0 + wid * 32, qpos = qlo + r32;
    const size_t rowbase = (size_t)b * SEQ;
    const bf16_t* Qp = proj + (rowbase + qlo) * NPROJ + 1536 + h * 64;
    const bf16_t* Kp = proj + rowbase * NPROJ + 2048 + h * 64;
    const bf16_t* Vp = proj + rowbase * NPROJ + 2560 + h * 64;
    bf16x8 qr[4];
#pragma unroll
    for (int s = 0; s < 4; ++s) qr[s] = *(const bf16x8*)(Qp + (size_t)r32 * NPROJ + 16 * s + 8 * hi);
    bf16x8 ntri[2], nones;
#pragma unroll
    for (int s = 0; s < 2; ++s)
#pragma unroll
        for (int j = 0; j < 8; ++j) { const int k = 16 * s + 8 * (j >> 2) + 4 * hi + (j & 3); ntri[s][j] = (k > r32) ? (short)0xBF80 : (short)0; }
#pragma unroll
    for (int j = 0; j < 8; ++j) nones[j] = (short)0xBF80;
    f32x16 R = {}; f32x16 o[2]; o[0] = f32x16{}; o[1] = f32x16{};
    const int skey = tid >> 3, sc = tid & 7;
    const int koff = SB_K + skey * 128 + ((sc ^ ((skey >> 1) & 7)) << 4);
    const int voff = SB_V + (sc >> 2) * 4096 + (skey >> 4) * 1024 + (skey & 15) * 64 + (sc & 3) * 16;
    const int vb = SB_V + ((lane >> 4) & 1) * 32 + (lane & 3) * 8 + (4 * hi + ((lane & 15) >> 2)) * 64;
    int kbi = 4 * qb + 3;
    u32x4 kreg = *(const u32x4*)(Kp + (size_t)(kbi * 64 + skey) * NPROJ + sc * 8), vreg = *(const u32x4*)(Vp + (size_t)(kbi * 64 + skey) * NPROJ + sc * 8);
    LAS int* dflag = (LAS int*)(lds + SB_FLAG);
    int done = 0;
    for (; kbi >= 0; --kbi) {
        const int k0 = kbi * 64;
        __syncthreads();
        *(LAS u32x4*)(lds + koff) = kreg; *(LAS u32x4*)(lds + voff) = vreg;
        if (lane == 0) dflag[wid] = done;
        __syncthreads();
        { const u32x4 f0 = *(const LAS u32x4*)dflag, f1 = *(const LAS u32x4*)(dflag + 4); if ((f0.x & f0.y & f0.z & f0.w & f1.x & f1.y & f1.z & f1.w) != 0u) break; }
        if (kbi > 0) { kreg = *(const u32x4*)(Kp + (size_t)(k0 - 64 + skey) * NPROJ + sc * 8); vreg = *(const u32x4*)(Vp + (size_t)(k0 - 64 + skey) * NPROJ + sc * 8); }
        if (!done && k0 < qlo + 31) {
            f32x16 p0 = {}, p1 = {};
#pragma unroll
            for (int s = 0; s < 4; ++s) { const int c = 2 * s + hi;
                const bf16x8 ka = *(const LAS bf16x8*)(lds + SB_K + r32 * 128 + ((c ^ ((r32 >> 1) & 7)) << 4));
                const bf16x8 kb = *(const LAS bf16x8*)(lds + SB_K + (r32 + 32) * 128 + ((c ^ (((r32 + 32) >> 1) & 7)) << 4));
                p0 = __builtin_amdgcn_mfma_f32_32x32x16_bf16(ka, qr[s], p0, 0, 0, 0); p1 = __builtin_amdgcn_mfma_f32_32x32x16_bf16(kb, qr[s], p1, 0, 0, 0); }
            const bool diag = (k0 + 63 >= qlo);
            f32x16 s0, s1;
#pragma unroll
            for (int r = 0; r < 16; ++r) {
                const float z0 = p0[r], z1 = p1[r];
                float sp0 = fmaxf(z0, 0.f) + __builtin_amdgcn_logf(1.0f + __builtin_amdgcn_exp2f(-fabsf(z0)));
                float sp1 = fmaxf(z1, 0.f) + __builtin_amdgcn_logf(1.0f + __builtin_amdgcn_exp2f(-fabsf(z1)));
                if (diag) { const int key = k0 + crow(r, hi); if (key >= qpos) sp0 = 0.f; if (key + 32 >= qpos) sp1 = 0.f; }
                s0[r] = sp0; s1[r] = sp1; p0[r] = z0 - sp0; p1[r] = z1 - sp1;
            }
            u32x4 w00 = {cvtpk_s(s0[0], s0[1]), cvtpk_s(s0[2], s0[3]), cvtpk_s(s0[4], s0[5]), cvtpk_s(s0[6], s0[7])}, w01 = {cvtpk_s(s0[8], s0[9]), cvtpk_s(s0[10], s0[11]), cvtpk_s(s0[12], s0[13]), cvtpk_s(s0[14], s0[15])};
            u32x4 w10 = {cvtpk_s(s1[0], s1[1]), cvtpk_s(s1[2], s1[3]), cvtpk_s(s1[4], s1[5]), cvtpk_s(s1[6], s1[7])}, w11 = {cvtpk_s(s1[8], s1[9]), cvtpk_s(s1[10], s1[11]), cvtpk_s(s1[12], s1[13]), cvtpk_s(s1[14], s1[15])};
            const bf16x8 sb00 = __builtin_bit_cast(bf16x8, w00), sb01 = __builtin_bit_cast(bf16x8, w01), sb10 = __builtin_bit_cast(bf16x8, w10), sb11 = __builtin_bit_cast(bf16x8, w11);
            f32x16 rest1 = __builtin_amdgcn_mfma_f32_32x32x16_bf16(ntri[0], sb10, R, 0, 0, 0); rest1 = __builtin_amdgcn_mfma_f32_32x32x16_bf16(ntri[1], sb11, rest1, 0, 0, 0);
            f32x16 U = __builtin_amdgcn_mfma_f32_32x32x16_bf16(nones, sb10, R, 0, 0, 0); U = __builtin_amdgcn_mfma_f32_32x32x16_bf16(nones, sb11, U, 0, 0, 0);
            f32x16 rest0 = __builtin_amdgcn_mfma_f32_32x32x16_bf16(ntri[0], sb00, U, 0, 0, 0); rest0 = __builtin_amdgcn_mfma_f32_32x32x16_bf16(ntri[1], sb01, rest0, 0, 0, 0);
            R = __builtin_amdgcn_mfma_f32_32x32x16_bf16(nones, sb00, U, 0, 0, 0); R = __builtin_amdgcn_mfma_f32_32x32x16_bf16(nones, sb01, R, 0, 0, 0);
            done = __all(R[0] < -150.0f) ? 1 : 0;
#pragma unroll
            for (int r = 0; r < 16; ++r) {
                float a0 = __builtin_amdgcn_exp2f(p0[r] + rest0[r]), a1 = __builtin_amdgcn_exp2f(p1[r] + rest1[r]);
                if (diag) { const int key = k0 + crow(r, hi); if (key >= qpos) a0 = 0.f; if (key + 32 >= qpos) a1 = 0.f; }
                p0[r] = a0; p1[r] = a1;
            }
            u32x4 a00 = {cvtpk_s(p0[0], p0[1]), cvtpk_s(p0[2], p0[3]), cvtpk_s(p0[4], p0[5]), cvtpk_s(p0[6], p0[7])}, a01 = {cvtpk_s(p0[8], p0[9]), cvtpk_s(p0[10], p0[11]), cvtpk_s(p0[12], p0[13]), cvtpk_s(p0[14], p0[15])};
            u32x4 a10 = {cvtpk_s(p1[0], p1[1]), cvtpk_s(p1[2], p1[3]), cvtpk_s(p1[4], p1[5]), cvtpk_s(p1[6], p1[7])}, a11 = {cvtpk_s(p1[8], p1[9]), cvtpk_s(p1[10], p1[11]), cvtpk_s(p1[12], p1[13]), cvtpk_s(p1[14], p1[15])};
            const bf16x8 pa[4] = {__builtin_bit_cast(bf16x8, a00), __builtin_bit_cast(bf16x8, a01), __builtin_bit_cast(bf16x8, a10), __builtin_bit_cast(bf16x8, a11)};
#pragma unroll
            for (int d0 = 0; d0 < 2; ++d0)
#pragma unroll
                for (int ks = 0; ks < 4; ++ks) {
                    const s16x4 lo = __builtin_bit_cast(s16x4, __builtin_amdgcn_ds_read_tr16_b64_v4i16((LAS s16x4*)(lds + vb + d0 * 4096 + ks * 1024)));
                    const s16x4 hh = __builtin_bit_cast(s16x4, __builtin_amdgcn_ds_read_tr16_b64_v4i16((LAS s16x4*)(lds + vb + d0 * 4096 + ks * 1024 + 512)));
                    const bf16x8 vf = {lo[0], lo[1], lo[2], lo[3], hh[0], hh[1], hh[2], hh[3]};
                    o[d0] = __builtin_amdgcn_mfma_f32_32x32x16_bf16(pa[ks], vf, o[d0], 0, 0, 0);
                }
        }
    }
    LAS float* stg = (LAS float*)(lds + SB_OST + wid * SB_OSTW);
#pragma unroll
    for (int r = 0; r < 16; ++r) { const int q = crow(r, hi); stg[q * 68 + r32] = o[0][r]; stg[q * 68 + 32 + r32] = o[1][r]; }
    LDS_WAIT(); asm volatile("" ::: "memory");
    { const int q = lane >> 1, half = lane & 1; const LAS f32x4* sp = (const LAS f32x4*)(stg + q * 68 + 32 * half);
      f32x4 v[8]; float ss = 0.f;
#pragma unroll
      for (int i = 0; i < 8; ++i) { v[i] = sp[i]; ss += (v[i][0] * v[i][0] + v[i][1] * v[i][1]) + (v[i][2] * v[i][2] + v[i][3] * v[i][3]); }
      ss += __shfl_xor(ss, 1);
      const float rstd = __builtin_amdgcn_rsqf(ss * (1.f / 64.f) + EPS);
      const f32x4* gp = (const f32x4*)(g_sb + h * 64 + 32 * half);
      bf16_t* op = ymix + (rowbase + qlo + q) * D + 512 + h * 64 + 32 * half;
#pragma unroll
      for (int i = 0; i < 4; ++i) { const f32x4 g0 = gp[2 * i], g1 = gp[2 * i + 1], a = v[2 * i] * rstd * g0, c = v[2 * i + 1] * rstd * g1;
          u32x4 w; w.x = cvtpk_s(a[0], a[1]); w.y = cvtpk_s(a[2], a[3]); w.z = cvtpk_s(c[0], c[1]); w.w = cvtpk_s(c[2], c[3]); *(u32x4*)(op + 8 * i) = w; } }
    LDS_WAIT();
}
__device__ __forceinline__ void p2_mix(Frame& F) {
    conv_rows(F);
    if (F.G == 256) {
        const int bh = F.vcu >> 2, s = F.vcu & 3;
        sb_attn_unit(F, bh >> 3, bh & 7, 7 - s);
        sb_attn_unit(F, bh >> 3, bh & 7, s);
    } else {
        for (int u = F.vcu; u < 512; u += F.G) sb_attn_unit(F, u >> 6, (u >> 3) & 7, u & 7);
    }
}

__device__ __forceinline__ void p8_router(Frame& F) {
    const bf16_t* x2 = (const bf16_t*)(F.ws + WS_X2); const float* wr = (const float*)(F.ws + WS_WR); const float* b_router = F.in[15];
    float* lrstd = (float*)(F.ws + WS_LRSTD); int* ltok = (int*)(F.ws + WS_LTOK); float* lgate = (float*)(F.ws + WS_LGATE); unsigned* cnt = F.ctl + CW_CNT;
    LAS float* wl = (LAS float*)(F.lds + RING_OFF);
    for (int i = F.tid; i < D * NE / 4; i += NWAVES * 64) ((LAS f32x4*)wl)[i] = ((const f32x4*)wr)[i];
    __syncthreads();
    const int lane = F.lane, tk = lane & 15, kq = lane >> 4;
    const int gw = F.vcu * NWAVES + F.wave, NGW = F.G * NWAVES;
    for (int item = gw; item < M / 16; item += NGW) {
        const int tok = item * 16 + tk; const bf16_t* xr = x2 + (size_t)tok * D + 8 * kq;
        f32x4 acc0 = {0.f, 0.f, 0.f, 0.f}, acc1 = {0.f, 0.f, 0.f, 0.f}; float ss = 0.f;
#pragma unroll 4
        for (int s2 = 0; s2 < 32; ++s2) {
            const u32x4 xw = *(const u32x4*)(xr + 32 * s2);
            const float xv[8] = {bf_lo(xw.x), bf_hi(xw.x), bf_lo(xw.y), bf_hi(xw.y), bf_lo(xw.z), bf_hi(xw.z), bf_lo(xw.w), bf_hi(xw.w)};
#pragma unroll
            for (int j = 0; j < 8; ++j) { ss += xv[j] * xv[j]; const LAS float* wp = wl + (32 * s2 + 8 * kq + j) * 32 + tk;
                acc0 = __builtin_amdgcn_mfma_f32_16x16x4f32(wp[0], xv[j], acc0, 0, 0, 0); acc1 = __builtin_amdgcn_mfma_f32_16x16x4f32(wp[16], xv[j], acc1, 0, 0, 0); }
        }
        ss += __shfl_xor(ss, 16); ss += __shfl_xor(ss, 32);
        const float rstd = __builtin_amdgcn_rsqf(ss * (1.f / D) + EPS);
        float lg[32];
#pragma unroll
        for (int q = 0; q < 4; ++q)
#pragma unroll
            for (int j = 0; j < 4; ++j) { const int src = tk + 16 * q; lg[4 * q + j] = __shfl(acc0[j], src) * rstd + b_router[4 * q + j]; lg[16 + 4 * q + j] = __shfl(acc1[j], src) * rstd + b_router[16 + 4 * q + j]; }
        float tv[4]; int ti[4]; unsigned used = 0u;
#pragma unroll
        for (int k = 0; k < 4; ++k) { float bv = -INFINITY; int bi = 0;
#pragma unroll
            for (int e = 0; e < 32; ++e) { const bool ok = !((used >> e) & 1u) && lg[e] > bv; bv = ok ? lg[e] : bv; bi = ok ? e : bi; }
            tv[k] = bv; ti[k] = bi; used |= 1u << bi; }
        const float e1 = __expf(tv[1] - tv[0]), e2 = __expf(tv[2] - tv[0]), e3 = __expf(tv[3] - tv[0]); const float inv = 1.0f / (1.0f + e1 + e2 + e3);
        const int myE = kq == 0 ? ti[0] : kq == 1 ? ti[1] : kq == 2 ? ti[2] : ti[3];
        const float myG = (kq == 0 ? 1.0f : kq == 1 ? e1 : kq == 2 ? e2 : e3) * inv;
        int rank = 0, mycount = 0;
#pragma unroll 1
        for (int e = 0; e < NE; ++e) { const unsigned long long mk = __ballot(myE == e); const int pc = __popcll(mk);
            if (myE == e) rank = __popcll(mk & ((1ull << lane) - 1ull)); if (lane == e) mycount = pc; }
        unsigned base = 0u; if (lane < NE && mycount > 0) base = atomicAdd(cnt + 64 * lane, (unsigned)mycount);
        const unsigned mybase = (unsigned)__shfl((int)base, myE);
        const size_t pos = (size_t)myE * LISTCAP + mybase + rank;
        ltok[pos] = tok * 4 + kq; lgate[pos] = myG; lrstd[pos] = rstd;
    }
}

typedef float f32x2_ __attribute__((ext_vector_type(2)));
__device__ __forceinline__ void p11_load(const bf16_t* x2, const unsigned char* y, int m, int lane, u32x4 (&xv)[2], u32x2 (&yv)[8]) {
#pragma unroll
    for (int j = 0; j < 2; ++j) { const int c = 8 * lane + 512 * j; xv[j] = *(const u32x4*)(x2 + (size_t)m * D + c);
#pragma unroll
        for (int sl = 0; sl < 4; ++sl) yv[4 * j + sl] = *(const u32x2*)(y + ((size_t)m * 4 + sl) * D + c); }
}
__device__ __forceinline__ void p11_final(Frame& F) {
    const bf16_t* x2 = (const bf16_t*)(F.ws + WS_X2); const unsigned char* y = (const unsigned char*)(F.ws + WS_Y); const float* g_final = F.in[20]; float* out = F.out;
    const int gw = F.vcu * NWAVES + F.wave, NGW = F.G * NWAVES, lane = F.lane;
    if (gw >= M) return;
    f32x4 gg[4];
#pragma unroll
    for (int j = 0; j < 2; ++j) { const int c = 8 * lane + 512 * j; gg[2 * j] = *(const f32x4*)(g_final + c); gg[2 * j + 1] = *(const f32x4*)(g_final + c + 4); }
    u32x4 xv[2], xn_[2]; u32x2 yv[8], yn_[8];
    p11_load(x2, y, gw, lane, xv, yv);
    for (int m = gw; m < M; m += NGW) {
        if (m + NGW < M) p11_load(x2, y, m + NGW, lane, xn_, yn_);
        f32x4 v[4]; float ss = 0.f;
#pragma unroll
        for (int j = 0; j < 2; ++j) { f32x4 s0 = {0.f, 0.f, 0.f, 0.f}, s1 = {0.f, 0.f, 0.f, 0.f};
#pragma unroll
            for (int sl = 0; sl < 4; ++sl) { const u32x2 w = yv[4 * j + sl];
                const f32x2_ a = __builtin_amdgcn_cvt_pk_f32_fp8((int)w.x, false), b = __builtin_amdgcn_cvt_pk_f32_fp8((int)w.x, true), c = __builtin_amdgcn_cvt_pk_f32_fp8((int)w.y, false), d = __builtin_amdgcn_cvt_pk_f32_fp8((int)w.y, true);
                s0[0] += a[0]; s0[1] += a[1]; s0[2] += b[0]; s0[3] += b[1]; s1[0] += c[0]; s1[1] += c[1]; s1[2] += d[0]; s1[3] += d[1]; }
            const u32x4 xw = xv[j]; const f32x4 x0 = {bf_lo(xw.x), bf_hi(xw.x), bf_lo(xw.y), bf_hi(xw.y)}, x1 = {bf_lo(xw.z), bf_hi(xw.z), bf_lo(xw.w), bf_hi(xw.w)};
            v[2 * j] = x0 + s0 * (1.0f / Y8_SCALE); v[2 * j + 1] = x1 + s1 * (1.0f / Y8_SCALE); }
#pragma unroll
        for (int i = 0; i < 4; ++i) ss += (v[i][0] * v[i][0] + v[i][1] * v[i][1]) + (v[i][2] * v[i][2] + v[i][3] * v[i][3]);
        const float rstd = __builtin_amdgcn_rsqf(wave_sum(ss) * (1.f / D) + EPS);
#pragma unroll
        for (int j = 0; j < 2; ++j) { const int c = 8 * lane + 512 * j;
            *(f32x4*)(out + (size_t)m * D + c) = v[2 * j] * rstd * gg[2 * j]; *(f32x4*)(out + (size_t)m * D + c + 4) = v[2 * j + 1] * rstd * gg[2 * j + 1]; }
        xv[0] = xn_[0]; xv[1] = xn_[1];
#pragma unroll
        for (int i = 0; i < 8; ++i) yv[i] = yn_[i];
    }
}

constexpr int NPHASE = 13;
struct Args { const float* in[21]; float* out; unsigned char* ws; int ph_lo, ph_hi; };
static_assert(sizeof(Args) == 21 * 8 + 8 + 8 + 8, "Args has no padding");

__global__ void __launch_bounds__(NWAVES * 64, 2) fwd(Args args) {
    extern __shared__ __attribute__((aligned(16))) unsigned char lds[];
    Frame F;
    F.lds = (LAS unsigned char*)lds; F.MISC = (volatile LAS unsigned*)(F.lds + MISC_OFF);
    F.tid = threadIdx.x; F.lane = F.tid & 63; F.wave = __builtin_amdgcn_readfirstlane(F.tid >> 6);
    F.G = gridDim.x; { const int bx = blockIdx.x; F.vcu = (F.G % 8 == 0) ? (bx % 8) * (F.G / 8) + bx / 8 : bx; }
    F.ws = args.ws; F.ctl = (unsigned*)(args.ws + WS_CTL); F.out = args.out;
    F.in = args.in;
    for (int u = F.tid; u < (LDS_BYTES - LDSCTL_OFF) / 4; u += NWAVES * 64) ((LAS unsigned*)(F.lds + LDSCTL_OFF))[u] = 0u;
    __syncthreads();
    const int lo = args.ph_lo, hi = args.ph_hi;
    const bool single = (hi - lo) > 1;
    XcdBarrier bar; bar.bar = F.ctl + CW_BAR; bar.x = 0; bar.st = nullptr;
    if (single) bar = xcd_barrier_post(F.ctl + CW_BAR, F.MISC + 8);
#ifndef PH_MASK
#define PH_MASK 0x1FFF
#endif
#define IN(k) (((PH_MASK >> (k)) & 1) && lo <= (k) && (k) < hi)
#define SEAM(k) do { if (IN(k) && IN((k) + 1)) xcd_barrier(bar); } while (0)
    unsigned char* ws = args.ws;
    const int bx = (int)blockIdx.x;

    if (IN(0)) {
        p0a_prologue(F);
        if (single) xcd_barrier(bar);
    }
    if (IN(12)) {
        const bool low = bx < 64;
        if (low) {
            pg8::OrderKV S; S.init(ws + WS_MEMN, ws + WS_WKV_T, bx);
            pg8::EpiP1 E{(bf16_t*)(ws + WS_PROJ), (bf16_t*)(ws + WS_KMEM), (bf16_t*)(ws + WS_VT)};
            pg8::gemm_phase<pg8::EpiP1, pg8::OrderKV, false, false, true>(F.lds + RING_OFF, 2 * D, 2 * D, 2 * D, S, E);
        }
        const int nlow = 64 * NWAVES, nhigh = (F.G - 64) * NWAVES;
        if (low) p0b_prologue(F, bx * NWAVES + F.wave, nlow, 4 * nlow, 4 * nlow + 5 * nhigh, true);
        else p0b_prologue(F, (bx - 64) * NWAVES + F.wave, nhigh, 4 * nlow, 4 * nlow + 5 * nhigh, false);
    }
    if (IN(12) && IN(1)) xcd_barrier(bar);
    if (IN(1)) {
        const bool split = (F.G == 256) && (XITEMS_P1 > 0);
        if (!split || bx < 192) {
            pg8::OrderIn S; S.init(ws + WS_XN, ws + WS_WIN_T, split ? 192 : F.G, bx);
            pg8::EpiP1 E{(bf16_t*)(ws + WS_PROJ), (bf16_t*)(ws + WS_KMEM), (bf16_t*)(ws + WS_VT)};
            pg8::gemm_phase<pg8::EpiP1, pg8::OrderIn, false, true, true>(F.lds + RING_OFF, 2 * D, 2 * D, 2 * D, S, E);
        } else convert_experts(F, (bx - 192) * NWAVES + F.wave, 64 * NWAVES, XITEMS_P1);
    }
    SEAM(1);
    if (IN(2)) { p2_mix(F); }
    SEAM(2);
    if (IN(3)) {
        pg8::OrderPlain S; S.init(ws + WS_YMIX, ws + WS_WOUT_T, D, D, M / 256, D / 256, F.G, bx);
        pg8::EpiRes<false, false> E{F.in[0], (bf16_t*)(ws + WS_X1B), nullptr, (float*)(ws + WS_SS1)};
        pg8::gemm_phase<pg8::EpiRes<false, false>, pg8::OrderPlain, false, false, true>(F.lds + RING_OFF, 2 * D, 2 * D, 2 * D, S, E);
    }
    SEAM(3);
    if (IN(4)) {
        pg8::OrderQ S; S.init(ws + WS_X1B, ws + WS_WQ_T, F.G, bx);
        pg8::EpiQm E{(bf16_t*)(ws + WS_QM), (const float*)(ws + WS_SS1)};
        pg8::gemm_phase<pg8::EpiQm, pg8::OrderQ, false, false, true>(F.lds + RING_OFF, 2 * D, 2 * D, 2 * D, S, E);
    }
    if (single && IN(4) && IN(5)) local_seam();
    if (IN(5)) {
        if (F.G == 256) {
            pg8::OrderX<0> S; S.init(ws + WS_QM, ws + WS_KMEM, F.G, bx);
            pg8::EpiSoftmax E{(bf16_t*)(ws + WS_PB)};
            pg8::gemm_phase<pg8::EpiSoftmax, pg8::OrderX<0>, false, false, true>(F.lds + RING_OFF, 2 * D, 2 * D, 2 * XHD, S, E);
        }
    }
    if (single && IN(5) && IN(6)) local_seam();
    if (IN(6)) {
        pg8::OrderX<1> S; S.init(ws + WS_PB, ws + WS_VT, F.G, bx);
        pg8::EpiO E{(bf16_t*)(ws + WS_OB)};
        pg8::gemm_phase<pg8::EpiO, pg8::OrderX<1>, false, true, true>(F.lds + RING_OFF, 2 * D, 2 * MROWS, 2 * MEMLEN, S, E);
    }
    SEAM(6);
    if (IN(7)) {
        pg8::OrderPlain S; S.init(ws + WS_OB, ws + WS_WO_T, D, D, M / 256, D / 256, F.G, bx);
        pg8::EpiRes<true, true> E{ws + WS_X1B, (bf16_t*)(ws + WS_X2), ws + WS_X2B, (float*)(ws + WS_SS2)};
        pg8::gemm_phase<pg8::EpiRes<true, true>, pg8::OrderPlain, false, false, true>(F.lds + RING_OFF, 2 * D, 2 * D, 2 * D, S, E);
    }
    SEAM(7);
    if (IN(8)) { p8_router(F); }
    SEAM(8);
    if (IN(9)) {
        pg8::OrderMoe<8, true> S; S.init(F.ctl + CW_CNT, (const int*)(ws + WS_LTOK), ws + WS_X2B, ws + WS_W1_T, F.G, bx);
        pg8::EpiAct E{(bf16_t*)(ws + WS_ACT), (const float*)(ws + WS_LRSTD), F.in[17]};
        pg8::gemm_phase<pg8::EpiAct, pg8::OrderMoe<8, true>, true, true, true, true>(F.lds + RING_OFF, D, D, D, S, E);
    }
    SEAM(9);
    if (IN(10)) {
        pg8::OrderMoe<4, false> S; S.init(F.ctl + CW_CNT, (const int*)(ws + WS_LTOK), ws + WS_ACT, ws + WS_W2_T, F.G, bx);
        pg8::EpiY E{(bf16_t*)(ws + WS_Y), (const float*)(ws + WS_LGATE), (const int*)(ws + WS_LTOK), F.in[19]};
        pg8::gemm_phase<pg8::EpiY, pg8::OrderMoe<4, false>, false, true, true, true>(F.lds + RING_OFF, DEXP, DEXP, DEXP, S, E);
    }
    SEAM(10);
    if (IN(11)) { p11_final(F); }
#undef IN
#undef SEAM
}

extern "C" void kernel_launch(void* const* d_in, const int* in_sizes, int n_in, void* d_out, int out_size, void* d_ws, size_t ws_size, hipStream_t stream) {
    static int grid = 0;
    if (grid == 0) {
        if (n_in != 21 || in_sizes[0] != M * D || out_size != M * D || ws_size < WS_END) { fprintf(stderr, "kernel_launch: unexpected shapes (n_in %d, in0 %d, out %d, ws %zu)\n", n_in, n_in > 0 ? in_sizes[0] : -1, out_size, ws_size); grid = -1; return; }
        int dev = 0, cus = 0, per_cu = 0;
        if (hipGetDevice(&dev) != hipSuccess || hipDeviceGetAttribute(&cus, hipDeviceAttributeMultiprocessorCount, dev) != hipSuccess) { grid = -1; return; }
        if (hipFuncSetAttribute((const void*)fwd, hipFuncAttributeMaxDynamicSharedMemorySize, LDS_BYTES) != hipSuccess) { fprintf(stderr, "kernel_launch: hipFuncSetAttribute failed\n"); grid = -1; return; }
        if (hipOccupancyMaxActiveBlocksPerMultiprocessor(&per_cu, (const void*)fwd, NWAVES * 64, LDS_BYTES) != hipSuccess || per_cu < 1) { fprintf(stderr, "kernel_launch: occupancy query says %d\n", per_cu); per_cu = 1; }
        (void)hipGetLastError();
        grid = cus;
    }
    if (grid < 0) return;
    (void)hipMemsetAsync((char*)d_ws + WS_CTL, 0, CTL_ZERO_BYTES, stream);
    Args a{};
    for (int i = 0; i < 21; ++i) a.in[i] = (const float*)d_in[i];
    a.out = (float*)d_out; a.ws = (unsigned char*)d_ws;
    if (MK_N_LAUNCHES == 1) {
        a.ph_lo = 0; a.ph_hi = NPHASE;
        void* kargs[] = {&a};
        hipError_t e = hipLaunchCooperativeKernel((const void*)fwd, dim3(grid), dim3(NWAVES * 64), kargs, LDS_BYTES, stream);
        if (e != hipSuccess) fprintf(stderr, "kernel_launch: cooperative launch failed: %s\n", hipGetErrorString(e));
    } else {
        for (int pi = 0; pi < NPHASE; ++pi) { const int p = pi == 0 ? 0 : pi == 1 ? 12 : pi - 1; a.ph_lo = p; a.ph_hi = p + 1; for (int rep = 0; rep < NREP(p); ++rep) hipLaunchKernelGGL(fwd, dim3(grid), dim3(NWAVES * 64), LDS_BYTES, stream, a); }
    }
}
```

```cpp
#include <hip/hip_runtime.h>
#include <hip/hip_cooperative_groups.h>
#include <cstdio>
#include <cstdint>
namespace cg = cooperative_groups;

#ifndef MK_N_LAUNCHES
#define MK_N_LAUNCHES 1
#endif
#ifndef DUP_MASK
#define DUP_MASK 0
#endif
#define NREP(k) (((DUP_MASK >> (k)) & 1) ? 2 : 1)

constexpr int D = 1024, BATCH = 8, SEQ = 2048, M = BATCH * SEQ, MEMLEN = 256, MROWS = BATCH * MEMLEN;
constexpr int NPROJ = 3072, NE = 32, TOPK = 4, DEXP = 1024;
constexpr int XH = 4, XHD = 256;
constexpr float EPS = 1e-5f;
constexpr float LOG2E = 1.4426950408889634f;
constexpr float C2Q = 0.125f * LOG2E;
constexpr float C2X = 0.0625f * LOG2E;
#ifndef P1_CONV_PCT
#define P1_CONV_PCT 100
#endif
#ifndef P1_NCONV
#define P1_NCONV 96
#endif
constexpr int N_XITEMS = NE * 8 * 64 + NE * 8 * 32;
constexpr int XITEMS_P1 = (int)((long)N_XITEMS * P1_CONV_PCT / 100);
constexpr int LISTCAP = M;
constexpr int ACT_ROWS = M * TOPK + NE * 256;

#define GAS __attribute__((address_space(1)))
#define LAS __attribute__((address_space(3)))
typedef unsigned short bf16_t;
typedef short bf16x8 __attribute__((ext_vector_type(8)));
typedef short s16x4 __attribute__((ext_vector_type(4)));
typedef float f32x4 __attribute__((ext_vector_type(4)));
typedef float f32x2 __attribute__((ext_vector_type(2)));
typedef float f32x16 __attribute__((ext_vector_type(16)));
typedef unsigned u32x4 __attribute__((ext_vector_type(4)));
typedef unsigned u32x2 __attribute__((ext_vector_type(2)));
typedef GAS unsigned gu32;

constexpr size_t MiB = 1u << 20;
constexpr size_t WS_CTL = 0, CTL_ZERO_BYTES = 1 * MiB;
constexpr size_t WS_WIN_T = 2 * MiB, WS_WOUT_T = 8 * MiB, WS_WQ_T = 10 * MiB, WS_WKV_T = 12 * MiB, WS_WO_T = 16 * MiB, WS_WR = 18 * MiB;
constexpr size_t WS_MEMN = 19 * MiB, WS_KMEM = 23 * MiB, WS_VT = 27 * MiB, WS_SS1 = 31 * MiB, WS_SS2 = 32 * MiB, WS_RSTD3 = 33 * MiB, WS_LTOK = 34 * MiB, WS_LGATE = 36 * MiB, WS_LRSTD = 38 * MiB;
constexpr size_t WS_W1_T = 40 * MiB, WS_W2_T = 168 * MiB;
constexpr size_t WS_XN = 232 * MiB, WS_PROJ = 264 * MiB, WS_YMIX = 360 * MiB;
constexpr size_t WS_X1 = 392 * MiB, WS_X1B = 456 * MiB, WS_QM = 488 * MiB, WS_PB = 520 * MiB, WS_OB = 552 * MiB, WS_X2 = 584 * MiB, WS_X2B = 648 * MiB;
constexpr size_t WS_ACT = 232 * MiB;
constexpr size_t WS_Y = 392 * MiB;
constexpr size_t WS_END = 680 * MiB;
static_assert(WS_ACT + (size_t)ACT_ROWS * DEXP <= WS_X1 && WS_Y + (size_t)M * TOPK * D * 2 <= WS_PB, "overlays");
constexpr int CW_TMO = 0, CW_CODE = 1, CW_BAR = 4096, CW_CNT = 8192;

__device__ __forceinline__ unsigned cvt_pk_bf16(float lo, float hi) { unsigned r; asm volatile("v_cvt_pk_bf16_f32 %0, %1, %2" : "=v"(r) : "v"(lo), "v"(hi)); return r; }
__device__ __forceinline__ unsigned cvtpk_s(float lo, float hi) { typedef __bf16 bf16x2_t __attribute__((ext_vector_type(2))); f32x2 v = {lo, hi}; bf16x2_t b = __builtin_convertvector(v, bf16x2_t); return __builtin_bit_cast(unsigned, b); }
__device__ __forceinline__ float clamp448(float v) { return fminf(fmaxf(v, -448.0f), 448.0f); }
__device__ __forceinline__ unsigned pk_fp8x4(float a, float b, float c, float d) { int w = 0; w = __builtin_amdgcn_cvt_pk_fp8_f32(clamp448(a), clamp448(b), w, false); w = __builtin_amdgcn_cvt_pk_fp8_f32(clamp448(c), clamp448(d), w, true); return (unsigned)w; }
constexpr float W8_SCALE = 64.0f, ACT8_SCALE = 4.0f, Y8_SCALE = 16.0f;
constexpr int E8_ONE = 0x7F7F7F7F, E8_W = 0x79797979, E8_ACT = 0x7D7D7D7D;
__device__ __forceinline__ float bf_lo(unsigned w) { return __uint_as_float(w << 16); }
__device__ __forceinline__ float bf_hi(unsigned w) { return __uint_as_float(w & 0xffff0000u); }
__device__ __forceinline__ float wave_sum(float v) {
#pragma unroll
    for (int o = 1; o < 64; o <<= 1) v += __shfl_xor(v, o);
    return v;
}
#define LDS_WAIT() asm volatile("s_waitcnt lgkmcnt(0)" ::: "memory")
#define VM_WAIT() asm volatile("s_waitcnt vmcnt(0)" ::: "memory")

namespace pg8 {
constexpr int BM = 256, BK = 64, HALF = 128, HTB = HALF * BK * 2, STAGE_BYTES = 8 * HTB, NXCD = 8, WGM = 8;
__host__ __device__ __forceinline__ int lds_byte(int r, int c) { const int st = (r >> 4) * 2 + (c >> 5), rr = r & 15, cc = c & 31, ob = rr * 64 + cc * 2; return st * 1024 + (ob ^ (((ob >> 9) & 1) << 5)); }
__host__ __device__ __forceinline__ void stage_rc(int b, int& R, int& C) { const int st = b / 1024, sb = b % 1024, swz = sb ^ (((sb >> 9) & 1) << 5); R = (st >> 1) * 16 + swz / 64; C = (st & 1) * 32 + (swz % 64) / 2; }
__host__ __device__ __forceinline__ int perm32(int rho) { const int n = rho >> 4, i = rho & 15; return 8 * (i >> 2) + 4 * n + (i & 3); }

struct Unit { const char* a; const char* b; int pm, pn; };
struct UnitK { const char* a; const char* b; int pm, pn, kind; };
struct UnitM { const char* a; const char* b; const int* tok; int pm, pn, nvalid, e, rowoff; };

struct GridOrder {
    int nM, nN, nwg;
    __device__ __forceinline__ void init(int nM_, int nN_) { nM = nM_; nN = nN_; nwg = nM * nN; }
    __device__ __forceinline__ void map(int L, int& pm, int& pn) const {
        int wgid = L; { const int q = nwg / NXCD, r = nwg % NXCD, xcd = wgid % NXCD, off = wgid / NXCD; wgid = (xcd < r ? xcd * (q + 1) : r * (q + 1) + (xcd - r) * q) + off; }
        const int nig = WGM * nN, gid = wgid / nig, fm = gid * WGM, gsz = (nM - fm) < WGM ? (nM - fm) : WGM;
        pm = fm + ((wgid % nig) % gsz); pn = (wgid % nig) / gsz;
    }
};

typedef f32x4 Acc[2][2][4][2];

template <class Epi, class Sched, bool GATHER, bool ALIGN_EPI, bool SP2, bool F8 = false, int SCA = 0x7F7F7F7F, int SCB = 0x7F7F7F7F>
__device__ __forceinline__ void gemm_phase(LAS unsigned char* lds, const int lda, const int ldb, const int K, const Sched& S, const Epi& E) {
    const int tid = threadIdx.x, wid = __builtin_amdgcn_readfirstlane(tid >> 6), lane = tid & 63, wr = wid >> 2, wc = wid & 3, fr = lane & 15, fq = lane >> 4;
    int nt = K / 128; asm volatile("" : "+s"(nt));
    int RA[2], CA[2]; unsigned voffB[2];
#pragma unroll
    for (int i = 0; i < 2; ++i) { int R, C; stage_rc(tid * 16 + i * 8192, R, C); const int Rb = Epi::PERM ? ((R & ~31) + perm32(R & 31)) : R;
        RA[i] = R; CA[i] = C; voffB[i] = (unsigned)(Rb * ldb + C * 2); }
    const size_t kstep = (size_t)(BK * 2);
    const size_t hstepB = (size_t)HALF * ldb;
    const unsigned ldsw = (unsigned)wid * 1024u;
    const int aoff = lds_byte(wr * 64 + fr, fq * 8), boff = lds_byte(wc * 32 + fr, fq * 8);
#define PG8_SA(b, h) (((b) * 2 + (h)) * HTB)
#define PG8_SB(b, h) ((4 + (b) * 2 + (h)) * HTB)
#define PG8_STAGE(bufoff, gbase, voff) do { _Pragma("unroll") for (int _i = 0; _i < 2; ++_i) \
        __builtin_amdgcn_global_load_lds((const unsigned*)((const char*)(gbase) + (voff)[_i]), (LAS unsigned*)(lds + (bufoff) + ldsw + _i * 8192), 16, 0, 0); } while (0)
#define PG8_LDA(dst, b, h) do { _Pragma("unroll") for (int m = 0; m < 4; ++m) { if constexpr (F8) { \
            dst##8[m] = __builtin_shufflevector(*(const LAS i32x4_*)(lds + PG8_SA(b, h) + aoff + m * 2048), *(const LAS i32x4_*)(lds + PG8_SA(b, h) + aoff + m * 2048 + 1024), 0, 1, 2, 3, 4, 5, 6, 7); } \
        else { _Pragma("unroll") for (int k = 0; k < 2; ++k) dst[m][k] = *(const LAS bf16x8*)(lds + PG8_SA(b, h) + aoff + m * 2048 + k * 1024); } } } while (0)
#define PG8_LDB(dst, b, h) do { _Pragma("unroll") for (int n = 0; n < 2; ++n) { if constexpr (F8) { \
            dst##8[n] = __builtin_shufflevector(*(const LAS i32x4_*)(lds + PG8_SB(b, h) + boff + n * 2048), *(const LAS i32x4_*)(lds + PG8_SB(b, h) + boff + n * 2048 + 1024), 0, 1, 2, 3, 4, 5, 6, 7); } \
        else { _Pragma("unroll") for (int k = 0; k < 2; ++k) dst[n][k] = *(const LAS bf16x8*)(lds + PG8_SB(b, h) + boff + n * 2048 + k * 1024); } } } while (0)
#define PG8_MMA(ai, bj, At, Bt) do { __builtin_amdgcn_s_setprio(1); _Pragma("unroll") for (int m = 0; m < 4; ++m) _Pragma("unroll") for (int n = 0; n < 2; ++n) { \
        if constexpr (F8) { acc[ai][bj][m][n] = __builtin_amdgcn_mfma_scale_f32_16x16x128_f8f6f4(Bt##8[n], At##8[m], acc[ai][bj][m][n], 0, 0, 0, SCA, 0, SCB); } \
        else { _Pragma("unroll") for (int k = 0; k < 2; ++k) acc[ai][bj][m][n] = __builtin_amdgcn_mfma_f32_16x16x32_bf16(Bt[n][k], At[m][k], acc[ai][bj][m][n], 0, 0, 0); } } \
        __builtin_amdgcn_s_setprio(0); } while (0)
#define PG8_WAIT_V(n) asm volatile("s_waitcnt vmcnt(" #n ")" ::: "memory")
#define PG8_WAIT_L(n) asm volatile("s_waitcnt lgkmcnt(" #n ")" ::: "memory")
#define PG8_BAR __builtin_amdgcn_s_barrier()
#define PG8_SCHED __builtin_amdgcn_sched_barrier(0)
#define PG8_VOFFA(dst, u) do { if constexpr (GATHER) { int _t[2][2]; _Pragma("unroll") for (int _h = 0; _h < 2; ++_h) _Pragma("unroll") for (int _i = 0; _i < 2; ++_i) _t[_h][_i] = (u).tok[_h * HALF + RA[_i]]; \
        _Pragma("unroll") for (int _h = 0; _h < 2; ++_h) _Pragma("unroll") for (int _i = 0; _i < 2; ++_i) { const int _row = _h * HALF + RA[_i]; const int _tt = (_row < (u).nvalid) ? (_t[_h][_i] >> 2) : 0; dst[_h][_i] = (unsigned)(_tt * lda + CA[_i] * 2); } } \
        else { _Pragma("unroll") for (int _h = 0; _h < 2; ++_h) _Pragma("unroll") for (int _i = 0; _i < 2; ++_i) dst[_h][_i] = (unsigned)((_h * HALF + RA[_i]) * lda + CA[_i] * 2); } } while (0)
#define PG8_VOFFA_LDS(dst, u, slot) do { const LAS int* _mt = (const LAS int*)(lds + 131072 + (slot) * 3072 + 1024); _Pragma("unroll") for (int _h = 0; _h < 2; ++_h) _Pragma("unroll") for (int _i = 0; _i < 2; ++_i) { \
        const int _row = _h * HALF + RA[_i]; const int _tt = (_row < (u).nvalid) ? (_mt[_row] >> 2) : 0; dst[_h][_i] = (unsigned)(_tt * lda + CA[_i] * 2); } } while (0)
    typename Sched::U cur, nxt; int ui = 0;
    if (!S.next(0, cur)) return;
    Acc acc;
#pragma unroll
    for (int a = 0; a < 2; ++a)
#pragma unroll
        for (int b = 0; b < 2; ++b)
#pragma unroll
            for (int m = 0; m < 4; ++m)
#pragma unroll
                for (int n = 0; n < 2; ++n) acc[a][b][m][n] = (f32x4){0.f, 0.f, 0.f, 0.f};
    typedef int i32x4_ __attribute__((ext_vector_type(4))); typedef int i32x8_ __attribute__((ext_vector_type(8)));
    bf16x8 At[4][2], B0[2][2], B1[2][2]; i32x8_ At8[4], B08[2], B18[2];
    unsigned vA[2][2];
    PG8_VOFFA(vA, cur);
    const char* cA = cur.a; const char* cB = cur.b;
    E.prefetch(cur, 0, lds, wid, lane);
    if constexpr (SP2) {
        PG8_STAGE(PG8_SB(0, 0), cB, voffB); PG8_STAGE(PG8_SB(0, 1), cB + hstepB, voffB); PG8_STAGE(PG8_SA(0, 0), cA, vA[0]); PG8_STAGE(PG8_SA(0, 1), cA, vA[1]);
        if (wr == 1) PG8_BAR;
        PG8_WAIT_V(2); PG8_BAR;
        PG8_STAGE(PG8_SB(1, 0), cB + kstep, voffB); PG8_STAGE(PG8_SA(1, 0), cA + kstep, vA[0]); PG8_STAGE(PG8_SB(1, 1), cB + hstepB + kstep, voffB);
        PG8_WAIT_V(6); PG8_BAR;
    } else {
        PG8_STAGE(PG8_SB(0, 0), cB, voffB); PG8_STAGE(PG8_SA(0, 0), cA, vA[0]); PG8_STAGE(PG8_SB(0, 1), cB + hstepB, voffB); PG8_STAGE(PG8_SA(0, 1), cA, vA[1]);
        if (wr == 1) PG8_BAR;
        PG8_WAIT_V(4); PG8_BAR;
        PG8_STAGE(PG8_SB(1, 0), cB + kstep, voffB); PG8_STAGE(PG8_SA(1, 0), cA + kstep, vA[0]); PG8_STAGE(PG8_SB(1, 1), cB + hstepB + kstep, voffB);
        PG8_WAIT_V(6); PG8_BAR;
    }
    for (;;) {
        const bool has_next = S.next(ui + 1, nxt);
        const char* nA = has_next ? nxt.a : cA; const char* nB = has_next ? nxt.b : cB;
        if (has_next) E.prefetch(nxt, ui + 1, lds, wid, lane);
        for (int t = 0; t < nt; t += 2) {
            const bool last = (t == nt - 2);
            asm volatile("" : "+v"(vA[0][0]), "+v"(vA[0][1]), "+v"(vA[1][0]), "+v"(vA[1][1]), "+v"(voffB[0]), "+v"(voffB[1]));
            const char* a1 = cA + (size_t)(t + 1) * kstep;
            const char* a2 = last ? nA : cA + (size_t)(t + 2) * kstep; const char* b2 = last ? nB : cB + (size_t)(t + 2) * kstep;
            const char* a3 = a2 + kstep; const char* b3 = b2 + kstep;
            if constexpr (SP2) {
            PG8_LDB(B0, 0, 0); PG8_LDB(B1, 0, 1); PG8_SCHED; PG8_LDA(At, 0, 0); PG8_STAGE(PG8_SA(1, 1), a1, vA[1]); if (last && has_next) { if constexpr (GATHER) { PG8_VOFFA_LDS(vA, nxt, (ui + 1) % 3); } else { PG8_VOFFA(vA, nxt); } }
            PG8_WAIT_V(8); PG8_WAIT_L(0); PG8_BAR; PG8_MMA(0, 0, At, B0); PG8_MMA(0, 1, At, B1); PG8_BAR; PG8_SCHED;
            PG8_LDA(At, 0, 1); PG8_STAGE(PG8_SB(0, 0), b2, voffB); PG8_STAGE(PG8_SB(0, 1), b2 + hstepB, voffB); PG8_STAGE(PG8_SA(0, 0), a2, vA[0]);
            PG8_WAIT_V(8); PG8_WAIT_L(0); PG8_BAR; PG8_MMA(1, 0, At, B0); PG8_MMA(1, 1, At, B1); PG8_BAR; PG8_SCHED;
            PG8_LDB(B0, 1, 0); PG8_LDB(B1, 1, 1); PG8_SCHED; PG8_LDA(At, 1, 0); PG8_STAGE(PG8_SA(0, 1), a2, vA[1]);
            PG8_WAIT_V(8); PG8_WAIT_L(0); PG8_BAR; PG8_MMA(0, 0, At, B0); PG8_MMA(0, 1, At, B1); PG8_BAR; PG8_SCHED;
            PG8_LDA(At, 1, 1); PG8_STAGE(PG8_SB(1, 0), b3, voffB); PG8_STAGE(PG8_SB(1, 1), b3 + hstepB, voffB); PG8_STAGE(PG8_SA(1, 0), a3, vA[0]);
            PG8_WAIT_V(8); PG8_WAIT_L(0); PG8_BAR; PG8_MMA(1, 0, At, B0); PG8_MMA(1, 1, At, B1); PG8_BAR; PG8_SCHED;
            } else {
            PG8_LDB(B0, 0, 0); PG8_SCHED; PG8_LDA(At, 0, 0); PG8_STAGE(PG8_SA(1, 1), a1, vA[1]); if (last && has_next) { if constexpr (GATHER) { PG8_VOFFA_LDS(vA, nxt, (ui + 1) % 3); } else { PG8_VOFFA(vA, nxt); } }
            PG8_WAIT_L(8); PG8_BAR; PG8_WAIT_L(0); PG8_MMA(0, 0, At, B0); PG8_BAR; PG8_SCHED;
            PG8_LDB(B1, 0, 1); PG8_STAGE(PG8_SB(0, 0), b2, voffB);
            PG8_BAR; PG8_WAIT_L(0); PG8_MMA(0, 1, At, B1); PG8_BAR;
            PG8_LDA(At, 0, 1); PG8_STAGE(PG8_SA(0, 0), a2, vA[0]);
            PG8_BAR; PG8_WAIT_L(0); PG8_MMA(1, 0, At, B0); PG8_BAR; PG8_SCHED;
            PG8_STAGE(PG8_SB(0, 1), b2 + hstepB, voffB);
            PG8_WAIT_V(6); PG8_BAR; PG8_MMA(1, 1, At, B1); PG8_BAR;
            PG8_LDB(B0, 1, 0); PG8_SCHED; PG8_LDA(At, 1, 0); PG8_STAGE(PG8_SA(0, 1), a2, vA[1]);
            PG8_WAIT_L(8); PG8_BAR; PG8_WAIT_L(0); PG8_MMA(0, 0, At, B0); PG8_BAR; PG8_SCHED;
            PG8_LDB(B1, 1, 1); PG8_STAGE(PG8_SB(1, 0), b3, voffB);
            PG8_BAR; PG8_WAIT_L(0); PG8_MMA(0, 1, At, B1); PG8_BAR;
            PG8_LDA(At, 1, 1); PG8_STAGE(PG8_SA(1, 0), a3, vA[0]);
            PG8_BAR; PG8_WAIT_L(0); PG8_MMA(1, 0, At, B0); PG8_BAR; PG8_SCHED;
            PG8_STAGE(PG8_SB(1, 1), b3 + hstepB, voffB);
            PG8_WAIT_V(6); PG8_BAR; PG8_MMA(1, 1, At, B1); PG8_BAR;
            }
        }
        if constexpr (ALIGN_EPI) { if (wr == 0) PG8_BAR; }
        if constexpr (!Epi::AFTER_DRAIN) { E(acc, cur, ui, lds, wr, wc, fr, fq); }
        if (!has_next) break;
#pragma unroll
        for (int a = 0; a < 2; ++a)
#pragma unroll
            for (int b = 0; b < 2; ++b)
#pragma unroll
                for (int m = 0; m < 4; ++m)
#pragma unroll
                    for (int n = 0; n < 2; ++n) acc[a][b][m][n] = (f32x4){0.f, 0.f, 0.f, 0.f};
        cur = nxt; cA = nA; cB = nB; ++ui;
        if constexpr (ALIGN_EPI) { if (wr == 1) PG8_BAR; }
    }
    PG8_WAIT_V(0);
    if constexpr (!ALIGN_EPI) { if (wr == 0) PG8_BAR; }
    PG8_BAR;
    if constexpr (Epi::AFTER_DRAIN) { E.fused(acc, cur, wr, wc, fr, fq, lds, wid, lane); }
#undef PG8_SA
#undef PG8_SB
#undef PG8_STAGE
#undef PG8_LDA
#undef PG8_LDB
#undef PG8_MMA
#undef PG8_WAIT_V
#undef PG8_WAIT_L
#undef PG8_BAR
#undef PG8_SCHED
#undef PG8_VOFFA
#undef PG8_VOFFA_LDS
}

struct OrderKV {
    typedef UnitK U;
    const char *memn, *wkv_t; int c;
    __device__ __forceinline__ void init(const void* memn_, const void* wkv_t_, int c_) { memn = (const char*)memn_; wkv_t = (const char*)wkv_t_; c = c_; }
    __device__ __forceinline__ bool next(int i, UnitK& u) const {
        if (i > 0 || c >= 64) return false;
        int r = c;
        if (r < 32) { u.kind = 1; u.pm = r >> 2; u.pn = r & 3; u.a = memn + (size_t)u.pm * 256 * D * 2; u.b = wkv_t + (size_t)u.pn * 256 * D * 2; return true; }
        r -= 32;
        u.kind = 2; u.pm = r >> 3; u.pn = r & 7; u.a = wkv_t + (size_t)(D + u.pm * 256) * D * 2; u.b = memn + (size_t)u.pn * 256 * D * 2; return true;
    }
};
struct OrderIn {
    typedef UnitK U;
    const char *A, *Bt; int G, c; GridOrder g0;
    __device__ __forceinline__ void init(const void* A_, const void* Bt_, int G_, int c_) { A = (const char*)A_; Bt = (const char*)Bt_; G = G_; c = c_; g0.init(M / 256, NPROJ / 256); }
    __device__ __forceinline__ bool next(int i, UnitK& u) const {
        const int L = i * G + c; if (L >= g0.nwg) return false;
        g0.map(L, u.pm, u.pn); u.kind = 0; u.a = A + (size_t)u.pm * 256 * D * 2; u.b = Bt + (size_t)u.pn * 256 * D * 2; return true;
    }
};
struct OrderPlain {
    typedef Unit U;
    const char *A, *Bt; int lda, ldb, G, c; GridOrder g0;
    __device__ __forceinline__ void init(const void* A_, const void* Bt_, int lda_, int ldb_, int nM, int nN, int G_, int c_) { A = (const char*)A_; Bt = (const char*)Bt_; lda = lda_; ldb = ldb_; G = G_; c = c_; g0.init(nM, nN); }
    __device__ __forceinline__ bool next(int i, Unit& u) const {
        const int L = i * G + c; if (L >= g0.nwg) return false;
        g0.map(L, u.pm, u.pn);
        u.a = A + (size_t)u.pm * 256 * lda * 2; u.b = Bt + (size_t)u.pn * 256 * ldb * 2; return true;
    }
};
struct OrderQ {
    typedef Unit U;
    const char *A, *Bt; int G, c;
    __device__ __forceinline__ void init(const void* A_, const void* Bt_, int G_, int c_) { A = (const char*)A_; Bt = (const char*)Bt_; G = G_; c = c_; }
    __device__ __forceinline__ bool next(int i, Unit& u) const {
        const int L = i * G + c; if (L >= (M / 256) * XH) return false;
        const int xcd = L & 7, j = L >> 3; u.pm = xcd * 8 + (j >> 2); u.pn = j & 3;
        u.a = A + (size_t)u.pm * 256 * D * 2; u.b = Bt + (size_t)u.pn * 256 * D * 2; return true;
    }
};
template <int MODE> struct OrderX {
    typedef Unit U;
    const char *A, *Bt; int G, c;
    __device__ __forceinline__ void init(const void* A_, const void* Bt_, int G_, int c_) { A = (const char*)A_; Bt = (const char*)Bt_; G = G_; c = c_; }
    __device__ __forceinline__ bool next(int i, Unit& u) const {
        const int L = i * G + c; if (L >= (M / 256) * XH) return false;
        const int xcd = L & 7, j = L >> 3; u.pm = xcd * 8 + (j >> 2); u.pn = j & 3;
        const int b = u.pm >> 3;
        u.a = A + ((size_t)u.pm * 256 * D + (size_t)u.pn * XHD) * 2;
        if (MODE == 0) u.b = Bt + ((size_t)b * MEMLEN * D + (size_t)u.pn * XHD) * 2;
        else u.b = Bt + ((size_t)u.pn * XHD * MROWS + (size_t)b * MEMLEN) * 2;
        return true;
    }
};
template <int NTN, bool G1> struct OrderMoe {
    typedef UnitM U;
    const int* ltok; const char* A; const char* Bt; int G, c; int seg[4], til[4], cn[4];
    __device__ __forceinline__ void init(const unsigned* cnt, const int* ltok_, const void* A_, const void* Bt_, int G_, int c_) {
        ltok = ltok_; A = (const char*)A_; Bt = (const char*)Bt_; G = G_; c = c_;
        const int lane = threadIdx.x & 63; const int cv = (lane < NE) ? (int)__hip_atomic_load(cnt + 64 * lane, __ATOMIC_RELAXED, __HIP_MEMORY_SCOPE_AGENT) : 0;
        const int t = (cv + 255) >> 8; int incl = t;
#pragma unroll
        for (int o = 1; o < 32; o <<= 1) { const int v = __shfl_up(incl, o); if (lane >= o) incl += v; }
        const int excl = incl - t, xcd = c & 7;
#pragma unroll
        for (int q = 0; q < 4; ++q) { seg[q] = __builtin_amdgcn_readlane(excl, xcd + 8 * q); til[q] = __builtin_amdgcn_readlane(t, xcd + 8 * q); cn[q] = __builtin_amdgcn_readlane(cv, xcd + 8 * q); }
    }
    __device__ __forceinline__ bool next(int i, UnitM& u) const {
        const int xcd = c & 7, slot = c >> 3, nslot = G >> 3; int j = i * nslot + slot;
#pragma unroll
        for (int q = 0; q < 4; ++q) {
            const int nu = til[q] * NTN;
            if (j < nu) { const int e = xcd + 8 * q, mt = j / NTN, nt = j % NTN;
                u.e = e; u.pm = mt; u.pn = nt; u.rowoff = (seg[q] + mt) * 256; u.nvalid = cn[q] - mt * 256 < 256 ? cn[q] - mt * 256 : 256; u.tok = ltok + (size_t)e * LISTCAP + mt * 256;
                if (G1) { u.a = A; u.b = Bt + ((size_t)e * 2048 + (size_t)nt * 256) * D; }
                else { u.a = A + (size_t)u.rowoff * DEXP; u.b = Bt + ((size_t)e * 1024 + (size_t)nt * 256) * DEXP; }
                return true; }
            j -= nu;
        }
        return false;
    }
};

struct EpiP1 {
    static constexpr bool PERM = true, AFTER_DRAIN = false;
    bf16_t *proj, *kmem, *vt;
    __device__ __forceinline__ void prefetch(const UnitK&, int, LAS unsigned char*, int, int) const {}
    __device__ __forceinline__ void operator()(const Acc& acc, const UnitK& u, int, LAS unsigned char*, int wr, int wc, int fr, int fq) const {
        bf16_t* base; int ldc; float sc = 1.f;
        if (u.kind == 0) { base = proj; ldc = NPROJ; if (u.pn >= 6 && u.pn < 8) sc = C2Q; } else if (u.kind == 1) { base = kmem; ldc = D; } else { base = vt; ldc = MROWS; }
        const int row0 = u.pm * BM + wr * 64 + fr, col0 = u.pn * BM + wc * 32 + 8 * fq;
#pragma unroll
        for (int ai = 0; ai < 2; ++ai)
#pragma unroll
            for (int m = 0; m < 4; ++m) { bf16_t* rowp = base + (size_t)(row0 + ai * HALF + m * 16) * ldc + col0;
#pragma unroll
                for (int bj = 0; bj < 2; ++bj) { const f32x4 v0 = acc[ai][bj][m][0] * sc, v1 = acc[ai][bj][m][1] * sc;
                    u32x4 w; w.x = cvt_pk_bf16(v0[0], v0[1]); w.y = cvt_pk_bf16(v0[2], v0[3]); w.z = cvt_pk_bf16(v1[0], v1[1]); w.w = cvt_pk_bf16(v1[2], v1[3]);
                    *(u32x4*)(rowp + bj * HALF) = w; } }
    }
};
template <bool BASE16, bool OUT8> struct EpiRes {
    static constexpr bool PERM = true, AFTER_DRAIN = true;
    const void* base; bf16_t* xb; unsigned char* x8; float* ss;
    __device__ __forceinline__ void prefetch(const Unit&, int, LAS unsigned char*, int, int) const {}
    __device__ __forceinline__ void fused(Acc& acc, const Unit& u, int wr, int wc, int fr, int fq, LAS unsigned char* lds, int wid, int lane) const {
        LAS float* PSS = (LAS float*)lds;
        const int col0 = u.pn * BM + wc * 32 + 8 * fq;
#pragma unroll
        for (int ai = 0; ai < 2; ++ai)
#pragma unroll
            for (int m = 0; m < 4; ++m) { const int r = ai * HALF + wr * 64 + m * 16 + fr; const size_t off = (size_t)(u.pm * BM + r) * D + col0; float sq = 0.f;
#pragma unroll
                for (int bj = 0; bj < 2; ++bj) { f32x4 b0, b1;
                    if constexpr (BASE16) { const u32x4 w = *(const u32x4*)((const bf16_t*)base + off + bj * HALF); b0 = (f32x4){bf_lo(w.x), bf_hi(w.x), bf_lo(w.y), bf_hi(w.y)}; b1 = (f32x4){bf_lo(w.z), bf_hi(w.z), bf_lo(w.w), bf_hi(w.w)}; }
                    else { b0 = *(const f32x4*)((const float*)base + off + bj * HALF); b1 = *(const f32x4*)((const float*)base + off + bj * HALF + 4); }
                    const f32x4 o0 = b0 + acc[ai][bj][m][0], o1 = b1 + acc[ai][bj][m][1];
                    { u32x4 w; w.x = cvt_pk_bf16(o0[0], o0[1]); w.y = cvt_pk_bf16(o0[2], o0[3]); w.z = cvt_pk_bf16(o1[0], o1[1]); w.w = cvt_pk_bf16(o1[2], o1[3]); *(u32x4*)(xb + off + bj * HALF) = w; }
                    if constexpr (OUT8) { u32x2 w; w.x = pk_fp8x4(o0[0], o0[1], o0[2], o0[3]); w.y = pk_fp8x4(o1[0], o1[1], o1[2], o1[3]); *(u32x2*)(x8 + off + bj * HALF) = w; }
                    sq += ((o0[0] * o0[0] + o0[1] * o0[1]) + (o0[2] * o0[2] + o0[3] * o0[3])) + ((o1[0] * o1[0] + o1[1] * o1[1]) + (o1[2] * o1[2] + o1[3] * o1[3])); }
                sq += __shfl_xor(sq, 16); sq += __shfl_xor(sq, 32);
                if (fq == 0) PSS[r * 4 + wc] = sq; }
        __syncthreads();
        if (threadIdx.x < 256) { const f32x4 p = *(const LAS f32x4*)(PSS + threadIdx.x * 4); ss[(size_t)(u.pm * BM + threadIdx.x) * 4 + u.pn] = (p[0] + p[1]) + (p[2] + p[3]); }
        __syncthreads();
    }
};
__device__ __forceinline__ float rstd_from_ss(const float* ss, int row) {
    const f32x4 a = *(const f32x4*)(ss + (size_t)row * 4);
    return __builtin_amdgcn_rsqf(((a[0] + a[1]) + (a[2] + a[3])) * (1.0f / D) + EPS);
}
struct EpiQm {
    static constexpr bool PERM = true, AFTER_DRAIN = true;
    bf16_t* qm; const float* ss;
    __device__ __forceinline__ void prefetch(const Unit&, int, LAS unsigned char*, int, int) const {}
    __device__ __forceinline__ void fused(Acc& acc, const Unit& u, int wr, int wc, int fr, int fq, LAS unsigned char* lds, int wid, int lane) const {
        const int row0 = u.pm * BM + wr * 64 + fr, col0 = u.pn * BM + wc * 32 + 8 * fq;
        float sc[2][4];
#pragma unroll
        for (int ai = 0; ai < 2; ++ai)
#pragma unroll
            for (int m = 0; m < 4; ++m) sc[ai][m] = rstd_from_ss(ss, row0 + ai * HALF + m * 16) * C2X;
#pragma unroll
        for (int ai = 0; ai < 2; ++ai)
#pragma unroll
            for (int m = 0; m < 4; ++m) { const int row = row0 + ai * HALF + m * 16; bf16_t* rowp = qm + (size_t)row * D + col0;
#pragma unroll
                for (int bj = 0; bj < 2; ++bj) { const f32x4 v0 = acc[ai][bj][m][0] * sc[ai][m], v1 = acc[ai][bj][m][1] * sc[ai][m];
                    u32x4 w; w.x = cvt_pk_bf16(v0[0], v0[1]); w.y = cvt_pk_bf16(v0[2], v0[3]); w.z = cvt_pk_bf16(v1[0], v1[1]); w.w = cvt_pk_bf16(v1[2], v1[3]);
                    *(u32x4*)(rowp + bj * HALF) = w; } }
    }
};
struct EpiSoftmax {
    static constexpr bool PERM = true, AFTER_DRAIN = true;
    bf16_t* pb;
    __device__ __forceinline__ void prefetch(const Unit&, int, LAS unsigned char*, int, int) const {}
    __device__ __forceinline__ void fused(Acc& acc, const Unit& u, int wr, int wc, int fr, int fq, LAS unsigned char* lds, int wid, int lane) const {
        LAS float* PM = (LAS float*)lds;
        LAS float* PS = (LAS float*)(lds + 4096);
#pragma unroll
        for (int ai = 0; ai < 2; ++ai)
#pragma unroll
            for (int m = 0; m < 4; ++m) { float mx = -INFINITY;
#pragma unroll
                for (int bj = 0; bj < 2; ++bj)
#pragma unroll
                    for (int n = 0; n < 2; ++n) { const f32x4 x = acc[ai][bj][m][n]; mx = fmaxf(mx, fmaxf(fmaxf(x[0], x[1]), fmaxf(x[2], x[3]))); }
                mx = fmaxf(mx, __shfl_xor(mx, 16)); mx = fmaxf(mx, __shfl_xor(mx, 32));
                if (fq == 0) PM[(ai * HALF + wr * 64 + m * 16 + fr) * 4 + wc] = mx; }
        __syncthreads();
#pragma unroll
        for (int ai = 0; ai < 2; ++ai)
#pragma unroll
            for (int m = 0; m < 4; ++m) { const int r = ai * HALF + wr * 64 + m * 16 + fr; const f32x4 pm4 = *(const LAS f32x4*)(PM + r * 4);
                const float mx = fmaxf(fmaxf(pm4[0], pm4[1]), fmaxf(pm4[2], pm4[3])); float s = 0.f;
#pragma unroll
                for (int bj = 0; bj < 2; ++bj)
#pragma unroll
                    for (int n = 0; n < 2; ++n) { f32x4 x = acc[ai][bj][m][n];
#pragma unroll
                        for (int j = 0; j < 4; ++j) { x[j] = __builtin_amdgcn_exp2f(x[j] - mx); s += x[j]; }
                        acc[ai][bj][m][n] = x; }
                s += __shfl_xor(s, 16); s += __shfl_xor(s, 32);
                if (fq == 0) PS[r * 4 + wc] = s; }
        __syncthreads();
        const int row0 = u.pm * BM + wr * 64 + fr, col0 = u.pn * XHD + wc * 32 + 8 * fq;
#pragma unroll
        for (int ai = 0; ai < 2; ++ai)
#pragma unroll
            for (int m = 0; m < 4; ++m) { const int r = ai * HALF + wr * 64 + m * 16 + fr; const f32x4 ps4 = *(const LAS f32x4*)(PS + r * 4);
                const float inv = 1.0f / ((ps4[0] + ps4[1]) + (ps4[2] + ps4[3])); bf16_t* rowp = pb + (size_t)(row0 + ai * HALF + m * 16) * D + col0;
#pragma unroll
                for (int bj = 0; bj < 2; ++bj) { const f32x4 v0 = acc[ai][bj][m][0] * inv, v1 = acc[ai][bj][m][1] * inv;
                    u32x4 w; w.x = cvt_pk_bf16(v0[0], v0[1]); w.y = cvt_pk_bf16(v0[2], v0[3]); w.z = cvt_pk_bf16(v1[0], v1[1]); w.w = cvt_pk_bf16(v1[2], v1[3]);
                    *(u32x4*)(rowp + bj * HALF) = w; } }
        __syncthreads();
    }
};
struct EpiO {
    static constexpr bool PERM = true, AFTER_DRAIN = false;
    bf16_t* ob;
    __device__ __forceinline__ void prefetch(const Unit&, int, LAS unsigned char*, int, int) const {}
    __device__ __forceinline__ void operator()(const Acc& acc, const Unit& u, int, LAS unsigned char*, int wr, int wc, int fr, int fq) const {
        const int row0 = u.pm * BM + wr * 64 + fr, col0 = u.pn * BM + wc * 32 + 8 * fq;
#pragma unroll
        for (int ai = 0; ai < 2; ++ai)
#pragma unroll
            for (int m = 0; m < 4; ++m) { bf16_t* rowp = ob + (size_t)(row0 + ai * HALF + m * 16) * D + col0;
#pragma unroll
                for (int bj = 0; bj < 2; ++bj) { const f32x4 v0 = acc[ai][bj][m][0], v1 = acc[ai][bj][m][1];
                    u32x4 w; w.x = cvt_pk_bf16(v0[0], v0[1]); w.y = cvt_pk_bf16(v0[2], v0[3]); w.z = cvt_pk_bf16(v1[0], v1[1]); w.w = cvt_pk_bf16(v1[2], v1[3]);
                    *(u32x4*)(rowp + bj * HALF) = w; } }
    }
};
constexpr int META_OFF = 131072, META_BYTES = 3072;
__device__ __forceinline__ void dma4(const void* g, LAS unsigned char* l) { __builtin_amdgcn_global_load_lds((const unsigned*)g, (LAS unsigned*)l, 4, 0, 0); }
__device__ __forceinline__ void dma16(const void* g, LAS unsigned char* l) { __builtin_amdgcn_global_load_lds((const unsigned*)g, (LAS unsigned*)l, 16, 0, 0); }
struct EpiAct {
    static constexpr bool PERM = true, AFTER_DRAIN = false;
    bf16_t* act; const float* lrstd; const float* b1;
    __device__ __forceinline__ void prefetch(const UnitM& u, int ui, LAS unsigned char* lds, int wid, int lane) const {
        LAS unsigned char* mb = lds + META_OFF + (ui % 3) * META_BYTES;
        if (wid < 4) dma4(lrstd + (size_t)u.e * LISTCAP + u.pm * 256 + wid * 64 + lane, mb + wid * 256);
        else dma4(u.tok + (wid - 4) * 64 + lane, mb + 1024 + (wid - 4) * 256);
        if (wid == 4) dma16(b1 + (size_t)u.e * 2048 + (lane >> 5) * 1024 + u.pn * 128 + (lane & 31) * 4, mb + 2048);
    }
    __device__ __forceinline__ void operator()(const Acc& acc, const UnitM& u, int ui, LAS unsigned char* lds, int wr, int wc, int fr, int fq) const {
        const LAS unsigned char* mb = lds + META_OFF + (ui % 3) * META_BYTES;
        const int cl = wc * 32 + 8 * fq, gcol = u.pn * 128 + cl; const LAS float* bg = (const LAS float*)(mb + 2048) + cl; const LAS float* bl = bg + 128;
        const f32x4 bg0 = *(const LAS f32x4*)bg, bg1 = *(const LAS f32x4*)(bg + 4), bl0 = *(const LAS f32x4*)bl, bl1 = *(const LAS f32x4*)(bl + 4);
        int rb = wr * 64 + fr; asm volatile("" : "+v"(rb));
#pragma unroll
        for (int ai = 0; ai < 2; ++ai)
#pragma unroll
            for (int m = 0; m < 4; ++m) { const int r = ai * HALF + m * 16 + rb; const float rs = ((const LAS float*)mb)[r] * (1.0f / W8_SCALE);
                float o[8];
#pragma unroll
                for (int n = 0; n < 2; ++n) { const f32x4 g4 = acc[ai][0][m][n] * rs + (n ? bg1 : bg0), l4 = acc[ai][1][m][n] * rs + (n ? bl1 : bl0);
#pragma unroll
                    for (int j = 0; j < 4; ++j) { const float g = fminf(g4[j], 7.0f), l = fminf(fmaxf(l4[j], -7.0f), 7.0f);
                        const float sg = __builtin_amdgcn_rcpf(1.0f + __builtin_amdgcn_exp2f(g * (-1.702f * LOG2E))); o[n * 4 + j] = g * sg * (l + 1.0f); } }
                u32x2 w; w.x = pk_fp8x4(o[0] * ACT8_SCALE, o[1] * ACT8_SCALE, o[2] * ACT8_SCALE, o[3] * ACT8_SCALE); w.y = pk_fp8x4(o[4] * ACT8_SCALE, o[5] * ACT8_SCALE, o[6] * ACT8_SCALE, o[7] * ACT8_SCALE);
                *(u32x2*)((unsigned char*)act + (size_t)(u.rowoff + r) * DEXP + gcol) = w; }
    }
};
struct EpiY {
    static constexpr bool PERM = true, AFTER_DRAIN = false;
    bf16_t* y; const float* lgate; const int* ltok; const float* b2;
    __device__ __forceinline__ void prefetch(const UnitM& u, int ui, LAS unsigned char* lds, int wid, int lane) const {
        LAS unsigned char* mb = lds + META_OFF + (ui % 3) * META_BYTES;
        const size_t li = (size_t)u.e * LISTCAP + u.pm * 256 + (wid & 3) * 64 + lane;
        if (wid < 4) dma4(lgate + li, mb + wid * 256); else dma4(ltok + li, mb + 1024 + (wid - 4) * 256);
        if (wid == 0) dma16(b2 + (size_t)u.e * D + u.pn * 256 + lane * 4, mb + 2048);
    }
    __device__ __forceinline__ void operator()(const Acc& acc, const UnitM& u, int ui, LAS unsigned char* lds, int wr, int wc, int fr, int fq) const {
        const LAS unsigned char* mb = lds + META_OFF + (ui % 3) * META_BYTES;
        const int cl = wc * 32 + 8 * fq, col0 = u.pn * BM + cl; const LAS float* bb = (const LAS float*)(mb + 2048) + cl;
        int rb = wr * 64 + fr; asm volatile("" : "+v"(rb));
#pragma unroll
        for (int bj = 0; bj < 2; ++bj) {
            const f32x4 bv0 = *(const LAS f32x4*)(bb + bj * HALF), bv1 = *(const LAS f32x4*)(bb + bj * HALF + 4);
#pragma unroll
            for (int ai = 0; ai < 2; ++ai)
#pragma unroll
                for (int m = 0; m < 4; ++m) { const int r = ai * HALF + m * 16 + rb;
                    if (r < u.nvalid) { const int ent = ((const LAS int*)(mb + 1024))[r]; const float gw = ((const LAS float*)mb)[r]; unsigned char* rowp = (unsigned char*)y + (size_t)ent * D + col0;
                        const f32x4 v0 = (acc[ai][bj][m][0] * (1.0f / (W8_SCALE * ACT8_SCALE)) + bv0) * gw, v1 = (acc[ai][bj][m][1] * (1.0f / (W8_SCALE * ACT8_SCALE)) + bv1) * gw;
                        u32x2 w; w.x = pk_fp8x4(v0[0] * Y8_SCALE, v0[1] * Y8_SCALE, v0[2] * Y8_SCALE, v0[3] * Y8_SCALE); w.y = pk_fp8x4(v1[0] * Y8_SCALE, v1[1] * Y8_SCALE, v1[2] * Y8_SCALE, v1[3] * Y8_SCALE);
                        *(u32x2*)(rowp + bj * HALF) = w; } }
        }
    }
};
}

#define XB_TMO      128
#define XB_XCNT(j)  (256  + 64 * (j))
#define XB_XSUB(j)  (1280 + 64 * (j))
#define XB_XGEN(j)  (2304 + 64 * (j))
#define XB_TOP      3328
#define XB_TOPGEN   3392
#define XCD_BAR_WORDS 3456
#define XB_SPIN_CAP (1u << 18)
__device__ __forceinline__ unsigned xb_ld(unsigned* p)              { return __hip_atomic_load(p, __ATOMIC_RELAXED, __HIP_MEMORY_SCOPE_AGENT); }
__device__ __forceinline__ unsigned xb_add(unsigned* p, unsigned v) { return __hip_atomic_fetch_add(p, v, __ATOMIC_RELAXED, __HIP_MEMORY_SCOPE_AGENT); }
__device__ __forceinline__ unsigned xb_xcc_id() { return (unsigned)__builtin_amdgcn_s_getreg((3 << 11) | 20) & 0xFu; }
#define XB_SPIN(cond, bar) do { unsigned _sp = 0; while (cond) { __builtin_amdgcn_s_sleep(1); \
    if ((++_sp & 255u) == 0u) { if (xb_ld(&(bar)[XB_TMO])) break; if (_sp > XB_SPIN_CAP) { atomicAdd(&(bar)[XB_TMO], 1u); break; } } } } while (0)
struct XcdBarrier { unsigned* bar; unsigned x; volatile LAS unsigned* st; };
__device__ __forceinline__ XcdBarrier xcd_barrier_post(unsigned* bar, volatile LAS unsigned* st) {
    XcdBarrier b; b.bar = bar; b.x = xb_xcc_id(); b.st = st;
    if (threadIdx.x == 0) (void)xb_add(&bar[XB_XCNT(b.x)], 1u);
    return b;
}
__device__ __forceinline__ void xcd_barrier_complete(unsigned* bar, unsigned x, unsigned& nloc, unsigned& nx) {
    const unsigned G = gridDim.x * gridDim.y * gridDim.z;
    unsigned sum, cnt, mine, sp = 0u;
    for (;;) {
        sum = 0u; cnt = 0u; mine = 0u;
#pragma unroll
        for (unsigned j = 0; j < 16; ++j) { const unsigned c = xb_ld(&bar[XB_XCNT(j)]); sum += c; cnt += (c > 0u) ? 1u : 0u; mine = (j == x) ? c : mine; }
        if (sum == G) break;
        __builtin_amdgcn_s_sleep(1);
        if ((++sp & 255u) == 0u) { if (xb_ld(&bar[XB_TMO])) break; if (sp > XB_SPIN_CAP) { atomicAdd(&bar[XB_TMO], 1u); break; } }
    }
    nloc = mine > 0u ? mine : 1u; nx = cnt > 0u ? cnt : 1u;
}
__device__ __forceinline__ void xcd_barrier(const XcdBarrier& b) {
    asm volatile("s_waitcnt vmcnt(0)" ::: "memory");
    __syncthreads();
    if (threadIdx.x == 0) {
        unsigned* bar = b.bar;
        __builtin_amdgcn_s_waitcnt(0);
        unsigned nloc = b.st[0], nx = b.st[1];
        if (nloc == 0u) { xcd_barrier_complete(bar, b.x, nloc, nx); b.st[0] = nloc; b.st[1] = nx; }
        const unsigned old = xb_add(&bar[XB_XSUB(b.x)], 1u);
        const unsigned gen = old / nloc;
        if (old + 1u == (gen + 1u) * nloc) {
            __builtin_amdgcn_fence(__ATOMIC_RELEASE, "agent");
            asm volatile("s_waitcnt vmcnt(0)" ::: "memory");
            const unsigned og = xb_add(&bar[XB_TOP], 1u);
            const unsigned tg = og / nx;
            if (og + 1u == (tg + 1u) * nx) xb_add(&bar[XB_TOPGEN], 1u);
            else XB_SPIN(xb_ld(&bar[XB_TOPGEN]) == tg, bar);
            __builtin_amdgcn_fence(__ATOMIC_ACQUIRE, "agent");
            xb_add(&bar[XB_XGEN(b.x)], 1u);
            asm volatile("s_waitcnt vmcnt(0)" ::: "memory");
        } else {
            XB_SPIN(xb_ld(&bar[XB_XGEN(b.x)]) == gen, bar);
            __builtin_amdgcn_fence(__ATOMIC_ACQUIRE, "agent");
            asm volatile("s_waitcnt vmcnt(0)" ::: "memory");
        }
    }
    __syncthreads();
}

__device__ __forceinline__ void local_seam() {
    asm volatile("s_waitcnt vmcnt(0)" ::: "memory");
    __syncthreads();
    if (threadIdx.x == 0) { __builtin_amdgcn_fence(__ATOMIC_ACQUIRE, "agent"); asm volatile("s_waitcnt vmcnt(0)" ::: "memory"); }
    __syncthreads();
}

constexpr int NWAVES = 8;
constexpr int RING_OFF = 0, RING_BYTES = 131072;
constexpr int LDSCTL_OFF = RING_BYTES + 12288, MISC_OFF = LDSCTL_OFF + 320;
constexpr int LDS_BYTES = 147456;
static_assert(MISC_OFF + 128 <= LDS_BYTES, "LDS map");

struct Frame {
    LAS unsigned char* lds; volatile LAS unsigned* MISC; unsigned* ctl; unsigned char* ws;
    int tid, lane, wave, vcu, G;
    const float* const* in; float* out;
};

__device__ __forceinline__ int nmap1(int n) { return n < 1024 ? (n >> 7) * 256 + (n & 127) : ((n - 1024) >> 7) * 256 + 128 + ((n - 1024) & 127); }
struct TItem { const float* W; bf16_t* WT; const float* g; int ldw, K, k0, n0, perm; };
__device__ __forceinline__ void titem_load(const TItem& t, f32x4 (&va)[8], f32x4 (&vb)[8], int lane) {
    const int nq = lane & 15, kp = lane >> 4;
#pragma unroll
    for (int it = 0; it < 8; ++it) { const int k = t.k0 + 2 * (kp + 4 * it); va[it] = *(const f32x4*)(t.W + (size_t)k * t.ldw + t.n0 + 4 * nq); vb[it] = *(const f32x4*)(t.W + (size_t)(k + 1) * t.ldw + t.n0 + 4 * nq); }
}
__device__ __forceinline__ void titem_store(const TItem& t, const f32x4 (&va)[8], const f32x4 (&vb)[8], LAS unsigned* scr, int lane) {
    const int nq = lane & 15, kp = lane >> 4;
#pragma unroll
    for (int it = 0; it < 8; ++it) { const int kk2 = kp + 4 * it; f32x4 a = va[it], b = vb[it];
        if (t.g) { const float g0 = t.g[t.k0 + 2 * kk2], g1 = t.g[t.k0 + 2 * kk2 + 1]; a = a * g0; b = b * g1; }
#pragma unroll
        for (int j = 0; j < 4; ++j) scr[(4 * nq + j) * 33 + kk2] = cvtpk_s(a[j], b[j]); }
    LDS_WAIT(); asm volatile("" ::: "memory");
    const int c = lane & 7;
#pragma unroll
    for (int it = 0; it < 8; ++it) { const int n = (lane >> 3) + 8 * it; const LAS unsigned* sp = scr + n * 33 + 4 * c;
        u32x4 o; o.x = sp[0]; o.y = sp[1]; o.z = sp[2]; o.w = sp[3];
        const int nn = t.n0 + n, nr = t.perm ? nmap1(nn) : nn;
        *(u32x4*)(t.WT + (size_t)nr * t.K + t.k0 + 8 * c) = o; }
    LDS_WAIT(); asm volatile("" ::: "memory");
}
__device__ __forceinline__ void titem8_load(const TItem& t, f32x4 (&va)[8], f32x4 (&vb)[8], int lane) {
    const int nq = lane & 7, kg = lane >> 3;
#pragma unroll
    for (int it = 0; it < 4; ++it) { const int k = t.k0 + 4 * (kg + 8 * it); const float* p = t.W + (size_t)k * t.ldw + t.n0 + 4 * nq;
        va[2 * it] = *(const f32x4*)p; va[2 * it + 1] = *(const f32x4*)(p + t.ldw); vb[2 * it] = *(const f32x4*)(p + 2 * (size_t)t.ldw); vb[2 * it + 1] = *(const f32x4*)(p + 3 * (size_t)t.ldw); }
}
__device__ __forceinline__ void titem8_store(const TItem& t, const f32x4 (&va)[8], const f32x4 (&vb)[8], LAS unsigned* scr, int lane) {
    const int nq = lane & 7, kg = lane >> 3;
#pragma unroll
    for (int it = 0; it < 4; ++it) { const int kq = kg + 8 * it; f32x4 a = va[2 * it], b = va[2 * it + 1], c = vb[2 * it], d = vb[2 * it + 1];
        float g0 = W8_SCALE, g1 = W8_SCALE, g2 = W8_SCALE, g3 = W8_SCALE;
        if (t.g) { const f32x4 gv = *(const f32x4*)(t.g + t.k0 + 4 * kq); g0 *= gv[0]; g1 *= gv[1]; g2 *= gv[2]; g3 *= gv[3]; }
#pragma unroll
        for (int j = 0; j < 4; ++j) scr[(4 * nq + j) * 33 + kq] = pk_fp8x4(a[j] * g0, b[j] * g1, c[j] * g2, d[j] * g3); }
    LDS_WAIT(); asm volatile("" ::: "memory");
    const int c = lane & 7;
#pragma unroll
    for (int it = 0; it < 4; ++it) { const int n = (lane >> 3) + 8 * it; const LAS unsigned* sp = scr + n * 33 + 4 * c;
        u32x4 o; o.x = sp[0]; o.y = sp[1]; o.z = sp[2]; o.w = sp[3];
        const int nn = t.n0 + n, nr = t.perm ? nmap1(nn) : nn;
        *(u32x4*)((unsigned char*)t.WT + (size_t)nr * t.K + t.k0 + 16 * c) = o; }
    LDS_WAIT(); asm volatile("" ::: "memory");
}
template <bool F8, class Dec> __device__ __forceinline__ void titem_loop(int first, int stride, int n, LAS unsigned* scr, int lane, const Dec& dec) {
    if (first >= n) return;
    TItem A, B; f32x4 a0[8], a1[8], b0[8], b1[8];
    int ia = first; dec(ia, A); if (F8) titem8_load(A, a0, a1, lane); else titem_load(A, a0, a1, lane);
    for (;;) {
        const int ib = ia + stride; const bool hb = ib < n;
        if (hb) { dec(ib, B); if (F8) titem8_load(B, b0, b1, lane); else titem_load(B, b0, b1, lane); }
        if (F8) titem8_store(A, a0, a1, scr, lane); else titem_store(A, a0, a1, scr, lane);
        if (!hb) break;
        ia = ib + stride; const bool ha = ia < n;
        if (ha) { dec(ia, A); if (F8) titem8_load(A, a0, a1, lane); else titem_load(A, a0, a1, lane); }
        if (F8) titem8_store(B, b0, b1, scr, lane); else titem_store(B, b0, b1, scr, lane);
        if (!ha) break;
    }
}
__device__ __forceinline__ void rms_rows_to_bf16(const float* x, const float* g, bf16_t* o, int first, int stride, int n, int lane) {
    if (first >= n) return;
    const f32x4* gr = (const f32x4*)g + lane; f32x4 gg[4];
#pragma unroll
    for (int j = 0; j < 4; ++j) gg[j] = gr[64 * j];
    f32x4 v[4], w[4];
#pragma unroll
    for (int j = 0; j < 4; ++j) v[j] = ((const f32x4*)(x + (size_t)first * D) + lane)[64 * j];
    for (int m = first; m < n; m += stride) {
        const int mn = m + stride;
        if (mn < n) {
#pragma unroll
            for (int j = 0; j < 4; ++j) w[j] = ((const f32x4*)(x + (size_t)mn * D) + lane)[64 * j];
        }
        float sq = 0.f;
#pragma unroll
        for (int j = 0; j < 4; ++j) sq += (v[j][0] * v[j][0] + v[j][1] * v[j][1]) + (v[j][2] * v[j][2] + v[j][3] * v[j][3]);
        const float rstd = __builtin_amdgcn_rsqf(wave_sum(sq) * (1.f / D) + EPS);
        u32x2* o8 = (u32x2*)(o + (size_t)m * D) + lane;
#pragma unroll
        for (int j = 0; j < 4; ++j) { u32x2 q; q.x = cvtpk_s(v[j][0] * rstd * gg[j][0], v[j][1] * rstd * gg[j][1]); q.y = cvtpk_s(v[j][2] * rstd * gg[j][2], v[j][3] * rstd * gg[j][3]); o8[64 * j] = q; }
#pragma unroll
        for (int j = 0; j < 4; ++j) v[j] = w[j];
    }
}
__device__ __forceinline__ void convert_experts(Frame& F, int first, int stride, int end) {
    LAS unsigned* scr = (LAS unsigned*)(F.lds + RING_OFF + F.wave * 16384);
    const float *g_moe = F.in[13], *w1 = F.in[16], *w2 = F.in[18];
    unsigned char *w1_t = F.ws + WS_W1_T, *w2_t = F.ws + WS_W2_T;
    constexpr int I_2 = NE * 8 * 32;
    titem_loop<true>(first, stride, end, scr, F.lane, [=](int r, TItem& t) {
        t.g = nullptr; t.perm = 0; t.K = D;
        if (r < I_2) { const int ex = r / 256, q = r % 256; t.W = w2 + (size_t)ex * DEXP * D; t.WT = (bf16_t*)(w2_t + (size_t)ex * D * DEXP); t.ldw = D; t.k0 = (q / 32) * 128; t.n0 = (q % 32) * 32; return; } r -= I_2;
        { const int ex = r / 512, q = r % 512; t.W = w1 + (size_t)ex * D * 2048; t.WT = (bf16_t*)(w1_t + (size_t)ex * 2048 * D); t.g = g_moe; t.ldw = 2048; t.perm = 1; t.k0 = (q / 64) * 128; t.n0 = (q % 64) * 32; }
    });
}
__device__ __forceinline__ void p0a_prologue(Frame& F) {
    LAS unsigned* scr = (LAS unsigned*)(F.lds + RING_OFF + F.wave * 16384);
    const int gw = F.vcu * NWAVES + F.wave, NGW = F.G * NWAVES;
    const float *mem = F.in[1], *g_mem = F.in[9], *w_kv = F.in[11];
    bf16_t *wkv_t = (bf16_t*)(F.ws + WS_WKV_T), *memn = (bf16_t*)(F.ws + WS_MEMN);
    rms_rows_to_bf16(mem, g_mem, memn, gw, NGW, MROWS, F.lane);
    titem_loop<false>(gw, NGW, 16 * 32, scr, F.lane, [=](int r, TItem& t) { t.W = w_kv; t.WT = wkv_t; t.g = nullptr; t.ldw = 2 * D; t.K = D; t.k0 = (r / 32) * 64; t.n0 = (r % 32) * 64; t.perm = 0; });
}
__device__ __forceinline__ void p0b_prologue(Frame& F, int wv, int nwv, int lo_frac_num, int lo_frac_den, bool low) {
    LAS unsigned* scr = (LAS unsigned*)(F.lds + RING_OFF + F.wave * 16384);
    const float *x = F.in[0], *g_mix = F.in[2], *w_in = F.in[3], *w_out = F.in[7], *g_xattn = F.in[8], *w_q = F.in[10], *w_o = F.in[12], *g_moe = F.in[13], *w_router = F.in[14], *w1 = F.in[16], *w2 = F.in[18];
    bf16_t *win_t = (bf16_t*)(F.ws + WS_WIN_T), *wout_t = (bf16_t*)(F.ws + WS_WOUT_T), *wq_t = (bf16_t*)(F.ws + WS_WQ_T), *wo_t = (bf16_t*)(F.ws + WS_WO_T),
           *w1_t = (bf16_t*)(F.ws + WS_W1_T), *w2_t = (bf16_t*)(F.ws + WS_W2_T), *xn = (bf16_t*)(F.ws + WS_XN);
    float* wr = (float*)(F.ws + WS_WR);
    auto range = [&](int n, int& first, int& end) { const int cut = (int)((long)n * lo_frac_num / lo_frac_den); if (low) { first = wv; end = cut; } else { first = cut + wv; end = n; } };
    int f, e;
    range(D * NE / 64, f, e); for (int i = f; i < e; i += nwv) { const int idx = i * 64 + F.lane; wr[idx] = w_router[idx] * g_moe[idx >> 5]; }
    { const int x0 = (F.G == 256) ? XITEMS_P1 : 0; range(N_XITEMS - x0, f, e); convert_experts(F, x0 + f, nwv, x0 + e); }
    constexpr int I_IN = 16 * 48, I_OUT = 16 * 16, I_Q = 16 * 16, I_O = 16 * 16;
    range(I_IN + I_OUT + I_Q + I_O, f, e);
    titem_loop<false>(f, nwv, e, scr, F.lane, [=](int r, TItem& t) {
        t.g = nullptr; t.perm = 0; t.K = D; t.ldw = D;
        if (r < I_O) { t.W = w_o; t.WT = wo_t; t.k0 = (r / 16) * 64; t.n0 = (r % 16) * 64; return; } r -= I_O;
        if (r < I_Q) { t.W = w_q; t.WT = wq_t; t.g = g_xattn; t.k0 = (r / 16) * 64; t.n0 = (r % 16) * 64; return; } r -= I_Q;
        if (r < I_OUT) { t.W = w_out; t.WT = wout_t; t.k0 = (r / 16) * 64; t.n0 = (r % 16) * 64; return; } r -= I_OUT;
        { t.W = w_in; t.WT = win_t; t.ldw = NPROJ; t.k0 = (r / 48) * 64; t.n0 = (r % 48) * 64; }
    });
    range(M, f, e); rms_rows_to_bf16(x, g_mix, xn, f, nwv, e, F.lane);
}

__device__ __forceinline__ void conv_rows(Frame& F) {
    const bf16_t* proj = (const bf16_t*)(F.ws + WS_PROJ); bf16_t* ymix = (bf16_t*)(F.ws + WS_YMIX);
    const float* conv_w = F.in[4]; const float* g_conv = F.in[5];
    const int gw = F.vcu * NWAVES + F.wave, NGW = F.G * NWAVES, c0 = 8 * F.lane;
    float w0[8], w1[8], w2[8], gg[8];
#pragma unroll
    for (int j = 0; j < 8; ++j) { w0[j] = conv_w[c0 + j]; w1[j] = conv_w[512 + c0 + j]; w2[j] = conv_w[1024 + c0 + j]; gg[j] = g_conv[c0 + j]; }
    auto ld = [&](int m, u32x4 (&v)[7]) {
        const int t = m & (SEQ - 1); const bf16_t* row = proj + (size_t)m * NPROJ + c0;
        v[0] = *(const u32x4*)row; v[1] = *(const u32x4*)(row + 512); v[2] = *(const u32x4*)(row + 1024);
        v[3] = (u32x4){0, 0, 0, 0}; v[4] = v[3]; v[5] = v[3]; v[6] = v[3];
        if (t >= 1) { v[3] = *(const u32x4*)(row - NPROJ + 512); v[4] = *(const u32x4*)(row - NPROJ + 1024); }
        if (t >= 2) { v[5] = *(const u32x4*)(row - 2 * NPROJ + 512); v[6] = *(const u32x4*)(row - 2 * NPROJ + 1024); }
    };
    if (gw >= M) return;
    u32x4 cur[7], nx[7];
    ld(gw, cur);
    for (int m = gw; m < M; m += NGW) {
        if (m + NGW < M) ld(m + NGW, nx);
        const u32x4 bg = cur[0], cg0 = cur[1], xv0 = cur[2], cg1 = cur[3], xv1 = cur[4], cg2 = cur[5], xv2 = cur[6];
        float y[8]; float ss = 0.f;
#pragma unroll
        for (int j = 0; j < 4; ++j) {
            const float u0l = bf_lo(cg0[j]) * bf_lo(xv0[j]), u0h = bf_hi(cg0[j]) * bf_hi(xv0[j]);
            const float u1l = bf_lo(cg1[j]) * bf_lo(xv1[j]), u1h = bf_hi(cg1[j]) * bf_hi(xv1[j]);
            const float u2l = bf_lo(cg2[j]) * bf_lo(xv2[j]), u2h = bf_hi(cg2[j]) * bf_hi(xv2[j]);
            y[2 * j] = bf_lo(bg[j]) * (w0[2 * j] * u2l + w1[2 * j] * u1l + w2[2 * j] * u0l);
            y[2 * j + 1] = bf_hi(bg[j]) * (w0[2 * j + 1] * u2h + w1[2 * j + 1] * u1h + w2[2 * j + 1] * u0h);
            ss += y[2 * j] * y[2 * j] + y[2 * j + 1] * y[2 * j + 1];
        }
        ss += __shfl_xor(ss, 1); ss += __shfl_xor(ss, 2); ss += __shfl_xor(ss, 4);
        const float rstd = __builtin_amdgcn_rsqf(ss * (1.f / 64.f) + EPS);
        u32x4 o; o.x = cvtpk_s(y[0] * rstd * gg[0], y[1] * rstd * gg[1]); o.y = cvtpk_s(y[2] * rstd * gg[2], y[3] * rstd * gg[3]);
        o.z = cvtpk_s(y[4] * rstd * gg[4], y[5] * rstd * gg[5]); o.w = cvtpk_s(y[6] * rstd * gg[6], y[7] * rstd * gg[7]);
        *(u32x4*)(ymix + (size_t)m * D + c0) = o;
#pragma unroll
        for (int i = 0; i < 7; ++i) cur[i] = nx[i];
    }
}
constexpr int SB_K = 0, SB_V = 8192, SB_OST = 16384, SB_OSTW = 32 * 68 * 4, SB_FLAG = 90112;
static_assert(SB_OST + 8 * SB_OSTW <= SB_FLAG && SB_FLAG + 32 <= RING_BYTES, "attention LDS");
__device__ __forceinline__ int crow(int r, int hi) { return (r & 3) + 8 * (r >> 2) + 4 * hi; }
__device__ __forceinline__ void sb_attn_unit(Frame& F, int b, int h, int qb) {
    const bf16_t* proj = (const bf16_t*)(F.ws + WS_PROJ); bf16_t* ymix = (bf16_t*)(F.ws + WS_YMIX); const float* g_sb = F.in[6];
    const int tid = F.tid, lane = F.lane, wid = F.wave, r32 = lane & 31, hi = lane >> 5;
    LAS unsigned char* lds = F.lds + RING_OFF;
    const int q0 = qb * 256, qlo = q0 + wid * 32, qpos = qlo + r32;
    const size_t rowbase = (size_t)b * SEQ;
    const bf16_t* Qp = proj + (rowbase + qlo) * NPROJ + 1536 + h * 64;
    const bf16_t* Kp = proj + rowbase * NPROJ + 2048 + h * 64;
    const bf16_t* Vp = proj + rowbase * NPROJ + 2560 + h * 64;
    bf16x8 qr[4];
#pragma unroll
    for (int s = 0; s < 4; ++s) qr[s] = *(const bf16x8*)(Qp + (size_t)r32 * NPROJ + 16 * s + 8 * hi);
    bf16x8 ntri[2], nones;
#pragma unroll
    for (int s = 0; s < 2; ++s)
#pragma unroll
        for (int j = 0; j < 8; ++j) { const int k = 16 * s + 8 * (j >> 2) + 4 * hi + (j & 3); ntri[s][j] = (k > r32) ? (short)0xBF80 : (short)0; }
#pragma unroll
    for (int j = 0; j < 8; ++j) nones[j] = (short)0xBF80;
    f32x16 R = {}; f32x16 o[2]; o[0] = f32x16{}; o[1] = f32x16{};
    const int skey = tid >> 3, sc = tid & 7;
    const int koff = SB_K + skey * 128 + ((sc ^ ((skey >> 1) & 7)) << 4);
    const int voff = SB_V + (sc >> 2) * 4096 + (skey >> 4) * 1024 + (skey & 15) * 64 + (sc & 3) * 16;
    const int vb = SB_V + ((lane >> 4) & 1) * 32 + (lane & 3) * 8 + (4 * hi + ((lane & 15) >> 2)) * 64;
    int kbi = 4 * qb + 3;
    u32x4 kreg = *(const u32x4*)(Kp + (size_t)(kbi * 64 + skey) * NPROJ + sc * 8), vreg = *(const u32x4*)(Vp + (size_t)(kbi * 64 + skey) * NPROJ + sc * 8);
    LAS int* dflag = (LAS int*)(lds + SB_FLAG);
    int done = 0;
    for (; kbi >= 0; --kbi) {
        const int k0 = kbi * 64;
        __syncthreads();
        *(LAS u32x4*)(lds + koff) = kreg; *(LAS u32x4*)(lds + voff) = vreg;
        if (lane == 0) dflag[wid] = done;
        __syncthreads();
        { const u32x4 f0 = *(const LAS u32x4*)dflag, f1 = *(const LAS u32x4*)(dflag + 4); if ((f0.x & f0.y & f0.z & f0.w & f1.x & f1.y & f1.z & f1.w) != 0u) break; }
        if (kbi > 0) { kreg = *(const u32x4*)(Kp + (size_t)(k0 - 64 + skey) * NPROJ + sc * 8); vreg = *(const u32x4*)(Vp + (size_t)(k0 - 64 + skey) * NPROJ + sc * 8); }
        if (!done && k0 < qlo + 31) {
            f32x16 p0 = {}, p1 = {};
#pragma unroll
            for (int s = 0; s < 4; ++s) { const int c = 2 * s + hi;
                const bf16x8 ka = *(const LAS bf16x8*)(lds + SB_K + r32 * 128 + ((c ^ ((r32 >> 1) & 7)) << 4));
                const bf16x8 kb = *(const LAS bf16x8*)(lds + SB_K + (r32 + 32) * 128 + ((c ^ (((r32 + 32) >> 1) & 7)) << 4));
                p0 = __builtin_amdgcn_mfma_f32_32x32x16_bf16(ka, qr[s], p0, 0, 0, 0); p1 = __builtin_amdgcn_mfma_f32_32x32x16_bf16(kb, qr[s], p1, 0, 0, 0); }
            const bool diag = (k0 + 63 >= qlo);
            f32x16 s0, s1;
#pragma unroll
            for (int r = 0; r < 16; ++r) {
                const float z0 = p0[r], z1 = p1[r];
                float sp0 = fmaxf(z0, 0.f) + __builtin_amdgcn_logf(1.0f + __builtin_amdgcn_exp2f(-fabsf(z0)));
                float sp1 = fmaxf(z1, 0.f) + __builtin_amdgcn_logf(1.0f + __builtin_amdgcn_exp2f(-fabsf(z1)));
                if (diag) { const int key = k0 + crow(r, hi); if (key >= qpos) sp0 = 0.f; if (key + 32 >= qpos) sp1 = 0.f; }
                s0[r] = sp0; s1[r] = sp1; p0[r] = z0 - sp0; p1[r] = z1 - sp1;
            }
            u32x4 w00 = {cvtpk_s(s0[0], s0[1]), cvtpk_s(s0[2], s0[3]), cvtpk_s(s0[4], s0[5]), cvtpk_s(s0[6], s0[7])}, w01 = {cvtpk_s(s0[8], s0[9]), cvtpk_s(s0[10], s0[11]), cvtpk_s(s0[12], s0[13]), cvtpk_s(s0[14], s0[15])};
            u32x4 w10 = {cvtpk_s(s1[0], s1[1]), cvtpk_s(s1[2], s1[3]), cvtpk_s(s1[4], s1[5]), cvtpk_s(s1[6], s1[7])}, w11 = {cvtpk_s(s1[8], s1[9]), cvtpk_s(s1[10], s1[11]), cvtpk_s(s1[12], s1[13]), cvtpk_s(s1[14], s1[15])};
            const bf16x8 sb00 = __builtin_bit_cast(bf16x8, w00), sb01 = __builtin_bit_cast(bf16x8, w01), sb10 = __builtin_bit_cast(bf16x8, w10), sb11 = __builtin_bit_cast(bf16x8, w11);
            f32x16 rest1 = __builtin_amdgcn_mfma_f32_32x32x16_bf16(ntri[0], sb10, R, 0, 0, 0); rest1 = __builtin_amdgcn_mfma_f32_32x32x16_bf16(ntri[1], sb11, rest1, 0, 0, 0);
            f32x16 U = __builtin_amdgcn_mfma_f32_32x32x16_bf16(nones, sb10, R, 0, 0, 0); U = __builtin_amdgcn_mfma_f32_32x32x16_bf16(nones, sb11, U, 0, 0, 0);
            f32x16 rest0 = __builtin_amdgcn_mfma_f32_32x32x16_bf16(ntri[0], sb00, U, 0, 0, 0); rest0 = __builtin_amdgcn_mfma_f32_32x32x16_bf16(ntri[1], sb01, rest0, 0, 0, 0);
            R = __builtin_amdgcn_mfma_f32_32x32x16_bf16(nones, sb00, U, 0, 0, 0); R = __builtin_amdgcn_mfma_f32_32x32x16_bf16(nones, sb01, R, 0, 0, 0);
            done = __all(R[0] < -150.0f) ? 1 : 0;
#pragma unroll
            for (int r = 0; r < 16; ++r) {
                float a0 = __builtin_amdgcn_exp2f(p0[r] + rest0[r]), a1 = __builtin_amdgcn_exp2f(p1[r] + rest1[r]);
                if (diag) { const int key = k0 + crow(r, hi); if (key >= qpos) a0 = 0.f; if (key + 32 >= qpos) a1 = 0.f; }
                p0[r] = a0; p1[r] = a1;
            }
            u32x4 a00 = {cvtpk_s(p0[0], p0[1]), cvtpk_s(p0[2], p0[3]), cvtpk_s(p0[4], p0[5]), cvtpk_s(p0[6], p0[7])}, a01 = {cvtpk_s(p0[8], p0[9]), cvtpk_s(p0[10], p0[11]), cvtpk_s(p0[12], p0[13]), cvtpk_s(p0[14], p0[15])};
            u32x4 a10 = {cvtpk_s(p1[0], p1[1]), cvtpk_s(p1[2], p1[3]), cvtpk_s(p1[4], p1[5]), cvtpk_s(p1[6], p1[7])}, a11 = {cvtpk_s(p1[8], p1[9]), cvtpk_s(p1[10], p1[11]), cvtpk_s(p1[12], p1[13]), cvtpk_s(p1[14], p1[15])};
            const bf16x8 pa[4] = {__builtin_bit_cast(bf16x8, a00), __builtin_bit_cast(bf16x8, a01), __builtin_bit_cast(bf16x8, a10), __builtin_bit_cast(bf16x8, a11)};
#pragma unroll
            for (int d0 = 0; d0 < 2; ++d0)
#pragma unroll
                for (int ks = 0; ks < 4; ++ks) {
                    const s16x4 lo = __builtin_bit_cast(s16x4, __builtin_amdgcn_ds_read_tr16_b64_v4i16((LAS s16x4*)(lds + vb + d0 * 4096 + ks * 1024)));
                    const s16x4 hh = __builtin_bit_cast(s16x4, __builtin_amdgcn_ds_read_tr16_b64_v4i16((LAS s16x4*)(lds + vb + d0 * 4096 + ks * 1024 + 512)));
                    const bf16x8 vf = {lo[0], lo[1], lo[2], lo[3], hh[0], hh[1], hh[2], hh[3]};
                    o[d0] = __builtin_amdgcn_mfma_f32_32x32x16_bf16(pa[ks], vf, o[d0], 0, 0, 0);
                }
        }
    }
    LAS float* stg = (LAS float*)(lds + SB_OST + wid * SB_OSTW);
#pragma unroll
    for (int r = 0; r < 16; ++r) { const int q = crow(r, hi); stg[q * 68 + r32] = o[0][r]; stg[q * 68 + 32 + r32] = o[1][r]; }
    LDS_WAIT(); asm volatile("" ::: "memory");
    { const int q = lane >> 1, half = lane & 1; const LAS f32x4* sp = (const LAS f32x4*)(stg + q * 68 + 32 * half);
      f32x4 v[8]; float ss = 0.f;
#pragma unroll
      for (int i = 0; i < 8; ++i) { v[i] = sp[i]; ss += (v[i][0] * v[i][0] + v[i][1] * v[i][1]) + (v[i][2] * v[i][2] + v[i][3] * v[i][3]); }
      ss += __shfl_xor(ss, 1);
      const float rstd = __builtin_amdgcn_rsqf(ss * (1.f / 64.f) + EPS);
      const f32x4* gp = (const f32x4*)(g_sb + h * 64 + 32 * half);
      bf16_t* op = ymix + (rowbase + qlo + q) * D + 512 + h * 64 + 32 * half;
#pragma unroll
      for (int i = 0; i < 4; ++i) { const f32x4 g0 = gp[2 * i], g1 = gp[2 * i + 1], a = v[2 * i] * rstd * g0, c = v[2 * i + 1] * rstd * g1;
          u32x4 w; w.x = cvtpk_s(a[0], a[1]); w.y = cvtpk_s(a[2], a[3]); w.z = cvtpk_s(c[0], c[1]); w.w = cvtpk_s(c[2], c[3]); *(u32x4*)(op + 8 * i) = w; } }
    LDS_WAIT();
}
__device__ __forceinline__ void p2_mix(Frame& F) {
    conv_rows(F);
    if (F.G == 256) {
        const int bh = F.vcu >> 2, s = F.vcu & 3;
        sb_attn_unit(F, bh >> 3, bh & 7, 7 - s);
        sb_attn_unit(F, bh >> 3, bh & 7, s);
    } else {
        for (int u = F.vcu; u < 512; u += F.G) sb_attn_unit(F, u >> 6, (u >> 3) & 7, u & 7);
    }
}

__device__ __forceinline__ void p8_router(Frame& F) {
    const bf16_t* x2 = (const bf16_t*)(F.ws + WS_X2); const float* wr = (const float*)(F.ws + WS_WR); const float* b_router = F.in[15];
    float* lrstd = (float*)(F.ws + WS_LRSTD); int* ltok = (int*)(F.ws + WS_LTOK); float* lgate = (float*)(F.ws + WS_LGATE); unsigned* cnt = F.ctl + CW_CNT;
    LAS float* wl = (LAS float*)(F.lds + RING_OFF);
    for (int i = F.tid; i < D * NE / 4; i += NWAVES * 64) ((LAS f32x4*)wl)[i] = ((const f32x4*)wr)[i];
    __syncthreads();
    const int lane = F.lane, tk = lane & 15, kq = lane >> 4;
    const int gw = F.vcu * NWAVES + F.wave, NGW = F.G * NWAVES;
    for (int item = gw; item < M / 16; item += NGW) {
        const int tok = item * 16 + tk; const bf16_t* xr = x2 + (size_t)tok * D + 8 * kq;
        f32x4 acc0 = {0.f, 0.f, 0.f, 0.f}, acc1 = {0.f, 0.f, 0.f, 0.f}; float ss = 0.f;
#pragma unroll 4
        for (int s2 = 0; s2 < 32; ++s2) {
            const u32x4 xw = *(const u32x4*)(xr + 32 * s2);
            const float xv[8] = {bf_lo(xw.x), bf_hi(xw.x), bf_lo(xw.y), bf_hi(xw.y), bf_lo(xw.z), bf_hi(xw.z), bf_lo(xw.w), bf_hi(xw.w)};
#pragma unroll
            for (int j = 0; j < 8; ++j) { ss += xv[j] * xv[j]; const LAS float* wp = wl + (32 * s2 + 8 * kq + j) * 32 + tk;
                acc0 = __builtin_amdgcn_mfma_f32_16x16x4f32(wp[0], xv[j], acc0, 0, 0, 0); acc1 = __builtin_amdgcn_mfma_f32_16x16x4f32(wp[16], xv[j], acc1, 0, 0, 0); }
        }
        ss += __shfl_xor(ss, 16); ss += __shfl_xor(ss, 32);
        const float rstd = __builtin_amdgcn_rsqf(ss * (1.f / D) + EPS);
        float lg[32];
#pragma unroll
        for (int q = 0; q < 4; ++q)
#pragma unroll
            for (int j = 0; j < 4; ++j) { const int src = tk + 16 * q; lg[4 * q + j] = __shfl(acc0[j], src) * rstd + b_router[4 * q + j]; lg[16 + 4 * q + j] = __shfl(acc1[j], src) * rstd + b_router[16 + 4 * q + j]; }
        float tv[4]; int ti[4]; unsigned used = 0u;
#pragma unroll
        for (int k = 0; k < 4; ++k) { float bv = -INFINITY; int bi = 0;
#pragma unroll
            for (int e = 0; e < 32; ++e) { const bool ok = !((used >> e) & 1u) && lg[e] > bv; bv = ok ? lg[e] : bv; bi = ok ? e : bi; }
            tv[k] = bv; ti[k] = bi; used |= 1u << bi; }
        const float e1 = __expf(tv[1] - tv[0]), e2 = __expf(tv[2] - tv[0]), e3 = __expf(tv[3] - tv[0]); const float inv = 1.0f / (1.0f + e1 + e2 + e3);
        const int myE = kq == 0 ? ti[0] : kq == 1 ? ti[1] : kq == 2 ? ti[2] : ti[3];
        const float myG = (kq == 0 ? 1.0f : kq == 1 ? e1 : kq == 2 ? e2 : e3) * inv;
        int rank = 0, mycount = 0;
#pragma unroll 1
        for (int e = 0; e < NE; ++e) { const unsigned long long mk = __ballot(myE == e); const int pc = __popcll(mk);
            if (myE == e) rank = __popcll(mk & ((1ull << lane) - 1ull)); if (lane == e) mycount = pc; }
        unsigned base = 0u; if (lane < NE && mycount > 0) base = atomicAdd(cnt + 64 * lane, (unsigned)mycount);
        const unsigned mybase = (unsigned)__shfl((int)base, myE);
        const size_t pos = (size_t)myE * LISTCAP + mybase + rank;
        ltok[pos] = tok * 4 + kq; lgate[pos] = myG; lrstd[pos] = rstd;
    }
}

typedef float f32x2_ __attribute__((ext_vector_type(2)));
__device__ __forceinline__ void p11_load(const bf16_t* x2, const unsigned char* y, int m, int lane, u32x4 (&xv)[2], u32x2 (&yv)[8]) {
#pragma unroll
    for (int j = 0; j < 2; ++j) { const int c = 8 * lane + 512 * j; xv[j] = *(const u32x4*)(x2 + (size_t)m * D + c);
#pragma unroll
        for (int sl = 0; sl < 4; ++sl) yv[4 * j + sl] = *(const u32x2*)(y + ((size_t)m * 4 + sl) * D + c); }
}
__device__ __forceinline__ void p11_final(Frame& F) {
    const bf16_t* x2 = (const bf16_t*)(F.ws + WS_X2); const unsigned char* y = (const unsigned char*)(F.ws + WS_Y); const float* g_final = F.in[20]; float* out = F.out;
    const int gw = F.vcu * NWAVES + F.wave, NGW = F.G * NWAVES, lane = F.lane;
    if (gw >= M) return;
    f32x4 gg[4];
#pragma unroll
    for (int j = 0; j < 2; ++j) { const int c = 8 * lane + 512 * j; gg[2 * j] = *(const f32x4*)(g_final + c); gg[2 * j + 1] = *(const f32x4*)(g_final + c + 4); }
    u32x4 xv[2], xn_[2]; u32x2 yv[8], yn_[8];
    p11_load(x2, y, gw, lane, xv, yv);
    for (int m = gw; m < M; m += NGW) {
        if (m + NGW < M) p11_load(x2, y, m + NGW, lane, xn_, yn_);
        f32x4 v[4]; float ss = 0.f;
#pragma unroll
        for (int j = 0; j < 2; ++j) { f32x4 s0 = {0.f, 0.f, 0.f, 0.f}, s1 = {0.f, 0.f, 0.f, 0.f};
#pragma unroll
            for (int sl = 0; sl < 4; ++sl) { const u32x2 w = yv[4 * j + sl];
                const f32x2_ a = __builtin_amdgcn_cvt_pk_f32_fp8((int)w.x, false), b = __builtin_amdgcn_cvt_pk_f32_fp8((int)w.x, true), c = __builtin_amdgcn_cvt_pk_f32_fp8((int)w.y, false), d = __builtin_amdgcn_cvt_pk_f32_fp8((int)w.y, true);
                s0[0] += a[0]; s0[1] += a[1]; s0[2] += b[0]; s0[3] += b[1]; s1[0] += c[0]; s1[1] += c[1]; s1[2] += d[0]; s1[3] += d[1]; }
            const u32x4 xw = xv[j]; const f32x4 x0 = {bf_lo(xw.x), bf_hi(xw.x), bf_lo(xw.y), bf_hi(xw.y)}, x1 = {bf_lo(xw.z), bf_hi(xw.z), bf_lo(xw.w), bf_hi(xw.w)};
            v[2 * j] = x0 + s0 * (1.0f / Y8_SCALE); v[2 * j + 1] = x1 + s1 * (1.0f / Y8_SCALE); }
#pragma unroll
        for (int i = 0; i < 4; ++i) ss += (v[i][0] * v[i][0] + v[i][1] * v[i][1]) + (v[i][2] * v[i][2] + v[i][3] * v[i][3]);
        const float rstd = __builtin_amdgcn_rsqf(wave_sum(ss) * (1.f / D) + EPS);
#pragma unroll
        for (int j = 0; j < 2; ++j) { const int c = 8 * lane + 512 * j;
            *(f32x4*)(out + (size_t)m * D + c) = v[2 * j] * rstd * gg[2 * j]; *(f32x4*)(out + (size_t)m * D + c + 4) = v[2 * j + 1] * rstd * gg[2 * j + 1]; }
        xv[0] = xn_[0]; xv[1] = xn_[1];
#pragma unroll
        for (int i = 0; i < 8; ++i) yv[i] = yn_[i];
    }
}

constexpr int NPHASE = 13;
struct Args { const float* in[21]; float* out; unsigned char* ws; int ph_lo, ph_hi; };
static_assert(sizeof(Args) == 21 * 8 + 8 + 8 + 8, "Args has no padding");

__global__ void __launch_bounds__(NWAVES * 64, 2) fwd(Args args) {
    extern __shared__ __attribute__((aligned(16))) unsigned char lds[];
    Frame F;
    F.lds = (LAS unsigned char*)lds; F.MISC = (volatile LAS unsigned*)(F.lds + MISC_OFF);
    F.tid = threadIdx.x; F.lane = F.tid & 63; F.wave = __builtin_amdgcn_readfirstlane(F.tid >> 6);
    F.G = gridDim.x; { const int bx = blockIdx.x; F.vcu = (F.G % 8 == 0) ? (bx % 8) * (F.G / 8) + bx / 8 : bx; }
    F.ws = args.ws; F.ctl = (unsigned*)(args.ws + WS_CTL); F.out = args.out;
    F.in = args.in;
    for (int u = F.tid; u < (LDS_BYTES - LDSCTL_OFF) / 4; u += NWAVES * 64) ((LAS unsigned*)(F.lds + LDSCTL_OFF))[u] = 0u;
    __syncthreads();
    const int lo = args.ph_lo, hi = args.ph_hi;
    const bool single = (hi - lo) > 1;
    XcdBarrier bar; bar.bar = F.ctl + CW_BAR; bar.x = 0; bar.st = nullptr;
    if (single) bar = xcd_barrier_post(F.ctl + CW_BAR, F.MISC + 8);
#ifndef PH_MASK
#define PH_MASK 0x1FFF
#endif
#define IN(k) (((PH_MASK >> (k)) & 1) && lo <= (k) && (k) < hi)
#define SEAM(k) do { if (IN(k) && IN((k) + 1)) xcd_barrier(bar); } while (0)
    unsigned char* ws = args.ws;
    const int bx = (int)blockIdx.x;

    if (IN(0)) {
        p0a_prologue(F);
        if (single) xcd_barrier(bar);
    }
    if (IN(12)) {
        const bool low = bx < 64;
        if (low) {
            pg8::OrderKV S; S.init(ws + WS_MEMN, ws + WS_WKV_T, bx);
            pg8::EpiP1 E{(bf16_t*)(ws + WS_PROJ), (bf16_t*)(ws + WS_KMEM), (bf16_t*)(ws + WS_VT)};
            pg8::gemm_phase<pg8::EpiP1, pg8::OrderKV, false, false, true>(F.lds + RING_OFF, 2 * D, 2 * D, 2 * D, S, E);
        }
        const int nlow = 64 * NWAVES, nhigh = (F.G - 64) * NWAVES;
        if (low) p0b_prologue(F, bx * NWAVES + F.wave, nlow, 3 * nlow, 3 * nlow + 10 * nhigh, true);
        else p0b_prologue(F, (bx - 64) * NWAVES + F.wave, nhigh, 3 * nlow, 3 * nlow + 10 * nhigh, false);
    }
    if (IN(12) && IN(1)) xcd_barrier(bar);
    if (IN(1)) {
        const bool split = (F.G == 256) && (XITEMS_P1 > 0);
        if (!split || bx < 256 - P1_NCONV) {
            pg8::OrderIn S; S.init(ws + WS_XN, ws + WS_WIN_T, split ? 256 - P1_NCONV : F.G, bx);
            pg8::EpiP1 E{(bf16_t*)(ws + WS_PROJ), (bf16_t*)(ws + WS_KMEM), (bf16_t*)(ws + WS_VT)};
            pg8::gemm_phase<pg8::EpiP1, pg8::OrderIn, false, true, true>(F.lds + RING_OFF, 2 * D, 2 * D, 2 * D, S, E);
        } else convert_experts(F, (bx - (256 - P1_NCONV)) * NWAVES + F.wave, P1_NCONV * NWAVES, XITEMS_P1);
    }
    SEAM(1);
    if (IN(2)) { p2_mix(F); }
    SEAM(2);
    if (IN(3)) {
        pg8::OrderPlain S; S.init(ws + WS_YMIX, ws + WS_WOUT_T, D, D, M / 256, D / 256, F.G, bx);
        pg8::EpiRes<false, false> E{F.in[0], (bf16_t*)(ws + WS_X1B), nullptr, (float*)(ws + WS_SS1)};
        pg8::gemm_phase<pg8::EpiRes<false, false>, pg8::OrderPlain, false, false, true>(F.lds + RING_OFF, 2 * D, 2 * D, 2 * D, S, E);
    }
    SEAM(3);
    if (IN(4)) {
        pg8::OrderQ S; S.init(ws + WS_X1B, ws + WS_WQ_T, F.G, bx);
        pg8::EpiQm E{(bf16_t*)(ws + WS_QM), (const float*)(ws + WS_SS1)};
        pg8::gemm_phase<pg8::EpiQm, pg8::OrderQ, false, false, true>(F.lds + RING_OFF, 2 * D, 2 * D, 2 * D, S, E);
    }
    if (single && IN(4) && IN(5)) local_seam();
    if (IN(5)) {
        if (F.G == 256) {
            pg8::OrderX<0> S; S.init(ws + WS_QM, ws + WS_KMEM, F.G, bx);
            pg8::EpiSoftmax E{(bf16_t*)(ws + WS_PB)};
            pg8::gemm_phase<pg8::EpiSoftmax, pg8::OrderX<0>, false, false, true>(F.lds + RING_OFF, 2 * D, 2 * D, 2 * XHD, S, E);
        }
    }
    if (single && IN(5) && IN(6)) local_seam();
    if (IN(6)) {
        pg8::OrderX<1> S; S.init(ws + WS_PB, ws + WS_VT, F.G, bx);
        pg8::EpiO E{(bf16_t*)(ws + WS_OB)};
        pg8::gemm_phase<pg8::EpiO, pg8::OrderX<1>, false, true, true>(F.lds + RING_OFF, 2 * D, 2 * MROWS, 2 * MEMLEN, S, E);
    }
    SEAM(6);
    if (IN(7)) {
        pg8::OrderPlain S; S.init(ws + WS_OB, ws + WS_WO_T, D, D, M / 256, D / 256, F.G, bx);
        pg8::EpiRes<true, true> E{ws + WS_X1B, (bf16_t*)(ws + WS_X2), ws + WS_X2B, (float*)(ws + WS_SS2)};
        pg8::gemm_phase<pg8::EpiRes<true, true>, pg8::OrderPlain, false, false, true>(F.lds + RING_OFF, 2 * D, 2 * D, 2 * D, S, E);
    }
    SEAM(7);
    if (IN(8)) { p8_router(F); }
    SEAM(8);
    if (IN(9)) {
        pg8::OrderMoe<8, true> S; S.init(F.ctl + CW_CNT, (const int*)(ws + WS_LTOK), ws + WS_X2B, ws + WS_W1_T, F.G, bx);
        pg8::EpiAct E{(bf16_t*)(ws + WS_ACT), (const float*)(ws + WS_LRSTD), F.in[17]};
        pg8::gemm_phase<pg8::EpiAct, pg8::OrderMoe<8, true>, true, true, true, true>(F.lds + RING_OFF, D, D, D, S, E);
    }
    SEAM(9);
    if (IN(10)) {
        pg8::OrderMoe<4, false> S; S.init(F.ctl + CW_CNT, (const int*)(ws + WS_LTOK), ws + WS_ACT, ws + WS_W2_T, F.G, bx);
        pg8::EpiY E{(bf16_t*)(ws + WS_Y), (const float*)(ws + WS_LGATE), (const int*)(ws + WS_LTOK), F.in[19]};
        pg8::gemm_phase<pg8::EpiY, pg8::OrderMoe<4, false>, false, true, true, true>(F.lds + RING_OFF, DEXP, DEXP, DEXP, S, E);
    }
    SEAM(10);
    if (IN(11)) { p11_final(F); }
#undef IN
#undef SEAM
}

extern "C" void kernel_launch(void* const* d_in, const int* in_sizes, int n_in, void* d_out, int out_size, void* d_ws, size_t ws_size, hipStream_t stream) {
    static int grid = 0;
    if (grid == 0) {
        if (n_in != 21 || in_sizes[0] != M * D || out_size != M * D || ws_size < WS_END) { fprintf(stderr, "kernel_launch: unexpected shapes (n_in %d, in0 %d, out %d, ws %zu)\n", n_in, n_in > 0 ? in_sizes[0] : -1, out_size, ws_size); grid = -1; return; }
        int dev = 0, cus = 0, per_cu = 0;
        if (hipGetDevice(&dev) != hipSuccess || hipDeviceGetAttribute(&cus, hipDeviceAttributeMultiprocessorCount, dev) != hipSuccess) { grid = -1; return; }
        if (hipFuncSetAttribute((const void*)fwd, hipFuncAttributeMaxDynamicSharedMemorySize, LDS_BYTES) != hipSuccess) { fprintf(stderr, "kernel_launch: hipFuncSetAttribute failed\n"); grid = -1; return; }
        if (hipOccupancyMaxActiveBlocksPerMultiprocessor(&per_cu, (const void*)fwd, NWAVES * 64, LDS_BYTES) != hipSuccess || per_cu < 1) { fprintf(stderr, "kernel_launch: occupancy query says %d\n", per_cu); per_cu = 1; }
        (void)hipGetLastError();
        grid = cus;
    }
    if (grid < 0) return;
    (void)hipMemsetAsync((char*)d_ws + WS_CTL, 0, CTL_ZERO_BYTES, stream);
    Args a{};
    for (int i = 0; i < 21; ++i) a.in[i] = (const float*)d_in[i];
    a.out = (float*)d_out; a.ws = (unsigned char*)d_ws;
    if (MK_N_LAUNCHES == 1) {
        a.ph_lo = 0; a.ph_hi = NPHASE;
        void* kargs[] = {&a};
        hipError_t e = hipLaunchCooperativeKernel((const void*)fwd, dim3(grid), dim3(NWAVES * 64), kargs, LDS_BYTES, stream);
        if (e != hipSuccess) fprintf(stderr, "kernel_launch: cooperative launch failed: %s\n", hipGetErrorString(e));
    } else {
        for (int pi = 0; pi < NPHASE; ++pi) { const int p = pi == 0 ? 0 : pi == 1 ? 12 : pi - 1; a.ph_lo = p; a.ph_hi = p + 1; for (int rep = 0; rep < NREP(p); ++rep) hipLaunchKernelGGL(fwd, dim3(grid), dim3(NWAVES * 64), LDS_BYTES, stream, a); }
    }
}
```

```cpp
#include <hip/hip_runtime.h>
#include <cstdio>
#include <cstdint>

#ifndef MK_N_LAUNCHES
#define MK_N_LAUNCHES 1
#endif
#ifndef DUP_MASK
#define DUP_MASK 0
#endif
#define NREP(k) (((DUP_MASK >> (k)) & 1) ? 2 : 1)

constexpr int D = 1024, BATCH = 8, SEQ = 2048, M = BATCH * SEQ, MEMLEN = 256, MROWS = BATCH * MEMLEN;
constexpr int NPROJ = 3072, NE = 32, TOPK = 4, DEXP = 1024;
constexpr int XH = 4, XHD = 256;
constexpr float EPS = 1e-5f;
constexpr float LOG2E = 1.4426950408889634f;
constexpr float C2Q = 0.125f * LOG2E;
constexpr float C2X = 0.0625f * LOG2E;
#ifndef P1_CONV_PCT
#define P1_CONV_PCT 100
#endif
#ifndef P1_DYN_PCT
#define P1_DYN_PCT 22
#endif
#ifndef P1_NCONV
#define P1_NCONV 96
#endif
constexpr int N_XITEMS = NE * 8 * 32 + NE * 8 * 16;
constexpr int XITEMS_P1 = (int)((long)N_XITEMS * P1_CONV_PCT / 100);
constexpr int LISTCAP = M;
constexpr int ACT_ROWS = M * TOPK + NE * 256;

#define GAS __attribute__((address_space(1)))
#define LAS __attribute__((address_space(3)))
typedef unsigned short bf16_t;
typedef short bf16x8 __attribute__((ext_vector_type(8)));
typedef short s16x4 __attribute__((ext_vector_type(4)));
typedef float f32x4 __attribute__((ext_vector_type(4)));
typedef float f32x2 __attribute__((ext_vector_type(2)));
typedef float f32x16 __attribute__((ext_vector_type(16)));
typedef unsigned u32x4 __attribute__((ext_vector_type(4)));
typedef unsigned u32x2 __attribute__((ext_vector_type(2)));
typedef GAS unsigned gu32;

constexpr size_t MiB = 1u << 20;
constexpr size_t WS_CTL = 0, CTL_ZERO_BYTES = 1 * MiB;
constexpr size_t WS_WIN_T = 2 * MiB, WS_WOUT_T = 8 * MiB, WS_WQ_T = 10 * MiB, WS_WKV_T = 12 * MiB, WS_WO_T = 16 * MiB, WS_WR = 18 * MiB;
constexpr size_t WS_MEMN = 19 * MiB, WS_KMEM = 23 * MiB, WS_VT = 27 * MiB, WS_SS1 = 31 * MiB, WS_SS2 = 32 * MiB, WS_RSTD3 = 33 * MiB, WS_LTOK = 34 * MiB, WS_LGATE = 36 * MiB, WS_LRSTD = 38 * MiB;
constexpr size_t WS_W1_T = 40 * MiB, WS_W2_T = 168 * MiB;
constexpr size_t WS_XN = 232 * MiB, WS_PROJ = 264 * MiB, WS_YMIX = 360 * MiB;
constexpr size_t WS_X1 = 392 * MiB, WS_X1B = 456 * MiB, WS_QM = 488 * MiB, WS_PB = 520 * MiB, WS_OB = 552 * MiB, WS_X2 = 584 * MiB, WS_X2B = 648 * MiB;
constexpr size_t WS_ACT = 232 * MiB;
constexpr size_t WS_Y = 392 * MiB;
constexpr size_t WS_WQKT = 680 * MiB, WS_VWOT = 696 * MiB;
constexpr size_t WS_END = 712 * MiB;
static_assert(WS_ACT + (size_t)ACT_ROWS * DEXP <= WS_X1 && WS_Y + (size_t)M * TOPK * D * 2 <= WS_PB, "overlays");
constexpr int CW_TMO = 0, CW_CODE = 1, CW_DYN = 64, CW_BAR = 4096, CW_CNT = 8192, CW_PAN = 16384;

__device__ __forceinline__ unsigned cvt_pk_bf16(float lo, float hi) { unsigned r; asm volatile("v_cvt_pk_bf16_f32 %0, %1, %2" : "=v"(r) : "v"(lo), "v"(hi)); return r; }
__device__ __forceinline__ unsigned cvtpk_s(float lo, float hi) { typedef __bf16 bf16x2_t __attribute__((ext_vector_type(2))); f32x2 v = {lo, hi}; bf16x2_t b = __builtin_convertvector(v, bf16x2_t); return __builtin_bit_cast(unsigned, b); }
__device__ __forceinline__ float clamp448(float v) { return fminf(fmaxf(v, -448.0f), 448.0f); }
__device__ __forceinline__ unsigned pk_fp8x4(float a, float b, float c, float d) { int w = 0; w = __builtin_amdgcn_cvt_pk_fp8_f32(clamp448(a), clamp448(b), w, false); w = __builtin_amdgcn_cvt_pk_fp8_f32(clamp448(c), clamp448(d), w, true); return (unsigned)w; }
constexpr float W8_SCALE = 64.0f, ACT8_SCALE = 4.0f, Y8_SCALE = 16.0f;
constexpr int E8_ONE = 0x7F7F7F7F, E8_W = 0x79797979, E8_ACT = 0x7D7D7D7D;
__device__ __forceinline__ float bf_lo(unsigned w) { return __uint_as_float(w << 16); }
__device__ __forceinline__ float bf_hi(unsigned w) { return __uint_as_float(w & 0xffff0000u); }
__device__ __forceinline__ float wave_sum(float v) {
#pragma unroll
    for (int o = 1; o < 64; o <<= 1) v += __shfl_xor(v, o);
    return v;
}
#define LDS_WAIT() asm volatile("s_waitcnt lgkmcnt(0)" ::: "memory")
#define VM_WAIT() asm volatile("s_waitcnt vmcnt(0)" ::: "memory")

namespace pg8 {
constexpr int BM = 256, BK = 64, HALF = 128, HTB = HALF * BK * 2, STAGE_BYTES = 8 * HTB, NXCD = 8, WGM = 8;
__host__ __device__ __forceinline__ int lds_byte(int r, int c) { const int st = (r >> 4) * 2 + (c >> 5), rr = r & 15, cc = c & 31, ob = rr * 64 + cc * 2; return st * 1024 + (ob ^ (((ob >> 9) & 1) << 5)); }
__host__ __device__ __forceinline__ void stage_rc(int b, int& R, int& C) { const int st = b / 1024, sb = b % 1024, swz = sb ^ (((sb >> 9) & 1) << 5); R = (st >> 1) * 16 + swz / 64; C = (st & 1) * 32 + (swz % 64) / 2; }
__host__ __device__ __forceinline__ int perm32(int rho) { const int n = rho >> 4, i = rho & 15; return 8 * (i >> 2) + 4 * n + (i & 3); }

struct Unit { const char* a; const char* b; int pm, pn; };
struct UnitK { const char* a; const char* b; int pm, pn, kind; };
struct UnitM { const char* a; const char* b; const int* tok; int pm, pn, nvalid, e, rowoff; };

struct GridOrder {
    int nM, nN, nwg;
    __device__ __forceinline__ void init(int nM_, int nN_) { nM = nM_; nN = nN_; nwg = nM * nN; }
    __device__ __forceinline__ void map(int L, int& pm, int& pn) const {
        int wgid = L; { const int q = nwg / NXCD, r = nwg % NXCD, xcd = wgid % NXCD, off = wgid / NXCD; wgid = (xcd < r ? xcd * (q + 1) : r * (q + 1) + (xcd - r) * q) + off; }
        const int nig = WGM * nN, gid = wgid / nig, fm = gid * WGM, gsz = (nM - fm) < WGM ? (nM - fm) : WGM;
        pm = fm + ((wgid % nig) % gsz); pn = (wgid % nig) / gsz;
    }
};

typedef f32x4 Acc[2][2][4][2];

template <class Epi, class Sched, bool GATHER, bool ALIGN_EPI, bool SP2, bool F8 = false, int SCA = 0x7F7F7F7F, int SCB = 0x7F7F7F7F>
__device__ __forceinline__ void gemm_phase(LAS unsigned char* lds, const int lda, const int ldb, const int K, const Sched& S, const Epi& E) {
    const int tid = threadIdx.x, wid = __builtin_amdgcn_readfirstlane(tid >> 6), lane = tid & 63, wr = wid >> 2, wc = wid & 3, fr = lane & 15, fq = lane >> 4;
    int nt = K / 128; asm volatile("" : "+s"(nt));
    int RA[2], CA[2]; unsigned voffB[2];
#pragma unroll
    for (int i = 0; i < 2; ++i) { int R, C; stage_rc(tid * 16 + i * 8192, R, C); const int Rb = Epi::PERM ? ((R & ~31) + perm32(R & 31)) : R;
        RA[i] = R; CA[i] = C; voffB[i] = (unsigned)(Rb * ldb + C * 2); }
    const size_t kstep = (size_t)(BK * 2);
    const size_t hstepB = (size_t)HALF * ldb;
    const unsigned ldsw = (unsigned)wid * 1024u;
    const int aoff = lds_byte(wr * 64 + fr, fq * 8), boff = lds_byte(wc * 32 + fr, fq * 8);
#define PG8_SA(b, h) (((b) * 2 + (h)) * HTB)
#define PG8_SB(b, h) ((4 + (b) * 2 + (h)) * HTB)
#define PG8_STAGE(bufoff, gbase, voff) do { _Pragma("unroll") for (int _i = 0; _i < 2; ++_i) \
        __builtin_amdgcn_global_load_lds((const unsigned*)((const char*)(gbase) + (voff)[_i]), (LAS unsigned*)(lds + (bufoff) + ldsw + _i * 8192), 16, 0, 0); } while (0)
#define PG8_LDA(dst, b, h) do { _Pragma("unroll") for (int m = 0; m < 4; ++m) { if constexpr (F8) { \
            dst##8[m] = __builtin_shufflevector(*(const LAS i32x4_*)(lds + PG8_SA(b, h) + aoff + m * 2048), *(const LAS i32x4_*)(lds + PG8_SA(b, h) + aoff + m * 2048 + 1024), 0, 1, 2, 3, 4, 5, 6, 7); } \
        else { _Pragma("unroll") for (int k = 0; k < 2; ++k) dst[m][k] = *(const LAS bf16x8*)(lds + PG8_SA(b, h) + aoff + m * 2048 + k * 1024); } } } while (0)
#define PG8_LDB(dst, b, h) do { _Pragma("unroll") for (int n = 0; n < 2; ++n) { if constexpr (F8) { \
            dst##8[n] = __builtin_shufflevector(*(const LAS i32x4_*)(lds + PG8_SB(b, h) + boff + n * 2048), *(const LAS i32x4_*)(lds + PG8_SB(b, h) + boff + n * 2048 + 1024), 0, 1, 2, 3, 4, 5, 6, 7); } \
        else { _Pragma("unroll") for (int k = 0; k < 2; ++k) dst[n][k] = *(const LAS bf16x8*)(lds + PG8_SB(b, h) + boff + n * 2048 + k * 1024); } } } while (0)
#define PG8_MMA(ai, bj, At, Bt) do { __builtin_amdgcn_s_setprio(1); _Pragma("unroll") for (int m = 0; m < 4; ++m) _Pragma("unroll") for (int n = 0; n < 2; ++n) { \
        if constexpr (F8) { acc[ai][bj][m][n] = __builtin_amdgcn_mfma_scale_f32_16x16x128_f8f6f4(Bt##8[n], At##8[m], acc[ai][bj][m][n], 0, 0, 0, SCA, 0, SCB); } \
        else { _Pragma("unroll") for (int k = 0; k < 2; ++k) acc[ai][bj][m][n] = __builtin_amdgcn_mfma_f32_16x16x32_bf16(Bt[n][k], At[m][k], acc[ai][bj][m][n], 0, 0, 0); } } \
        __builtin_amdgcn_s_setprio(0); } while (0)
#define PG8_WAIT_V(n) asm volatile("s_waitcnt vmcnt(" #n ")" ::: "memory")
#define PG8_WAIT_L(n) asm volatile("s_waitcnt lgkmcnt(" #n ")" ::: "memory")
#define PG8_BAR __builtin_amdgcn_s_barrier()
#define PG8_SCHED __builtin_amdgcn_sched_barrier(0)
#define PG8_VOFFA(dst, u) do { if constexpr (GATHER) { int _t[2][2]; _Pragma("unroll") for (int _h = 0; _h < 2; ++_h) _Pragma("unroll") for (int _i = 0; _i < 2; ++_i) _t[_h][_i] = (u).tok[_h * HALF + RA[_i]]; \
        _Pragma("unroll") for (int _h = 0; _h < 2; ++_h) _Pragma("unroll") for (int _i = 0; _i < 2; ++_i) { const int _row = _h * HALF + RA[_i]; const int _tt = (_row < (u).nvalid) ? (_t[_h][_i] >> 2) : 0; dst[_h][_i] = (unsigned)(_tt * lda + CA[_i] * 2); } } \
        else { _Pragma("unroll") for (int _h = 0; _h < 2; ++_h) _Pragma("unroll") for (int _i = 0; _i < 2; ++_i) dst[_h][_i] = (unsigned)((_h * HALF + RA[_i]) * lda + CA[_i] * 2); } } while (0)
#define PG8_VOFFA_LDS(dst, u, slot) do { const LAS int* _mt = (const LAS int*)(lds + 131072 + (slot) * 3072 + 1024); _Pragma("unroll") for (int _h = 0; _h < 2; ++_h) _Pragma("unroll") for (int _i = 0; _i < 2; ++_i) { \
        const int _row = _h * HALF + RA[_i]; const int _tt = (_row < (u).nvalid) ? (_mt[_row] >> 2) : 0; dst[_h][_i] = (unsigned)(_tt * lda + CA[_i] * 2); } } while (0)
    typename Sched::U cur, nxt; int ui = 0;
    if (!S.next(0, cur)) return;
    Acc acc;
#pragma unroll
    for (int a = 0; a < 2; ++a)
#pragma unroll
        for (int b = 0; b < 2; ++b)
#pragma unroll
            for (int m = 0; m < 4; ++m)
#pragma unroll
                for (int n = 0; n < 2; ++n) acc[a][b][m][n] = (f32x4){0.f, 0.f, 0.f, 0.f};
    typedef int i32x4_ __attribute__((ext_vector_type(4))); typedef int i32x8_ __attribute__((ext_vector_type(8)));
    bf16x8 At[4][2], B0[2][2], B1[2][2]; i32x8_ At8[4], B08[2], B18[2];
    unsigned vA[2][2];
    PG8_VOFFA(vA, cur);
    const char* cA = cur.a; const char* cB = cur.b;
    E.prefetch(cur, 0, lds, wid, lane);
    if constexpr (SP2) {
        PG8_STAGE(PG8_SB(0, 0), cB, voffB); PG8_STAGE(PG8_SB(0, 1), cB + hstepB, voffB); PG8_STAGE(PG8_SA(0, 0), cA, vA[0]); PG8_STAGE(PG8_SA(0, 1), cA, vA[1]);
        if (wr == 1) PG8_BAR;
        PG8_WAIT_V(2); PG8_BAR;
        PG8_STAGE(PG8_SB(1, 0), cB + kstep, voffB); PG8_STAGE(PG8_SA(1, 0), cA + kstep, vA[0]); PG8_STAGE(PG8_SB(1, 1), cB + hstepB + kstep, voffB);
        PG8_WAIT_V(6); PG8_BAR;
    } else {
        PG8_STAGE(PG8_SB(0, 0), cB, voffB); PG8_STAGE(PG8_SA(0, 0), cA, vA[0]); PG8_STAGE(PG8_SB(0, 1), cB + hstepB, voffB); PG8_STAGE(PG8_SA(0, 1), cA, vA[1]);
        if (wr == 1) PG8_BAR;
        PG8_WAIT_V(4); PG8_BAR;
        PG8_STAGE(PG8_SB(1, 0), cB + kstep, voffB); PG8_STAGE(PG8_SA(1, 0), cA + kstep, vA[0]); PG8_STAGE(PG8_SB(1, 1), cB + hstepB + kstep, voffB);
        PG8_WAIT_V(6); PG8_BAR;
    }
    for (;;) {
        const bool has_next = S.next(ui + 1, nxt);
        const char* nA = has_next ? nxt.a : cA; const char* nB = has_next ? nxt.b : cB;
        if (has_next) E.prefetch(nxt, ui + 1, lds, wid, lane);
        for (int t = 0; t < nt; t += 2) {
            const bool last = (t == nt - 2);
            asm volatile("" : "+v"(vA[0][0]), "+v"(vA[0][1]), "+v"(vA[1][0]), "+v"(vA[1][1]), "+v"(voffB[0]), "+v"(voffB[1]));
            const char* a1 = cA + (size_t)(t + 1) * kstep;
            const char* a2 = last ? nA : cA + (size_t)(t + 2) * kstep; const char* b2 = last ? nB : cB + (size_t)(t + 2) * kstep;
            const char* a3 = a2 + kstep; const char* b3 = b2 + kstep;
            if constexpr (SP2) {
            PG8_LDB(B0, 0, 0); PG8_LDB(B1, 0, 1); PG8_SCHED; PG8_LDA(At, 0, 0); PG8_STAGE(PG8_SA(1, 1), a1, vA[1]); if (last && has_next) { if constexpr (GATHER) { PG8_VOFFA_LDS(vA, nxt, (ui + 1) % 3); } else { PG8_VOFFA(vA, nxt); } }
            PG8_WAIT_V(8); PG8_WAIT_L(0); PG8_BAR; PG8_MMA(0, 0, At, B0); PG8_MMA(0, 1, At, B1); PG8_BAR; PG8_SCHED;
            PG8_LDA(At, 0, 1); PG8_STAGE(PG8_SB(0, 0), b2, voffB); PG8_STAGE(PG8_SB(0, 1), b2 + hstepB, voffB); PG8_STAGE(PG8_SA(0, 0), a2, vA[0]);
            PG8_WAIT_V(8); PG8_WAIT_L(0); PG8_BAR; PG8_MMA(1, 0, At, B0); PG8_MMA(1, 1, At, B1); PG8_BAR; PG8_SCHED;
            PG8_LDB(B0, 1, 0); PG8_LDB(B1, 1, 1); PG8_SCHED; PG8_LDA(At, 1, 0); PG8_STAGE(PG8_SA(0, 1), a2, vA[1]);
            PG8_WAIT_V(8); PG8_WAIT_L(0); PG8_BAR; PG8_MMA(0, 0, At, B0); PG8_MMA(0, 1, At, B1); PG8_BAR; PG8_SCHED;
            PG8_LDA(At, 1, 1); PG8_STAGE(PG8_SB(1, 0), b3, voffB); PG8_STAGE(PG8_SB(1, 1), b3 + hstepB, voffB); PG8_STAGE(PG8_SA(1, 0), a3, vA[0]);
            PG8_WAIT_V(8); PG8_WAIT_L(0); PG8_BAR; PG8_MMA(1, 0, At, B0); PG8_MMA(1, 1, At, B1); PG8_BAR; PG8_SCHED;
            } else {
            PG8_LDB(B0, 0, 0); PG8_SCHED; PG8_LDA(At, 0, 0); PG8_STAGE(PG8_SA(1, 1), a1, vA[1]); if (last && has_next) { if constexpr (GATHER) { PG8_VOFFA_LDS(vA, nxt, (ui + 1) % 3); } else { PG8_VOFFA(vA, nxt); } }
            PG8_WAIT_L(8); PG8_BAR; PG8_WAIT_L(0); PG8_MMA(0, 0, At, B0); PG8_BAR; PG8_SCHED;
            PG8_LDB(B1, 0, 1); PG8_STAGE(PG8_SB(0, 0), b2, voffB);
            PG8_BAR; PG8_WAIT_L(0); PG8_MMA(0, 1, At, B1); PG8_BAR;
            PG8_LDA(At, 0, 1); PG8_STAGE(PG8_SA(0, 0), a2, vA[0]);
            PG8_BAR; PG8_WAIT_L(0); PG8_MMA(1, 0, At, B0); PG8_BAR; PG8_SCHED;
            PG8_STAGE(PG8_SB(0, 1), b2 + hstepB, voffB);
            PG8_WAIT_V(6); PG8_BAR; PG8_MMA(1, 1, At, B1); PG8_BAR;
            PG8_LDB(B0, 1, 0); PG8_SCHED; PG8_LDA(At, 1, 0); PG8_STAGE(PG8_SA(0, 1), a2, vA[1]);
            PG8_WAIT_L(8); PG8_BAR; PG8_WAIT_L(0); PG8_MMA(0, 0, At, B0); PG8_BAR; PG8_SCHED;
            PG8_LDB(B1, 1, 1); PG8_STAGE(PG8_SB(1, 0), b3, voffB);
            PG8_BAR; PG8_WAIT_L(0); PG8_MMA(0, 1, At, B1); PG8_BAR;
            PG8_LDA(At, 1, 1); PG8_STAGE(PG8_SA(1, 0), a3, vA[0]);
            PG8_BAR; PG8_WAIT_L(0); PG8_MMA(1, 0, At, B0); PG8_BAR; PG8_SCHED;
            PG8_STAGE(PG8_SB(1, 1), b3 + hstepB, voffB);
            PG8_WAIT_V(6); PG8_BAR; PG8_MMA(1, 1, At, B1); PG8_BAR;
            }
        }
        if constexpr (ALIGN_EPI) { if (wr == 0) PG8_BAR; }
        if constexpr (!Epi::AFTER_DRAIN) { E(acc, cur, ui, lds, wr, wc, fr, fq); }
        if (!has_next) break;
#pragma unroll
        for (int a = 0; a < 2; ++a)
#pragma unroll
            for (int b = 0; b < 2; ++b)
#pragma unroll
                for (int m = 0; m < 4; ++m)
#pragma unroll
                    for (int n = 0; n < 2; ++n) acc[a][b][m][n] = (f32x4){0.f, 0.f, 0.f, 0.f};
        cur = nxt; cA = nA; cB = nB; ++ui;
        if constexpr (ALIGN_EPI) { if (wr == 1) PG8_BAR; }
    }
    PG8_WAIT_V(0);
    if constexpr (!ALIGN_EPI) { if (wr == 0) PG8_BAR; }
    PG8_BAR;
    if constexpr (Epi::AFTER_DRAIN) { E.fused(acc, cur, wr, wc, fr, fq, lds, wid, lane); }
#undef PG8_SA
#undef PG8_SB
#undef PG8_STAGE
#undef PG8_LDA
#undef PG8_LDB
#undef PG8_MMA
#undef PG8_WAIT_V
#undef PG8_WAIT_L
#undef PG8_BAR
#undef PG8_SCHED
#undef PG8_VOFFA
#undef PG8_VOFFA_LDS
}

struct OrderKV {
    typedef UnitK U;
    const char *memn, *wkv_t; int c;
    __device__ __forceinline__ void init(const void* memn_, const void* wkv_t_, int c_) { memn = (const char*)memn_; wkv_t = (const char*)wkv_t_; c = c_; }
    __device__ __forceinline__ bool next(int i, UnitK& u) const {
        if (i > 0 || c >= 64) return false;
        int r = c;
        if (r < 32) { u.kind = 1; u.pm = r >> 2; u.pn = r & 3; u.a = memn + (size_t)u.pm * 256 * D * 2; u.b = wkv_t + (size_t)u.pn * 256 * D * 2; return true; }
        r -= 32;
        u.kind = 2; u.pm = r >> 2; u.pn = r & 3; u.a = memn + (size_t)u.pm * 256 * D * 2; u.b = wkv_t + (size_t)(D + u.pn * 256) * D * 2; return true;
    }
};
struct OrderIn {
    typedef UnitK U;
    const char *A, *Bt, *memn, *wkv_t; int G, c, nextra; GridOrder g0;
    __device__ __forceinline__ void init(const void* A_, const void* Bt_, const void* memn_, const void* wkv_t_, int nextra_, int G_, int c_) {
        A = (const char*)A_; Bt = (const char*)Bt_; memn = (const char*)memn_; wkv_t = (const char*)wkv_t_; nextra = nextra_; G = G_; c = c_; g0.init(M / 256, NPROJ / 256); }
    __device__ __forceinline__ bool next(int i, UnitK& u) const {
        const int L = i * G + c;
        if (L < g0.nwg) { g0.map(L, u.pm, u.pn); u.kind = 0; u.a = A + (size_t)u.pm * 256 * D * 2; u.b = Bt + (size_t)u.pn * 256 * D * 2; return true; }
        int r = L - g0.nwg; if (r >= nextra) return false;
        if (r < 32) { u.kind = 1; u.pm = r >> 2; u.pn = r & 3; u.a = memn + (size_t)u.pm * 256 * D * 2; u.b = wkv_t + (size_t)u.pn * 256 * D * 2; return true; }
        r -= 32; u.kind = 2; u.pm = r >> 2; u.pn = r & 3; u.a = memn + (size_t)u.pm * 256 * D * 2; u.b = wkv_t + (size_t)(D + u.pn * 256) * D * 2; return true;
    }
};
struct OrderPlain {
    typedef Unit U;
    const char *A, *Bt; int lda, ldb, G, c; GridOrder g0;
    __device__ __forceinline__ void init(const void* A_, const void* Bt_, int lda_, int ldb_, int nM, int nN, int G_, int c_) { A = (const char*)A_; Bt = (const char*)Bt_; lda = lda_; ldb = ldb_; G = G_; c = c_; g0.init(nM, nN); }
    __device__ __forceinline__ bool next(int i, Unit& u) const {
        const int L = i * G + c; if (L >= g0.nwg) return false;
        g0.map(L, u.pm, u.pn);
        u.a = A + (size_t)u.pm * 256 * lda * 2; u.b = Bt + (size_t)u.pn * 256 * ldb * 2; return true;
    }
};
template <int NTN, bool G1> struct OrderMoe {
    typedef UnitM U;
    const int* ltok; const char* A; const char* Bt; int G, c; int seg[4], til[4], cn[4];
    __device__ __forceinline__ void init(const unsigned* cnt, const int* ltok_, const void* A_, const void* Bt_, int G_, int c_) {
        ltok = ltok_; A = (const char*)A_; Bt = (const char*)Bt_; G = G_; c = c_;
        const int lane = threadIdx.x & 63; const int cv = (lane < NE) ? (int)__hip_atomic_load(cnt + 64 * lane, __ATOMIC_RELAXED, __HIP_MEMORY_SCOPE_AGENT) : 0;
        const int t = (cv + 255) >> 8; int incl = t;
#pragma unroll
        for (int o = 1; o < 32; o <<= 1) { const int v = __shfl_up(incl, o); if (lane >= o) incl += v; }
        const int excl = incl - t, xcd = c & 7;
#pragma unroll
        for (int q = 0; q < 4; ++q) { seg[q] = __builtin_amdgcn_readlane(excl, xcd + 8 * q); til[q] = __builtin_amdgcn_readlane(t, xcd + 8 * q); cn[q] = __builtin_amdgcn_readlane(cv, xcd + 8 * q); }
    }
    __device__ __forceinline__ bool next(int i, UnitM& u) const {
        const int xcd = c & 7, slot = c >> 3, nslot = G >> 3; int j = i * nslot + slot;
#pragma unroll
        for (int q = 0; q < 4; ++q) {
            const int nu = til[q] * NTN;
            if (j < nu) { const int e = xcd + 8 * q, mt = j / NTN, nt = j % NTN;
                u.e = e; u.pm = mt; u.pn = nt; u.rowoff = (seg[q] + mt) * 256; u.nvalid = cn[q] - mt * 256 < 256 ? cn[q] - mt * 256 : 256; u.tok = ltok + (size_t)e * LISTCAP + mt * 256;
                if (G1) { u.a = A; u.b = Bt + ((size_t)e * 2048 + (size_t)nt * 256) * D; }
                else { u.a = A + (size_t)u.rowoff * DEXP; u.b = Bt + ((size_t)e * 1024 + (size_t)nt * 256) * DEXP; }
                return true; }
            j -= nu;
        }
        return false;
    }
};

struct UnitX { const char* a; const char* b; bf16_t* out; int pm, pn; };
struct OrderPX {
    typedef UnitX U;
    const char *kmem, *vmem, *wqb, *wo_t; bf16_t *wqkt, *vwot; int c;
    __device__ __forceinline__ void init(const void* kmem_, const void* vmem_, const void* wqb_, const void* wo_t_, void* wqkt_, void* vwot_, int c_) {
        kmem = (const char*)kmem_; vmem = (const char*)vmem_; wqb = (const char*)wqb_; wo_t = (const char*)wo_t_; wqkt = (bf16_t*)wqkt_; vwot = (bf16_t*)vwot_; c = c_; }
    __device__ __forceinline__ bool next(int i, UnitX& u) const {
        if (i > 0 || c >= 256) return false;
        const int kind = c >> 7, r = c & 127, b = r >> 4, h = (r >> 2) & 3, t = r & 3; u.pm = 0; u.pn = 0;
        if (kind == 0) { u.a = kmem + ((size_t)(b * MEMLEN) * D + h * XHD) * 2; u.b = wqb + ((size_t)(t * 256) * D + h * XHD) * 2; u.out = wqkt + (size_t)b * D * D + (size_t)(h * XHD) * D + t * 256; }
        else { u.a = wo_t + ((size_t)(t * 256) * D + h * XHD) * 2; u.b = vmem + ((size_t)(b * MEMLEN) * D + h * XHD) * 2; u.out = vwot + (size_t)b * D * D + (size_t)(t * 256) * D + h * XHD; }
        return true;
    }
};
struct EpiPX {
    static constexpr bool PERM = true, AFTER_DRAIN = false;
    __device__ __forceinline__ void prefetch(const UnitX&, int, LAS unsigned char*, int, int) const {}
    __device__ __forceinline__ void operator()(const Acc& acc, const UnitX& u, int, LAS unsigned char*, int wr, int wc, int fr, int fq) const {
        const int row0 = wr * 64 + fr, col0 = wc * 32 + 8 * fq;
#pragma unroll
        for (int ai = 0; ai < 2; ++ai)
#pragma unroll
            for (int m = 0; m < 4; ++m) { bf16_t* rowp = u.out + (size_t)(row0 + ai * HALF + m * 16) * D + col0;
#pragma unroll
                for (int bj = 0; bj < 2; ++bj) { const f32x4 v0 = acc[ai][bj][m][0], v1 = acc[ai][bj][m][1];
                    u32x4 w; w.x = cvtpk_s(v0[0], v0[1]); w.y = cvtpk_s(v0[2], v0[3]); w.z = cvtpk_s(v1[0], v1[1]); w.w = cvtpk_s(v1[2], v1[3]);
                    *(u32x4*)(rowp + bj * HALF) = w; } }
    }
};
struct OrderXB {
    typedef Unit U; static constexpr bool HALFM = false;
    const char *A, *W; int G, c;
    __device__ __forceinline__ void init(const void* A_, const void* W_, int G_, int c_) { A = (const char*)A_; W = (const char*)W_; G = G_; c = c_; }
    __device__ __forceinline__ bool next(int i, Unit& u) const {
        const int L = i * G + c; if (L >= (M / 256) * XH) return false;
        const int xcd = L & 7, j = L >> 3; u.pm = xcd * 8 + (j >> 2); u.pn = j & 3;
        u.a = A + (size_t)u.pm * 256 * D * 2; u.b = W + ((size_t)(u.pm >> 3) * D * D + (size_t)u.pn * 256 * D) * 2; return true;
    }
};

struct EpiP1 {
    static constexpr bool PERM = true, AFTER_DRAIN = false;
    bf16_t *proj, *kmem, *vt;
    __device__ __forceinline__ void prefetch(const UnitK&, int, LAS unsigned char*, int, int) const {}
    __device__ __forceinline__ void operator()(const Acc& acc, const UnitK& u, int, LAS unsigned char*, int wr, int wc, int fr, int fq) const {
        bf16_t* base; int ldc; float sc = 1.f;
        if (u.kind == 0) { base = proj; ldc = NPROJ; if (u.pn >= 6 && u.pn < 8) sc = C2Q; } else if (u.kind == 1) { base = kmem; ldc = D; } else { base = vt; ldc = D; }
        const int row0 = u.pm * BM + wr * 64 + fr, col0 = u.pn * BM + wc * 32 + 8 * fq;
#pragma unroll
        for (int ai = 0; ai < 2; ++ai)
#pragma unroll
            for (int m = 0; m < 4; ++m) { bf16_t* rowp = base + (size_t)(row0 + ai * HALF + m * 16) * ldc + col0;
#pragma unroll
                for (int bj = 0; bj < 2; ++bj) { const f32x4 v0 = acc[ai][bj][m][0] * sc, v1 = acc[ai][bj][m][1] * sc;
                    u32x4 w; w.x = cvt_pk_bf16(v0[0], v0[1]); w.y = cvt_pk_bf16(v0[2], v0[3]); w.z = cvt_pk_bf16(v1[0], v1[1]); w.w = cvt_pk_bf16(v1[2], v1[3]);
                    *(u32x4*)(rowp + bj * HALF) = w; } }
    }
};
template <bool BASE16, bool OUT8> struct EpiRes {
    static constexpr bool PERM = true, AFTER_DRAIN = true;
    const void* base; bf16_t* xb; unsigned char* x8; float* ss;
    __device__ __forceinline__ void prefetch(const Unit&, int, LAS unsigned char*, int, int) const {}
    __device__ __forceinline__ void fused(Acc& acc, const Unit& u, int wr, int wc, int fr, int fq, LAS unsigned char* lds, int wid, int lane) const {
        LAS float* PSS = (LAS float*)lds;
        const int col0 = u.pn * BM + wc * 32 + 8 * fq;
#pragma unroll
        for (int ai = 0; ai < 2; ++ai)
#pragma unroll
            for (int m = 0; m < 4; ++m) { const int r = ai * HALF + wr * 64 + m * 16 + fr; const size_t off = (size_t)(u.pm * BM + r) * D + col0; float sq = 0.f;
#pragma unroll
                for (int bj = 0; bj < 2; ++bj) { f32x4 b0, b1;
                    if constexpr (BASE16) { const u32x4 w = __builtin_nontemporal_load((const u32x4*)((const bf16_t*)base + off + bj * HALF)); b0 = (f32x4){bf_lo(w.x), bf_hi(w.x), bf_lo(w.y), bf_hi(w.y)}; b1 = (f32x4){bf_lo(w.z), bf_hi(w.z), bf_lo(w.w), bf_hi(w.w)}; }
                    else { b0 = __builtin_nontemporal_load((const f32x4*)((const float*)base + off + bj * HALF)); b1 = __builtin_nontemporal_load((const f32x4*)((const float*)base + off + bj * HALF + 4)); }
                    const f32x4 o0 = b0 + acc[ai][bj][m][0], o1 = b1 + acc[ai][bj][m][1];
                    { u32x4 w; w.x = cvt_pk_bf16(o0[0], o0[1]); w.y = cvt_pk_bf16(o0[2], o0[3]); w.z = cvt_pk_bf16(o1[0], o1[1]); w.w = cvt_pk_bf16(o1[2], o1[3]); *(u32x4*)(xb + off + bj * HALF) = w; }
                    if constexpr (OUT8) { u32x2 w; w.x = pk_fp8x4(o0[0], o0[1], o0[2], o0[3]); w.y = pk_fp8x4(o1[0], o1[1], o1[2], o1[3]); *(u32x2*)(x8 + off + bj * HALF) = w; }
                    sq += ((o0[0] * o0[0] + o0[1] * o0[1]) + (o0[2] * o0[2] + o0[3] * o0[3])) + ((o1[0] * o1[0] + o1[1] * o1[1]) + (o1[2] * o1[2] + o1[3] * o1[3])); }
                sq += __shfl_xor(sq, 16); sq += __shfl_xor(sq, 32);
                if (fq == 0) PSS[r * 4 + wc] = sq; }
        __syncthreads();
        if (threadIdx.x < 256) { const f32x4 p = *(const LAS f32x4*)(PSS + threadIdx.x * 4); ss[(size_t)(u.pm * BM + threadIdx.x) * 4 + u.pn] = (p[0] + p[1]) + (p[2] + p[3]); }
        __syncthreads();
    }
};
__device__ __forceinline__ float rstd_from_ss(const float* ss, int row) {
    const f32x4 a = *(const f32x4*)(ss + (size_t)row * 4);
    return __builtin_amdgcn_rsqf(((a[0] + a[1]) + (a[2] + a[3])) * (1.0f / D) + EPS);
}
struct EpiSoftmax {
    static constexpr bool PERM = true, AFTER_DRAIN = true;
    bf16_t* pb; const float* ss;
    __device__ __forceinline__ void prefetch(const Unit&, int, LAS unsigned char*, int, int) const {}
    __device__ __forceinline__ void fused(Acc& acc, const Unit& u, int wr, int wc, int fr, int fq, LAS unsigned char* lds, int wid, int lane) const {
        LAS float* PM = (LAS float*)lds;
        LAS float* PS = (LAS float*)(lds + 4096);
#pragma unroll
        for (int ai = 0; ai < 2; ++ai)
#pragma unroll
            for (int m = 0; m < 4; ++m) { const float sc = rstd_from_ss(ss, u.pm * BM + ai * HALF + wr * 64 + m * 16 + fr) * C2X;
#pragma unroll
                for (int bj = 0; bj < 2; ++bj)
#pragma unroll
                    for (int n = 0; n < 2; ++n) acc[ai][bj][m][n] = acc[ai][bj][m][n] * sc; }
#pragma unroll
        for (int ai = 0; ai < 2; ++ai)
#pragma unroll
            for (int m = 0; m < 4; ++m) { float mx = -INFINITY;
#pragma unroll
                for (int bj = 0; bj < 2; ++bj)
#pragma unroll
                    for (int n = 0; n < 2; ++n) { const f32x4 x = acc[ai][bj][m][n]; mx = fmaxf(mx, fmaxf(fmaxf(x[0], x[1]), fmaxf(x[2], x[3]))); }
                mx = fmaxf(mx, __shfl_xor(mx, 16)); mx = fmaxf(mx, __shfl_xor(mx, 32));
                if (fq == 0) PM[(ai * HALF + wr * 64 + m * 16 + fr) * 4 + wc] = mx; }
        __syncthreads();
#pragma unroll
        for (int ai = 0; ai < 2; ++ai)
#pragma unroll
            for (int m = 0; m < 4; ++m) { const int r = ai * HALF + wr * 64 + m * 16 + fr; const f32x4 pm4 = *(const LAS f32x4*)(PM + r * 4);
                const float mx = fmaxf(fmaxf(pm4[0], pm4[1]), fmaxf(pm4[2], pm4[3])); float s = 0.f;
#pragma unroll
                for (int bj = 0; bj < 2; ++bj)
#pragma unroll
                    for (int n = 0; n < 2; ++n) { f32x4 x = acc[ai][bj][m][n];
#pragma unroll
                        for (int j = 0; j < 4; ++j) { x[j] = __builtin_amdgcn_exp2f(x[j] - mx); s += x[j]; }
                        acc[ai][bj][m][n] = x; }
                s += __shfl_xor(s, 16); s += __shfl_xor(s, 32);
                if (fq == 0) PS[r * 4 + wc] = s; }
        __syncthreads();
        const int row0 = u.pm * BM + wr * 64 + fr, col0 = u.pn * XHD + wc * 32 + 8 * fq;
#pragma unroll
        for (int ai = 0; ai < 2; ++ai)
#pragma unroll
            for (int m = 0; m < 4; ++m) { const int r = ai * HALF + wr * 64 + m * 16 + fr; const f32x4 ps4 = *(const LAS f32x4*)(PS + r * 4);
                const float inv = 1.0f / ((ps4[0] + ps4[1]) + (ps4[2] + ps4[3])); bf16_t* rowp = pb + (size_t)(row0 + ai * HALF + m * 16) * D + col0;
#pragma unroll
                for (int bj = 0; bj < 2; ++bj) { const f32x4 v0 = acc[ai][bj][m][0] * inv, v1 = acc[ai][bj][m][1] * inv;
                    u32x4 w; w.x = cvt_pk_bf16(v0[0], v0[1]); w.y = cvt_pk_bf16(v0[2], v0[3]); w.z = cvt_pk_bf16(v1[0], v1[1]); w.w = cvt_pk_bf16(v1[2], v1[3]);
                    *(u32x4*)(rowp + bj * HALF) = w; } }
        __syncthreads();
    }
};
constexpr int META_OFF = 131072, META_BYTES = 3072;
__device__ __forceinline__ void dma4(const void* g, LAS unsigned char* l) { __builtin_amdgcn_global_load_lds((const unsigned*)g, (LAS unsigned*)l, 4, 0, 0); }
__device__ __forceinline__ void dma16(const void* g, LAS unsigned char* l) { __builtin_amdgcn_global_load_lds((const unsigned*)g, (LAS unsigned*)l, 16, 0, 0); }
struct EpiAct {
    static constexpr bool PERM = true, AFTER_DRAIN = false;
    bf16_t* act; const float* lrstd; const float* b1;
    __device__ __forceinline__ void prefetch(const UnitM& u, int ui, LAS unsigned char* lds, int wid, int lane) const {
        LAS unsigned char* mb = lds + META_OFF + (ui % 3) * META_BYTES;
        if (wid < 4) dma4(lrstd + (size_t)u.e * LISTCAP + u.pm * 256 + wid * 64 + lane, mb + wid * 256);
        else dma4(u.tok + (wid - 4) * 64 + lane, mb + 1024 + (wid - 4) * 256);
        if (wid == 4) dma16(b1 + (size_t)u.e * 2048 + (lane >> 5) * 1024 + u.pn * 128 + (lane & 31) * 4, mb + 2048);
    }
    __device__ __forceinline__ void operator()(const Acc& acc, const UnitM& u, int ui, LAS unsigned char* lds, int wr, int wc, int fr, int fq) const {
        const LAS unsigned char* mb = lds + META_OFF + (ui % 3) * META_BYTES;
        const int cl = wc * 32 + 8 * fq, gcol = u.pn * 128 + cl; const LAS float* bg = (const LAS float*)(mb + 2048) + cl; const LAS float* bl = bg + 128;
        const f32x4 bg0 = *(const LAS f32x4*)bg, bg1 = *(const LAS f32x4*)(bg + 4), bl0 = *(const LAS f32x4*)bl, bl1 = *(const LAS f32x4*)(bl + 4);
        int rb = wr * 64 + fr; asm volatile("" : "+v"(rb));
#pragma unroll
        for (int ai = 0; ai < 2; ++ai)
#pragma unroll
            for (int m = 0; m < 4; ++m) { const int r = ai * HALF + m * 16 + rb; const float rs = ((const LAS float*)mb)[r] * (1.0f / W8_SCALE);
                int w[2];
#pragma unroll
                for (int n = 0; n < 2; ++n) { const f32x4 ga = acc[ai][0][m][n], la = acc[ai][1][m][n], bgn = n ? bg1 : bg0, bln = n ? bl1 : bl0; int wn = 0;
#pragma unroll
                    for (int hh = 0; hh < 2; ++hh) {
                        f32x2 g2 = (f32x2){ga[2 * hh], ga[2 * hh + 1]} * rs + (f32x2){bgn[2 * hh], bgn[2 * hh + 1]}, l2 = (f32x2){la[2 * hh], la[2 * hh + 1]} * rs + (f32x2){bln[2 * hh], bln[2 * hh + 1]};
                        g2 = __builtin_elementwise_min(g2, (f32x2){7.0f, 7.0f});
                        l2 = __builtin_elementwise_min(__builtin_elementwise_max(l2, (f32x2){-7.0f, -7.0f}), (f32x2){7.0f, 7.0f});
                        const f32x2 t2 = g2 * (-1.702f * LOG2E); f32x2 d2; d2.x = __builtin_amdgcn_exp2f(t2.x); d2.y = __builtin_amdgcn_exp2f(t2.y); d2 = d2 + 1.0f;
                        f32x2 r2; r2.x = __builtin_amdgcn_rcpf(d2.x); r2.y = __builtin_amdgcn_rcpf(d2.y);
                        const f32x2 o2 = (g2 * r2) * (l2 * ACT8_SCALE + ACT8_SCALE);
                        if (hh == 0) wn = __builtin_amdgcn_cvt_pk_fp8_f32(o2.x, o2.y, wn, false); else wn = __builtin_amdgcn_cvt_pk_fp8_f32(o2.x, o2.y, wn, true); }
                    w[n] = wn; }
                *(u32x2*)((unsigned char*)act + (size_t)(u.rowoff + r) * DEXP + gcol) = (u32x2){(unsigned)w[0], (unsigned)w[1]}; }
    }
};
struct EpiY {
    static constexpr bool PERM = true, AFTER_DRAIN = false;
    bf16_t* y; const float* lgate; const int* ltok; const float* b2;
    __device__ __forceinline__ void prefetch(const UnitM& u, int ui, LAS unsigned char* lds, int wid, int lane) const {
        LAS unsigned char* mb = lds + META_OFF + (ui % 3) * META_BYTES;
        const size_t li = (size_t)u.e * LISTCAP + u.pm * 256 + (wid & 3) * 64 + lane;
        if (wid < 4) dma4(lgate + li, mb + wid * 256); else dma4(ltok + li, mb + 1024 + (wid - 4) * 256);
        if (wid == 0) dma16(b2 + (size_t)u.e * D + u.pn * 256 + lane * 4, mb + 2048);
    }
    __device__ __forceinline__ void operator()(const Acc& acc, const UnitM& u, int ui, LAS unsigned char* lds, int wr, int wc, int fr, int fq) const {
        const LAS unsigned char* mb = lds + META_OFF + (ui % 3) * META_BYTES;
        const int cl = wc * 32 + 8 * fq, col0 = u.pn * BM + cl; const LAS float* bb = (const LAS float*)(mb + 2048) + cl;
        int rb = wr * 64 + fr; asm volatile("" : "+v"(rb));
#pragma unroll
        for (int bj = 0; bj < 2; ++bj) {
            const f32x4 bv0 = *(const LAS f32x4*)(bb + bj * HALF), bv1 = *(const LAS f32x4*)(bb + bj * HALF + 4);
#pragma unroll
            for (int ai = 0; ai < 2; ++ai)
#pragma unroll
                for (int m = 0; m < 4; ++m) { const int r = ai * HALF + m * 16 + rb;
                    if (r < u.nvalid) { const int ent = ((const LAS int*)(mb + 1024))[r]; const float gs = ((const LAS float*)mb)[r] * Y8_SCALE; unsigned char* rowp = (unsigned char*)y + (size_t)ent * D + col0;
                        const f32x4 a0 = acc[ai][bj][m][0], a1 = acc[ai][bj][m][1]; constexpr float CS = 1.0f / (W8_SCALE * ACT8_SCALE);
                        const f32x2 p0 = ((f32x2){a0[0], a0[1]} * CS + (f32x2){bv0[0], bv0[1]}) * gs, p1 = ((f32x2){a0[2], a0[3]} * CS + (f32x2){bv0[2], bv0[3]}) * gs;
                        const f32x2 p2 = ((f32x2){a1[0], a1[1]} * CS + (f32x2){bv1[0], bv1[1]}) * gs, p3 = ((f32x2){a1[2], a1[3]} * CS + (f32x2){bv1[2], bv1[3]}) * gs;
                        u32x2 w; w.x = pk_fp8x4(p0.x, p0.y, p1.x, p1.y); w.y = pk_fp8x4(p2.x, p2.y, p3.x, p3.y);
                        *(u32x2*)(rowp + bj * HALF) = w; } }
        }
    }
};
}

#define XB_TMO      128
#define XB_XCNT(j)  (256  + 64 * (j))
#define XB_XSUB(j)  (1280 + 64 * (j))
#define XB_XGEN(j)  (2304 + 64 * (j))
#define XB_TOP      3328
#define XB_TOPGEN   3392
#define XCD_BAR_WORDS 3456
#define XB_SPIN_CAP (1u << 18)
__device__ __forceinline__ unsigned xb_ld(unsigned* p)              { return __hip_atomic_load(p, __ATOMIC_RELAXED, __HIP_MEMORY_SCOPE_AGENT); }
__device__ __forceinline__ unsigned xb_add(unsigned* p, unsigned v) { return __hip_atomic_fetch_add(p, v, __ATOMIC_RELAXED, __HIP_MEMORY_SCOPE_AGENT); }
__device__ __forceinline__ unsigned xb_xcc_id() { return (unsigned)__builtin_amdgcn_s_getreg((3 << 11) | 20) & 0xFu; }
#define XB_SPIN(cond, bar) do { unsigned _sp = 0; while (cond) { __builtin_amdgcn_s_sleep(1); \
    if ((++_sp & 255u) == 0u) { if (xb_ld(&(bar)[XB_TMO])) break; if (_sp > XB_SPIN_CAP) { atomicAdd(&(bar)[XB_TMO], 1u); break; } } } } while (0)
struct XcdBarrier { unsigned* bar; unsigned x; volatile LAS unsigned* st; };
__device__ __forceinline__ XcdBarrier xcd_barrier_post(unsigned* bar, volatile LAS unsigned* st) {
    XcdBarrier b; b.bar = bar; b.x = xb_xcc_id(); b.st = st;
    if (threadIdx.x == 0) (void)xb_add(&bar[XB_XCNT(b.x)], 1u);
    return b;
}
__device__ __forceinline__ void xcd_barrier_complete(unsigned* bar, unsigned x, unsigned& nloc, unsigned& nx) {
    const unsigned G = gridDim.x * gridDim.y * gridDim.z;
    unsigned sum, cnt, mine, sp = 0u;
    for (;;) {
        sum = 0u; cnt = 0u; mine = 0u;
#pragma unroll
        for (unsigned j = 0; j < 16; ++j) { const unsigned c = xb_ld(&bar[XB_XCNT(j)]); sum += c; cnt += (c > 0u) ? 1u : 0u; mine = (j == x) ? c : mine; }
        if (sum == G) break;
        __builtin_amdgcn_s_sleep(1);
        if ((++sp & 255u) == 0u) { if (xb_ld(&bar[XB_TMO])) break; if (sp > XB_SPIN_CAP) { atomicAdd(&bar[XB_TMO], 1u); break; } }
    }
    nloc = mine > 0u ? mine : 1u; nx = cnt > 0u ? cnt : 1u;
}
__device__ __forceinline__ void xcd_barrier(const XcdBarrier& b) {
    asm volatile("s_waitcnt vmcnt(0)" ::: "memory");
    __syncthreads();
    if (threadIdx.x == 0) {
        unsigned* bar = b.bar;
        __builtin_amdgcn_s_waitcnt(0);
        unsigned nloc = b.st[0], nx = b.st[1];
        if (nloc == 0u) { xcd_barrier_complete(bar, b.x, nloc, nx); b.st[0] = nloc; b.st[1] = nx; }
        const unsigned old = xb_add(&bar[XB_XSUB(b.x)], 1u);
        const unsigned gen = old / nloc;
        if (old + 1u == (gen + 1u) * nloc) {
            __builtin_amdgcn_fence(__ATOMIC_RELEASE, "agent");
            asm volatile("s_waitcnt vmcnt(0)" ::: "memory");
            const unsigned og = xb_add(&bar[XB_TOP], 1u);
            const unsigned tg = og / nx;
            if (og + 1u == (tg + 1u) * nx) xb_add(&bar[XB_TOPGEN], 1u);
            else XB_SPIN(xb_ld(&bar[XB_TOPGEN]) == tg, bar);
            __builtin_amdgcn_fence(__ATOMIC_ACQUIRE, "agent");
            xb_add(&bar[XB_XGEN(b.x)], 1u);
            asm volatile("s_waitcnt vmcnt(0)" ::: "memory");
        } else {
            XB_SPIN(xb_ld(&bar[XB_XGEN(b.x)]) == gen, bar);
            __builtin_amdgcn_fence(__ATOMIC_ACQUIRE, "agent");
            asm volatile("s_waitcnt vmcnt(0)" ::: "memory");
        }
    }
    __syncthreads();
}

__device__ __forceinline__ void team_signal(unsigned* c) {
    asm volatile("s_waitcnt vmcnt(0)" ::: "memory");
    __syncthreads();
    if (threadIdx.x == 0) { __builtin_amdgcn_fence(__ATOMIC_RELEASE, "agent"); asm volatile("s_waitcnt vmcnt(0)" ::: "memory"); (void)xb_add(c, 1u); }
}
__device__ __forceinline__ void team_wait(unsigned* c, unsigned target, unsigned* bar) {
    if (threadIdx.x == 0) { XB_SPIN(xb_ld(c) < target, bar); __builtin_amdgcn_fence(__ATOMIC_ACQUIRE, "agent"); asm volatile("s_waitcnt vmcnt(0)" ::: "memory"); }
    __syncthreads();
}

constexpr int NWAVES = 8;
constexpr int RING_OFF = 0, RING_BYTES = 131072;
constexpr int LDSCTL_OFF = RING_BYTES + 12288, MISC_OFF = LDSCTL_OFF + 320;
constexpr int LDS_BYTES = 147456;
static_assert(MISC_OFF + 128 <= LDS_BYTES, "LDS map");

struct Frame {
    LAS unsigned char* lds; volatile LAS unsigned* MISC; unsigned* ctl; unsigned char* ws;
    int tid, lane, wave, vcu, G;
    const float* const* in; float* out;
};

__device__ __forceinline__ int nmap1(int n) { return n < 1024 ? (n >> 7) * 256 + (n & 127) : ((n - 1024) >> 7) * 256 + 128 + ((n - 1024) & 127); }
struct TItem { const float* W; bf16_t* WT; const float* g; int ldw, K, k0, n0, perm; };
__device__ __forceinline__ void titem_load(const TItem& t, f32x4 (&va)[8], f32x4 (&vb)[8], int lane) {
    const int nq = lane & 15, kp = lane >> 4;
#pragma unroll
    for (int it = 0; it < 8; ++it) { const int k = t.k0 + 2 * (kp + 4 * it); va[it] = __builtin_nontemporal_load((const f32x4*)(t.W + (size_t)k * t.ldw + t.n0 + 4 * nq)); vb[it] = __builtin_nontemporal_load((const f32x4*)(t.W + (size_t)(k + 1) * t.ldw + t.n0 + 4 * nq)); }
}
__device__ __forceinline__ void titem_store(const TItem& t, const f32x4 (&va)[8], const f32x4 (&vb)[8], LAS unsigned* scr, int lane) {
    const int nq = lane & 15, kp = lane >> 4;
#pragma unroll
    for (int it = 0; it < 8; ++it) { const int kk2 = kp + 4 * it; f32x4 a = va[it], b = vb[it];
        if (t.g) { const float g0 = t.g[t.k0 + 2 * kk2], g1 = t.g[t.k0 + 2 * kk2 + 1]; a = a * g0; b = b * g1; }
#pragma unroll
        for (int j = 0; j < 4; ++j) scr[(4 * nq + j) * 33 + kk2] = cvtpk_s(a[j], b[j]); }
    LDS_WAIT(); asm volatile("" ::: "memory");
    const int c = lane & 7;
#pragma unroll
    for (int it = 0; it < 8; ++it) { const int n = (lane >> 3) + 8 * it; const LAS unsigned* sp = scr + n * 33 + 4 * c;
        u32x4 o; o.x = sp[0]; o.y = sp[1]; o.z = sp[2]; o.w = sp[3];
        const int nn = t.n0 + n, nr = t.perm ? nmap1(nn) : nn;
        *(u32x4*)(t.WT + (size_t)nr * t.K + t.k0 + 8 * c) = o; }
    LDS_WAIT(); asm volatile("" ::: "memory");
}
__device__ __forceinline__ void titem8_run(const TItem& t, LAS unsigned* scr, int lane) {
    const int nq = lane & 15, kg = lane >> 4;
    f32x4 v[8][4];
#pragma unroll
    for (int it = 0; it < 8; ++it) { const int k = t.k0 + 4 * (kg + 4 * it); const float* p = t.W + (size_t)k * t.ldw + t.n0 + 4 * nq;
#pragma unroll
        for (int q = 0; q < 4; ++q) v[it][q] = __builtin_nontemporal_load((const f32x4*)(p + (size_t)q * t.ldw)); }
#pragma unroll
    for (int it = 0; it < 8; ++it) { const int kq = kg + 4 * it;
        float g0 = W8_SCALE, g1 = W8_SCALE, g2 = W8_SCALE, g3 = W8_SCALE;
        if (t.g) { const f32x4 gv = *(const f32x4*)(t.g + t.k0 + 4 * kq); g0 *= gv[0]; g1 *= gv[1]; g2 *= gv[2]; g3 *= gv[3]; }
#pragma unroll
        for (int j = 0; j < 4; ++j) scr[(4 * nq + j) * 33 + kq] = pk_fp8x4(v[it][0][j] * g0, v[it][1][j] * g1, v[it][2][j] * g2, v[it][3][j] * g3); }
    LDS_WAIT(); asm volatile("" ::: "memory");
    const int c = lane & 7;
#pragma unroll
    for (int it = 0; it < 8; ++it) { const int n = (lane >> 3) + 8 * it; const LAS unsigned* sp = scr + n * 33 + 4 * c;
        u32x4 o; o.x = sp[0]; o.y = sp[1]; o.z = sp[2]; o.w = sp[3];
        const int nn = t.n0 + n, nr = t.perm ? nmap1(nn) : nn;
        __builtin_nontemporal_store(o, (u32x4*)((unsigned char*)t.WT + (size_t)nr * t.K + t.k0 + 16 * c)); }
    LDS_WAIT(); asm volatile("" ::: "memory");
}
template <bool F8, class Dec> __device__ __forceinline__ void titem_loop(int first, int stride, int n, LAS unsigned* scr, int lane, const Dec& dec) {
    if (first >= n) return;
    if constexpr (F8) { TItem A; for (int i = first; i < n; i += stride) { dec(i, A); titem8_run(A, scr, lane); } }
    else {
        TItem A, B; f32x4 a0[8], a1[8], b0[8], b1[8];
        int ia = first; dec(ia, A); titem_load(A, a0, a1, lane);
        for (;;) {
            const int ib = ia + stride; const bool hb = ib < n;
            if (hb) { dec(ib, B); titem_load(B, b0, b1, lane); }
            titem_store(A, a0, a1, scr, lane);
            if (!hb) break;
            ia = ib + stride; const bool ha = ia < n;
            if (ha) { dec(ia, A); titem_load(A, a0, a1, lane); }
            titem_store(B, b0, b1, scr, lane);
            if (!ha) break;
        }
    }
}
__device__ __forceinline__ void rms_rows_to_bf16(const float* x, const float* g, bf16_t* o, int first, int stride, int n, int lane) {
    if (first >= n) return;
    const f32x4* gr = (const f32x4*)g + lane; f32x4 gg[4];
#pragma unroll
    for (int j = 0; j < 4; ++j) gg[j] = gr[64 * j];
    f32x4 v[4], w[4];
#pragma unroll
    for (int j = 0; j < 4; ++j) v[j] = __builtin_nontemporal_load((const f32x4*)(x + (size_t)first * D) + lane + 64 * j);
    for (int m = first; m < n; m += stride) {
        const int mn = m + stride;
        if (mn < n) {
#pragma unroll
            for (int j = 0; j < 4; ++j) w[j] = __builtin_nontemporal_load((const f32x4*)(x + (size_t)mn * D) + lane + 64 * j);
        }
        float sq = 0.f;
#pragma unroll
        for (int j = 0; j < 4; ++j) sq += (v[j][0] * v[j][0] + v[j][1] * v[j][1]) + (v[j][2] * v[j][2] + v[j][3] * v[j][3]);
        const float rstd = __builtin_amdgcn_rsqf(wave_sum(sq) * (1.f / D) + EPS);
        u32x2* o8 = (u32x2*)(o + (size_t)m * D) + lane;
#pragma unroll
        for (int j = 0; j < 4; ++j) { u32x2 q; q.x = cvtpk_s(v[j][0] * rstd * gg[j][0], v[j][1] * rstd * gg[j][1]); q.y = cvtpk_s(v[j][2] * rstd * gg[j][2], v[j][3] * rstd * gg[j][3]); o8[64 * j] = q; }
#pragma unroll
        for (int j = 0; j < 4; ++j) v[j] = w[j];
    }
}
__device__ __forceinline__ void convert_experts(Frame& F, int first, int stride, int end) {
    LAS unsigned* scr = (LAS unsigned*)(F.lds + RING_OFF + F.wave * 16384);
    const float *g_moe = F.in[13], *w1 = F.in[16], *w2 = F.in[18];
    unsigned char *w1_t = F.ws + WS_W1_T, *w2_t = F.ws + WS_W2_T;
    constexpr int I_2 = NE * 8 * 16;
    titem_loop<true>(first, stride, end, scr, F.lane, [=](int r, TItem& t) {
        t.g = nullptr; t.perm = 0; t.K = D;
        if (r < I_2) { const int ex = r / 128, q = r % 128; t.W = w2 + (size_t)ex * DEXP * D; t.WT = (bf16_t*)(w2_t + (size_t)ex * D * DEXP); t.ldw = D; t.k0 = (q / 16) * 128; t.n0 = (q % 16) * 64; return; } r -= I_2;
        { const int ex = r / 256, q = r % 256; t.W = w1 + (size_t)ex * D * 2048; t.WT = (bf16_t*)(w1_t + (size_t)ex * 2048 * D); t.g = g_moe; t.ldw = 2048; t.perm = 1; t.k0 = (q / 32) * 128; t.n0 = (q % 32) * 64; }
    });
}
__device__ __forceinline__ void p0_prologue(Frame& F) {
    LAS unsigned* scr = (LAS unsigned*)(F.lds + RING_OFF + F.wave * 16384);
    const int gw = F.vcu * NWAVES + F.wave, NGW = F.G * NWAVES;
    const float *x = F.in[0], *mem = F.in[1], *g_mix = F.in[2], *w_in = F.in[3], *w_out = F.in[7], *g_xattn = F.in[8], *g_mem = F.in[9], *w_q = F.in[10], *w_kv = F.in[11], *w_o = F.in[12], *g_moe = F.in[13], *w_router = F.in[14];
    bf16_t *win_t = (bf16_t*)(F.ws + WS_WIN_T), *wout_t = (bf16_t*)(F.ws + WS_WOUT_T), *wq_t = (bf16_t*)(F.ws + WS_WQ_T), *wkv_t = (bf16_t*)(F.ws + WS_WKV_T), *wo_t = (bf16_t*)(F.ws + WS_WO_T),
           *xn = (bf16_t*)(F.ws + WS_XN), *memn = (bf16_t*)(F.ws + WS_MEMN);
    bf16_t* wr = (bf16_t*)(F.ws + WS_WR);
    for (int i = gw; i < D * NE / 64; i += NGW) { const int idx = i * 64 + F.lane, k = idx >> 5, ex = idx & 31; const float w = w_router[idx] * g_moe[k];
        const unsigned hi = cvtpk_s(w, 0.f) & 0xffffu; const float rem = w - __uint_as_float(hi << 16); const unsigned lo = cvtpk_s(rem, 0.f) & 0xffffu;
        const int ti = (k >> 3) * 256 + ex * 8 + (k & 7);
        wr[ti] = (bf16_t)hi; wr[NE * D + ti] = (bf16_t)lo; }
    rms_rows_to_bf16(mem, g_mem, memn, gw, NGW, MROWS, F.lane);
    for (int i = gw * 64 + F.lane; i < D * D / 4; i += NGW * 64) {
        const f32x4 v = __builtin_nontemporal_load((const f32x4*)w_q + i) * g_xattn[i >> 8]; u32x2 w; w.x = cvtpk_s(v[0], v[1]); w.y = cvtpk_s(v[2], v[3]); ((u32x2*)wq_t)[i] = w; }
    constexpr int I_KV = 16 * 32, I_O = 16 * 16, I_OUT = 16 * 16, I_IN = 16 * 48;
    titem_loop<false>(gw, NGW, I_KV + I_O + I_OUT + I_IN, scr, F.lane, [=](int r, TItem& t) {
        t.g = nullptr; t.perm = 0; t.K = D; t.ldw = D;
        if (r < I_KV) { t.W = w_kv; t.WT = wkv_t; t.ldw = 2 * D; t.k0 = (r / 32) * 64; t.n0 = (r % 32) * 64; return; } r -= I_KV;
        if (r < I_O) { t.W = w_o; t.WT = wo_t; t.k0 = (r / 16) * 64; t.n0 = (r % 16) * 64; return; } r -= I_O;
        if (r < I_OUT) { t.W = w_out; t.WT = wout_t; t.k0 = (r / 16) * 64; t.n0 = (r % 16) * 64; return; } r -= I_OUT;
        { t.W = w_in; t.WT = win_t; t.ldw = NPROJ; t.k0 = (r / 48) * 64; t.n0 = (r % 48) * 64; }
    });
    rms_rows_to_bf16(x, g_mix, xn, gw, NGW, M, F.lane);
}

__device__ __forceinline__ void conv_rows(Frame& F) {
    const bf16_t* proj = (const bf16_t*)(F.ws + WS_PROJ); bf16_t* ymix = (bf16_t*)(F.ws + WS_YMIX);
    const float* conv_w = F.in[4]; const float* g_conv = F.in[5];
    const int gw = F.vcu * NWAVES + F.wave, NGW = F.G * NWAVES, c0 = 8 * F.lane;
    float w0[8], w1[8], w2[8], gg[8];
#pragma unroll
    for (int j = 0; j < 8; ++j) { w0[j] = conv_w[c0 + j]; w1[j] = conv_w[512 + c0 + j]; w2[j] = conv_w[1024 + c0 + j]; gg[j] = g_conv[c0 + j]; }
    auto ld = [&](int m, u32x4 (&v)[7]) {
        const int t = m & (SEQ - 1); const bf16_t* row = proj + (size_t)m * NPROJ + c0;
        v[0] = *(const u32x4*)row; v[1] = *(const u32x4*)(row + 512); v[2] = *(const u32x4*)(row + 1024);
        v[3] = (u32x4){0, 0, 0, 0}; v[4] = v[3]; v[5] = v[3]; v[6] = v[3];
        if (t >= 1) { v[3] = *(const u32x4*)(row - NPROJ + 512); v[4] = *(const u32x4*)(row - NPROJ + 1024); }
        if (t >= 2) { v[5] = *(const u32x4*)(row - 2 * NPROJ + 512); v[6] = *(const u32x4*)(row - 2 * NPROJ + 1024); }
    };
    if (gw >= M) return;
    u32x4 cur[7], nx[7];
    ld(gw, cur);
    for (int m = gw; m < M; m += NGW) {
        if (m + NGW < M) ld(m + NGW, nx);
        const u32x4 bg = cur[0], cg0 = cur[1], xv0 = cur[2], cg1 = cur[3], xv1 = cur[4], cg2 = cur[5], xv2 = cur[6];
        float y[8]; float ss = 0.f;
#pragma unroll
        for (int j = 0; j < 4; ++j) {
            const float u0l = bf_lo(cg0[j]) * bf_lo(xv0[j]), u0h = bf_hi(cg0[j]) * bf_hi(xv0[j]);
            const float u1l = bf_lo(cg1[j]) * bf_lo(xv1[j]), u1h = bf_hi(cg1[j]) * bf_hi(xv1[j]);
            const float u2l = bf_lo(cg2[j]) * bf_lo(xv2[j]), u2h = bf_hi(cg2[j]) * bf_hi(xv2[j]);
            y[2 * j] = bf_lo(bg[j]) * (w0[2 * j] * u2l + w1[2 * j] * u1l + w2[2 * j] * u0l);
            y[2 * j + 1] = bf_hi(bg[j]) * (w0[2 * j + 1] * u2h + w1[2 * j + 1] * u1h + w2[2 * j + 1] * u0h);
            ss += y[2 * j] * y[2 * j] + y[2 * j + 1] * y[2 * j + 1];
        }
        ss += __shfl_xor(ss, 1); ss += __shfl_xor(ss, 2); ss += __shfl_xor(ss, 4);
        const float rstd = __builtin_amdgcn_rsqf(ss * (1.f / 64.f) + EPS);
        u32x4 o; o.x = cvtpk_s(y[0] * rstd * gg[0], y[1] * rstd * gg[1]); o.y = cvtpk_s(y[2] * rstd * gg[2], y[3] * rstd * gg[3]);
        o.z = cvtpk_s(y[4] * rstd * gg[4], y[5] * rstd * gg[5]); o.w = cvtpk_s(y[6] * rstd * gg[6], y[7] * rstd * gg[7]);
        *(u32x4*)(ymix + (size_t)m * D + c0) = o;
#pragma unroll
        for (int i = 0; i < 7; ++i) cur[i] = nx[i];
    }
}
constexpr int SB_SLOT = 16384, SB_V = 8192, SB_OST = 4 * SB_SLOT, SB_OSTW = 32 * 68 * 4, SB_FLAG = SB_OST + 8 * SB_OSTW;
static_assert(SB_FLAG + 32 <= RING_BYTES + 12288, "attention LDS (the O stage may extend into the GEMM phases' metadata area, unused here)");
__device__ __forceinline__ int crow(int r, int hi) { return (r & 3) + 8 * (r >> 2) + 4 * hi; }
__device__ __forceinline__ void sb_attn_unit(Frame& F, int b, int h, int qb) {
    const bf16_t* proj = (const bf16_t*)(F.ws + WS_PROJ); bf16_t* ymix = (bf16_t*)(F.ws + WS_YMIX); const float* g_sb = F.in[6];
    const int tid = F.tid, lane = F.lane, wid = F.wave, r32 = lane & 31, hi = lane >> 5;
    LAS unsigned char* lds = F.lds + RING_OFF;
    const int q0 = qb * 256, qlo = q0 + wid * 32, qpos = qlo + r32;
    const size_t rowbase = (size_t)b * SEQ;
    const bf16_t* Qp = proj + (rowbase + qlo) * NPROJ + 1536 + h * 64;
    const bf16_t* Kp = proj + rowbase * NPROJ + 2048 + h * 64;
    const bf16_t* Vp = proj + rowbase * NPROJ + 2560 + h * 64;
    bf16x8 qr[4];
#pragma unroll
    for (int s = 0; s < 4; ++s) qr[s] = *(const bf16x8*)(Qp + (size_t)r32 * NPROJ + 16 * s + 8 * hi);
    bf16x8 ntri[2], nones;
#pragma unroll
    for (int s = 0; s < 2; ++s)
#pragma unroll
        for (int j = 0; j < 8; ++j) { const int k = 16 * s + 8 * (j >> 2) + 4 * hi + (j & 3); ntri[s][j] = (k > r32) ? (short)0xBF80 : (short)0; }
#pragma unroll
    for (int j = 0; j < 8; ++j) nones[j] = (short)0xBF80;
    f32x16 R = {}; f32x16 o[2]; o[0] = f32x16{}; o[1] = f32x16{};
    const int skey = tid >> 3, sc = tid & 7;
    const int koff = skey * 128 + ((sc ^ ((skey >> 1) & 7)) << 4);
    const int voff = SB_V + (sc >> 2) * 4096 + (skey >> 4) * 1024 + (skey & 15) * 64 + (sc & 3) * 16;
    const int vbl = SB_V + ((lane >> 4) & 1) * 32 + (lane & 3) * 8 + (4 * hi + ((lane & 15) >> 2)) * 64;
    const int dw = 4 * qb + (wid >> 1);
    LAS int* dflag = (LAS int*)(lds + SB_FLAG);
    __syncthreads();
    {   u32x4 kr[4], vr[4];
#pragma unroll
        for (int p = 0; p < 4; ++p) { const size_t row = (size_t)((4 * qb + p) * 64 + skey) * NPROJ + sc * 8; kr[p] = *(const u32x4*)(Kp + row); vr[p] = *(const u32x4*)(Vp + row); }
#pragma unroll
        for (int p = 0; p < 4; ++p) { const int so = ((4 * qb + p) & 3) * SB_SLOT; *(LAS u32x4*)(lds + so + koff) = kr[p]; *(LAS u32x4*)(lds + so + voff) = vr[p]; } }
    int nb = 4 * qb - 1;
    u32x4 kreg = {0, 0, 0, 0}, vreg = {0, 0, 0, 0};
    if (nb >= 0) { const size_t row = (size_t)(nb * 64 + skey) * NPROJ + sc * 8; kreg = *(const u32x4*)(Kp + row); vreg = *(const u32x4*)(Vp + row); }
    __syncthreads();
    int done = 0;
    for (int kbi = dw; ; --kbi) {
        if (kbi < 0) done = 1;
        const int k0 = kbi * 64, so = (kbi & 3) * SB_SLOT, vb = so + vbl;
        if (!done) {
            f32x16 p0 = {}, p1 = {};
#pragma unroll
            for (int s = 0; s < 4; ++s) { const int c = 2 * s + hi;
                const bf16x8 ka = *(const LAS bf16x8*)(lds + so + r32 * 128 + ((c ^ ((r32 >> 1) & 7)) << 4));
                const bf16x8 kb = *(const LAS bf16x8*)(lds + so + (r32 + 32) * 128 + ((c ^ (((r32 + 32) >> 1) & 7)) << 4));
                p0 = __builtin_amdgcn_mfma_f32_32x32x16_bf16(ka, qr[s], p0, 0, 0, 0); p1 = __builtin_amdgcn_mfma_f32_32x32x16_bf16(kb, qr[s], p1, 0, 0, 0); }
            const bool diag = (k0 + 63 >= qlo);
            f32x16 s0, s1;
#pragma unroll
            for (int r = 0; r < 16; ++r) {
                const float z0 = p0[r], z1 = p1[r];
                float sp0 = fmaxf(z0, 0.f) + __builtin_amdgcn_logf(1.0f + __builtin_amdgcn_exp2f(-fabsf(z0)));
                float sp1 = fmaxf(z1, 0.f) + __builtin_amdgcn_logf(1.0f + __builtin_amdgcn_exp2f(-fabsf(z1)));
                if (diag) { const int key = k0 + crow(r, hi); if (key >= qpos) sp0 = 0.f; if (key + 32 >= qpos) sp1 = 0.f; }
                s0[r] = sp0; s1[r] = sp1; p0[r] = z0 - sp0; p1[r] = z1 - sp1;
            }
            u32x4 w00 = {cvtpk_s(s0[0], s0[1]), cvtpk_s(s0[2], s0[3]), cvtpk_s(s0[4], s0[5]), cvtpk_s(s0[6], s0[7])}, w01 = {cvtpk_s(s0[8], s0[9]), cvtpk_s(s0[10], s0[11]), cvtpk_s(s0[12], s0[13]), cvtpk_s(s0[14], s0[15])};
            u32x4 w10 = {cvtpk_s(s1[0], s1[1]), cvtpk_s(s1[2], s1[3]), cvtpk_s(s1[4], s1[5]), cvtpk_s(s1[6], s1[7])}, w11 = {cvtpk_s(s1[8], s1[9]), cvtpk_s(s1[10], s1[11]), cvtpk_s(s1[12], s1[13]), cvtpk_s(s1[14], s1[15])};
            const bf16x8 sb00 = __builtin_bit_cast(bf16x8, w00), sb01 = __builtin_bit_cast(bf16x8, w01), sb10 = __builtin_bit_cast(bf16x8, w10), sb11 = __builtin_bit_cast(bf16x8, w11);
            f32x16 rest1 = __builtin_amdgcn_mfma_f32_32x32x16_bf16(ntri[0], sb10, R, 0, 0, 0); rest1 = __builtin_amdgcn_mfma_f32_32x32x16_bf16(ntri[1], sb11, rest1, 0, 0, 0);
            f32x16 U = __builtin_amdgcn_mfma_f32_32x32x16_bf16(nones, sb10, R, 0, 0, 0); U = __builtin_amdgcn_mfma_f32_32x32x16_bf16(nones, sb11, U, 0, 0, 0);
            f32x16 rest0 = __builtin_amdgcn_mfma_f32_32x32x16_bf16(ntri[0], sb00, U, 0, 0, 0); rest0 = __builtin_amdgcn_mfma_f32_32x32x16_bf16(ntri[1], sb01, rest0, 0, 0, 0);
            R = __builtin_amdgcn_mfma_f32_32x32x16_bf16(nones, sb00, U, 0, 0, 0); R = __builtin_amdgcn_mfma_f32_32x32x16_bf16(nones, sb01, R, 0, 0, 0);
            done = __all(R[0] < -150.0f) ? 1 : 0;
#pragma unroll
            for (int r = 0; r < 16; ++r) {
                float a0 = __builtin_amdgcn_exp2f(p0[r] + rest0[r]), a1 = __builtin_amdgcn_exp2f(p1[r] + rest1[r]);
                if (diag) { const int key = k0 + crow(r, hi); if (key >= qpos) a0 = 0.f; if (key + 32 >= qpos) a1 = 0.f; }
                p0[r] = a0; p1[r] = a1;
            }
            u32x4 a00 = {cvtpk_s(p0[0], p0[1]), cvtpk_s(p0[2], p0[3]), cvtpk_s(p0[4], p0[5]), cvtpk_s(p0[6], p0[7])}, a01 = {cvtpk_s(p0[8], p0[9]), cvtpk_s(p0[10], p0[11]), cvtpk_s(p0[12], p0[13]), cvtpk_s(p0[14], p0[15])};
            u32x4 a10 = {cvtpk_s(p1[0], p1[1]), cvtpk_s(p1[2], p1[3]), cvtpk_s(p1[4], p1[5]), cvtpk_s(p1[6], p1[7])}, a11 = {cvtpk_s(p1[8], p1[9]), cvtpk_s(p1[10], p1[11]), cvtpk_s(p1[12], p1[13]), cvtpk_s(p1[14], p1[15])};
            const bf16x8 pa[4] = {__builtin_bit_cast(bf16x8, a00), __builtin_bit_cast(bf16x8, a01), __builtin_bit_cast(bf16x8, a10), __builtin_bit_cast(bf16x8, a11)};
#pragma unroll
            for (int d0 = 0; d0 < 2; ++d0)
#pragma unroll
                for (int ks = 0; ks < 4; ++ks) {
                    const s16x4 lo = __builtin_bit_cast(s16x4, __builtin_amdgcn_ds_read_tr16_b64_v4i16((LAS s16x4*)(lds + vb + d0 * 4096 + ks * 1024)));
                    const s16x4 hh = __builtin_bit_cast(s16x4, __builtin_amdgcn_ds_read_tr16_b64_v4i16((LAS s16x4*)(lds + vb + d0 * 4096 + ks * 1024 + 512)));
                    const bf16x8 vf = {lo[0], lo[1], lo[2], lo[3], hh[0], hh[1], hh[2], hh[3]};
                    o[d0] = __builtin_amdgcn_mfma_f32_32x32x16_bf16(pa[ks], vf, o[d0], 0, 0, 0);
                }
        }
        __syncthreads();
        if (nb >= 0) { const int sn = (nb & 3) * SB_SLOT; *(LAS u32x4*)(lds + sn + koff) = kreg; *(LAS u32x4*)(lds + sn + voff) = vreg; }
        if (lane == 0) dflag[wid] = done;
        __syncthreads();
        { const u32x4 f0 = *(const LAS u32x4*)dflag, f1 = *(const LAS u32x4*)(dflag + 4); if ((f0.x & f0.y & f0.z & f0.w & f1.x & f1.y & f1.z & f1.w) != 0u) break; }
        --nb;
        if (nb >= 0) { const size_t row = (size_t)(nb * 64 + skey) * NPROJ + sc * 8; kreg = *(const u32x4*)(Kp + row); vreg = *(const u32x4*)(Vp + row); }
    }
    LAS float* stg = (LAS float*)(lds + SB_OST + wid * SB_OSTW);
#pragma unroll
    for (int r = 0; r < 16; ++r) { const int q = crow(r, hi); stg[q * 68 + r32] = o[0][r]; stg[q * 68 + 32 + r32] = o[1][r]; }
    LDS_WAIT(); asm volatile("" ::: "memory");
    { const int q = lane >> 1, half = lane & 1; const LAS f32x4* sp = (const LAS f32x4*)(stg + q * 68 + 32 * half);
      f32x4 v[8]; float ss = 0.f;
#pragma unroll
      for (int i = 0; i < 8; ++i) { v[i] = sp[i]; ss += (v[i][0] * v[i][0] + v[i][1] * v[i][1]) + (v[i][2] * v[i][2] + v[i][3] * v[i][3]); }
      ss += __shfl_xor(ss, 1);
      const float rstd = __builtin_amdgcn_rsqf(ss * (1.f / 64.f) + EPS);
      const f32x4* gp = (const f32x4*)(g_sb + h * 64 + 32 * half);
      bf16_t* op = ymix + (rowbase + qlo + q) * D + 512 + h * 64 + 32 * half;
#pragma unroll
      for (int i = 0; i < 4; ++i) { const f32x4 g0 = gp[2 * i], g1 = gp[2 * i + 1], a = v[2 * i] * rstd * g0, c = v[2 * i + 1] * rstd * g1;
          u32x4 w; w.x = cvtpk_s(a[0], a[1]); w.y = cvtpk_s(a[2], a[3]); w.z = cvtpk_s(c[0], c[1]); w.w = cvtpk_s(c[2], c[3]); *(u32x4*)(op + 8 * i) = w; } }
    LDS_WAIT();
}
__device__ __forceinline__ void p2_mix(Frame& F) {
    conv_rows(F);
    if (F.G == 256) {
        const int bh = F.vcu >> 2, s = F.vcu & 3;
        sb_attn_unit(F, bh >> 3, bh & 7, 7 - s);
        sb_attn_unit(F, bh >> 3, bh & 7, s);
    } else {
        for (int u = F.vcu; u < 512; u += F.G) sb_attn_unit(F, u >> 6, (u >> 3) & 7, u & 7);
    }
}

__device__ __forceinline__ void p8_router(Frame& F) {
    const bf16_t* x2 = (const bf16_t*)(F.ws + WS_X2); const bf16_t* wt = (const bf16_t*)(F.ws + WS_WR); const float* b_router = F.in[15];
    float* lrstd = (float*)(F.ws + WS_LRSTD); int* ltok = (int*)(F.ws + WS_LTOK); float* lgate = (float*)(F.ws + WS_LGATE); unsigned* cnt = F.ctl + CW_CNT;
    const int lane = F.lane, c32 = lane & 31, hi = lane >> 5, wid = F.wave, kpart = wid & 3, grp = wid >> 2;
    LAS float* part = (LAS float*)(F.lds + RING_OFF);
    for (int item = 2 * F.vcu + grp; item < M / 32; item += 2 * F.G) {
        const int tok = item * 32 + c32; const bf16_t* xr = x2 + (size_t)tok * D + 256 * kpart + 8 * hi; const bf16_t* wh = wt + (size_t)(32 * kpart + hi) * 256 + c32 * 8; const bf16_t* wl = wh + NE * D;
        f32x16 acc = {}; float ss = 0.f;
#pragma unroll 4
        for (int s2 = 0; s2 < 16; ++s2) {
            const u32x4 xw = *(const u32x4*)(xr + 16 * s2); const bf16x8 xb = __builtin_bit_cast(bf16x8, xw);
            const bf16x8 a_hi = *(const bf16x8*)(wh + 512 * s2), a_lo = *(const bf16x8*)(wl + 512 * s2);
            acc = __builtin_amdgcn_mfma_f32_32x32x16_bf16(a_hi, xb, acc, 0, 0, 0); acc = __builtin_amdgcn_mfma_f32_32x32x16_bf16(a_lo, xb, acc, 0, 0, 0);
            const float x0 = bf_lo(xw.x), x1 = bf_hi(xw.x), x2_ = bf_lo(xw.y), x3 = bf_hi(xw.y), x4 = bf_lo(xw.z), x5 = bf_hi(xw.z), x6 = bf_lo(xw.w), x7 = bf_hi(xw.w);
            ss += ((x0 * x0 + x1 * x1) + (x2_ * x2_ + x3 * x3)) + ((x4 * x4 + x5 * x5) + (x6 * x6 + x7 * x7));
        }
        __syncthreads();
#pragma unroll
        for (int r = 0; r < 16; ++r) part[(wid * 17 + r) * 64 + lane] = acc[r];
        part[(wid * 17 + 16) * 64 + lane] = ss;
        __syncthreads();
        if (kpart == 0) {
#pragma unroll
            for (int r = 0; r < 16; ++r) acc[r] = ((part[((wid + 0) * 17 + r) * 64 + lane] + part[((wid + 1) * 17 + r) * 64 + lane]) + (part[((wid + 2) * 17 + r) * 64 + lane] + part[((wid + 3) * 17 + r) * 64 + lane]));
            ss = (part[((wid + 0) * 17 + 16) * 64 + lane] + part[((wid + 1) * 17 + 16) * 64 + lane]) + (part[((wid + 2) * 17 + 16) * 64 + lane] + part[((wid + 3) * 17 + 16) * 64 + lane]);
            ss += __shfl_xor(ss, 32);
            const float rstd = __builtin_amdgcn_rsqf(ss * (1.f / D) + EPS);
            float lg[32];
#pragma unroll
            for (int r = 0; r < 16; ++r) { const float mine = acc[r], other = __shfl_xor(acc[r], 32); const int e0 = (r & 3) + 8 * (r >> 2);
                lg[e0] = (hi ? other : mine) * rstd + b_router[e0]; lg[e0 + 4] = (hi ? mine : other) * rstd + b_router[e0 + 4]; }
            float tv[4] = {0.f, 0.f, 0.f, 0.f}; int ti[4] = {0, 0, 0, 0}; unsigned used = 0u;
#pragma unroll 1
            for (int k = 0; k < 4; ++k) { float bv = -INFINITY; int bi = 0;
#pragma unroll
                for (int e = 0; e < 32; ++e) { const bool ok = !((used >> e) & 1u) && lg[e] > bv; bv = ok ? lg[e] : bv; bi = ok ? e : bi; }
                used |= 1u << bi;
                tv[3] = (k == 3) ? bv : tv[3]; tv[2] = (k == 2) ? bv : tv[2]; tv[1] = (k == 1) ? bv : tv[1]; tv[0] = (k == 0) ? bv : tv[0];
                ti[3] = (k == 3) ? bi : ti[3]; ti[2] = (k == 2) ? bi : ti[2]; ti[1] = (k == 1) ? bi : ti[1]; ti[0] = (k == 0) ? bi : ti[0]; }
            const float e1 = __expf(tv[1] - tv[0]), e2 = __expf(tv[2] - tv[0]), e3 = __expf(tv[3] - tv[0]); const float inv = 1.0f / (1.0f + e1 + e2 + e3);
            const int E0 = hi ? ti[2] : ti[0], E1 = hi ? ti[3] : ti[1];
            const float G0 = (hi ? e2 : 1.0f) * inv, G1 = (hi ? e3 : e1) * inv;
            int rank0 = 0, rank1 = 0, mycount = 0;
#pragma unroll 1
            for (int e = 0; e < NE; ++e) { const unsigned long long m0 = __ballot(E0 == e), m1 = __ballot(E1 == e); const int p0 = __popcll(m0), p1 = __popcll(m1);
                if (E0 == e) rank0 = __popcll(m0 & ((1ull << lane) - 1ull)); if (E1 == e) rank1 = p0 + __popcll(m1 & ((1ull << lane) - 1ull)); if (lane == e) mycount = p0 + p1; }
            unsigned base = 0u; if (lane < NE && mycount > 0) base = atomicAdd(cnt + 64 * lane, (unsigned)mycount);
            const size_t pos0 = (size_t)E0 * LISTCAP + (unsigned)__shfl((int)base, E0) + rank0, pos1 = (size_t)E1 * LISTCAP + (unsigned)__shfl((int)base, E1) + rank1;
            ltok[pos0] = tok * 4 + 2 * hi; lgate[pos0] = G0; lrstd[pos0] = rstd;
            ltok[pos1] = tok * 4 + 2 * hi + 1; lgate[pos1] = G1; lrstd[pos1] = rstd;
        }
    }
}

typedef float f32x2_ __attribute__((ext_vector_type(2)));
__device__ __forceinline__ void p11_load(const bf16_t* x2, const unsigned char* y, int m, int lane, u32x4 (&xv)[2], u32x2 (&yv)[8]) {
#pragma unroll
    for (int j = 0; j < 2; ++j) { const int c = 8 * lane + 512 * j; xv[j] = __builtin_nontemporal_load((const u32x4*)(x2 + (size_t)m * D + c));
#pragma unroll
        for (int sl = 0; sl < 4; ++sl) yv[4 * j + sl] = __builtin_nontemporal_load((const u32x2*)(y + ((size_t)m * 4 + sl) * D + c)); }
}
__device__ __forceinline__ void p11_final(Frame& F) {
    const bf16_t* x2 = (const bf16_t*)(F.ws + WS_X2); const unsigned char* y = (const unsigned char*)(F.ws + WS_Y); const float* g_final = F.in[20]; float* out = F.out;
    const int gw = F.vcu * NWAVES + F.wave, NGW = F.G * NWAVES, lane = F.lane;
    if (gw >= M) return;
    f32x4 gg[4];
#pragma unroll
    for (int j = 0; j < 2; ++j) { const int c = 8 * lane + 512 * j; gg[2 * j] = *(const f32x4*)(g_final + c); gg[2 * j + 1] = *(const f32x4*)(g_final + c + 4); }
    u32x4 xv[2], xn_[2]; u32x2 yv[8], yn_[8];
    p11_load(x2, y, gw, lane, xv, yv);
    for (int m = gw; m < M; m += NGW) {
        if (m + NGW < M) p11_load(x2, y, m + NGW, lane, xn_, yn_);
        f32x4 v[4]; float ss = 0.f;
#pragma unroll
        for (int j = 0; j < 2; ++j) { f32x4 s0 = {0.f, 0.f, 0.f, 0.f}, s1 = {0.f, 0.f, 0.f, 0.f};
#pragma unroll
            for (int sl = 0; sl < 4; ++sl) { const u32x2 w = yv[4 * j + sl];
                const f32x2_ a = __builtin_amdgcn_cvt_pk_f32_fp8((int)w.x, false), b = __builtin_amdgcn_cvt_pk_f32_fp8((int)w.x, true), c = __builtin_amdgcn_cvt_pk_f32_fp8((int)w.y, false), d = __builtin_amdgcn_cvt_pk_f32_fp8((int)w.y, true);
                s0[0] += a[0]; s0[1] += a[1]; s0[2] += b[0]; s0[3] += b[1]; s1[0] += c[0]; s1[1] += c[1]; s1[2] += d[0]; s1[3] += d[1]; }
            const u32x4 xw = xv[j]; const f32x4 x0 = {bf_lo(xw.x), bf_hi(xw.x), bf_lo(xw.y), bf_hi(xw.y)}, x1 = {bf_lo(xw.z), bf_hi(xw.z), bf_lo(xw.w), bf_hi(xw.w)};
            v[2 * j] = x0 + s0 * (1.0f / Y8_SCALE); v[2 * j + 1] = x1 + s1 * (1.0f / Y8_SCALE); }
#pragma unroll
        for (int i = 0; i < 4; ++i) ss += (v[i][0] * v[i][0] + v[i][1] * v[i][1]) + (v[i][2] * v[i][2] + v[i][3] * v[i][3]);
        const float rstd = __builtin_amdgcn_rsqf(wave_sum(ss) * (1.f / D) + EPS);
#pragma unroll
        for (int j = 0; j < 2; ++j) { const int c = 8 * lane + 512 * j;
            __builtin_nontemporal_store(v[2 * j] * rstd * gg[2 * j], (f32x4*)(out + (size_t)m * D + c)); __builtin_nontemporal_store(v[2 * j + 1] * rstd * gg[2 * j + 1], (f32x4*)(out + (size_t)m * D + c + 4)); }
        xv[0] = xn_[0]; xv[1] = xn_[1];
#pragma unroll
        for (int i = 0; i < 8; ++i) yv[i] = yn_[i];
    }
}

constexpr int NPHASE = 12;
struct Args { const float* in[21]; float* out; unsigned char* ws; int ph_lo, ph_hi; };
static_assert(sizeof(Args) == 21 * 8 + 8 + 8 + 8, "Args has no padding");

__global__ void __launch_bounds__(NWAVES * 64, 2) fwd(Args args) {
    extern __shared__ __attribute__((aligned(16))) unsigned char lds[];
    Frame F;
    F.lds = (LAS unsigned char*)lds; F.MISC = (volatile LAS unsigned*)(F.lds + MISC_OFF);
    F.tid = threadIdx.x; F.lane = F.tid & 63; F.wave = __builtin_amdgcn_readfirstlane(F.tid >> 6);
    F.G = gridDim.x; { const int bx = blockIdx.x; F.vcu = (F.G % 8 == 0) ? (bx % 8) * (F.G / 8) + bx / 8 : bx; }
    F.ws = args.ws; F.ctl = (unsigned*)(args.ws + WS_CTL); F.out = args.out;
    F.in = args.in;
    for (int u = F.tid; u < (LDS_BYTES - LDSCTL_OFF) / 4; u += NWAVES * 64) ((LAS unsigned*)(F.lds + LDSCTL_OFF))[u] = 0u;
    __syncthreads();
    const int lo = args.ph_lo, hi = args.ph_hi;
    const bool single = (hi - lo) > 1;
    XcdBarrier bar; bar.bar = F.ctl + CW_BAR; bar.x = 0; bar.st = nullptr;
    if (single) bar = xcd_barrier_post(F.ctl + CW_BAR, F.MISC + 8);
#ifndef PH_MASK
#define PH_MASK 0xFFF
#endif
#define IN(k) (((PH_MASK >> (k)) & 1) && lo <= (k) && (k) < hi)
#ifndef PROBE_LO
#define PROBE_LO -1
#define PROBE_HI -1
#endif
#define PROBE_DIV 10.0f
    unsigned long long pt0 = 0ull, pt1 = 0ull;
#define STAMP_B(k) do { if (PROBE_LO == (k) && bx == 0) pt0 = __builtin_amdgcn_s_memrealtime(); } while (0)
#define STAMP_A(k) do { if (PROBE_HI == (k) && bx == 0) pt1 = __builtin_amdgcn_s_memrealtime(); } while (0)
#define SEAM(k) do { if (IN(k) && IN((k) + 1)) xcd_barrier(bar); } while (0)
    unsigned char* ws = args.ws;
    const int bx = (int)blockIdx.x;
    const bool team = single && F.G == 256 && IN(3) && IN(4) && IN(7) && IN(8);
    unsigned* const pan = F.ctl + CW_PAN;

    STAMP_B(0);
    if (IN(0)) { p0_prologue(F); }
    SEAM(0);
    STAMP_A(0); STAMP_B(1);
    if (IN(1)) {
        const bool split = (F.G == 256);
        if (!split || bx < 256 - P1_NCONV) {
            pg8::OrderIn S; S.init(ws + WS_XN, ws + WS_WIN_T, ws + WS_MEMN, ws + WS_WKV_T, split ? 32 : 64, split ? 256 - P1_NCONV : F.G, bx);
            pg8::EpiP1 E{(bf16_t*)(ws + WS_PROJ), (bf16_t*)(ws + WS_KMEM), (bf16_t*)(ws + WS_VT)};
            pg8::gemm_phase<pg8::EpiP1, pg8::OrderIn, false, true, true>(F.lds + RING_OFF, 2 * D, 2 * D, 2 * D, S, E);
        }
        if (!split) convert_experts(F, bx * NWAVES + F.wave, F.G * NWAVES, N_XITEMS);
        else if (bx >= 256 - P1_NCONV) {
            const int cb = bx - (256 - P1_NCONV);
            if (cb < 32) { pg8::OrderKV S; S.init(ws + WS_MEMN, ws + WS_WKV_T, 32 + cb); pg8::EpiP1 E{(bf16_t*)(ws + WS_PROJ), (bf16_t*)(ws + WS_KMEM), (bf16_t*)(ws + WS_VT)};
                pg8::gemm_phase<pg8::EpiP1, pg8::OrderKV, false, false, true>(F.lds + RING_OFF, 2 * D, 2 * D, 2 * D, S, E); }
            constexpr int NSTAT = (int)((long)N_XITEMS * (100 - P1_DYN_PCT) / 100), NLOW = 32 * NWAVES, NHIGH = (P1_NCONV - 32) * NWAVES; constexpr int CUT = (int)((long)NSTAT * (5 * NLOW) / (5 * NLOW + 6 * NHIGH));
            if (cb < 32) convert_experts(F, cb * NWAVES + F.wave, NLOW, CUT);
            else convert_experts(F, CUT + (cb - 32) * NWAVES + F.wave, NHIGH, NSTAT);
        }
        if (split) {
            constexpr int NSTAT = (int)((long)N_XITEMS * (100 - P1_DYN_PCT) / 100);
            for (;;) {
                __syncthreads();
                if (F.tid == 0) F.MISC[24] = atomicAdd(F.ctl + CW_DYN, (unsigned)NWAVES);
                __syncthreads();
                const int base = NSTAT + (int)F.MISC[24];
                if (base >= N_XITEMS) break;
                convert_experts(F, base + F.wave, N_XITEMS, N_XITEMS);
            }
        }
    }
    SEAM(1);
    STAMP_A(1); STAMP_B(2);
    if (IN(2)) {
        {
            pg8::OrderPX S; S.init(ws + WS_KMEM, ws + WS_VT, ws + WS_WQ_T, ws + WS_WO_T, ws + WS_WQKT, ws + WS_VWOT, bx);
            pg8::EpiPX E;
            pg8::gemm_phase<pg8::EpiPX, pg8::OrderPX, false, false, true>(F.lds + RING_OFF, 2 * D, 2 * D, 2 * XHD, S, E);
        }
        p2_mix(F);
    }
    SEAM(2);
    STAMP_A(2); STAMP_B(3);
    if (IN(3)) {
        pg8::OrderPlain S; S.init(ws + WS_YMIX, ws + WS_WOUT_T, D, D, M / 256, D / 256, F.G, bx);
        pg8::EpiRes<false, false> E{F.in[0], (bf16_t*)(ws + WS_X1B), nullptr, (float*)(ws + WS_SS1)};
        pg8::gemm_phase<pg8::EpiRes<false, false>, pg8::OrderPlain, false, false, true>(F.lds + RING_OFF, 2 * D, 2 * D, 2 * D, S, E);
        if (team) { pg8::Unit u; if (S.next(0, u)) team_signal(pan + (0 * 64 + u.pm) * 16); }
    }
    if (!team) SEAM(3);
    STAMP_A(3); STAMP_B(4);
    if (IN(4)) {
        if (F.G == 256) {
            pg8::OrderXB S; S.init(ws + WS_X1B, ws + WS_WQKT, F.G, bx);
            pg8::EpiSoftmax E{(bf16_t*)(ws + WS_PB), (const float*)(ws + WS_SS1)};
            pg8::Unit u0; const bool has = S.next(0, u0);
            if (team && has) team_wait(pan + (0 * 64 + u0.pm) * 16, 4u, F.ctl + CW_BAR);
            pg8::gemm_phase<pg8::EpiSoftmax, pg8::OrderXB, false, false, true>(F.lds + RING_OFF, 2 * D, 2 * D, 2 * D, S, E);
            if (team && has) team_signal(pan + (1 * 64 + u0.pm) * 16);
        }
    }
    if (!team) SEAM(4);
    STAMP_A(4); STAMP_B(7);
    if (IN(7)) {
        pg8::OrderXB S; S.init(ws + WS_PB, ws + WS_VWOT, F.G, bx);
        pg8::EpiRes<true, true> E{ws + WS_X1B, (bf16_t*)(ws + WS_X2), ws + WS_X2B, (float*)(ws + WS_SS2)};
        pg8::Unit u0; const bool has = S.next(0, u0);
        if (team && has) team_wait(pan + (1 * 64 + u0.pm) * 16, 4u, F.ctl + CW_BAR);
        pg8::gemm_phase<pg8::EpiRes<true, true>, pg8::OrderXB, false, false, true>(F.lds + RING_OFF, 2 * D, 2 * D, 2 * D, S, E);
        if (team && has) team_signal(pan + (2 * 64 + u0.pm) * 16);
    }
    if (!team) SEAM(7);
    STAMP_A(7); STAMP_B(8);
    if (IN(8)) { if (team) team_wait(pan + (2 * 64 + (F.vcu >> 2)) * 16, 4u, F.ctl + CW_BAR);
        p8_router(F); }
    SEAM(8);
    STAMP_A(8); STAMP_B(9);
    if (IN(9)) {
        pg8::OrderMoe<8, true> S; S.init(F.ctl + CW_CNT, (const int*)(ws + WS_LTOK), ws + WS_X2B, ws + WS_W1_T, F.G, bx);
        pg8::EpiAct E{(bf16_t*)(ws + WS_ACT), (const float*)(ws + WS_LRSTD), F.in[17]};
        pg8::gemm_phase<pg8::EpiAct, pg8::OrderMoe<8, true>, true, true, true, true>(F.lds + RING_OFF, D, D, D, S, E);
    }
    SEAM(9);
    STAMP_A(9); STAMP_B(10);
    if (IN(10)) {
        pg8::OrderMoe<4, false> S; S.init(F.ctl + CW_CNT, (const int*)(ws + WS_LTOK), ws + WS_ACT, ws + WS_W2_T, F.G, bx);
        pg8::EpiY E{(bf16_t*)(ws + WS_Y), (const float*)(ws + WS_LGATE), (const int*)(ws + WS_LTOK), F.in[19]};
        pg8::gemm_phase<pg8::EpiY, pg8::OrderMoe<4, false>, false, true, true, true>(F.lds + RING_OFF, DEXP, DEXP, DEXP, S, E);
    }
    SEAM(10);
    STAMP_A(10); STAMP_B(11);
    if (IN(11)) { p11_final(F); }
    STAMP_A(11);
    if (PROBE_LO >= 0 && bx == 0) { asm volatile("s_waitcnt vmcnt(0)" ::: "memory"); __syncthreads(); if (F.tid == 0) { const float us = (float)(pt1 - pt0) * 0.01f; F.out[(size_t)(F.vcu * NWAVES) * D] += us / PROBE_DIV; } }
#undef IN
#undef SEAM
}

extern "C" void kernel_launch(void* const* d_in, const int* in_sizes, int n_in, void* d_out, int out_size, void* d_ws, size_t ws_size, hipStream_t stream) {
    static int grid = 0;
    if (grid == 0) {
        if (n_in != 21 || in_sizes[0] != M * D || out_size != M * D || ws_size < WS_END) { fprintf(stderr, "kernel_launch: unexpected shapes (n_in %d, in0 %d, out %d, ws %zu)\n", n_in, n_in > 0 ? in_sizes[0] : -1, out_size, ws_size); grid = -1; return; }
        int dev = 0, cus = 0, per_cu = 0;
        if (hipGetDevice(&dev) != hipSuccess || hipDeviceGetAttribute(&cus, hipDeviceAttributeMultiprocessorCount, dev) != hipSuccess) { grid = -1; return; }
        if (hipFuncSetAttribute((const void*)fwd, hipFuncAttributeMaxDynamicSharedMemorySize, LDS_BYTES) != hipSuccess) { fprintf(stderr, "kernel_launch: hipFuncSetAttribute failed\n"); grid = -1; return; }
        if (hipOccupancyMaxActiveBlocksPerMultiprocessor(&per_cu, (const void*)fwd, NWAVES * 64, LDS_BYTES) != hipSuccess || per_cu < 1) { fprintf(stderr, "kernel_launch: occupancy query says %d\n", per_cu); per_cu = 1; }
        (void)hipGetLastError();
        if (cus != 256) fprintf(stderr, "kernel_launch: built for a 256-CU device (one 256x256 tile per workgroup in the fused phases); found %d CUs\n", cus);
        grid = cus;
    }
    if (grid < 0) return;
    (void)hipMemsetAsync((char*)d_ws + WS_CTL, 0, CTL_ZERO_BYTES, stream);
    Args a{};
    for (int i = 0; i < 21; ++i) a.in[i] = (const float*)d_in[i];
    a.out = (float*)d_out; a.ws = (unsigned char*)d_ws;
    if (MK_N_LAUNCHES == 1) {
        a.ph_lo = 0; a.ph_hi = NPHASE;
        void* kargs[] = {&a};
        hipError_t e = hipLaunchCooperativeKernel((const void*)fwd, dim3(grid), dim3(NWAVES * 64), kargs, LDS_BYTES, stream);
        if (e != hipSuccess) fprintf(stderr, "kernel_launch: cooperative launch failed: %s\n", hipGetErrorString(e));
    } else {
        for (int p = 0; p < NPHASE; ++p) { a.ph_lo = p; a.ph_hi = p + 1; for (int rep = 0; rep < NREP(p); ++rep) hipLaunchKernelGGL(fwd, dim3(grid), dim3(NWAVES * 64), LDS_BYTES, stream, a); }
    }
}
```

```cpp
#include <hip/hip_runtime.h>
#include <cstdio>
#include <cstdint>

#ifndef MK_N_LAUNCHES
#define MK_N_LAUNCHES 1
#endif
#ifndef DUP_MASK
#define DUP_MASK 0
#endif
#define NREP(k) (((DUP_MASK >> (k)) & 1) ? 2 : 1)

constexpr int D = 1024, BATCH = 8, SEQ = 2048, M = BATCH * SEQ, MEMLEN = 256, MROWS = BATCH * MEMLEN;
constexpr int NPROJ = 3072, NE = 32, TOPK = 4, DEXP = 1024;
constexpr int XH = 4, XHD = 256;
constexpr float EPS = 1e-5f;
constexpr float LOG2E = 1.4426950408889634f;
constexpr float C2Q = 0.125f * LOG2E;
constexpr float C2X = 0.0625f * LOG2E;
#ifndef P1_CONV_PCT
#define P1_CONV_PCT 100
#endif
#ifndef P1_DYN_PCT
#define P1_DYN_PCT 22
#endif
#ifndef P1_NCONV
#define P1_NCONV 96
#endif
constexpr int N_XITEMS = NE * 8 * 32 + NE * 8 * 16;
constexpr int XITEMS_P1 = (int)((long)N_XITEMS * P1_CONV_PCT / 100);
constexpr int LISTCAP = M;
constexpr int ACT_ROWS = M * TOPK + NE * 256;

#define GAS __attribute__((address_space(1)))
#define LAS __attribute__((address_space(3)))
typedef unsigned short bf16_t;
typedef short bf16x8 __attribute__((ext_vector_type(8)));
typedef short s16x4 __attribute__((ext_vector_type(4)));
typedef float f32x4 __attribute__((ext_vector_type(4)));
typedef float f32x2 __attribute__((ext_vector_type(2)));
typedef float f32x16 __attribute__((ext_vector_type(16)));
typedef unsigned u32x4 __attribute__((ext_vector_type(4)));
typedef unsigned u32x2 __attribute__((ext_vector_type(2)));
typedef GAS unsigned gu32;

constexpr size_t MiB = 1u << 20;
constexpr size_t WS_CTL = 0, CTL_ZERO_BYTES = 1 * MiB;
constexpr size_t WS_WIN_T = 2 * MiB, WS_WOUT_T = 8 * MiB, WS_WQ_T = 10 * MiB, WS_WKV_T = 12 * MiB, WS_WO_T = 16 * MiB, WS_WR = 18 * MiB;
constexpr size_t WS_MEMN = 19 * MiB, WS_KMEM = 23 * MiB, WS_VT = 27 * MiB, WS_SS1 = 31 * MiB, WS_SS2 = 32 * MiB, WS_RSTD3 = 33 * MiB, WS_LTOK = 34 * MiB, WS_LGATE = 36 * MiB, WS_LRSTD = 38 * MiB;
constexpr size_t WS_W1_T = 40 * MiB, WS_W2_T = 168 * MiB;
constexpr size_t WS_XN = 232 * MiB, WS_PROJ = 264 * MiB, WS_YMIX = 360 * MiB;
constexpr size_t WS_X1 = 392 * MiB, WS_X1B = 456 * MiB, WS_X1B8 = 488 * MiB, WS_PB = 520 * MiB, WS_OB = 552 * MiB, WS_X2 = 584 * MiB, WS_X2B = 648 * MiB;
constexpr size_t WS_ACT = 232 * MiB;
constexpr size_t WS_Y = 392 * MiB;
constexpr size_t WS_WQKT = 680 * MiB, WS_VWOT = 696 * MiB;
constexpr size_t WS_END = 712 * MiB;
static_assert(WS_ACT + (size_t)ACT_ROWS * DEXP <= WS_X1 && WS_Y + (size_t)M * TOPK * D * 2 <= WS_PB, "overlays");
constexpr int CW_TMO = 0, CW_CODE = 1, CW_DYN = 64, CW_BAR = 4096, CW_CNT = 8192;

__device__ __forceinline__ unsigned cvt_pk_bf16(float lo, float hi) { unsigned r; asm volatile("v_cvt_pk_bf16_f32 %0, %1, %2" : "=v"(r) : "v"(lo), "v"(hi)); return r; }
__device__ __forceinline__ unsigned cvtpk_s(float lo, float hi) { typedef __bf16 bf16x2_t __attribute__((ext_vector_type(2))); f32x2 v = {lo, hi}; bf16x2_t b = __builtin_convertvector(v, bf16x2_t); return __builtin_bit_cast(unsigned, b); }
__device__ __forceinline__ float clamp448(float v) { return fminf(fmaxf(v, -448.0f), 448.0f); }
__device__ __forceinline__ unsigned pk_fp8x4(float a, float b, float c, float d) { int w = 0; w = __builtin_amdgcn_cvt_pk_fp8_f32(clamp448(a), clamp448(b), w, false); w = __builtin_amdgcn_cvt_pk_fp8_f32(clamp448(c), clamp448(d), w, true); return (unsigned)w; }
constexpr float W8_SCALE = 64.0f, ACT8_SCALE = 4.0f, Y8_SCALE = 16.0f, PX8_SCALE = 64.0f, P8_SCALE = 256.0f;
constexpr int E8_ONE = 0x7F7F7F7F, E8_W = 0x79797979, E8_ACT = 0x7D7D7D7D;
__device__ __forceinline__ float bf_lo(unsigned w) { return __uint_as_float(w << 16); }
__device__ __forceinline__ float bf_hi(unsigned w) { return __uint_as_float(w & 0xffff0000u); }
__device__ __forceinline__ float wave_sum(float v) {
#pragma unroll
    for (int o = 1; o < 64; o <<= 1) v += __shfl_xor(v, o);
    return v;
}
#define LDS_WAIT() asm volatile("s_waitcnt lgkmcnt(0)" ::: "memory")
#define VM_WAIT() asm volatile("s_waitcnt vmcnt(0)" ::: "memory")

namespace pg8 {
constexpr int BM = 256, BK = 64, HALF = 128, HTB = HALF * BK * 2, STAGE_BYTES = 8 * HTB, NXCD = 8, WGM = 8;
__host__ __device__ __forceinline__ int lds_byte(int r, int c) { const int st = (r >> 4) * 2 + (c >> 5), rr = r & 15, cc = c & 31, ob = rr * 64 + cc * 2; return st * 1024 + (ob ^ (((ob >> 9) & 1) << 5)); }
__host__ __device__ __forceinline__ void stage_rc(int b, int& R, int& C) { const int st = b / 1024, sb = b % 1024, swz = sb ^ (((sb >> 9) & 1) << 5); R = (st >> 1) * 16 + swz / 64; C = (st & 1) * 32 + (swz % 64) / 2; }
__host__ __device__ __forceinline__ int perm32(int rho) { const int n = rho >> 4, i = rho & 15; return 8 * (i >> 2) + 4 * n + (i & 3); }

struct Unit { const char* a; const char* b; int pm, pn; };
struct UnitK { const char* a; const char* b; int pm, pn, kind; };
struct UnitM { const char* a; const char* b; const int* tok; int pm, pn, nvalid, e, rowoff; };

struct GridOrder {
    int nM, nN, nwg;
    __device__ __forceinline__ void init(int nM_, int nN_) { nM = nM_; nN = nN_; nwg = nM * nN; }
    __device__ __forceinline__ void map(int L, int& pm, int& pn) const {
        int wgid = L; { const int q = nwg / NXCD, r = nwg % NXCD, xcd = wgid % NXCD, off = wgid / NXCD; wgid = (xcd < r ? xcd * (q + 1) : r * (q + 1) + (xcd - r) * q) + off; }
        const int nig = WGM * nN, gid = wgid / nig, fm = gid * WGM, gsz = (nM - fm) < WGM ? (nM - fm) : WGM;
        pm = fm + ((wgid % nig) % gsz); pn = (wgid % nig) / gsz;
    }
};

typedef f32x4 Acc[2][2][4][2];

template <class Epi, class Sched, bool GATHER, bool ALIGN_EPI, bool SP2, bool F8 = false, int SCA = 0x7F7F7F7F, int SCB = 0x7F7F7F7F>
__device__ __forceinline__ void gemm_phase(LAS unsigned char* lds, const int lda, const int ldb, const int K, const Sched& S, const Epi& E) {
    const int tid = threadIdx.x, wid = __builtin_amdgcn_readfirstlane(tid >> 6), lane = tid & 63, wr = wid >> 2, wc = wid & 3, fr = lane & 15, fq = lane >> 4;
    int nt = K / 128; asm volatile("" : "+s"(nt));
    int RA[2], CA[2]; unsigned voffB[2];
#pragma unroll
    for (int i = 0; i < 2; ++i) { int R, C; stage_rc(tid * 16 + i * 8192, R, C); const int Rb = Epi::PERM ? ((R & ~31) + perm32(R & 31)) : R;
        RA[i] = R; CA[i] = C; voffB[i] = (unsigned)(Rb * ldb + C * 2); }
    const size_t kstep = (size_t)(BK * 2);
    const size_t hstepB = (size_t)HALF * ldb;
    const unsigned ldsw = (unsigned)wid * 1024u;
    const int aoff = lds_byte(wr * 64 + fr, fq * 8), boff = lds_byte(wc * 32 + fr, fq * 8);
#define PG8_SA(b, h) (((b) * 2 + (h)) * HTB)
#define PG8_SB(b, h) ((4 + (b) * 2 + (h)) * HTB)
#define PG8_STAGE(bufoff, gbase, voff) do { _Pragma("unroll") for (int _i = 0; _i < 2; ++_i) \
        __builtin_amdgcn_global_load_lds((const unsigned*)((const char*)(gbase) + (voff)[_i]), (LAS unsigned*)(lds + (bufoff) + ldsw + _i * 8192), 16, 0, 0); } while (0)
#define PG8_LDA(dst, b, h) do { _Pragma("unroll") for (int m = 0; m < 4; ++m) { if constexpr (F8) { \
            dst##8[m] = __builtin_shufflevector(*(const LAS i32x4_*)(lds + PG8_SA(b, h) + aoff + m * 2048), *(const LAS i32x4_*)(lds + PG8_SA(b, h) + aoff + m * 2048 + 1024), 0, 1, 2, 3, 4, 5, 6, 7); } \
        else { _Pragma("unroll") for (int k = 0; k < 2; ++k) dst[m][k] = *(const LAS bf16x8*)(lds + PG8_SA(b, h) + aoff + m * 2048 + k * 1024); } } } while (0)
#define PG8_LDB(dst, b, h) do { _Pragma("unroll") for (int n = 0; n < 2; ++n) { if constexpr (F8) { \
            dst##8[n] = __builtin_shufflevector(*(const LAS i32x4_*)(lds + PG8_SB(b, h) + boff + n * 2048), *(const LAS i32x4_*)(lds + PG8_SB(b, h) + boff + n * 2048 + 1024), 0, 1, 2, 3, 4, 5, 6, 7); } \
        else { _Pragma("unroll") for (int k = 0; k < 2; ++k) dst[n][k] = *(const LAS bf16x8*)(lds + PG8_SB(b, h) + boff + n * 2048 + k * 1024); } } } while (0)
#define PG8_MMA(ai, bj, At, Bt) do { __builtin_amdgcn_s_setprio(1); _Pragma("unroll") for (int m = 0; m < 4; ++m) _Pragma("unroll") for (int n = 0; n < 2; ++n) { \
        if constexpr (F8) { acc[ai][bj][m][n] = __builtin_amdgcn_mfma_scale_f32_16x16x128_f8f6f4(Bt##8[n], At##8[m], acc[ai][bj][m][n], 0, 0, 0, SCA, 0, SCB); } \
        else { _Pragma("unroll") for (int k = 0; k < 2; ++k) acc[ai][bj][m][n] = __builtin_amdgcn_mfma_f32_16x16x32_bf16(Bt[n][k], At[m][k], acc[ai][bj][m][n], 0, 0, 0); } } \
        __builtin_amdgcn_s_setprio(0); } while (0)
#define PG8_WAIT_V(n) asm volatile("s_waitcnt vmcnt(" #n ")" ::: "memory")
#define PG8_WAIT_L(n) asm volatile("s_waitcnt lgkmcnt(" #n ")" ::: "memory")
#define PG8_BAR __builtin_amdgcn_s_barrier()
#define PG8_SCHED __builtin_amdgcn_sched_barrier(0)
#define PG8_VOFFA(dst, u) do { if constexpr (GATHER) { int _t[2][2]; _Pragma("unroll") for (int _h = 0; _h < 2; ++_h) _Pragma("unroll") for (int _i = 0; _i < 2; ++_i) _t[_h][_i] = (u).tok[_h * HALF + RA[_i]]; \
        _Pragma("unroll") for (int _h = 0; _h < 2; ++_h) _Pragma("unroll") for (int _i = 0; _i < 2; ++_i) { const int _row = _h * HALF + RA[_i]; const int _tt = (_row < (u).nvalid) ? (_t[_h][_i] >> 2) : 0; dst[_h][_i] = (unsigned)(_tt * lda + CA[_i] * 2); } } \
        else { _Pragma("unroll") for (int _h = 0; _h < 2; ++_h) _Pragma("unroll") for (int _i = 0; _i < 2; ++_i) dst[_h][_i] = (unsigned)((_h * HALF + RA[_i]) * lda + CA[_i] * 2); } } while (0)
#define PG8_VOFFA_LDS(dst, u, slot) do { const LAS int* _mt = (const LAS int*)(lds + 131072 + (slot) * 3072 + 1024); _Pragma("unroll") for (int _h = 0; _h < 2; ++_h) _Pragma("unroll") for (int _i = 0; _i < 2; ++_i) { \
        const int _row = _h * HALF + RA[_i]; const int _tt = (_row < (u).nvalid) ? (_mt[_row] >> 2) : 0; dst[_h][_i] = (unsigned)(_tt * lda + CA[_i] * 2); } } while (0)
    typename Sched::U cur, nxt; int ui = 0;
    if (!S.next(0, cur)) return;
    Acc acc;
#pragma unroll
    for (int a = 0; a < 2; ++a)
#pragma unroll
        for (int b = 0; b < 2; ++b)
#pragma unroll
            for (int m = 0; m < 4; ++m)
#pragma unroll
                for (int n = 0; n < 2; ++n) acc[a][b][m][n] = (f32x4){0.f, 0.f, 0.f, 0.f};
    typedef int i32x4_ __attribute__((ext_vector_type(4))); typedef int i32x8_ __attribute__((ext_vector_type(8)));
    bf16x8 At[4][2], B0[2][2], B1[2][2]; i32x8_ At8[4], B08[2], B18[2];
    unsigned vA[2][2];
    PG8_VOFFA(vA, cur);
    const char* cA = cur.a; const char* cB = cur.b;
    E.prefetch(cur, 0, lds, wid, lane);
    if constexpr (SP2) {
        PG8_STAGE(PG8_SB(0, 0), cB, voffB); PG8_STAGE(PG8_SB(0, 1), cB + hstepB, voffB); PG8_STAGE(PG8_SA(0, 0), cA, vA[0]); PG8_STAGE(PG8_SA(0, 1), cA, vA[1]);
        if (wr == 1) PG8_BAR;
        PG8_WAIT_V(2); PG8_BAR;
        PG8_STAGE(PG8_SB(1, 0), cB + kstep, voffB); PG8_STAGE(PG8_SA(1, 0), cA + kstep, vA[0]); PG8_STAGE(PG8_SB(1, 1), cB + hstepB + kstep, voffB);
        PG8_WAIT_V(6); PG8_BAR;
    } else {
        PG8_STAGE(PG8_SB(0, 0), cB, voffB); PG8_STAGE(PG8_SA(0, 0), cA, vA[0]); PG8_STAGE(PG8_SB(0, 1), cB + hstepB, voffB); PG8_STAGE(PG8_SA(0, 1), cA, vA[1]);
        if (wr == 1) PG8_BAR;
        PG8_WAIT_V(4); PG8_BAR;
        PG8_STAGE(PG8_SB(1, 0), cB + kstep, voffB); PG8_STAGE(PG8_SA(1, 0), cA + kstep, vA[0]); PG8_STAGE(PG8_SB(1, 1), cB + hstepB + kstep, voffB);
        PG8_WAIT_V(6); PG8_BAR;
    }
    for (;;) {
        const bool has_next = S.next(ui + 1, nxt);
        const char* nA = has_next ? nxt.a : cA; const char* nB = has_next ? nxt.b : cB;
        if (has_next) E.prefetch(nxt, ui + 1, lds, wid, lane);
        for (int t = 0; t < nt; t += 2) {
            const bool last = (t == nt - 2);
            asm volatile("" : "+v"(vA[0][0]), "+v"(vA[0][1]), "+v"(vA[1][0]), "+v"(vA[1][1]), "+v"(voffB[0]), "+v"(voffB[1]));
            const char* a1 = cA + (size_t)(t + 1) * kstep;
            const char* a2 = last ? nA : cA + (size_t)(t + 2) * kstep; const char* b2 = last ? nB : cB + (size_t)(t + 2) * kstep;
            const char* a3 = a2 + kstep; const char* b3 = b2 + kstep;
            if constexpr (SP2) {
            PG8_LDB(B0, 0, 0); PG8_LDB(B1, 0, 1); PG8_SCHED; PG8_LDA(At, 0, 0); PG8_STAGE(PG8_SA(1, 1), a1, vA[1]); if (last && has_next) { if constexpr (GATHER) { PG8_VOFFA_LDS(vA, nxt, (ui + 1) % 3); } else { PG8_VOFFA(vA, nxt); } }
            PG8_WAIT_V(8); PG8_WAIT_L(0); PG8_BAR; PG8_MMA(0, 0, At, B0); PG8_MMA(0, 1, At, B1); PG8_BAR; PG8_SCHED;
            PG8_LDA(At, 0, 1); PG8_STAGE(PG8_SB(0, 0), b2, voffB); PG8_STAGE(PG8_SB(0, 1), b2 + hstepB, voffB); PG8_STAGE(PG8_SA(0, 0), a2, vA[0]);
            PG8_WAIT_V(8); PG8_WAIT_L(0); PG8_BAR; PG8_MMA(1, 0, At, B0); PG8_MMA(1, 1, At, B1); PG8_BAR; PG8_SCHED;
            PG8_LDB(B0, 1, 0); PG8_LDB(B1, 1, 1); PG8_SCHED; PG8_LDA(At, 1, 0); PG8_STAGE(PG8_SA(0, 1), a2, vA[1]);
            PG8_WAIT_V(8); PG8_WAIT_L(0); PG8_BAR; PG8_MMA(0, 0, At, B0); PG8_MMA(0, 1, At, B1); PG8_BAR; PG8_SCHED;
            PG8_LDA(At, 1, 1); PG8_STAGE(PG8_SB(1, 0), b3, voffB); PG8_STAGE(PG8_SB(1, 1), b3 + hstepB, voffB); PG8_STAGE(PG8_SA(1, 0), a3, vA[0]);
            PG8_WAIT_V(8); PG8_WAIT_L(0); PG8_BAR; PG8_MMA(1, 0, At, B0); PG8_MMA(1, 1, At, B1); PG8_BAR; PG8_SCHED;
            } else {
            PG8_LDB(B0, 0, 0); PG8_SCHED; PG8_LDA(At, 0, 0); PG8_STAGE(PG8_SA(1, 1), a1, vA[1]); if (last && has_next) { if constexpr (GATHER) { PG8_VOFFA_LDS(vA, nxt, (ui + 1) % 3); } else { PG8_VOFFA(vA, nxt); } }
            PG8_WAIT_L(8); PG8_BAR; PG8_WAIT_L(0); PG8_MMA(0, 0, At, B0); PG8_BAR; PG8_SCHED;
            PG8_LDB(B1, 0, 1); PG8_STAGE(PG8_SB(0, 0), b2, voffB);
            PG8_BAR; PG8_WAIT_L(0); PG8_MMA(0, 1, At, B1); PG8_BAR;
            PG8_LDA(At, 0, 1); PG8_STAGE(PG8_SA(0, 0), a2, vA[0]);
            PG8_BAR; PG8_WAIT_L(0); PG8_MMA(1, 0, At, B0); PG8_BAR; PG8_SCHED;
            PG8_STAGE(PG8_SB(0, 1), b2 + hstepB, voffB);
            PG8_WAIT_V(6); PG8_BAR; PG8_MMA(1, 1, At, B1); PG8_BAR;
            PG8_LDB(B0, 1, 0); PG8_SCHED; PG8_LDA(At, 1, 0); PG8_STAGE(PG8_SA(0, 1), a2, vA[1]);
            PG8_WAIT_L(8); PG8_BAR; PG8_WAIT_L(0); PG8_MMA(0, 0, At, B0); PG8_BAR; PG8_SCHED;
            PG8_LDB(B1, 1, 1); PG8_STAGE(PG8_SB(1, 0), b3, voffB);
            PG8_BAR; PG8_WAIT_L(0); PG8_MMA(0, 1, At, B1); PG8_BAR;
            PG8_LDA(At, 1, 1); PG8_STAGE(PG8_SA(1, 0), a3, vA[0]);
            PG8_BAR; PG8_WAIT_L(0); PG8_MMA(1, 0, At, B0); PG8_BAR; PG8_SCHED;
            PG8_STAGE(PG8_SB(1, 1), b3 + hstepB, voffB);
            PG8_WAIT_V(6); PG8_BAR; PG8_MMA(1, 1, At, B1); PG8_BAR;
            }
        }
        if constexpr (ALIGN_EPI) { if (wr == 0) PG8_BAR; }
        if constexpr (!Epi::AFTER_DRAIN) { E(acc, cur, ui, lds, wr, wc, fr, fq); }
        if (!has_next) break;
#pragma unroll
        for (int a = 0; a < 2; ++a)
#pragma unroll
            for (int b = 0; b < 2; ++b)
#pragma unroll
                for (int m = 0; m < 4; ++m)
#pragma unroll
                    for (int n = 0; n < 2; ++n) acc[a][b][m][n] = (f32x4){0.f, 0.f, 0.f, 0.f};
        cur = nxt; cA = nA; cB = nB; ++ui;
        if constexpr (ALIGN_EPI) { if (wr == 1) PG8_BAR; }
    }
    PG8_WAIT_V(0);
    if constexpr (!ALIGN_EPI) { if (wr == 0) PG8_BAR; }
    PG8_BAR;
    if constexpr (Epi::AFTER_DRAIN) { E.fused(acc, cur, wr, wc, fr, fq, lds, wid, lane); }
#undef PG8_SA
#undef PG8_SB
#undef PG8_STAGE
#undef PG8_LDA
#undef PG8_LDB
#undef PG8_MMA
#undef PG8_WAIT_V
#undef PG8_WAIT_L
#undef PG8_BAR
#undef PG8_SCHED
#undef PG8_VOFFA
#undef PG8_VOFFA_LDS
}

struct OrderKV {
    typedef UnitK U;
    const char *memn, *wkv_t; int c;
    __device__ __forceinline__ void init(const void* memn_, const void* wkv_t_, int c_) { memn = (const char*)memn_; wkv_t = (const char*)wkv_t_; c = c_; }
    __device__ __forceinline__ bool next(int i, UnitK& u) const {
        if (i > 0 || c >= 64) return false;
        int r = c;
        if (r < 32) { u.kind = 1; u.pm = r >> 2; u.pn = r & 3; u.a = memn + (size_t)u.pm * 256 * D * 2; u.b = wkv_t + (size_t)u.pn * 256 * D * 2; return true; }
        r -= 32;
        u.kind = 2; u.pm = r >> 2; u.pn = r & 3; u.a = memn + (size_t)u.pm * 256 * D * 2; u.b = wkv_t + (size_t)(D + u.pn * 256) * D * 2; return true;
    }
};
struct OrderIn {
    typedef UnitK U;
    const char *A, *Bt, *memn, *wkv_t; int G, c, nextra; GridOrder g0;
    __device__ __forceinline__ void init(const void* A_, const void* Bt_, const void* memn_, const void* wkv_t_, int nextra_, int G_, int c_) {
        A = (const char*)A_; Bt = (const char*)Bt_; memn = (const char*)memn_; wkv_t = (const char*)wkv_t_; nextra = nextra_; G = G_; c = c_; g0.init(M / 256, NPROJ / 256); }
    __device__ __forceinline__ bool next(int i, UnitK& u) const {
        const int L = i * G + c;
        if (L < g0.nwg) { g0.map(L, u.pm, u.pn); u.kind = 0; u.a = A + (size_t)u.pm * 256 * D * 2; u.b = Bt + (size_t)u.pn * 256 * D * 2; return true; }
        int r = L - g0.nwg; if (r >= nextra) return false;
        if (r < 32) { u.kind = 1; u.pm = r >> 2; u.pn = r & 3; u.a = memn + (size_t)u.pm * 256 * D * 2; u.b = wkv_t + (size_t)u.pn * 256 * D * 2; return true; }
        r -= 32; u.kind = 2; u.pm = r >> 2; u.pn = r & 3; u.a = memn + (size_t)u.pm * 256 * D * 2; u.b = wkv_t + (size_t)(D + u.pn * 256) * D * 2; return true;
    }
};
struct OrderPlain {
    typedef Unit U;
    const char *A, *Bt; int lda, ldb, G, c; GridOrder g0;
    __device__ __forceinline__ void init(const void* A_, const void* Bt_, int lda_, int ldb_, int nM, int nN, int G_, int c_) { A = (const char*)A_; Bt = (const char*)Bt_; lda = lda_; ldb = ldb_; G = G_; c = c_; g0.init(nM, nN); }
    __device__ __forceinline__ bool next(int i, Unit& u) const {
        const int L = i * G + c; if (L >= g0.nwg) return false;
        g0.map(L, u.pm, u.pn);
        u.a = A + (size_t)u.pm * 256 * lda * 2; u.b = Bt + (size_t)u.pn * 256 * ldb * 2; return true;
    }
};
template <int NTN, bool G1> struct OrderMoe {
    typedef UnitM U;
    const int* ltok; const char* A; const char* Bt; int G, c; int seg[4], til[4], cn[4];
    __device__ __forceinline__ void init(const unsigned* cnt, const int* ltok_, const void* A_, const void* Bt_, int G_, int c_) {
        ltok = ltok_; A = (const char*)A_; Bt = (const char*)Bt_; G = G_; c = c_;
        const int lane = threadIdx.x & 63; const int cv = (lane < NE) ? (int)__hip_atomic_load(cnt + 64 * lane, __ATOMIC_RELAXED, __HIP_MEMORY_SCOPE_AGENT) : 0;
        const int t = (cv + 255) >> 8; int incl = t;
#pragma unroll
        for (int o = 1; o < 32; o <<= 1) { const int v = __shfl_up(incl, o); if (lane >= o) incl += v; }
        const int excl = incl - t, xcd = c & 7;
#pragma unroll
        for (int q = 0; q < 4; ++q) { seg[q] = __builtin_amdgcn_readlane(excl, xcd + 8 * q); til[q] = __builtin_amdgcn_readlane(t, xcd + 8 * q); cn[q] = __builtin_amdgcn_readlane(cv, xcd + 8 * q); }
    }
    __device__ __forceinline__ bool next(int i, UnitM& u) const {
        const int xcd = c & 7, slot = c >> 3, nslot = G >> 3; int j = i * nslot + slot;
#pragma unroll
        for (int q = 0; q < 4; ++q) {
            const int nu = til[q] * NTN;
            if (j < nu) { const int e = xcd + 8 * q, mt = j / NTN, nt = j % NTN;
                u.e = e; u.pm = mt; u.pn = nt; u.rowoff = (seg[q] + mt) * 256; u.nvalid = cn[q] - mt * 256 < 256 ? cn[q] - mt * 256 : 256; u.tok = ltok + (size_t)e * LISTCAP + mt * 256;
                if (G1) { u.a = A; u.b = Bt + ((size_t)e * 2048 + (size_t)nt * 256) * D; }
                else { u.a = A + (size_t)u.rowoff * DEXP; u.b = Bt + ((size_t)e * 1024 + (size_t)nt * 256) * DEXP; }
                return true; }
            j -= nu;
        }
        return false;
    }
};

struct UnitX { const char* a; const char* b; unsigned char* out; int pm, pn; };
struct OrderPX {
    typedef UnitX U;
    const char *kmem, *vmem, *wqb, *wo_t; unsigned char *wqkt, *vwot; int c;
    __device__ __forceinline__ void init(const void* kmem_, const void* vmem_, const void* wqb_, const void* wo_t_, void* wqkt_, void* vwot_, int c_) {
        kmem = (const char*)kmem_; vmem = (const char*)vmem_; wqb = (const char*)wqb_; wo_t = (const char*)wo_t_; wqkt = (unsigned char*)wqkt_; vwot = (unsigned char*)vwot_; c = c_; }
    __device__ __forceinline__ bool next(int i, UnitX& u) const {
        if (i > 0 || c >= 256) return false;
        const int kind = c >> 7, r = c & 127, b = r >> 4, h = (r >> 2) & 3, t = r & 3; u.pm = 0; u.pn = 0;
        if (kind == 0) { u.a = kmem + ((size_t)(b * MEMLEN) * D + h * XHD) * 2; u.b = wqb + ((size_t)(t * 256) * D + h * XHD) * 2; u.out = wqkt + (size_t)b * D * D + (size_t)(h * XHD) * D + t * 256; }
        else { u.a = wo_t + ((size_t)(t * 256) * D + h * XHD) * 2; u.b = vmem + ((size_t)(b * MEMLEN) * D + h * XHD) * 2; u.out = vwot + (size_t)b * D * D + (size_t)(t * 256) * D + h * XHD; }
        return true;
    }
};
struct EpiPX {
    static constexpr bool PERM = true, AFTER_DRAIN = false;
    __device__ __forceinline__ void prefetch(const UnitX&, int, LAS unsigned char*, int, int) const {}
    __device__ __forceinline__ void operator()(const Acc& acc, const UnitX& u, int, LAS unsigned char*, int wr, int wc, int fr, int fq) const {
        const int row0 = wr * 64 + fr, col0 = wc * 32 + 8 * fq;
#pragma unroll
        for (int ai = 0; ai < 2; ++ai)
#pragma unroll
            for (int m = 0; m < 4; ++m) { unsigned char* rowp = u.out + (size_t)(row0 + ai * HALF + m * 16) * D + col0;
#pragma unroll
                for (int bj = 0; bj < 2; ++bj) { const f32x4 v0 = acc[ai][bj][m][0] * PX8_SCALE, v1 = acc[ai][bj][m][1] * PX8_SCALE;
                    u32x2 w; w.x = pk_fp8x4(v0[0], v0[1], v0[2], v0[3]); w.y = pk_fp8x4(v1[0], v1[1], v1[2], v1[3]);
                    *(u32x2*)(rowp + bj * HALF) = w; } }
    }
};
struct OrderXB {
    typedef Unit U; static constexpr bool HALFM = false;
    const char *A, *W; int G, c;
    __device__ __forceinline__ void init(const void* A_, const void* W_, int G_, int c_) { A = (const char*)A_; W = (const char*)W_; G = G_; c = c_; }
    __device__ __forceinline__ bool next(int i, Unit& u) const {
        const int L = i * G + c; if (L >= (M / 256) * XH) return false;
        const int xcd = L & 7, j = L >> 3; u.pm = xcd * 8 + (j >> 2); u.pn = j & 3;
        u.a = A + (size_t)u.pm * 256 * D; u.b = W + ((size_t)(u.pm >> 3) * D * D + (size_t)u.pn * 256 * D); return true;
    }
};

struct EpiP1 {
    static constexpr bool PERM = true, AFTER_DRAIN = false;
    bf16_t *proj, *kmem, *vt;
    __device__ __forceinline__ void prefetch(const UnitK&, int, LAS unsigned char*, int, int) const {}
    __device__ __forceinline__ void operator()(const Acc& acc, const UnitK& u, int, LAS unsigned char*, int wr, int wc, int fr, int fq) const {
        bf16_t* base; int ldc; float sc = 1.f;
        if (u.kind == 0) { base = proj; ldc = NPROJ; if (u.pn >= 6 && u.pn < 8) sc = C2Q; } else if (u.kind == 1) { base = kmem; ldc = D; } else { base = vt; ldc = D; }
        const int row0 = u.pm * BM + wr * 64 + fr, col0 = u.pn * BM + wc * 32 + 8 * fq;
#pragma unroll
        for (int ai = 0; ai < 2; ++ai)
#pragma unroll
            for (int m = 0; m < 4; ++m) { bf16_t* rowp = base + (size_t)(row0 + ai * HALF + m * 16) * ldc + col0;
#pragma unroll
                for (int bj = 0; bj < 2; ++bj) { const f32x4 v0 = acc[ai][bj][m][0] * sc, v1 = acc[ai][bj][m][1] * sc;
                    u32x4 w; w.x = cvt_pk_bf16(v0[0], v0[1]); w.y = cvt_pk_bf16(v0[2], v0[3]); w.z = cvt_pk_bf16(v1[0], v1[1]); w.w = cvt_pk_bf16(v1[2], v1[3]);
                    *(u32x4*)(rowp + bj * HALF) = w; } }
    }
};
template <bool BASE16, bool OUT8> struct EpiRes {
    static constexpr bool PERM = true, AFTER_DRAIN = true;
    const void* base; bf16_t* xb; unsigned char* x8; float* ss; float cs;
    __device__ __forceinline__ void prefetch(const Unit&, int, LAS unsigned char*, int, int) const {}
    __device__ __forceinline__ void fused(Acc& acc, const Unit& u, int wr, int wc, int fr, int fq, LAS unsigned char* lds, int wid, int lane) const {
        LAS float* PSS = (LAS float*)lds;
        const int col0 = u.pn * BM + wc * 32 + 8 * fq;
#pragma unroll
        for (int ai = 0; ai < 2; ++ai)
#pragma unroll
            for (int m = 0; m < 4; ++m) { const int r = ai * HALF + wr * 64 + m * 16 + fr; const size_t off = (size_t)(u.pm * BM + r) * D + col0; float sq = 0.f;
#pragma unroll
                for (int bj = 0; bj < 2; ++bj) { f32x4 b0, b1;
                    if constexpr (BASE16) { const u32x4 w = __builtin_nontemporal_load((const u32x4*)((const bf16_t*)base + off + bj * HALF)); b0 = (f32x4){bf_lo(w.x), bf_hi(w.x), bf_lo(w.y), bf_hi(w.y)}; b1 = (f32x4){bf_lo(w.z), bf_hi(w.z), bf_lo(w.w), bf_hi(w.w)}; }
                    else { b0 = __builtin_nontemporal_load((const f32x4*)((const float*)base + off + bj * HALF)); b1 = __builtin_nontemporal_load((const f32x4*)((const float*)base + off + bj * HALF + 4)); }
                    const f32x4 o0 = b0 + acc[ai][bj][m][0] * cs, o1 = b1 + acc[ai][bj][m][1] * cs;
                    { u32x4 w; w.x = cvt_pk_bf16(o0[0], o0[1]); w.y = cvt_pk_bf16(o0[2], o0[3]); w.z = cvt_pk_bf16(o1[0], o1[1]); w.w = cvt_pk_bf16(o1[2], o1[3]); *(u32x4*)(xb + off + bj * HALF) = w; }
                    if constexpr (OUT8) { u32x2 w; w.x = pk_fp8x4(o0[0], o0[1], o0[2], o0[3]); w.y = pk_fp8x4(o1[0], o1[1], o1[2], o1[3]); *(u32x2*)(x8 + off + bj * HALF) = w; }
                    sq += ((o0[0] * o0[0] + o0[1] * o0[1]) + (o0[2] * o0[2] + o0[3] * o0[3])) + ((o1[0] * o1[0] + o1[1] * o1[1]) + (o1[2] * o1[2] + o1[3] * o1[3])); }
                sq += __shfl_xor(sq, 16); sq += __shfl_xor(sq, 32);
                if (fq == 0) PSS[r * 4 + wc] = sq; }
        __syncthreads();
        if (threadIdx.x < 256) { const f32x4 p = *(const LAS f32x4*)(PSS + threadIdx.x * 4); ss[(size_t)(u.pm * BM + threadIdx.x) * 4 + u.pn] = (p[0] + p[1]) + (p[2] + p[3]); }
        __syncthreads();
    }
};
__device__ __forceinline__ float rstd_from_ss(const float* ss, int row) {
    const f32x4 a = *(const f32x4*)(ss + (size_t)row * 4);
    return __builtin_amdgcn_rsqf(((a[0] + a[1]) + (a[2] + a[3])) * (1.0f / D) + EPS);
}
struct EpiSoftmax {
    static constexpr bool PERM = true, AFTER_DRAIN = true;
    unsigned char* pb; const float* ss;
    __device__ __forceinline__ void prefetch(const Unit&, int, LAS unsigned char*, int, int) const {}
    __device__ __forceinline__ void fused(Acc& acc, const Unit& u, int wr, int wc, int fr, int fq, LAS unsigned char* lds, int wid, int lane) const {
        LAS float* PM = (LAS float*)lds;
        LAS float* PS = (LAS float*)(lds + 4096);
#pragma unroll
        for (int ai = 0; ai < 2; ++ai)
#pragma unroll
            for (int m = 0; m < 4; ++m) { const float sc = rstd_from_ss(ss, u.pm * BM + ai * HALF + wr * 64 + m * 16 + fr) * (C2X / PX8_SCALE);
#pragma unroll
                for (int bj = 0; bj < 2; ++bj)
#pragma unroll
                    for (int n = 0; n < 2; ++n) acc[ai][bj][m][n] = acc[ai][bj][m][n] * sc; }
#pragma unroll
        for (int ai = 0; ai < 2; ++ai)
#pragma unroll
            for (int m = 0; m < 4; ++m) { float mx = -INFINITY;
#pragma unroll
                for (int bj = 0; bj < 2; ++bj)
#pragma unroll
                    for (int n = 0; n < 2; ++n) { const f32x4 x = acc[ai][bj][m][n]; mx = fmaxf(mx, fmaxf(fmaxf(x[0], x[1]), fmaxf(x[2], x[3]))); }
                mx = fmaxf(mx, __shfl_xor(mx, 16)); mx = fmaxf(mx, __shfl_xor(mx, 32));
                if (fq == 0) PM[(ai * HALF + wr * 64 + m * 16 + fr) * 4 + wc] = mx; }
        __syncthreads();
#pragma unroll
        for (int ai = 0; ai < 2; ++ai)
#pragma unroll
            for (int m = 0; m < 4; ++m) { const int r = ai * HALF + wr * 64 + m * 16 + fr; const f32x4 pm4 = *(const LAS f32x4*)(PM + r * 4);
                const float mx = fmaxf(fmaxf(pm4[0], pm4[1]), fmaxf(pm4[2], pm4[3])); float s = 0.f;
#pragma unroll
                for (int bj = 0; bj < 2; ++bj)
#pragma unroll
                    for (int n = 0; n < 2; ++n) { f32x4 x = acc[ai][bj][m][n];
#pragma unroll
                        for (int j = 0; j < 4; ++j) { x[j] = __builtin_amdgcn_exp2f(x[j] - mx); s += x[j]; }
                        acc[ai][bj][m][n] = x; }
                s += __shfl_xor(s, 16); s += __shfl_xor(s, 32);
                if (fq == 0) PS[r * 4 + wc] = s; }
        __syncthreads();
        const int row0 = u.pm * BM + wr * 64 + fr, col0 = u.pn * XHD + wc * 32 + 8 * fq;
#pragma unroll
        for (int ai = 0; ai < 2; ++ai)
#pragma unroll
            for (int m = 0; m < 4; ++m) { const int r = ai * HALF + wr * 64 + m * 16 + fr; const f32x4 ps4 = *(const LAS f32x4*)(PS + r * 4);
                const float inv = P8_SCALE / ((ps4[0] + ps4[1]) + (ps4[2] + ps4[3])); unsigned char* rowp = pb + (size_t)(row0 + ai * HALF + m * 16) * D + col0;
#pragma unroll
                for (int bj = 0; bj < 2; ++bj) { const f32x4 v0 = acc[ai][bj][m][0] * inv, v1 = acc[ai][bj][m][1] * inv;
                    u32x2 w; w.x = pk_fp8x4(v0[0], v0[1], v0[2], v0[3]); w.y = pk_fp8x4(v1[0], v1[1], v1[2], v1[3]);
                    *(u32x2*)(rowp + bj * HALF) = w; } }
        __syncthreads();
    }
};
constexpr int META_OFF = 131072, META_BYTES = 3072;
__device__ __forceinline__ void dma4(const void* g, LAS unsigned char* l) { __builtin_amdgcn_global_load_lds((const unsigned*)g, (LAS unsigned*)l, 4, 0, 0); }
__device__ __forceinline__ void dma16(const void* g, LAS unsigned char* l) { __builtin_amdgcn_global_load_lds((const unsigned*)g, (LAS unsigned*)l, 16, 0, 0); }
struct EpiAct {
    static constexpr bool PERM = true, AFTER_DRAIN = false;
    bf16_t* act; const float* lrstd; const float* b1;
    __device__ __forceinline__ void prefetch(const UnitM& u, int ui, LAS unsigned char* lds, int wid, int lane) const {
        LAS unsigned char* mb = lds + META_OFF + (ui % 3) * META_BYTES;
        if (wid < 4) dma4(lrstd + (size_t)u.e * LISTCAP + u.pm * 256 + wid * 64 + lane, mb + wid * 256);
        else dma4(u.tok + (wid - 4) * 64 + lane, mb + 1024 + (wid - 4) * 256);
        if (wid == 4) dma16(b1 + (size_t)u.e * 2048 + (lane >> 5) * 1024 + u.pn * 128 + (lane & 31) * 4, mb + 2048);
    }
    __device__ __forceinline__ void operator()(const Acc& acc, const UnitM& u, int ui, LAS unsigned char* lds, int wr, int wc, int fr, int fq) const {
        const LAS unsigned char* mb = lds + META_OFF + (ui % 3) * META_BYTES;
        const int cl = wc * 32 + 8 * fq, gcol = u.pn * 128 + cl; const LAS float* bg = (const LAS float*)(mb + 2048) + cl; const LAS float* bl = bg + 128;
        const f32x4 bg0 = *(const LAS f32x4*)bg, bg1 = *(const LAS f32x4*)(bg + 4), bl0 = *(const LAS f32x4*)bl, bl1 = *(const LAS f32x4*)(bl + 4);
        int rb = wr * 64 + fr; asm volatile("" : "+v"(rb));
#pragma unroll
        for (int ai = 0; ai < 2; ++ai)
#pragma unroll
            for (int m = 0; m < 4; ++m) { const int r = ai * HALF + m * 16 + rb; const float rs = ((const LAS float*)mb)[r] * (1.0f / W8_SCALE);
                int w[2];
#pragma unroll
                for (int n = 0; n < 2; ++n) { const f32x4 ga = acc[ai][0][m][n], la = acc[ai][1][m][n], bgn = n ? bg1 : bg0, bln = n ? bl1 : bl0; int wn = 0;
#pragma unroll
                    for (int hh = 0; hh < 2; ++hh) {
                        f32x2 g2 = (f32x2){ga[2 * hh], ga[2 * hh + 1]} * rs + (f32x2){bgn[2 * hh], bgn[2 * hh + 1]}, l2 = (f32x2){la[2 * hh], la[2 * hh + 1]} * rs + (f32x2){bln[2 * hh], bln[2 * hh + 1]};
                        g2 = __builtin_elementwise_min(g2, (f32x2){7.0f, 7.0f});
                        l2 = __builtin_elementwise_min(__builtin_elementwise_max(l2, (f32x2){-7.0f, -7.0f}), (f32x2){7.0f, 7.0f});
                        const f32x2 t2 = g2 * (-1.702f * LOG2E); f32x2 d2; d2.x = __builtin_amdgcn_exp2f(t2.x); d2.y = __builtin_amdgcn_exp2f(t2.y); d2 = d2 + 1.0f;
                        f32x2 r2; r2.x = __builtin_amdgcn_rcpf(d2.x); r2.y = __builtin_amdgcn_rcpf(d2.y);
                        const f32x2 o2 = (g2 * r2) * (l2 * ACT8_SCALE + ACT8_SCALE);
                        if (hh == 0) wn = __builtin_amdgcn_cvt_pk_fp8_f32(o2.x, o2.y, wn, false); else wn = __builtin_amdgcn_cvt_pk_fp8_f32(o2.x, o2.y, wn, true); }
                    w[n] = wn; }
                *(u32x2*)((unsigned char*)act + (size_t)(u.rowoff + r) * DEXP + gcol) = (u32x2){(unsigned)w[0], (unsigned)w[1]}; }
    }
};
struct EpiY {
    static constexpr bool PERM = true, AFTER_DRAIN = false;
    bf16_t* y; const float* lgate; const int* ltok; const float* b2;
    __device__ __forceinline__ void prefetch(const UnitM& u, int ui, LAS unsigned char* lds, int wid, int lane) const {
        LAS unsigned char* mb = lds + META_OFF + (ui % 3) * META_BYTES;
        const size_t li = (size_t)u.e * LISTCAP + u.pm * 256 + (wid & 3) * 64 + lane;
        if (wid < 4) dma4(lgate + li, mb + wid * 256); else dma4(ltok + li, mb + 1024 + (wid - 4) * 256);
        if (wid == 0) dma16(b2 + (size_t)u.e * D + u.pn * 256 + lane * 4, mb + 2048);
    }
    __device__ __forceinline__ void operator()(const Acc& acc, const UnitM& u, int ui, LAS unsigned char* lds, int wr, int wc, int fr, int fq) const {
        const LAS unsigned char* mb = lds + META_OFF + (ui % 3) * META_BYTES;
        const int cl = wc * 32 + 8 * fq, col0 = u.pn * BM + cl; const LAS float* bb = (const LAS float*)(mb + 2048) + cl;
        int rb = wr * 64 + fr; asm volatile("" : "+v"(rb));
#pragma unroll
        for (int bj = 0; bj < 2; ++bj) {
            const f32x4 bv0 = *(const LAS f32x4*)(bb + bj * HALF), bv1 = *(const LAS f32x4*)(bb + bj * HALF + 4);
#pragma unroll
            for (int ai = 0; ai < 2; ++ai)
#pragma unroll
                for (int m = 0; m < 4; ++m) { const int r = ai * HALF + m * 16 + rb;
                    if (r < u.nvalid) { const int ent = ((const LAS int*)(mb + 1024))[r]; const float gs = ((const LAS float*)mb)[r] * Y8_SCALE; unsigned char* rowp = (unsigned char*)y + (size_t)ent * D + col0;
                        const f32x4 a0 = acc[ai][bj][m][0], a1 = acc[ai][bj][m][1]; constexpr float CS = 1.0f / (W8_SCALE * ACT8_SCALE);
                        const f32x2 p0 = ((f32x2){a0[0], a0[1]} * CS + (f32x2){bv0[0], bv0[1]}) * gs, p1 = ((f32x2){a0[2], a0[3]} * CS + (f32x2){bv0[2], bv0[3]}) * gs;
                        const f32x2 p2 = ((f32x2){a1[0], a1[1]} * CS + (f32x2){bv1[0], bv1[1]}) * gs, p3 = ((f32x2){a1[2], a1[3]} * CS + (f32x2){bv1[2], bv1[3]}) * gs;
                        u32x2 w; w.x = pk_fp8x4(p0.x, p0.y, p1.x, p1.y); w.y = pk_fp8x4(p2.x, p2.y, p3.x, p3.y);
                        *(u32x2*)(rowp + bj * HALF) = w; } }
        }
    }
};
}

#define XB_TMO      128
#define XB_XCNT(j)  (256  + 64 * (j))
#define XB_XSUB(j)  (1280 + 64 * (j))
#define XB_XGEN(j)  (2304 + 64 * (j))
#define XB_TOP      3328
#define XB_TOPGEN   3392
#define XCD_BAR_WORDS 3456
#define XB_SPIN_CAP (1u << 18)
__device__ __forceinline__ unsigned xb_ld(unsigned* p)              { return __hip_atomic_load(p, __ATOMIC_RELAXED, __HIP_MEMORY_SCOPE_AGENT); }
__device__ __forceinline__ unsigned xb_add(unsigned* p, unsigned v) { return __hip_atomic_fetch_add(p, v, __ATOMIC_RELAXED, __HIP_MEMORY_SCOPE_AGENT); }
__device__ __forceinline__ unsigned xb_xcc_id() { return (unsigned)__builtin_amdgcn_s_getreg((3 << 11) | 20) & 0xFu; }
#define XB_SPIN(cond, bar) do { unsigned _sp = 0; while (cond) { __builtin_amdgcn_s_sleep(1); \
    if ((++_sp & 255u) == 0u) { if (xb_ld(&(bar)[XB_TMO])) break; if (_sp > XB_SPIN_CAP) { atomicAdd(&(bar)[XB_TMO], 1u); break; } } } } while (0)
struct XcdBarrier { unsigned* bar; unsigned x; volatile LAS unsigned* st; };
__device__ __forceinline__ XcdBarrier xcd_barrier_post(unsigned* bar, volatile LAS unsigned* st) {
    XcdBarrier b; b.bar = bar; b.x = xb_xcc_id(); b.st = st;
    if (threadIdx.x == 0) (void)xb_add(&bar[XB_XCNT(b.x)], 1u);
    return b;
}
__device__ __forceinline__ void xcd_barrier_complete(unsigned* bar, unsigned x, unsigned& nloc, unsigned& nx) {
    const unsigned G = gridDim.x * gridDim.y * gridDim.z;
    unsigned sum, cnt, mine, sp = 0u;
    for (;;) {
        sum = 0u; cnt = 0u; mine = 0u;
#pragma unroll
        for (unsigned j = 0; j < 16; ++j) { const unsigned c = xb_ld(&bar[XB_XCNT(j)]); sum += c; cnt += (c > 0u) ? 1u : 0u; mine = (j == x) ? c : mine; }
        if (sum == G) break;
        __builtin_amdgcn_s_sleep(1);
        if ((++sp & 255u) == 0u) { if (xb_ld(&bar[XB_TMO])) break; if (sp > XB_SPIN_CAP) { atomicAdd(&bar[XB_TMO], 1u); break; } }
    }
    nloc = mine > 0u ? mine : 1u; nx = cnt > 0u ? cnt : 1u;
}
__device__ __forceinline__ void xcd_barrier(const XcdBarrier& b) {
    asm volatile("s_waitcnt vmcnt(0)" ::: "memory");
    __syncthreads();
    if (threadIdx.x == 0) {
        unsigned* bar = b.bar;
        __builtin_amdgcn_s_waitcnt(0);
        unsigned nloc = b.st[0], nx = b.st[1];
        if (nloc == 0u) { xcd_barrier_complete(bar, b.x, nloc, nx); b.st[0] = nloc; b.st[1] = nx; }
        const unsigned old = xb_add(&bar[XB_XSUB(b.x)], 1u);
        const unsigned gen = old / nloc;
        if (old + 1u == (gen + 1u) * nloc) {
            __builtin_amdgcn_fence(__ATOMIC_RELEASE, "agent");
            asm volatile("s_waitcnt vmcnt(0)" ::: "memory");
            const unsigned og = xb_add(&bar[XB_TOP], 1u);
            const unsigned tg = og / nx;
            if (og + 1u == (tg + 1u) * nx) xb_add(&bar[XB_TOPGEN], 1u);
            else XB_SPIN(xb_ld(&bar[XB_TOPGEN]) == tg, bar);
            __builtin_amdgcn_fence(__ATOMIC_ACQUIRE, "agent");
            xb_add(&bar[XB_XGEN(b.x)], 1u);
            asm volatile("s_waitcnt vmcnt(0)" ::: "memory");
        } else {
            XB_SPIN(xb_ld(&bar[XB_XGEN(b.x)]) == gen, bar);
            __builtin_amdgcn_fence(__ATOMIC_ACQUIRE, "agent");
            asm volatile("s_waitcnt vmcnt(0)" ::: "memory");
        }
    }
    __syncthreads();
}

constexpr int NWAVES = 8;
constexpr int RING_OFF = 0, RING_BYTES = 131072;
constexpr int LDSCTL_OFF = RING_BYTES + 12288, MISC_OFF = LDSCTL_OFF + 320;
constexpr int LDS_BYTES = 147456;
static_assert(MISC_OFF + 128 <= LDS_BYTES, "LDS map");

struct Frame {
    LAS unsigned char* lds; volatile LAS unsigned* MISC; unsigned* ctl; unsigned char* ws;
    int tid, lane, wave, vcu, G;
    const float* const* in; float* out;
};

__device__ __forceinline__ int nmap1(int n) { return n < 1024 ? (n >> 7) * 256 + (n & 127) : ((n - 1024) >> 7) * 256 + 128 + ((n - 1024) & 127); }
struct TItem { const float* W; bf16_t* WT; const float* g; int ldw, K, k0, n0, perm; };
__device__ __forceinline__ void titem_load(const TItem& t, f32x4 (&va)[8], f32x4 (&vb)[8], int lane) {
    const int nq = lane & 15, kp = lane >> 4;
#pragma unroll
    for (int it = 0; it < 8; ++it) { const int k = t.k0 + 2 * (kp + 4 * it); va[it] = __builtin_nontemporal_load((const f32x4*)(t.W + (size_t)k * t.ldw + t.n0 + 4 * nq)); vb[it] = __builtin_nontemporal_load((const f32x4*)(t.W + (size_t)(k + 1) * t.ldw + t.n0 + 4 * nq)); }
}
__device__ __forceinline__ void titem_store(const TItem& t, const f32x4 (&va)[8], const f32x4 (&vb)[8], LAS unsigned* scr, int lane) {
    const int nq = lane & 15, kp = lane >> 4;
#pragma unroll
    for (int it = 0; it < 8; ++it) { const int kk2 = kp + 4 * it; f32x4 a = va[it], b = vb[it];
        if (t.g) { const float g0 = t.g[t.k0 + 2 * kk2], g1 = t.g[t.k0 + 2 * kk2 + 1]; a = a * g0; b = b * g1; }
#pragma unroll
        for (int j = 0; j < 4; ++j) scr[(4 * nq + j) * 33 + kk2] = cvtpk_s(a[j], b[j]); }
    LDS_WAIT(); asm volatile("" ::: "memory");
    const int c = lane & 7;
#pragma unroll
    for (int it = 0; it < 8; ++it) { const int n = (lane >> 3) + 8 * it; const LAS unsigned* sp = scr + n * 33 + 4 * c;
        u32x4 o; o.x = sp[0]; o.y = sp[1]; o.z = sp[2]; o.w = sp[3];
        const int nn = t.n0 + n, nr = t.perm ? nmap1(nn) : nn;
        *(u32x4*)(t.WT + (size_t)nr * t.K + t.k0 + 8 * c) = o; }
    LDS_WAIT(); asm volatile("" ::: "memory");
}
__device__ __forceinline__ void titem8_run(const TItem& t, LAS unsigned* scr, int lane) {
    const int nq = lane & 15, kg = lane >> 4;
    f32x4 v[8][4];
#pragma unroll
    for (int it = 0; it < 8; ++it) { const int k = t.k0 + 4 * (kg + 4 * it); const float* p = t.W + (size_t)k * t.ldw + t.n0 + 4 * nq;
#pragma unroll
        for (int q = 0; q < 4; ++q) v[it][q] = __builtin_nontemporal_load((const f32x4*)(p + (size_t)q * t.ldw)); }
#pragma unroll
    for (int it = 0; it < 8; ++it) { const int kq = kg + 4 * it;
        float g0 = W8_SCALE, g1 = W8_SCALE, g2 = W8_SCALE, g3 = W8_SCALE;
        if (t.g) { const f32x4 gv = *(const f32x4*)(t.g + t.k0 + 4 * kq); g0 *= gv[0]; g1 *= gv[1]; g2 *= gv[2]; g3 *= gv[3]; }
#pragma unroll
        for (int j = 0; j < 4; ++j) scr[(4 * nq + j) * 33 + kq] = pk_fp8x4(v[it][0][j] * g0, v[it][1][j] * g1, v[it][2][j] * g2, v[it][3][j] * g3); }
    LDS_WAIT(); asm volatile("" ::: "memory");
    const int c = lane & 7;
#pragma unroll
    for (int it = 0; it < 8; ++it) { const int n = (lane >> 3) + 8 * it; const LAS unsigned* sp = scr + n * 33 + 4 * c;
        u32x4 o; o.x = sp[0]; o.y = sp[1]; o.z = sp[2]; o.w = sp[3];
        const int nn = t.n0 + n, nr = t.perm ? nmap1(nn) : nn;
        __builtin_nontemporal_store(o, (u32x4*)((unsigned char*)t.WT + (size_t)nr * t.K + t.k0 + 16 * c)); }
    LDS_WAIT(); asm volatile("" ::: "memory");
}
template <bool F8, class Dec> __device__ __forceinline__ void titem_loop(int first, int stride, int n, LAS unsigned* scr, int lane, const Dec& dec) {
    if (first >= n) return;
    if constexpr (F8) { TItem A; for (int i = first; i < n; i += stride) { dec(i, A); titem8_run(A, scr, lane); } }
    else {
        TItem A, B; f32x4 a0[8], a1[8], b0[8], b1[8];
        int ia = first; dec(ia, A); titem_load(A, a0, a1, lane);
        for (;;) {
            const int ib = ia + stride; const bool hb = ib < n;
            if (hb) { dec(ib, B); titem_load(B, b0, b1, lane); }
            titem_store(A, a0, a1, scr, lane);
            if (!hb) break;
            ia = ib + stride; const bool ha = ia < n;
            if (ha) { dec(ia, A); titem_load(A, a0, a1, lane); }
            titem_store(B, b0, b1, scr, lane);
            if (!ha) break;
        }
    }
}
__device__ __forceinline__ void rms_rows_to_bf16(const float* x, const float* g, bf16_t* o, int first, int stride, int n, int lane) {
    if (first >= n) return;
    const f32x4* gr = (const f32x4*)g + lane; f32x4 gg[4];
#pragma unroll
    for (int j = 0; j < 4; ++j) gg[j] = gr[64 * j];
    f32x4 v[4], w[4];
#pragma unroll
    for (int j = 0; j < 4; ++j) v[j] = __builtin_nontemporal_load((const f32x4*)(x + (size_t)first * D) + lane + 64 * j);
    for (int m = first; m < n; m += stride) {
        const int mn = m + stride;
        if (mn < n) {
#pragma unroll
            for (int j = 0; j < 4; ++j) w[j] = __builtin_nontemporal_load((const f32x4*)(x + (size_t)mn * D) + lane + 64 * j);
        }
        float sq = 0.f;
#pragma unroll
        for (int j = 0; j < 4; ++j) sq += (v[j][0] * v[j][0] + v[j][1] * v[j][1]) + (v[j][2] * v[j][2] + v[j][3] * v[j][3]);
        const float rstd = __builtin_amdgcn_rsqf(wave_sum(sq) * (1.f / D) + EPS);
        u32x2* o8 = (u32x2*)(o + (size_t)m * D) + lane;
#pragma unroll
        for (int j = 0; j < 4; ++j) { u32x2 q; q.x = cvtpk_s(v[j][0] * rstd * gg[j][0], v[j][1] * rstd * gg[j][1]); q.y = cvtpk_s(v[j][2] * rstd * gg[j][2], v[j][3] * rstd * gg[j][3]); o8[64 * j] = q; }
#pragma unroll
        for (int j = 0; j < 4; ++j) v[j] = w[j];
    }
}
__device__ __forceinline__ void convert_experts(Frame& F, int first, int stride, int end) {
    LAS unsigned* scr = (LAS unsigned*)(F.lds + RING_OFF + F.wave * 16384);
    const float *g_moe = F.in[13], *w1 = F.in[16], *w2 = F.in[18];
    unsigned char *w1_t = F.ws + WS_W1_T, *w2_t = F.ws + WS_W2_T;
    constexpr int I_2 = NE * 8 * 16;
    titem_loop<true>(first, stride, end, scr, F.lane, [=](int r, TItem& t) {
        t.g = nullptr; t.perm = 0; t.K = D;
        if (r < I_2) { const int ex = r / 128, q = r % 128; t.W = w2 + (size_t)ex * DEXP * D; t.WT = (bf16_t*)(w2_t + (size_t)ex * D * DEXP); t.ldw = D; t.k0 = (q / 16) * 128; t.n0 = (q % 16) * 64; return; } r -= I_2;
        { const int ex = r / 256, q = r % 256; t.W = w1 + (size_t)ex * D * 2048; t.WT = (bf16_t*)(w1_t + (size_t)ex * 2048 * D); t.g = g_moe; t.ldw = 2048; t.perm = 1; t.k0 = (q / 32) * 128; t.n0 = (q % 32) * 64; }
    });
}
__device__ __forceinline__ void p0_prologue(Frame& F) {
    LAS unsigned* scr = (LAS unsigned*)(F.lds + RING_OFF + F.wave * 16384);
    const int gw = F.vcu * NWAVES + F.wave, NGW = F.G * NWAVES;
    const float *x = F.in[0], *mem = F.in[1], *g_mix = F.in[2], *w_in = F.in[3], *w_out = F.in[7], *g_xattn = F.in[8], *g_mem = F.in[9], *w_q = F.in[10], *w_kv = F.in[11], *w_o = F.in[12], *g_moe = F.in[13], *w_router = F.in[14];
    bf16_t *win_t = (bf16_t*)(F.ws + WS_WIN_T), *wout_t = (bf16_t*)(F.ws + WS_WOUT_T), *wq_t = (bf16_t*)(F.ws + WS_WQ_T), *wkv_t = (bf16_t*)(F.ws + WS_WKV_T), *wo_t = (bf16_t*)(F.ws + WS_WO_T),
           *xn = (bf16_t*)(F.ws + WS_XN), *memn = (bf16_t*)(F.ws + WS_MEMN);
    bf16_t* wr = (bf16_t*)(F.ws + WS_WR);
    for (int i = gw; i < D * NE / 64; i += NGW) { const int idx = i * 64 + F.lane, k = idx >> 5, ex = idx & 31; const float w = w_router[idx] * g_moe[k];
        const unsigned hi = cvtpk_s(w, 0.f) & 0xffffu; const float rem = w - __uint_as_float(hi << 16); const unsigned lo = cvtpk_s(rem, 0.f) & 0xffffu;
        const int ti = (k >> 3) * 256 + ex * 8 + (k & 7);
        wr[ti] = (bf16_t)hi; wr[NE * D + ti] = (bf16_t)lo; }
    rms_rows_to_bf16(mem, g_mem, memn, gw, NGW, MROWS, F.lane);
    for (int i = gw * 64 + F.lane; i < D * D / 4; i += NGW * 64) {
        const f32x4 v = __builtin_nontemporal_load((const f32x4*)w_q + i) * g_xattn[i >> 8]; u32x2 w; w.x = cvtpk_s(v[0], v[1]); w.y = cvtpk_s(v[2], v[3]); ((u32x2*)wq_t)[i] = w; }
    constexpr int I_KV = 16 * 32, I_O = 16 * 16, I_OUT = 16 * 16, I_IN = 16 * 48;
    titem_loop<false>(gw, NGW, I_KV + I_O + I_OUT + I_IN, scr, F.lane, [=](int r, TItem& t) {
        t.g = nullptr; t.perm = 0; t.K = D; t.ldw = D;
        if (r < I_KV) { t.W = w_kv; t.WT = wkv_t; t.ldw = 2 * D; t.k0 = (r / 32) * 64; t.n0 = (r % 32) * 64; return; } r -= I_KV;
        if (r < I_O) { t.W = w_o; t.WT = wo_t; t.k0 = (r / 16) * 64; t.n0 = (r % 16) * 64; return; } r -= I_O;
        if (r < I_OUT) { t.W = w_out; t.WT = wout_t; t.k0 = (r / 16) * 64; t.n0 = (r % 16) * 64; return; } r -= I_OUT;
        { t.W = w_in; t.WT = win_t; t.ldw = NPROJ; t.k0 = (r / 48) * 64; t.n0 = (r % 48) * 64; }
    });
    rms_rows_to_bf16(x, g_mix, xn, gw, NGW, M, F.lane);
}

__device__ __forceinline__ void conv_rows(Frame& F) {
    const bf16_t* proj = (const bf16_t*)(F.ws + WS_PROJ); bf16_t* ymix = (bf16_t*)(F.ws + WS_YMIX);
    const float* conv_w = F.in[4]; const float* g_conv = F.in[5];
    const int gw = F.vcu * NWAVES + F.wave, NGW = F.G * NWAVES, c0 = 8 * F.lane;
    float w0[8], w1[8], w2[8], gg[8];
#pragma unroll
    for (int j = 0; j < 8; ++j) { w0[j] = conv_w[c0 + j]; w1[j] = conv_w[512 + c0 + j]; w2[j] = conv_w[1024 + c0 + j]; gg[j] = g_conv[c0 + j]; }
    auto ld = [&](int m, u32x4 (&v)[7]) {
        const int t = m & (SEQ - 1); const bf16_t* row = proj + (size_t)m * NPROJ + c0;
        v[0] = *(const u32x4*)row; v[1] = *(const u32x4*)(row + 512); v[2] = *(const u32x4*)(row + 1024);
        v[3] = (u32x4){0, 0, 0, 0}; v[4] = v[3]; v[5] = v[3]; v[6] = v[3];
        if (t >= 1) { v[3] = *(const u32x4*)(row - NPROJ + 512); v[4] = *(const u32x4*)(row - NPROJ + 1024); }
        if (t >= 2) { v[5] = *(const u32x4*)(row - 2 * NPROJ + 512); v[6] = *(const u32x4*)(row - 2 * NPROJ + 1024); }
    };
    if (gw >= M) return;
    u32x4 cur[7], nx[7];
    ld(gw, cur);
    for (int m = gw; m < M; m += NGW) {
        if (m + NGW < M) ld(m + NGW, nx);
        const u32x4 bg = cur[0], cg0 = cur[1], xv0 = cur[2], cg1 = cur[3], xv1 = cur[4], cg2 = cur[5], xv2 = cur[6];
        float y[8]; float ss = 0.f;
#pragma unroll
        for (int j = 0; j < 4; ++j) {
            const float u0l = bf_lo(cg0[j]) * bf_lo(xv0[j]), u0h = bf_hi(cg0[j]) * bf_hi(xv0[j]);
            const float u1l = bf_lo(cg1[j]) * bf_lo(xv1[j]), u1h = bf_hi(cg1[j]) * bf_hi(xv1[j]);
            const float u2l = bf_lo(cg2[j]) * bf_lo(xv2[j]), u2h = bf_hi(cg2[j]) * bf_hi(xv2[j]);
            y[2 * j] = bf_lo(bg[j]) * (w0[2 * j] * u2l + w1[2 * j] * u1l + w2[2 * j] * u0l);
            y[2 * j + 1] = bf_hi(bg[j]) * (w0[2 * j + 1] * u2h + w1[2 * j + 1] * u1h + w2[2 * j + 1] * u0h);
            ss += y[2 * j] * y[2 * j] + y[2 * j + 1] * y[2 * j + 1];
        }
        ss += __shfl_xor(ss, 1); ss += __shfl_xor(ss, 2); ss += __shfl_xor(ss, 4);
        const float rstd = __builtin_amdgcn_rsqf(ss * (1.f / 64.f) + EPS);
        u32x4 o; o.x = cvtpk_s(y[0] * rstd * gg[0], y[1] * rstd * gg[1]); o.y = cvtpk_s(y[2] * rstd * gg[2], y[3] * rstd * gg[3]);
        o.z = cvtpk_s(y[4] * rstd * gg[4], y[5] * rstd * gg[5]); o.w = cvtpk_s(y[6] * rstd * gg[6], y[7] * rstd * gg[7]);
        *(u32x4*)(ymix + (size_t)m * D + c0) = o;
#pragma unroll
        for (int i = 0; i < 7; ++i) cur[i] = nx[i];
    }
}
constexpr int SB_SLOT = 16384, SB_V = 8192, SB_OST = 4 * SB_SLOT, SB_OSTW = 32 * 68 * 4, SB_FLAG = SB_OST + 8 * SB_OSTW;
static_assert(SB_FLAG + 32 <= RING_BYTES + 12288, "attention LDS (the O stage may extend into the GEMM phases' metadata area, unused here)");
__device__ __forceinline__ int crow(int r, int hi) { return (r & 3) + 8 * (r >> 2) + 4 * hi; }
__device__ __forceinline__ void sb_attn_unit(Frame& F, int b, int h, int qb) {
    const bf16_t* proj = (const bf16_t*)(F.ws + WS_PROJ); bf16_t* ymix = (bf16_t*)(F.ws + WS_YMIX); const float* g_sb = F.in[6];
    const int tid = F.tid, lane = F.lane, wid = F.wave, r32 = lane & 31, hi = lane >> 5;
    LAS unsigned char* lds = F.lds + RING_OFF;
    const int q0 = qb * 256, qlo = q0 + wid * 32, qpos = qlo + r32;
    const size_t rowbase = (size_t)b * SEQ;
    const bf16_t* Qp = proj + (rowbase + qlo) * NPROJ + 1536 + h * 64;
    const bf16_t* Kp = proj + rowbase * NPROJ + 2048 + h * 64;
    const bf16_t* Vp = proj + rowbase * NPROJ + 2560 + h * 64;
    bf16x8 qr[4];
#pragma unroll
    for (int s = 0; s < 4; ++s) qr[s] = *(const bf16x8*)(Qp + (size_t)r32 * NPROJ + 16 * s + 8 * hi);
    bf16x8 ntri[2], nones;
#pragma unroll
    for (int s = 0; s < 2; ++s)
#pragma unroll
        for (int j = 0; j < 8; ++j) { const int k = 16 * s + 8 * (j >> 2) + 4 * hi + (j & 3); ntri[s][j] = (k > r32) ? (short)0xBF80 : (short)0; }
#pragma unroll
    for (int j = 0; j < 8; ++j) nones[j] = (short)0xBF80;
    f32x16 R = {}; f32x16 o[2]; o[0] = f32x16{}; o[1] = f32x16{};
    const int skey = tid >> 3, sc = tid & 7;
    const int koff = skey * 128 + ((sc ^ ((skey >> 1) & 7)) << 4);
    const int voff = SB_V + (sc >> 2) * 4096 + (skey >> 4) * 1024 + (skey & 15) * 64 + (sc & 3) * 16;
    const int vbl = SB_V + ((lane >> 4) & 1) * 32 + (lane & 3) * 8 + (4 * hi + ((lane & 15) >> 2)) * 64;
    const int dw = 4 * qb + (wid >> 1);
    LAS int* dflag = (LAS int*)(lds + SB_FLAG);
    __syncthreads();
    {   u32x4 kr[4], vr[4];
#pragma unroll
        for (int p = 0; p < 4; ++p) { const size_t row = (size_t)((4 * qb + p) * 64 + skey) * NPROJ + sc * 8; kr[p] = *(const u32x4*)(Kp + row); vr[p] = *(const u32x4*)(Vp + row); }
#pragma unroll
        for (int p = 0; p < 4; ++p) { const int so = ((4 * qb + p) & 3) * SB_SLOT; *(LAS u32x4*)(lds + so + koff) = kr[p]; *(LAS u32x4*)(lds + so + voff) = vr[p]; } }
    int nb = 4 * qb - 1;
    u32x4 kreg = {0, 0, 0, 0}, vreg = {0, 0, 0, 0};
    if (nb >= 0) { const size_t row = (size_t)(nb * 64 + skey) * NPROJ + sc * 8; kreg = *(const u32x4*)(Kp + row); vreg = *(const u32x4*)(Vp + row); }
    __syncthreads();
    int done = 0;
    for (int kbi = dw; ; --kbi) {
        if (kbi < 0) done = 1;
        const int k0 = kbi * 64, so = (kbi & 3) * SB_SLOT, vb = so + vbl;
        if (!done) {
            f32x16 p0 = {}, p1 = {};
#pragma unroll
            for (int s = 0; s < 4; ++s) { const int c = 2 * s + hi;
                const bf16x8 ka = *(const LAS bf16x8*)(lds + so + r32 * 128 + ((c ^ ((r32 >> 1) & 7)) << 4));
                const bf16x8 kb = *(const LAS bf16x8*)(lds + so + (r32 + 32) * 128 + ((c ^ (((r32 + 32) >> 1) & 7)) << 4));
                p0 = __builtin_amdgcn_mfma_f32_32x32x16_bf16(ka, qr[s], p0, 0, 0, 0); p1 = __builtin_amdgcn_mfma_f32_32x32x16_bf16(kb, qr[s], p1, 0, 0, 0); }
            const bool diag = (k0 + 63 >= qlo);
            f32x16 s0, s1;
#pragma unroll
            for (int r = 0; r < 16; ++r) {
                const float z0 = p0[r], z1 = p1[r];
                float sp0 = fmaxf(z0, 0.f) + __builtin_amdgcn_logf(1.0f + __builtin_amdgcn_exp2f(-fabsf(z0)));
                float sp1 = fmaxf(z1, 0.f) + __builtin_amdgcn_logf(1.0f + __builtin_amdgcn_exp2f(-fabsf(z1)));
                if (diag) { const int key = k0 + crow(r, hi); if (key >= qpos) sp0 = 0.f; if (key + 32 >= qpos) sp1 = 0.f; }
                s0[r] = sp0; s1[r] = sp1; p0[r] = z0 - sp0; p1[r] = z1 - sp1;
            }
            u32x4 w00 = {cvtpk_s(s0[0], s0[1]), cvtpk_s(s0[2], s0[3]), cvtpk_s(s0[4], s0[5]), cvtpk_s(s0[6], s0[7])}, w01 = {cvtpk_s(s0[8], s0[9]), cvtpk_s(s0[10], s0[11]), cvtpk_s(s0[12], s0[13]), cvtpk_s(s0[14], s0[15])};
            u32x4 w10 = {cvtpk_s(s1[0], s1[1]), cvtpk_s(s1[2], s1[3]), cvtpk_s(s1[4], s1[5]), cvtpk_s(s1[6], s1[7])}, w11 = {cvtpk_s(s1[8], s1[9]), cvtpk_s(s1[10], s1[11]), cvtpk_s(s1[12], s1[13]), cvtpk_s(s1[14], s1[15])};
            const bf16x8 sb00 = __builtin_bit_cast(bf16x8, w00), sb01 = __builtin_bit_cast(bf16x8, w01), sb10 = __builtin_bit_cast(bf16x8, w10), sb11 = __builtin_bit_cast(bf16x8, w11);
            f32x16 rest1 = __builtin_amdgcn_mfma_f32_32x32x16_bf16(ntri[0], sb10, R, 0, 0, 0); rest1 = __builtin_amdgcn_mfma_f32_32x32x16_bf16(ntri[1], sb11, rest1, 0, 0, 0);
            f32x16 U = __builtin_amdgcn_mfma_f32_32x32x16_bf16(nones, sb10, R, 0, 0, 0); U = __builtin_amdgcn_mfma_f32_32x32x16_bf16(nones, sb11, U, 0, 0, 0);
            f32x16 rest0 = __builtin_amdgcn_mfma_f32_32x32x16_bf16(ntri[0], sb00, U, 0, 0, 0); rest0 = __builtin_amdgcn_mfma_f32_32x32x16_bf16(ntri[1], sb01, rest0, 0, 0, 0);
            R = __builtin_amdgcn_mfma_f32_32x32x16_bf16(nones, sb00, U, 0, 0, 0); R = __builtin_amdgcn_mfma_f32_32x32x16_bf16(nones, sb01, R, 0, 0, 0);
            done = __all(R[0] < -150.0f) ? 1 : 0;
#pragma unroll
            for (int r = 0; r < 16; ++r) {
                float a0 = __builtin_amdgcn_exp2f(p0[r] + rest0[r]), a1 = __builtin_amdgcn_exp2f(p1[r] + rest1[r]);
                if (diag) { const int key = k0 + crow(r, hi); if (key >= qpos) a0 = 0.f; if (key + 32 >= qpos) a1 = 0.f; }
                p0[r] = a0; p1[r] = a1;
            }
            u32x4 a00 = {cvtpk_s(p0[0], p0[1]), cvtpk_s(p0[2], p0[3]), cvtpk_s(p0[4], p0[5]), cvtpk_s(p0[6], p0[7])}, a01 = {cvtpk_s(p0[8], p0[9]), cvtpk_s(p0[10], p0[11]), cvtpk_s(p0[12], p0[13]), cvtpk_s(p0[14], p0[15])};
            u32x4 a10 = {cvtpk_s(p1[0], p1[1]), cvtpk_s(p1[2], p1[3]), cvtpk_s(p1[4], p1[5]), cvtpk_s(p1[6], p1[7])}, a11 = {cvtpk_s(p1[8], p1[9]), cvtpk_s(p1[10], p1[11]), cvtpk_s(p1[12], p1[13]), cvtpk_s(p1[14], p1[15])};
            const bf16x8 pa[4] = {__builtin_bit_cast(bf16x8, a00), __builtin_bit_cast(bf16x8, a01), __builtin_bit_cast(bf16x8, a10), __builtin_bit_cast(bf16x8, a11)};
#pragma unroll
            for (int d0 = 0; d0 < 2; ++d0)
#pragma unroll
                for (int ks = 0; ks < 4; ++ks) {
                    const s16x4 lo = __builtin_bit_cast(s16x4, __builtin_amdgcn_ds_read_tr16_b64_v4i16((LAS s16x4*)(lds + vb + d0 * 4096 + ks * 1024)));
                    const s16x4 hh = __builtin_bit_cast(s16x4, __builtin_amdgcn_ds_read_tr16_b64_v4i16((LAS s16x4*)(lds + vb + d0 * 4096 + ks * 1024 + 512)));
                    const bf16x8 vf = {lo[0], lo[1], lo[2], lo[3], hh[0], hh[1], hh[2], hh[3]};
                    o[d0] = __builtin_amdgcn_mfma_f32_32x32x16_bf16(pa[ks], vf, o[d0], 0, 0, 0);
                }
        }
        __syncthreads();
        if (nb >= 0) { const int sn = (nb & 3) * SB_SLOT; *(LAS u32x4*)(lds + sn + koff) = kreg; *(LAS u32x4*)(lds + sn + voff) = vreg; }
        if (lane == 0) dflag[wid] = done;
        __syncthreads();
        { const u32x4 f0 = *(const LAS u32x4*)dflag, f1 = *(const LAS u32x4*)(dflag + 4); if ((f0.x & f0.y & f0.z & f0.w & f1.x & f1.y & f1.z & f1.w) != 0u) break; }
        --nb;
        if (nb >= 0) { const size_t row = (size_t)(nb * 64 + skey) * NPROJ + sc * 8; kreg = *(const u32x4*)(Kp + row); vreg = *(const u32x4*)(Vp + row); }
    }
    LAS float* stg = (LAS float*)(lds + SB_OST + wid * SB_OSTW);
#pragma unroll
    for (int r = 0; r < 16; ++r) { const int q = crow(r, hi); stg[q * 68 + r32] = o[0][r]; stg[q * 68 + 32 + r32] = o[1][r]; }
    LDS_WAIT(); asm volatile("" ::: "memory");
    { const int q = lane >> 1, half = lane & 1; const LAS f32x4* sp = (const LAS f32x4*)(stg + q * 68 + 32 * half);
      f32x4 v[8]; float ss = 0.f;
#pragma unroll
      for (int i = 0; i < 8; ++i) { v[i] = sp[i]; ss += (v[i][0] * v[i][0] + v[i][1] * v[i][1]) + (v[i][2] * v[i][2] + v[i][3] * v[i][3]); }
      ss += __shfl_xor(ss, 1);
      const float rstd = __builtin_amdgcn_rsqf(ss * (1.f / 64.f) + EPS);
      const f32x4* gp = (const f32x4*)(g_sb + h * 64 + 32 * half);
      bf16_t* op = ymix + (rowbase + qlo + q) * D + 512 + h * 64 + 32 * half;
#pragma unroll
      for (int i = 0; i < 4; ++i) { const f32x4 g0 = gp[2 * i], g1 = gp[2 * i + 1], a = v[2 * i] * rstd * g0, c = v[2 * i + 1] * rstd * g1;
          u32x4 w; w.x = cvtpk_s(a[0], a[1]); w.y = cvtpk_s(a[2], a[3]); w.z = cvtpk_s(c[0], c[1]); w.w = cvtpk_s(c[2], c[3]); *(u32x4*)(op + 8 * i) = w; } }
    LDS_WAIT();
}
__device__ __forceinline__ void p2_mix(Frame& F) {
    conv_rows(F);
    if (F.G == 256) {
        const int bh = F.vcu >> 2, s = F.vcu & 3;
        sb_attn_unit(F, bh >> 3, bh & 7, 7 - s);
        sb_attn_unit(F, bh >> 3, bh & 7, s);
    } else {
        for (int u = F.vcu; u < 512; u += F.G) sb_attn_unit(F, u >> 6, (u >> 3) & 7, u & 7);
    }
}

__device__ __forceinline__ void p8_router(Frame& F) {
    const bf16_t* x2 = (const bf16_t*)(F.ws + WS_X2); const bf16_t* wt = (const bf16_t*)(F.ws + WS_WR); const float* b_router = F.in[15];
    float* lrstd = (float*)(F.ws + WS_LRSTD); int* ltok = (int*)(F.ws + WS_LTOK); float* lgate = (float*)(F.ws + WS_LGATE); unsigned* cnt = F.ctl + CW_CNT;
    const int lane = F.lane, c32 = lane & 31, hi = lane >> 5, wid = F.wave, kpart = wid & 3, grp = wid >> 2;
    LAS float* part = (LAS float*)(F.lds + RING_OFF);
    for (int item = 2 * F.vcu + grp; item < M / 32; item += 2 * F.G) {
        const int tok = item * 32 + c32; const bf16_t* xr = x2 + (size_t)tok * D + 256 * kpart + 8 * hi; const bf16_t* wh = wt + (size_t)(32 * kpart + hi) * 256 + c32 * 8; const bf16_t* wl = wh + NE * D;
        f32x16 acc = {}; float ss = 0.f;
#pragma unroll 4
        for (int s2 = 0; s2 < 16; ++s2) {
            const u32x4 xw = *(const u32x4*)(xr + 16 * s2); const bf16x8 xb = __builtin_bit_cast(bf16x8, xw);
            const bf16x8 a_hi = *(const bf16x8*)(wh + 512 * s2), a_lo = *(const bf16x8*)(wl + 512 * s2);
            acc = __builtin_amdgcn_mfma_f32_32x32x16_bf16(a_hi, xb, acc, 0, 0, 0); acc = __builtin_amdgcn_mfma_f32_32x32x16_bf16(a_lo, xb, acc, 0, 0, 0);
            const float x0 = bf_lo(xw.x), x1 = bf_hi(xw.x), x2_ = bf_lo(xw.y), x3 = bf_hi(xw.y), x4 = bf_lo(xw.z), x5 = bf_hi(xw.z), x6 = bf_lo(xw.w), x7 = bf_hi(xw.w);
            ss += ((x0 * x0 + x1 * x1) + (x2_ * x2_ + x3 * x3)) + ((x4 * x4 + x5 * x5) + (x6 * x6 + x7 * x7));
        }
        __syncthreads();
#pragma unroll
        for (int r = 0; r < 16; ++r) part[(wid * 17 + r) * 64 + lane] = acc[r];
        part[(wid * 17 + 16) * 64 + lane] = ss;
        __syncthreads();
        if (kpart == 0) {
#pragma unroll
            for (int r = 0; r < 16; ++r) acc[r] = ((part[((wid + 0) * 17 + r) * 64 + lane] + part[((wid + 1) * 17 + r) * 64 + lane]) + (part[((wid + 2) * 17 + r) * 64 + lane] + part[((wid + 3) * 17 + r) * 64 + lane]));
            ss = (part[((wid + 0) * 17 + 16) * 64 + lane] + part[((wid + 1) * 17 + 16) * 64 + lane]) + (part[((wid + 2) * 17 + 16) * 64 + lane] + part[((wid + 3) * 17 + 16) * 64 + lane]);
            ss += __shfl_xor(ss, 32);
            const float rstd = __builtin_amdgcn_rsqf(ss * (1.f / D) + EPS);
            float lg[32];
#pragma unroll
            for (int r = 0; r < 16; ++r) { const float mine = acc[r], other = __shfl_xor(acc[r], 32); const int e0 = (r & 3) + 8 * (r >> 2);
                lg[e0] = (hi ? other : mine) * rstd + b_router[e0]; lg[e0 + 4] = (hi ? mine : other) * rstd + b_router[e0 + 4]; }
            float tv[4] = {0.f, 0.f, 0.f, 0.f}; int ti[4] = {0, 0, 0, 0}; unsigned used = 0u;
#pragma unroll 1
            for (int k = 0; k < 4; ++k) { float bv = -INFINITY; int bi = 0;
#pragma unroll
                for (int e = 0; e < 32; ++e) { const bool ok = !((used >> e) & 1u) && lg[e] > bv; bv = ok ? lg[e] : bv; bi = ok ? e : bi; }
                used |= 1u << bi;
                tv[3] = (k == 3) ? bv : tv[3]; tv[2] = (k == 2) ? bv : tv[2]; tv[1] = (k == 1) ? bv : tv[1]; tv[0] = (k == 0) ? bv : tv[0];
                ti[3] = (k == 3) ? bi : ti[3]; ti[2] = (k == 2) ? bi : ti[2]; ti[1] = (k == 1) ? bi : ti[1]; ti[0] = (k == 0) ? bi : ti[0]; }
            const float e1 = __expf(tv[1] - tv[0]), e2 = __expf(tv[2] - tv[0]), e3 = __expf(tv[3] - tv[0]); const float inv = 1.0f / (1.0f + e1 + e2 + e3);
            const int E0 = hi ? ti[2] : ti[0], E1 = hi ? ti[3] : ti[1];
            const float G0 = (hi ? e2 : 1.0f) * inv, G1 = (hi ? e3 : e1) * inv;
            int rank0 = 0, rank1 = 0, mycount = 0;
#pragma unroll 1
            for (int e = 0; e < NE; ++e) { const unsigned long long m0 = __ballot(E0 == e), m1 = __ballot(E1 == e); const int p0 = __popcll(m0), p1 = __popcll(m1);
                if (E0 == e) rank0 = __popcll(m0 & ((1ull << lane) - 1ull)); if (E1 == e) rank1 = p0 + __popcll(m1 & ((1ull << lane) - 1ull)); if (lane == e) mycount = p0 + p1; }
            unsigned base = 0u; if (lane < NE && mycount > 0) base = atomicAdd(cnt + 64 * lane, (unsigned)mycount);
            const size_t pos0 = (size_t)E0 * LISTCAP + (unsigned)__shfl((int)base, E0) + rank0, pos1 = (size_t)E1 * LISTCAP + (unsigned)__shfl((int)base, E1) + rank1;
            ltok[pos0] = tok * 4 + 2 * hi; lgate[pos0] = G0; lrstd[pos0] = rstd;
            ltok[pos1] = tok * 4 + 2 * hi + 1; lgate[pos1] = G1; lrstd[pos1] = rstd;
        }
    }
}

typedef float f32x2_ __attribute__((ext_vector_type(2)));
__device__ __forceinline__ void p11_load(const bf16_t* x2, const unsigned char* y, int m, int lane, u32x4 (&xv)[2], u32x2 (&yv)[8]) {
#pragma unroll
    for (int j = 0; j < 2; ++j) { const int c = 8 * lane + 512 * j; xv[j] = __builtin_nontemporal_load((const u32x4*)(x2 + (size_t)m * D + c));
#pragma unroll
        for (int sl = 0; sl < 4; ++sl) yv[4 * j + sl] = __builtin_nontemporal_load((const u32x2*)(y + ((size_t)m * 4 + sl) * D + c)); }
}
__device__ __forceinline__ void p11_final(Frame& F) {
    const bf16_t* x2 = (const bf16_t*)(F.ws + WS_X2); const unsigned char* y = (const unsigned char*)(F.ws + WS_Y); const float* g_final = F.in[20]; float* out = F.out;
    const int gw = F.vcu * NWAVES + F.wave, NGW = F.G * NWAVES, lane = F.lane;
    if (gw >= M) return;
    f32x4 gg[4];
#pragma unroll
    for (int j = 0; j < 2; ++j) { const int c = 8 * lane + 512 * j; gg[2 * j] = *(const f32x4*)(g_final + c); gg[2 * j + 1] = *(const f32x4*)(g_final + c + 4); }
    u32x4 xv[2], xn_[2]; u32x2 yv[8], yn_[8];
    p11_load(x2, y, gw, lane, xv, yv);
    for (int m = gw; m < M; m += NGW) {
        if (m + NGW < M) p11_load(x2, y, m + NGW, lane, xn_, yn_);
        f32x4 v[4]; float ss = 0.f;
#pragma unroll
        for (int j = 0; j < 2; ++j) { f32x4 s0 = {0.f, 0.f, 0.f, 0.f}, s1 = {0.f, 0.f, 0.f, 0.f};
#pragma unroll
            for (int sl = 0; sl < 4; ++sl) { const u32x2 w = yv[4 * j + sl];
                const f32x2_ a = __builtin_amdgcn_cvt_pk_f32_fp8((int)w.x, false), b = __builtin_amdgcn_cvt_pk_f32_fp8((int)w.x, true), c = __builtin_amdgcn_cvt_pk_f32_fp8((int)w.y, false), d = __builtin_amdgcn_cvt_pk_f32_fp8((int)w.y, true);
                s0[0] += a[0]; s0[1] += a[1]; s0[2] += b[0]; s0[3] += b[1]; s1[0] += c[0]; s1[1] += c[1]; s1[2] += d[0]; s1[3] += d[1]; }
            const u32x4 xw = xv[j]; const f32x4 x0 = {bf_lo(xw.x), bf_hi(xw.x), bf_lo(xw.y), bf_hi(xw.y)}, x1 = {bf_lo(xw.z), bf_hi(xw.z), bf_lo(xw.w), bf_hi(xw.w)};
            v[2 * j] = x0 + s0 * (1.0f / Y8_SCALE); v[2 * j + 1] = x1 + s1 * (1.0f / Y8_SCALE); }
#pragma unroll
        for (int i = 0; i < 4; ++i) ss += (v[i][0] * v[i][0] + v[i][1] * v[i][1]) + (v[i][2] * v[i][2] + v[i][3] * v[i][3]);
        const float rstd = __builtin_amdgcn_rsqf(wave_sum(ss) * (1.f / D) + EPS);
#pragma unroll
        for (int j = 0; j < 2; ++j) { const int c = 8 * lane + 512 * j;
            __builtin_nontemporal_store(v[2 * j] * rstd * gg[2 * j], (f32x4*)(out + (size_t)m * D + c)); __builtin_nontemporal_store(v[2 * j + 1] * rstd * gg[2 * j + 1], (f32x4*)(out + (size_t)m * D + c + 4)); }
        xv[0] = xn_[0]; xv[1] = xn_[1];
#pragma unroll
        for (int i = 0; i < 8; ++i) yv[i] = yn_[i];
    }
}

constexpr int NPHASE = 12;
struct Args { const float* in[21]; float* out; unsigned char* ws; int ph_lo, ph_hi; };
static_assert(sizeof(Args) == 21 * 8 + 8 + 8 + 8, "Args has no padding");

__global__ void __launch_bounds__(NWAVES * 64, 2) fwd(Args args) {
    extern __shared__ __attribute__((aligned(16))) unsigned char lds[];
    Frame F;
    F.lds = (LAS unsigned char*)lds; F.MISC = (volatile LAS unsigned*)(F.lds + MISC_OFF);
    F.tid = threadIdx.x; F.lane = F.tid & 63; F.wave = __builtin_amdgcn_readfirstlane(F.tid >> 6);
    F.G = gridDim.x; { const int bx = blockIdx.x; F.vcu = (F.G % 8 == 0) ? (bx % 8) * (F.G / 8) + bx / 8 : bx; }
    F.ws = args.ws; F.ctl = (unsigned*)(args.ws + WS_CTL); F.out = args.out;
    F.in = args.in;
    for (int u = F.tid; u < (LDS_BYTES - LDSCTL_OFF) / 4; u += NWAVES * 64) ((LAS unsigned*)(F.lds + LDSCTL_OFF))[u] = 0u;
    __syncthreads();
    const int lo = args.ph_lo, hi = args.ph_hi;
    const bool single = (hi - lo) > 1;
    XcdBarrier bar; bar.bar = F.ctl + CW_BAR; bar.x = 0; bar.st = nullptr;
    if (single) bar = xcd_barrier_post(F.ctl + CW_BAR, F.MISC + 8);
#ifndef PH_MASK
#define PH_MASK 0xFFF
#endif
#define IN(k) (((PH_MASK >> (k)) & 1) && lo <= (k) && (k) < hi)
#ifndef PROBE_LO
#define PROBE_LO -1
#define PROBE_HI -1
#endif
#define PROBE_DIV 10.0f
    unsigned long long pt0 = 0ull, pt1 = 0ull;
#define STAMP_B(k) do { if (PROBE_LO == (k) && bx == 0) pt0 = __builtin_amdgcn_s_memrealtime(); } while (0)
#define STAMP_A(k) do { if (PROBE_HI == (k) && bx == 0) pt1 = __builtin_amdgcn_s_memrealtime(); } while (0)
#define SEAM(k) do { if (IN(k) && IN((k) + 1)) xcd_barrier(bar); } while (0)
    unsigned char* ws = args.ws;
    const int bx = (int)blockIdx.x;

    STAMP_B(0);
    if (IN(0)) { p0_prologue(F); }
    SEAM(0);
    STAMP_A(0); STAMP_B(1);
    if (IN(1)) {
        const bool split = (F.G == 256);
        if (!split || bx < 256 - P1_NCONV) {
            pg8::OrderIn S; S.init(ws + WS_XN, ws + WS_WIN_T, ws + WS_MEMN, ws + WS_WKV_T, split ? 32 : 64, split ? 256 - P1_NCONV : F.G, bx);
            pg8::EpiP1 E{(bf16_t*)(ws + WS_PROJ), (bf16_t*)(ws + WS_KMEM), (bf16_t*)(ws + WS_VT)};
            pg8::gemm_phase<pg8::EpiP1, pg8::OrderIn, false, true, true>(F.lds + RING_OFF, 2 * D, 2 * D, 2 * D, S, E);
        }
        if (!split) convert_experts(F, bx * NWAVES + F.wave, F.G * NWAVES, N_XITEMS);
        else if (bx >= 256 - P1_NCONV) {
            const int cb = bx - (256 - P1_NCONV);
            if (cb < 32) { pg8::OrderKV S; S.init(ws + WS_MEMN, ws + WS_WKV_T, 32 + cb); pg8::EpiP1 E{(bf16_t*)(ws + WS_PROJ), (bf16_t*)(ws + WS_KMEM), (bf16_t*)(ws + WS_VT)};
                pg8::gemm_phase<pg8::EpiP1, pg8::OrderKV, false, false, true>(F.lds + RING_OFF, 2 * D, 2 * D, 2 * D, S, E); }
            constexpr int NSTAT = (int)((long)N_XITEMS * (100 - P1_DYN_PCT) / 100), NLOW = 32 * NWAVES, NHIGH = (P1_NCONV - 32) * NWAVES; constexpr int CUT = (int)((long)NSTAT * (5 * NLOW) / (5 * NLOW + 6 * NHIGH));
            if (cb < 32) convert_experts(F, cb * NWAVES + F.wave, NLOW, CUT);
            else convert_experts(F, CUT + (cb - 32) * NWAVES + F.wave, NHIGH, NSTAT);
        }
        if (split) {
            constexpr int NSTAT = (int)((long)N_XITEMS * (100 - P1_DYN_PCT) / 100);
            for (;;) {
                __syncthreads();
                if (F.tid == 0) F.MISC[24] = atomicAdd(F.ctl + CW_DYN, (unsigned)NWAVES);
                __syncthreads();
                const int base = NSTAT + (int)F.MISC[24];
                if (base >= N_XITEMS) break;
                convert_experts(F, base + F.wave, N_XITEMS, N_XITEMS);
            }
        }
    }
    SEAM(1);
    STAMP_A(1); STAMP_B(2);
    if (IN(2)) {
        {
            pg8::OrderPX S; S.init(ws + WS_KMEM, ws + WS_VT, ws + WS_WQ_T, ws + WS_WO_T, ws + WS_WQKT, ws + WS_VWOT, bx);
            pg8::EpiPX E;
            pg8::gemm_phase<pg8::EpiPX, pg8::OrderPX, false, false, true>(F.lds + RING_OFF, 2 * D, 2 * D, 2 * XHD, S, E);
        }
        p2_mix(F);
    }
    SEAM(2);
    STAMP_A(2); STAMP_B(3);
    if (IN(3)) {
        pg8::OrderPlain S; S.init(ws + WS_YMIX, ws + WS_WOUT_T, D, D, M / 256, D / 256, F.G, bx);
        pg8::EpiRes<false, true> E{F.in[0], (bf16_t*)(ws + WS_X1B), ws + WS_X1B8, (float*)(ws + WS_SS1), 1.0f};
        pg8::gemm_phase<pg8::EpiRes<false, true>, pg8::OrderPlain, false, false, true>(F.lds + RING_OFF, 2 * D, 2 * D, 2 * D, S, E);
    }
    SEAM(3);
    STAMP_A(3); STAMP_B(4);
    if (IN(4)) {
        if (F.G == 256) {
            pg8::OrderXB S; S.init(ws + WS_X1B8, ws + WS_WQKT, F.G, bx);
            pg8::EpiSoftmax E{ws + WS_PB, (const float*)(ws + WS_SS1)};
            pg8::gemm_phase<pg8::EpiSoftmax, pg8::OrderXB, false, false, true, true>(F.lds + RING_OFF, D, D, D, S, E);
        }
    }
    SEAM(4);
    STAMP_A(4); STAMP_B(7);
    if (IN(7)) {
        pg8::OrderXB S; S.init(ws + WS_PB, ws + WS_VWOT, F.G, bx);
        pg8::EpiRes<true, true> E{ws + WS_X1B, (bf16_t*)(ws + WS_X2), ws + WS_X2B, (float*)(ws + WS_SS2), 1.0f / (P8_SCALE * PX8_SCALE)};
        pg8::gemm_phase<pg8::EpiRes<true, true>, pg8::OrderXB, false, false, true, true>(F.lds + RING_OFF, D, D, D, S, E);
    }
    SEAM(7);
    STAMP_A(7); STAMP_B(8);
    if (IN(8)) { p8_router(F); }
    SEAM(8);
    STAMP_A(8); STAMP_B(9);
    if (IN(9)) {
        pg8::OrderMoe<8, true> S; S.init(F.ctl + CW_CNT, (const int*)(ws + WS_LTOK), ws + WS_X2B, ws + WS_W1_T, F.G, bx);
        pg8::EpiAct E{(bf16_t*)(ws + WS_ACT), (const float*)(ws + WS_LRSTD), F.in[17]};
        pg8::gemm_phase<pg8::EpiAct, pg8::OrderMoe<8, true>, true, true, true, true>(F.lds + RING_OFF, D, D, D, S, E);
    }
    SEAM(9);
    STAMP_A(9); STAMP_B(10);
    if (IN(10)) {
        pg8::OrderMoe<4, false> S; S.init(F.ctl + CW_CNT, (const int*)(ws + WS_LTOK), ws + WS_ACT, ws + WS_W2_T, F.G, bx);
        pg8::EpiY E{(bf16_t*)(ws + WS_Y), (const float*)(ws + WS_LGATE), (const int*)(ws + WS_LTOK), F.in[19]};
        pg8::gemm_phase<pg8::EpiY, pg8::OrderMoe<4, false>, false, true, true, true>(F.lds + RING_OFF, DEXP, DEXP, DEXP, S, E);
    }
    SEAM(10);
    STAMP_A(10); STAMP_B(11);
    if (IN(11)) { p11_final(F); }
    STAMP_A(11);
    if (PROBE_LO >= 0 && bx == 0) { asm volatile("s_waitcnt vmcnt(0)" ::: "memory"); __syncthreads(); if (F.tid == 0) { const float us = (float)(pt1 - pt0) * 0.01f; F.out[(size_t)(F.vcu * NWAVES) * D] += us / PROBE_DIV; } }
#undef IN
#undef SEAM
}

extern "C" void kernel_launch(void* const* d_in, const int* in_sizes, int n_in, void* d_out, int out_size, void* d_ws, size_t ws_size, hipStream_t stream) {
    static int grid = 0;
    if (grid == 0) {
        if (n_in != 21 || in_sizes[0] != M * D || out_size != M * D || ws_size < WS_END) { fprintf(stderr, "kernel_launch: unexpected shapes (n_in %d, in0 %d, out %d, ws %zu)\n", n_in, n_in > 0 ? in_sizes[0] : -1, out_size, ws_size); grid = -1; return; }
        int dev = 0, cus = 0, per_cu = 0;
        if (hipGetDevice(&dev) != hipSuccess || hipDeviceGetAttribute(&cus, hipDeviceAttributeMultiprocessorCount, dev) != hipSuccess) { grid = -1; return; }
        if (hipFuncSetAttribute((const void*)fwd, hipFuncAttributeMaxDynamicSharedMemorySize, LDS_BYTES) != hipSuccess) { fprintf(stderr, "kernel_launch: hipFuncSetAttribute failed\n"); grid = -1; return; }
        if (hipOccupancyMaxActiveBlocksPerMultiprocessor(&per_cu, (const void*)fwd, NWAVES * 64, LDS_BYTES) != hipSuccess || per_cu < 1) { fprintf(stderr, "kernel_launch: occupancy query says %d\n", per_cu); per_cu = 1; }
        (void)hipGetLastError();
        if (cus != 256) fprintf(stderr, "kernel_launch: built for a 256-CU device (one 256x256 tile per workgroup in the fused phases); found %d CUs\n", cus);
        grid = cus;
    }
    if (grid < 0) return;
    (void)hipMemsetAsync((char*)d_ws + WS_CTL, 0, CTL_ZERO_BYTES, stream);
    Args a{};
    for (int i = 0; i < 21; ++i) a.in[i] = (const float*)d_in[i];
    a.out = (float*)d_out; a.ws = (unsigned char*)d_ws;
    if (MK_N_LAUNCHES == 1) {
        a.ph_lo = 0; a.ph_hi = NPHASE;
        void* kargs[] = {&a};
        hipError_t e = hipLaunchCooperativeKernel((const void*)fwd, dim3(grid), dim3(NWAVES * 64), kargs, LDS_BYTES, stream);
        if (e != hipSuccess) fprintf(stderr, "kernel_launch: cooperative launch failed: %s\n", hipGetErrorString(e));
    } else {
        for (int p = 0; p < NPHASE; ++p) { a.ph_lo = p; a.ph_hi = p + 1; for (int rep = 0; rep < NREP(p); ++rep) hipLaunchKernelGGL(fwd, dim3(grid), dim3(NWAVES * 64), LDS_BYTES, stream, a); }
    }
}
```

```cpp
#include <hip/hip_runtime.h>
#include <cstdio>
#include <cstdint>

#ifndef MK_N_LAUNCHES
#define MK_N_LAUNCHES 1
#endif
#ifndef DUP_MASK
#define DUP_MASK 0
#endif
#define NREP(k) (((DUP_MASK >> (k)) & 1) ? 2 : 1)

constexpr int D = 1024, BATCH = 8, SEQ = 2048, M = BATCH * SEQ, MEMLEN = 256, MROWS = BATCH * MEMLEN;
constexpr int NPROJ = 3072, NE = 32, TOPK = 4, DEXP = 1024;
constexpr int XH = 4, XHD = 256;
constexpr float EPS = 1e-5f;
constexpr float LOG2E = 1.4426950408889634f;
constexpr float C2Q = 0.125f * LOG2E;
constexpr float C2X = 0.0625f * LOG2E;
#ifndef P1_DYN_PCT
#define P1_DYN_PCT 22
#endif
#ifndef P1_NCONV
#define P1_NCONV 96
#endif
constexpr int N_XITEMS = NE * 8 * 32 + NE * 8 * 16;
#ifndef P8_XPW
#define P8_XPW 4
#endif
#ifndef P9_XTAIL
#define P9_XTAIL 1536
#endif
constexpr int I_W2 = NE * 8 * 16, N_P8X = 256 * P8_XPW, X_P1 = N_P8X + P9_XTAIL, N_P1X = N_XITEMS - X_P1;
static_assert(X_P1 <= I_W2, "only w2 items may be converted after P1");
constexpr int LISTCAP = M;
constexpr int ACT_ROWS = M * TOPK + NE * 256;

#define GAS __attribute__((address_space(1)))
#define LAS __attribute__((address_space(3)))
typedef unsigned short bf16_t;
typedef short bf16x8 __attribute__((ext_vector_type(8)));
typedef short s16x4 __attribute__((ext_vector_type(4)));
typedef float f32x4 __attribute__((ext_vector_type(4)));
typedef float f32x2 __attribute__((ext_vector_type(2)));
typedef float f32x16 __attribute__((ext_vector_type(16)));
typedef unsigned u32x4 __attribute__((ext_vector_type(4)));
typedef unsigned u32x2 __attribute__((ext_vector_type(2)));
typedef GAS unsigned gu32;

constexpr size_t MiB = 1u << 20;
constexpr size_t WS_CTL = 0, CTL_ZERO_BYTES = 1 * MiB;
constexpr size_t WS_WIN_T = 2 * MiB, WS_WOUT_T = 8 * MiB, WS_WQ_T = 10 * MiB, WS_WKV_T = 12 * MiB, WS_WO_T = 16 * MiB, WS_WR = 18 * MiB;
constexpr size_t WS_MEMN = 19 * MiB, WS_KMEM = 23 * MiB, WS_VT = 27 * MiB, WS_SS1 = 31 * MiB, WS_SS2 = 32 * MiB, WS_RSTD3 = 33 * MiB, WS_LTOK = 34 * MiB, WS_LGATE = 36 * MiB, WS_LRSTD = 38 * MiB;
constexpr size_t WS_W1_T = 40 * MiB, WS_W2_T = 168 * MiB;
constexpr size_t WS_XN = 232 * MiB, WS_PROJ = 264 * MiB, WS_YMIX = 360 * MiB;
constexpr size_t WS_X1 = 392 * MiB, WS_X1B = 456 * MiB, WS_X1B8 = 488 * MiB, WS_PB = 520 * MiB, WS_LPART = 552 * MiB, WS_X2 = 584 * MiB, WS_X2B = 648 * MiB;
constexpr size_t WS_ACT = 232 * MiB;
constexpr size_t WS_Y = 392 * MiB;
constexpr size_t WS_WQKT = 680 * MiB, WS_VWOT = 696 * MiB;
constexpr size_t WS_END = 712 * MiB;
static_assert(WS_ACT + (size_t)ACT_ROWS * DEXP <= WS_X1 && WS_Y + (size_t)M * TOPK * D * 2 <= WS_PB, "overlays");
constexpr int CW_TMO = 0, CW_CODE = 1, CW_DYN = 64, CW_DYN9 = 128, CW_BAR = 4096, CW_CNT = 8192;

__device__ __forceinline__ unsigned cvt_pk_bf16(float lo, float hi) { unsigned r; asm volatile("v_cvt_pk_bf16_f32 %0, %1, %2" : "=v"(r) : "v"(lo), "v"(hi)); return r; }
__device__ __forceinline__ unsigned cvtpk_s(float lo, float hi) { typedef __bf16 bf16x2_t __attribute__((ext_vector_type(2))); f32x2 v = {lo, hi}; bf16x2_t b = __builtin_convertvector(v, bf16x2_t); return __builtin_bit_cast(unsigned, b); }
__device__ __forceinline__ float clamp448(float v) { return fminf(fmaxf(v, -448.0f), 448.0f); }
__device__ __forceinline__ unsigned pk_fp8x4(float a, float b, float c, float d) { int w = 0; w = __builtin_amdgcn_cvt_pk_fp8_f32(clamp448(a), clamp448(b), w, false); w = __builtin_amdgcn_cvt_pk_fp8_f32(clamp448(c), clamp448(d), w, true); return (unsigned)w; }
constexpr float W8_SCALE = 64.0f, ACT8_SCALE = 4.0f, Y8_SCALE = 16.0f, PX8_SCALE = 64.0f, P8_SCALE = 256.0f;
constexpr int E8_ONE = 0x7F7F7F7F, E8_W = 0x79797979, E8_ACT = 0x7D7D7D7D;
__device__ __forceinline__ float bf_lo(unsigned w) { return __uint_as_float(w << 16); }
__device__ __forceinline__ float bf_hi(unsigned w) { return __uint_as_float(w & 0xffff0000u); }
__device__ __forceinline__ float wave_sum(float v) {
#pragma unroll
    for (int o = 1; o < 64; o <<= 1) v += __shfl_xor(v, o);
    return v;
}
#define LDS_WAIT() asm volatile("s_waitcnt lgkmcnt(0)" ::: "memory")
#define VM_WAIT() asm volatile("s_waitcnt vmcnt(0)" ::: "memory")

namespace pg8 {
constexpr int BM = 256, BK = 64, HALF = 128, HTB = HALF * BK * 2, STAGE_BYTES = 8 * HTB, NXCD = 8, WGM = 8;
__host__ __device__ __forceinline__ int lds_byte(int r, int c) { const int st = (r >> 4) * 2 + (c >> 5), rr = r & 15, cc = c & 31, ob = rr * 64 + cc * 2; return st * 1024 + (ob ^ (((ob >> 9) & 1) << 5)); }
__host__ __device__ __forceinline__ void stage_rc(int b, int& R, int& C) { const int st = b / 1024, sb = b % 1024, swz = sb ^ (((sb >> 9) & 1) << 5); R = (st >> 1) * 16 + swz / 64; C = (st & 1) * 32 + (swz % 64) / 2; }
__host__ __device__ __forceinline__ int perm32(int rho) { const int n = rho >> 4, i = rho & 15; return 8 * (i >> 2) + 4 * n + (i & 3); }

struct Unit { const char* a; const char* b; int pm, pn; };
struct UnitK { const char* a; const char* b; int pm, pn, kind; };
struct UnitM { const char* a; const char* b; const int* tok; int pm, pn, nvalid, e, rowoff; };

struct GridOrder {
    int nM, nN, nwg;
    __device__ __forceinline__ void init(int nM_, int nN_) { nM = nM_; nN = nN_; nwg = nM * nN; }
    __device__ __forceinline__ void map(int L, int& pm, int& pn) const {
        int wgid = L; { const int q = nwg / NXCD, r = nwg % NXCD, xcd = wgid % NXCD, off = wgid / NXCD; wgid = (xcd < r ? xcd * (q + 1) : r * (q + 1) + (xcd - r) * q) + off; }
        const int nig = WGM * nN, gid = wgid / nig, fm = gid * WGM, gsz = (nM - fm) < WGM ? (nM - fm) : WGM;
        pm = fm + ((wgid % nig) % gsz); pn = (wgid % nig) / gsz;
    }
};

typedef f32x4 Acc[2][2][4][2];

template <class Epi, class Sched, bool GATHER, bool ALIGN_EPI, bool SP2, bool F8 = false, int SCA = 0x7F7F7F7F, int SCB = 0x7F7F7F7F>
__device__ __forceinline__ void gemm_phase(LAS unsigned char* lds, const int lda, const int ldb, const int K, const Sched& S, const Epi& E) {
    const int tid = threadIdx.x, wid = __builtin_amdgcn_readfirstlane(tid >> 6), lane = tid & 63, wr = wid >> 2, wc = wid & 3, fr = lane & 15, fq = lane >> 4;
    int nt = K / 128; asm volatile("" : "+s"(nt));
    int RA[2], CA[2]; unsigned voffB[2];
#pragma unroll
    for (int i = 0; i < 2; ++i) { int R, C; stage_rc(tid * 16 + i * 8192, R, C); const int Rb = Epi::PERM ? ((R & ~31) + perm32(R & 31)) : R;
        RA[i] = R; CA[i] = C; voffB[i] = (unsigned)(Rb * ldb + C * 2); }
    const size_t kstep = (size_t)(BK * 2);
    const size_t hstepB = (size_t)HALF * ldb;
    const unsigned ldsw = (unsigned)wid * 1024u;
    const int aoff = lds_byte(wr * 64 + fr, fq * 8), boff = lds_byte(wc * 32 + fr, fq * 8);
#define PG8_SA(b, h) (((b) * 2 + (h)) * HTB)
#define PG8_SB(b, h) ((4 + (b) * 2 + (h)) * HTB)
#define PG8_STAGE(bufoff, gbase, voff) do { _Pragma("unroll") for (int _i = 0; _i < 2; ++_i) \
        __builtin_amdgcn_global_load_lds((const unsigned*)((const char*)(gbase) + (voff)[_i]), (LAS unsigned*)(lds + (bufoff) + ldsw + _i * 8192), 16, 0, 0); } while (0)
#define PG8_LDA(dst, b, h) do { _Pragma("unroll") for (int m = 0; m < 4; ++m) { if constexpr (F8) { \
            dst##8[m] = __builtin_shufflevector(*(const LAS i32x4_*)(lds + PG8_SA(b, h) + aoff + m * 2048), *(const LAS i32x4_*)(lds + PG8_SA(b, h) + aoff + m * 2048 + 1024), 0, 1, 2, 3, 4, 5, 6, 7); } \
        else { _Pragma("unroll") for (int k = 0; k < 2; ++k) dst[m][k] = *(const LAS bf16x8*)(lds + PG8_SA(b, h) + aoff + m * 2048 + k * 1024); } } } while (0)
#define PG8_LDB(dst, b, h) do { _Pragma("unroll") for (int n = 0; n < 2; ++n) { if constexpr (F8) { \
            dst##8[n] = __builtin_shufflevector(*(const LAS i32x4_*)(lds + PG8_SB(b, h) + boff + n * 2048), *(const LAS i32x4_*)(lds + PG8_SB(b, h) + boff + n * 2048 + 1024), 0, 1, 2, 3, 4, 5, 6, 7); } \
        else { _Pragma("unroll") for (int k = 0; k < 2; ++k) dst[n][k] = *(const LAS bf16x8*)(lds + PG8_SB(b, h) + boff + n * 2048 + k * 1024); } } } while (0)
#define PG8_MMA(ai, bj, At, Bt) do { __builtin_amdgcn_s_setprio(1); _Pragma("unroll") for (int m = 0; m < 4; ++m) _Pragma("unroll") for (int n = 0; n < 2; ++n) { \
        if constexpr (F8) { acc[ai][bj][m][n] = __builtin_amdgcn_mfma_scale_f32_16x16x128_f8f6f4(Bt##8[n], At##8[m], acc[ai][bj][m][n], 0, 0, 0, SCA, 0, SCB); } \
        else { _Pragma("unroll") for (int k = 0; k < 2; ++k) acc[ai][bj][m][n] = __builtin_amdgcn_mfma_f32_16x16x32_bf16(Bt[n][k], At[m][k], acc[ai][bj][m][n], 0, 0, 0); } } \
        __builtin_amdgcn_s_setprio(0); } while (0)
#define PG8_WAIT_V(n) asm volatile("s_waitcnt vmcnt(" #n ")" ::: "memory")
#define PG8_WAIT_L(n) asm volatile("s_waitcnt lgkmcnt(" #n ")" ::: "memory")
#define PG8_BAR __builtin_amdgcn_s_barrier()
#define PG8_SCHED __builtin_amdgcn_sched_barrier(0)
#define PG8_VOFFA(dst, u) do { if constexpr (GATHER) { int _t[2][2]; _Pragma("unroll") for (int _h = 0; _h < 2; ++_h) _Pragma("unroll") for (int _i = 0; _i < 2; ++_i) _t[_h][_i] = (u).tok[_h * HALF + RA[_i]]; \
        _Pragma("unroll") for (int _h = 0; _h < 2; ++_h) _Pragma("unroll") for (int _i = 0; _i < 2; ++_i) { const int _row = _h * HALF + RA[_i]; const int _tt = (_row < (u).nvalid) ? (_t[_h][_i] >> 2) : 0; dst[_h][_i] = (unsigned)(_tt * lda + CA[_i] * 2); } } \
        else { _Pragma("unroll") for (int _h = 0; _h < 2; ++_h) _Pragma("unroll") for (int _i = 0; _i < 2; ++_i) dst[_h][_i] = (unsigned)((_h * HALF + RA[_i]) * lda + CA[_i] * 2); } } while (0)
#define PG8_VOFFA_LDS(dst, u, slot) do { const LAS int* _mt = (const LAS int*)(lds + 131072 + (slot) * 3072 + 1024); _Pragma("unroll") for (int _h = 0; _h < 2; ++_h) _Pragma("unroll") for (int _i = 0; _i < 2; ++_i) { \
        const int _row = _h * HALF + RA[_i]; const int _tt = (_row < (u).nvalid) ? (_mt[_row] >> 2) : 0; dst[_h][_i] = (unsigned)(_tt * lda + CA[_i] * 2); } } while (0)
    typename Sched::U cur, nxt; int ui = 0;
    if (!S.next(0, cur)) return;
    Acc acc;
#pragma unroll
    for (int a = 0; a < 2; ++a)
#pragma unroll
        for (int b = 0; b < 2; ++b)
#pragma unroll
            for (int m = 0; m < 4; ++m)
#pragma unroll
                for (int n = 0; n < 2; ++n) acc[a][b][m][n] = (f32x4){0.f, 0.f, 0.f, 0.f};
    typedef int i32x4_ __attribute__((ext_vector_type(4))); typedef int i32x8_ __attribute__((ext_vector_type(8)));
    bf16x8 At[4][2], B0[2][2], B1[2][2]; i32x8_ At8[4], B08[2], B18[2];
    unsigned vA[2][2];
    PG8_VOFFA(vA, cur);
    const char* cA = cur.a; const char* cB = cur.b;
    E.prefetch(cur, 0, lds, wid, lane);
    if constexpr (SP2) {
        PG8_STAGE(PG8_SB(0, 0), cB, voffB); PG8_STAGE(PG8_SB(0, 1), cB + hstepB, voffB); PG8_STAGE(PG8_SA(0, 0), cA, vA[0]); PG8_STAGE(PG8_SA(0, 1), cA, vA[1]);
        if (wr == 1) PG8_BAR;
        PG8_WAIT_V(2); PG8_BAR;
        PG8_STAGE(PG8_SB(1, 0), cB + kstep, voffB); PG8_STAGE(PG8_SA(1, 0), cA + kstep, vA[0]); PG8_STAGE(PG8_SB(1, 1), cB + hstepB + kstep, voffB);
        PG8_WAIT_V(6); PG8_BAR;
    } else {
        PG8_STAGE(PG8_SB(0, 0), cB, voffB); PG8_STAGE(PG8_SA(0, 0), cA, vA[0]); PG8_STAGE(PG8_SB(0, 1), cB + hstepB, voffB); PG8_STAGE(PG8_SA(0, 1), cA, vA[1]);
        if (wr == 1) PG8_BAR;
        PG8_WAIT_V(4); PG8_BAR;
        PG8_STAGE(PG8_SB(1, 0), cB + kstep, voffB); PG8_STAGE(PG8_SA(1, 0), cA + kstep, vA[0]); PG8_STAGE(PG8_SB(1, 1), cB + hstepB + kstep, voffB);
        PG8_WAIT_V(6); PG8_BAR;
    }
    for (;;) {
        const bool has_next = S.next(ui + 1, nxt);
        const char* nA = has_next ? nxt.a : cA; const char* nB = has_next ? nxt.b : cB;
        if (has_next) E.prefetch(nxt, ui + 1, lds, wid, lane);
        for (int t = 0; t < nt; t += 2) {
            const bool last = (t == nt - 2);
            asm volatile("" : "+v"(vA[0][0]), "+v"(vA[0][1]), "+v"(vA[1][0]), "+v"(vA[1][1]), "+v"(voffB[0]), "+v"(voffB[1]));
            const char* a1 = cA + (size_t)(t + 1) * kstep;
            const char* a2 = last ? nA : cA + (size_t)(t + 2) * kstep; const char* b2 = last ? nB : cB + (size_t)(t + 2) * kstep;
            const char* a3 = a2 + kstep; const char* b3 = b2 + kstep;
            if constexpr (SP2) {
            PG8_LDB(B0, 0, 0); PG8_LDB(B1, 0, 1); PG8_SCHED; PG8_LDA(At, 0, 0); PG8_STAGE(PG8_SA(1, 1), a1, vA[1]); if (last && has_next) { if constexpr (GATHER) { PG8_VOFFA_LDS(vA, nxt, (ui + 1) % 3); } else { PG8_VOFFA(vA, nxt); } }
            PG8_WAIT_V(8); PG8_WAIT_L(0); PG8_BAR; PG8_MMA(0, 0, At, B0); PG8_MMA(0, 1, At, B1); PG8_BAR; PG8_SCHED;
            PG8_LDA(At, 0, 1); PG8_STAGE(PG8_SB(0, 0), b2, voffB); PG8_STAGE(PG8_SB(0, 1), b2 + hstepB, voffB); PG8_STAGE(PG8_SA(0, 0), a2, vA[0]);
            PG8_WAIT_V(8); PG8_WAIT_L(0); PG8_BAR; PG8_MMA(1, 0, At, B0); PG8_MMA(1, 1, At, B1); PG8_BAR; PG8_SCHED;
            PG8_LDB(B0, 1, 0); PG8_LDB(B1, 1, 1); PG8_SCHED; PG8_LDA(At, 1, 0); PG8_STAGE(PG8_SA(0, 1), a2, vA[1]);
            PG8_WAIT_V(8); PG8_WAIT_L(0); PG8_BAR; PG8_MMA(0, 0, At, B0); PG8_MMA(0, 1, At, B1); PG8_BAR; PG8_SCHED;
            PG8_LDA(At, 1, 1); PG8_STAGE(PG8_SB(1, 0), b3, voffB); PG8_STAGE(PG8_SB(1, 1), b3 + hstepB, voffB); PG8_STAGE(PG8_SA(1, 0), a3, vA[0]);
            PG8_WAIT_V(8); PG8_WAIT_L(0); PG8_BAR; PG8_MMA(1, 0, At, B0); PG8_MMA(1, 1, At, B1); PG8_BAR; PG8_SCHED;
            } else {
            PG8_LDB(B0, 0, 0); PG8_SCHED; PG8_LDA(At, 0, 0); PG8_STAGE(PG8_SA(1, 1), a1, vA[1]); if (last && has_next) { if constexpr (GATHER) { PG8_VOFFA_LDS(vA, nxt, (ui + 1) % 3); } else { PG8_VOFFA(vA, nxt); } }
            PG8_WAIT_L(8); PG8_BAR; PG8_WAIT_L(0); PG8_MMA(0, 0, At, B0); PG8_BAR; PG8_SCHED;
            PG8_LDB(B1, 0, 1); PG8_STAGE(PG8_SB(0, 0), b2, voffB);
            PG8_BAR; PG8_WAIT_L(0); PG8_MMA(0, 1, At, B1); PG8_BAR;
            PG8_LDA(At, 0, 1); PG8_STAGE(PG8_SA(0, 0), a2, vA[0]);
            PG8_BAR; PG8_WAIT_L(0); PG8_MMA(1, 0, At, B0); PG8_BAR; PG8_SCHED;
            PG8_STAGE(PG8_SB(0, 1), b2 + hstepB, voffB);
            PG8_WAIT_V(6); PG8_BAR; PG8_MMA(1, 1, At, B1); PG8_BAR;
            PG8_LDB(B0, 1, 0); PG8_SCHED; PG8_LDA(At, 1, 0); PG8_STAGE(PG8_SA(0, 1), a2, vA[1]);
            PG8_WAIT_L(8); PG8_BAR; PG8_WAIT_L(0); PG8_MMA(0, 0, At, B0); PG8_BAR; PG8_SCHED;
            PG8_LDB(B1, 1, 1); PG8_STAGE(PG8_SB(1, 0), b3, voffB);
            PG8_BAR; PG8_WAIT_L(0); PG8_MMA(0, 1, At, B1); PG8_BAR;
            PG8_LDA(At, 1, 1); PG8_STAGE(PG8_SA(1, 0), a3, vA[0]);
            PG8_BAR; PG8_WAIT_L(0); PG8_MMA(1, 0, At, B0); PG8_BAR; PG8_SCHED;
            PG8_STAGE(PG8_SB(1, 1), b3 + hstepB, voffB);
            PG8_WAIT_V(6); PG8_BAR; PG8_MMA(1, 1, At, B1); PG8_BAR;
            }
        }
        if constexpr (ALIGN_EPI) { if (wr == 0) PG8_BAR; }
        if constexpr (!Epi::AFTER_DRAIN) { E(acc, cur, ui, lds, wr, wc, fr, fq); }
        if (!has_next) break;
#pragma unroll
        for (int a = 0; a < 2; ++a)
#pragma unroll
            for (int b = 0; b < 2; ++b)
#pragma unroll
                for (int m = 0; m < 4; ++m)
#pragma unroll
                    for (int n = 0; n < 2; ++n) acc[a][b][m][n] = (f32x4){0.f, 0.f, 0.f, 0.f};
        cur = nxt; cA = nA; cB = nB; ++ui;
        if constexpr (ALIGN_EPI) { if (wr == 1) PG8_BAR; }
    }
    PG8_WAIT_V(0);
    if constexpr (!ALIGN_EPI) { if (wr == 0) PG8_BAR; }
    PG8_BAR;
    if constexpr (Epi::AFTER_DRAIN) { E.fused(acc, cur, wr, wc, fr, fq, lds, wid, lane); }
#undef PG8_SA
#undef PG8_SB
#undef PG8_STAGE
#undef PG8_LDA
#undef PG8_LDB
#undef PG8_MMA
#undef PG8_WAIT_V
#undef PG8_WAIT_L
#undef PG8_BAR
#undef PG8_SCHED
#undef PG8_VOFFA
#undef PG8_VOFFA_LDS
}

struct OrderKV {
    typedef UnitK U;
    const char *memn, *wkv_t; int c;
    __device__ __forceinline__ void init(const void* memn_, const void* wkv_t_, int c_) { memn = (const char*)memn_; wkv_t = (const char*)wkv_t_; c = c_; }
    __device__ __forceinline__ bool next(int i, UnitK& u) const {
        if (i > 0 || c >= 64) return false;
        int r = c;
        if (r < 32) { u.kind = 1; u.pm = r >> 2; u.pn = r & 3; u.a = memn + (size_t)u.pm * 256 * D * 2; u.b = wkv_t + (size_t)u.pn * 256 * D * 2; return true; }
        r -= 32;
        u.kind = 2; u.pm = r >> 2; u.pn = r & 3; u.a = memn + (size_t)u.pm * 256 * D * 2; u.b = wkv_t + (size_t)(D + u.pn * 256) * D * 2; return true;
    }
};
struct OrderIn {
    typedef UnitK U;
    const char *A, *Bt, *memn, *wkv_t; int G, c, nextra; GridOrder g0;
    __device__ __forceinline__ void init(const void* A_, const void* Bt_, const void* memn_, const void* wkv_t_, int nextra_, int G_, int c_) {
        A = (const char*)A_; Bt = (const char*)Bt_; memn = (const char*)memn_; wkv_t = (const char*)wkv_t_; nextra = nextra_; G = G_; c = c_; g0.init(M / 256, NPROJ / 256); }
    __device__ __forceinline__ bool next(int i, UnitK& u) const {
        const int L = i * G + c;
        if (L < g0.nwg) { g0.map(L, u.pm, u.pn); u.kind = 0; u.a = A + (size_t)u.pm * 256 * D * 2; u.b = Bt + (size_t)u.pn * 256 * D * 2; return true; }
        int r = L - g0.nwg; if (r >= nextra) return false;
        if (r < 32) { u.kind = 1; u.pm = r >> 2; u.pn = r & 3; u.a = memn + (size_t)u.pm * 256 * D * 2; u.b = wkv_t + (size_t)u.pn * 256 * D * 2; return true; }
        r -= 32; u.kind = 2; u.pm = r >> 2; u.pn = r & 3; u.a = memn + (size_t)u.pm * 256 * D * 2; u.b = wkv_t + (size_t)(D + u.pn * 256) * D * 2; return true;
    }
};
struct OrderPlain {
    typedef Unit U;
    const char *A, *Bt; int lda, ldb, G, c; GridOrder g0;
    __device__ __forceinline__ void init(const void* A_, const void* Bt_, int lda_, int ldb_, int nM, int nN, int G_, int c_) { A = (const char*)A_; Bt = (const char*)Bt_; lda = lda_; ldb = ldb_; G = G_; c = c_; g0.init(nM, nN); }
    __device__ __forceinline__ bool next(int i, Unit& u) const {
        const int L = i * G + c; if (L >= g0.nwg) return false;
        g0.map(L, u.pm, u.pn);
        u.a = A + (size_t)u.pm * 256 * lda * 2; u.b = Bt + (size_t)u.pn * 256 * ldb * 2; return true;
    }
};
template <int NTN, bool G1> struct OrderMoe {
    typedef UnitM U;
    const int* ltok; const char* A; const char* Bt; int G, c; int seg[4], til[4], cn[4];
    __device__ __forceinline__ void init(const unsigned* cnt, const int* ltok_, const void* A_, const void* Bt_, int G_, int c_) {
        ltok = ltok_; A = (const char*)A_; Bt = (const char*)Bt_; G = G_; c = c_;
        const int lane = threadIdx.x & 63; const int cv = (lane < NE) ? (int)__hip_atomic_load(cnt + 64 * lane, __ATOMIC_RELAXED, __HIP_MEMORY_SCOPE_AGENT) : 0;
        const int t = (cv + 255) >> 8; int incl = t;
#pragma unroll
        for (int o = 1; o < 32; o <<= 1) { const int v = __shfl_up(incl, o); if (lane >= o) incl += v; }
        const int excl = incl - t, xcd = c & 7;
#pragma unroll
        for (int q = 0; q < 4; ++q) { seg[q] = __builtin_amdgcn_readlane(excl, xcd + 8 * q); til[q] = __builtin_amdgcn_readlane(t, xcd + 8 * q); cn[q] = __builtin_amdgcn_readlane(cv, xcd + 8 * q); }
    }
    __device__ __forceinline__ bool next(int i, UnitM& u) const {
        const int xcd = c & 7, slot = c >> 3, nslot = G >> 3; int j = i * nslot + slot;
#pragma unroll
        for (int q = 0; q < 4; ++q) {
            const int nu = til[q] * NTN;
            if (j < nu) { const int e = xcd + 8 * q, mt = j / NTN, nt = j % NTN;
                u.e = e; u.pm = mt; u.pn = nt; u.rowoff = (seg[q] + mt) * 256; u.nvalid = cn[q] - mt * 256 < 256 ? cn[q] - mt * 256 : 256; u.tok = ltok + (size_t)e * LISTCAP + mt * 256;
                if (G1) { u.a = A; u.b = Bt + ((size_t)e * 2048 + (size_t)nt * 256) * D; }
                else { u.a = A + (size_t)u.rowoff * DEXP; u.b = Bt + ((size_t)e * 1024 + (size_t)nt * 256) * DEXP; }
                return true; }
            j -= nu;
        }
        return false;
    }
};

struct UnitX { const char* a; const char* b; unsigned char* out; int pm, pn; };
struct OrderPX {
    typedef UnitX U;
    const char *kmem, *vmem, *wqb, *wo_t; unsigned char *wqkt, *vwot; int c;
    __device__ __forceinline__ void init(const void* kmem_, const void* vmem_, const void* wqb_, const void* wo_t_, void* wqkt_, void* vwot_, int c_) {
        kmem = (const char*)kmem_; vmem = (const char*)vmem_; wqb = (const char*)wqb_; wo_t = (const char*)wo_t_; wqkt = (unsigned char*)wqkt_; vwot = (unsigned char*)vwot_; c = c_; }
    __device__ __forceinline__ bool next(int i, UnitX& u) const {
        if (i > 0 || c >= 256) return false;
        const int kind = c >> 7, r = c & 127, b = r >> 4, h = (r >> 2) & 3, t = r & 3; u.pm = 0; u.pn = 0;
        if (kind == 0) { u.a = kmem + ((size_t)(b * MEMLEN) * D + h * XHD) * 2; u.b = wqb + ((size_t)(t * 256) * D + h * XHD) * 2; u.out = wqkt + (size_t)b * D * D + (size_t)(h * XHD) * D + t * 256; }
        else { u.a = wo_t + ((size_t)(t * 256) * D + h * XHD) * 2; u.b = vmem + ((size_t)(b * MEMLEN) * D + h * XHD) * 2; u.out = vwot + (size_t)b * D * D + (size_t)(t * 256) * D + h * XHD; }
        return true;
    }
};
struct EpiPX {
    static constexpr bool PERM = true, AFTER_DRAIN = false;
    __device__ __forceinline__ void prefetch(const UnitX&, int, LAS unsigned char*, int, int) const {}
    __device__ __forceinline__ void operator()(const Acc& acc, const UnitX& u, int, LAS unsigned char*, int wr, int wc, int fr, int fq) const {
        const int row0 = wr * 64 + fr, col0 = wc * 32 + 8 * fq;
#pragma unroll
        for (int ai = 0; ai < 2; ++ai)
#pragma unroll
            for (int m = 0; m < 4; ++m) { unsigned char* rowp = u.out + (size_t)(row0 + ai * HALF + m * 16) * D + col0;
#pragma unroll
                for (int bj = 0; bj < 2; ++bj) { const f32x4 v0 = acc[ai][bj][m][0] * PX8_SCALE, v1 = acc[ai][bj][m][1] * PX8_SCALE;
                    u32x2 w; w.x = pk_fp8x4(v0[0], v0[1], v0[2], v0[3]); w.y = pk_fp8x4(v1[0], v1[1], v1[2], v1[3]);
                    *(u32x2*)(rowp + bj * HALF) = w; } }
    }
};
struct OrderXB {
    typedef Unit U; static constexpr bool HALFM = false;
    const char *A, *W; int G, c;
    __device__ __forceinline__ void init(const void* A_, const void* W_, int G_, int c_) { A = (const char*)A_; W = (const char*)W_; G = G_; c = c_; }
    __device__ __forceinline__ bool next(int i, Unit& u) const {
        const int L = i * G + c; if (L >= (M / 256) * XH) return false;
        const int xcd = L & 7, j = L >> 3; u.pm = xcd * 8 + (j >> 2); u.pn = j & 3;
        u.a = A + (size_t)u.pm * 256 * D; u.b = W + ((size_t)(u.pm >> 3) * D * D + (size_t)u.pn * 256 * D); return true;
    }
};

struct EpiP1 {
    static constexpr bool PERM = true, AFTER_DRAIN = false;
    bf16_t *proj, *kmem, *vt; const float* rstd1;
    __device__ __forceinline__ void prefetch(const UnitK& u, int ui, LAS unsigned char* lds, int wid, int lane) const {
        if (wid < 4 && u.kind == 0) __builtin_amdgcn_global_load_lds((const unsigned*)(rstd1 + u.pm * BM + wid * 64 + lane), (LAS unsigned*)(lds + 131072 + (ui % 3) * 3072 + wid * 256), 4, 0, 0);
    }
    __device__ __forceinline__ void operator()(const Acc& acc, const UnitK& u, int ui, LAS unsigned char* lds, int wr, int wc, int fr, int fq) const {
        bf16_t* base; int ldc; float sc = 1.f;
        if (u.kind == 0) { base = proj; ldc = NPROJ; if (u.pn >= 6 && u.pn < 8) sc = C2Q; } else if (u.kind == 1) { base = kmem; ldc = D; } else { base = vt; ldc = D; }
        const LAS float* rsl = (const LAS float*)(lds + 131072 + (ui % 3) * 3072);
        const int row0 = u.pm * BM + wr * 64 + fr, col0 = u.pn * BM + wc * 32 + 8 * fq;
#pragma unroll
        for (int ai = 0; ai < 2; ++ai)
#pragma unroll
            for (int m = 0; m < 4; ++m) { bf16_t* rowp = base + (size_t)(row0 + ai * HALF + m * 16) * ldc + col0;
                const float rs = (u.kind == 0) ? sc * rsl[wr * 64 + fr + ai * HALF + m * 16] : 1.f;
#pragma unroll
                for (int bj = 0; bj < 2; ++bj) { const f32x4 v0 = acc[ai][bj][m][0] * rs, v1 = acc[ai][bj][m][1] * rs;
                    u32x4 w; w.x = cvt_pk_bf16(v0[0], v0[1]); w.y = cvt_pk_bf16(v0[2], v0[3]); w.z = cvt_pk_bf16(v1[0], v1[1]); w.w = cvt_pk_bf16(v1[2], v1[3]);
                    *(u32x4*)(rowp + bj * HALF) = w; } }
    }
};
template <bool BASE16, bool OUT8, bool ROUTE = false> struct EpiRes {
    static constexpr bool PERM = true, AFTER_DRAIN = true;
    const void* base; bf16_t* xb; unsigned char* x8; float* ss; float cs;
    const bf16_t* wrt; float* lpart;
    __device__ __forceinline__ void prefetch(const Unit&, int, LAS unsigned char*, int, int) const {}
    __device__ __forceinline__ void fused(Acc& acc, const Unit& u, int wr, int wc, int fr, int fq, LAS unsigned char* lds, int wid, int lane) const {
        LAS float* PSS = (LAS float*)(lds + (ROUTE ? 131072 : 0));
        LAS float* PL = (LAS float*)lds;
        const int col0 = u.pn * BM + wc * 32 + 8 * fq;
        bf16x8 wa[2][2][2];
        if constexpr (ROUTE) {
#pragma unroll
            for (int bj = 0; bj < 2; ++bj)
#pragma unroll
                for (int eh = 0; eh < 2; ++eh)
#pragma unroll
                    for (int pt = 0; pt < 2; ++pt) wa[bj][eh][pt] = *(const bf16x8*)(wrt + (size_t)pt * NE * D + (size_t)(((u.pn * BM + bj * HALF + wc * 32) >> 3) + fq) * 256 + (16 * eh + fr) * 8);
        }
        u32x4 pb[2][4][2];
        if constexpr (BASE16) {
#pragma unroll
            for (int ai = 0; ai < 2; ++ai)
#pragma unroll
                for (int m = 0; m < 4; ++m)
#pragma unroll
                    for (int bj = 0; bj < 2; ++bj) pb[ai][m][bj] = __builtin_nontemporal_load((const u32x4*)((const bf16_t*)base + (size_t)(u.pm * BM + ai * HALF + wr * 64 + m * 16 + fr) * D + col0 + bj * HALF));
            __builtin_amdgcn_sched_barrier(0);
        }
#pragma unroll
        for (int ai = 0; ai < 2; ++ai)
#pragma unroll
            for (int m = 0; m < 4; ++m) { const int r = ai * HALF + wr * 64 + m * 16 + fr; const size_t off = (size_t)(u.pm * BM + r) * D + col0; float sq = 0.f; f32x4 lacc[2] = {{0.f, 0.f, 0.f, 0.f}, {0.f, 0.f, 0.f, 0.f}};
#pragma unroll
                for (int bj = 0; bj < 2; ++bj) { f32x4 b0, b1;
                    if constexpr (BASE16) { const u32x4 w = pb[ai][m][bj]; b0 = (f32x4){bf_lo(w.x), bf_hi(w.x), bf_lo(w.y), bf_hi(w.y)}; b1 = (f32x4){bf_lo(w.z), bf_hi(w.z), bf_lo(w.w), bf_hi(w.w)}; }
                    else { b0 = __builtin_nontemporal_load((const f32x4*)((const float*)base + off + bj * HALF)); b1 = __builtin_nontemporal_load((const f32x4*)((const float*)base + off + bj * HALF + 4)); }
                    const f32x4 o0 = b0 + acc[ai][bj][m][0] * cs, o1 = b1 + acc[ai][bj][m][1] * cs;
                    { u32x4 w; w.x = cvt_pk_bf16(o0[0], o0[1]); w.y = cvt_pk_bf16(o0[2], o0[3]); w.z = cvt_pk_bf16(o1[0], o1[1]); w.w = cvt_pk_bf16(o1[2], o1[3]); *(u32x4*)(xb + off + bj * HALF) = w;
                      if constexpr (ROUTE) { const bf16x8 xbf = __builtin_bit_cast(bf16x8, w);
#pragma unroll
                          for (int eh = 0; eh < 2; ++eh) { lacc[eh] = __builtin_amdgcn_mfma_f32_16x16x32_bf16(wa[bj][eh][0], xbf, lacc[eh], 0, 0, 0); lacc[eh] = __builtin_amdgcn_mfma_f32_16x16x32_bf16(wa[bj][eh][1], xbf, lacc[eh], 0, 0, 0); } } }
                    if constexpr (OUT8) { u32x2 w; w.x = pk_fp8x4(o0[0], o0[1], o0[2], o0[3]); w.y = pk_fp8x4(o1[0], o1[1], o1[2], o1[3]); *(u32x2*)(x8 + off + bj * HALF) = w; }
                    sq += ((o0[0] * o0[0] + o0[1] * o0[1]) + (o0[2] * o0[2] + o0[3] * o0[3])) + ((o1[0] * o1[0] + o1[1] * o1[1]) + (o1[2] * o1[2] + o1[3] * o1[3])); }
                sq += __shfl_xor(sq, 16); sq += __shfl_xor(sq, 32);
                if (fq == 0) PSS[r * 4 + wc] = sq;
                if constexpr (ROUTE) {
#pragma unroll
                    for (int eh = 0; eh < 2; ++eh) *(LAS f32x4*)(PL + r * 128 + wc * 32 + 16 * eh + 4 * fq) = lacc[eh]; } }
        __syncthreads();
        if (threadIdx.x < 256) { const f32x4 p = *(const LAS f32x4*)(PSS + threadIdx.x * 4); ss[(size_t)(u.pm * BM + threadIdx.x) * 4 + u.pn] = (p[0] + p[1]) + (p[2] + p[3]); }
        if constexpr (ROUTE) { const int row = threadIdx.x >> 1, hf = threadIdx.x & 1; const LAS float* src = PL + row * 128 + 16 * hf; float* dst = lpart + ((size_t)(u.pm * BM + row) * 4 + u.pn) * 32 + 16 * hf;
#pragma unroll
            for (int q = 0; q < 4; ++q) { const f32x4 a0 = *(const LAS f32x4*)(src + 4 * q), a1 = *(const LAS f32x4*)(src + 32 + 4 * q), a2 = *(const LAS f32x4*)(src + 64 + 4 * q), a3 = *(const LAS f32x4*)(src + 96 + 4 * q);
                *(f32x4*)(dst + 4 * q) = (a0 + a1) + (a2 + a3); } }
        __syncthreads();
    }
};
__device__ __forceinline__ float rstd_from_ss(const float* ss, int row) {
    const f32x4 a = *(const f32x4*)(ss + (size_t)row * 4);
    return __builtin_amdgcn_rsqf(((a[0] + a[1]) + (a[2] + a[3])) * (1.0f / D) + EPS);
}
struct EpiSoftmax {
    static constexpr bool PERM = true, AFTER_DRAIN = true;
    unsigned char* pb; const float* ss;
    __device__ __forceinline__ void prefetch(const Unit&, int, LAS unsigned char*, int, int) const {}
    __device__ __forceinline__ void fused(Acc& acc, const Unit& u, int wr, int wc, int fr, int fq, LAS unsigned char* lds, int wid, int lane) const {
        LAS float* PM = (LAS float*)lds;
        LAS float* PS = (LAS float*)(lds + 4096);
#pragma unroll
        for (int ai = 0; ai < 2; ++ai)
#pragma unroll
            for (int m = 0; m < 4; ++m) { const float sc = rstd_from_ss(ss, u.pm * BM + ai * HALF + wr * 64 + m * 16 + fr) * (C2X / PX8_SCALE);
#pragma unroll
                for (int bj = 0; bj < 2; ++bj)
#pragma unroll
                    for (int n = 0; n < 2; ++n) acc[ai][bj][m][n] = acc[ai][bj][m][n] * sc; }
#pragma unroll
        for (int ai = 0; ai < 2; ++ai)
#pragma unroll
            for (int m = 0; m < 4; ++m) { float mx = -INFINITY;
#pragma unroll
                for (int bj = 0; bj < 2; ++bj)
#pragma unroll
                    for (int n = 0; n < 2; ++n) { const f32x4 x = acc[ai][bj][m][n]; mx = fmaxf(mx, fmaxf(fmaxf(x[0], x[1]), fmaxf(x[2], x[3]))); }
                mx = fmaxf(mx, __shfl_xor(mx, 16)); mx = fmaxf(mx, __shfl_xor(mx, 32));
                if (fq == 0) PM[(ai * HALF + wr * 64 + m * 16 + fr) * 4 + wc] = mx; }
        __syncthreads();
#pragma unroll
        for (int ai = 0; ai < 2; ++ai)
#pragma unroll
            for (int m = 0; m < 4; ++m) { const int r = ai * HALF + wr * 64 + m * 16 + fr; const f32x4 pm4 = *(const LAS f32x4*)(PM + r * 4);
                const float mx = fmaxf(fmaxf(pm4[0], pm4[1]), fmaxf(pm4[2], pm4[3])); float s = 0.f;
#pragma unroll
                for (int bj = 0; bj < 2; ++bj)
#pragma unroll
                    for (int n = 0; n < 2; ++n) { f32x4 x = acc[ai][bj][m][n];
#pragma unroll
                        for (int j = 0; j < 4; ++j) { x[j] = __builtin_amdgcn_exp2f(x[j] - mx); s += x[j]; }
                        acc[ai][bj][m][n] = x; }
                s += __shfl_xor(s, 16); s += __shfl_xor(s, 32);
                if (fq == 0) PS[r * 4 + wc] = s; }
        __syncthreads();
        const int row0 = u.pm * BM + wr * 64 + fr, col0 = u.pn * XHD + wc * 32 + 8 * fq;
#pragma unroll
        for (int ai = 0; ai < 2; ++ai)
#pragma unroll
            for (int m = 0; m < 4; ++m) { const int r = ai * HALF + wr * 64 + m * 16 + fr; const f32x4 ps4 = *(const LAS f32x4*)(PS + r * 4);
                const float inv = P8_SCALE / ((ps4[0] + ps4[1]) + (ps4[2] + ps4[3])); unsigned char* rowp = pb + (size_t)(row0 + ai * HALF + m * 16) * D + col0;
#pragma unroll
                for (int bj = 0; bj < 2; ++bj) { const f32x4 v0 = acc[ai][bj][m][0] * inv, v1 = acc[ai][bj][m][1] * inv;
                    u32x2 w; w.x = pk_fp8x4(v0[0], v0[1], v0[2], v0[3]); w.y = pk_fp8x4(v1[0], v1[1], v1[2], v1[3]);
                    *(u32x2*)(rowp + bj * HALF) = w; } }
        __syncthreads();
    }
};
constexpr int META_OFF = 131072, META_BYTES = 3072;
__device__ __forceinline__ void dma4(const void* g, LAS unsigned char* l) { __builtin_amdgcn_global_load_lds((const unsigned*)g, (LAS unsigned*)l, 4, 0, 0); }
__device__ __forceinline__ void dma16(const void* g, LAS unsigned char* l) { __builtin_amdgcn_global_load_lds((const unsigned*)g, (LAS unsigned*)l, 16, 0, 0); }
struct EpiAct {
    static constexpr bool PERM = true, AFTER_DRAIN = false;
    bf16_t* act; const float* lrstd; const float* b1;
    __device__ __forceinline__ void prefetch(const UnitM& u, int ui, LAS unsigned char* lds, int wid, int lane) const {
        LAS unsigned char* mb = lds + META_OFF + (ui % 3) * META_BYTES;
        if (wid < 4) dma4(lrstd + (size_t)u.e * LISTCAP + u.pm * 256 + wid * 64 + lane, mb + wid * 256);
        else dma4(u.tok + (wid - 4) * 64 + lane, mb + 1024 + (wid - 4) * 256);
        if (wid == 4) dma16(b1 + (size_t)u.e * 2048 + (lane >> 5) * 1024 + u.pn * 128 + (lane & 31) * 4, mb + 2048);
    }
    __device__ __forceinline__ void operator()(const Acc& acc, const UnitM& u, int ui, LAS unsigned char* lds, int wr, int wc, int fr, int fq) const {
        const LAS unsigned char* mb = lds + META_OFF + (ui % 3) * META_BYTES;
        const int cl = wc * 32 + 8 * fq, gcol = u.pn * 128 + cl; const LAS float* bg = (const LAS float*)(mb + 2048) + cl; const LAS float* bl = bg + 128;
        const f32x4 bg0 = *(const LAS f32x4*)bg, bg1 = *(const LAS f32x4*)(bg + 4), bl0 = *(const LAS f32x4*)bl, bl1 = *(const LAS f32x4*)(bl + 4);
        int rb = wr * 64 + fr; asm volatile("" : "+v"(rb));
#pragma unroll
        for (int ai = 0; ai < 2; ++ai)
#pragma unroll
            for (int m = 0; m < 4; ++m) { const int r = ai * HALF + m * 16 + rb; const float rs = ((const LAS float*)mb)[r] * (1.0f / W8_SCALE);
                int w[2];
#pragma unroll
                for (int n = 0; n < 2; ++n) { const f32x4 ga = acc[ai][0][m][n], la = acc[ai][1][m][n], bgn = n ? bg1 : bg0, bln = n ? bl1 : bl0; int wn = 0;
#pragma unroll
                    for (int hh = 0; hh < 2; ++hh) {
                        f32x2 g2 = (f32x2){ga[2 * hh], ga[2 * hh + 1]} * rs + (f32x2){bgn[2 * hh], bgn[2 * hh + 1]}, l2 = (f32x2){la[2 * hh], la[2 * hh + 1]} * rs + (f32x2){bln[2 * hh], bln[2 * hh + 1]};
                        g2 = __builtin_elementwise_min(g2, (f32x2){7.0f, 7.0f});
                        l2 = __builtin_elementwise_min(__builtin_elementwise_max(l2, (f32x2){-7.0f, -7.0f}), (f32x2){7.0f, 7.0f});
                        const f32x2 t2 = g2 * (-1.702f * LOG2E); f32x2 d2; d2.x = __builtin_amdgcn_exp2f(t2.x); d2.y = __builtin_amdgcn_exp2f(t2.y); d2 = d2 + 1.0f;
                        f32x2 r2; r2.x = __builtin_amdgcn_rcpf(d2.x); r2.y = __builtin_amdgcn_rcpf(d2.y);
                        const f32x2 o2 = (g2 * r2) * (l2 * ACT8_SCALE + ACT8_SCALE);
                        if (hh == 0) wn = __builtin_amdgcn_cvt_pk_fp8_f32(o2.x, o2.y, wn, false); else wn = __builtin_amdgcn_cvt_pk_fp8_f32(o2.x, o2.y, wn, true); }
                    w[n] = wn; }
                *(u32x2*)((unsigned char*)act + (size_t)(u.rowoff + r) * DEXP + gcol) = (u32x2){(unsigned)w[0], (unsigned)w[1]}; }
    }
};
struct EpiY {
    static constexpr bool PERM = true, AFTER_DRAIN = false;
    bf16_t* y; const float* lgate; const int* ltok; const float* b2;
    __device__ __forceinline__ void prefetch(const UnitM& u, int ui, LAS unsigned char* lds, int wid, int lane) const {
        LAS unsigned char* mb = lds + META_OFF + (ui % 3) * META_BYTES;
        const size_t li = (size_t)u.e * LISTCAP + u.pm * 256 + (wid & 3) * 64 + lane;
        if (wid < 4) dma4(lgate + li, mb + wid * 256); else dma4(ltok + li, mb + 1024 + (wid - 4) * 256);
        if (wid == 0) dma16(b2 + (size_t)u.e * D + u.pn * 256 + lane * 4, mb + 2048);
    }
    __device__ __forceinline__ void operator()(const Acc& acc, const UnitM& u, int ui, LAS unsigned char* lds, int wr, int wc, int fr, int fq) const {
        const LAS unsigned char* mb = lds + META_OFF + (ui % 3) * META_BYTES;
        const int cl = wc * 32 + 8 * fq, col0 = u.pn * BM + cl; const LAS float* bb = (const LAS float*)(mb + 2048) + cl;
        int rb = wr * 64 + fr; asm volatile("" : "+v"(rb));
#pragma unroll
        for (int bj = 0; bj < 2; ++bj) {
            const f32x4 bv0 = *(const LAS f32x4*)(bb + bj * HALF), bv1 = *(const LAS f32x4*)(bb + bj * HALF + 4);
#pragma unroll
            for (int ai = 0; ai < 2; ++ai)
#pragma unroll
                for (int m = 0; m < 4; ++m) { const int r = ai * HALF + m * 16 + rb;
                    if (r < u.nvalid) { const int ent = ((const LAS int*)(mb + 1024))[r]; const float gs = ((const LAS float*)mb)[r] * Y8_SCALE; unsigned char* rowp = (unsigned char*)y + (size_t)ent * D + col0;
                        const f32x4 a0 = acc[ai][bj][m][0], a1 = acc[ai][bj][m][1]; constexpr float CS = 1.0f / (W8_SCALE * ACT8_SCALE);
                        const f32x2 p0 = ((f32x2){a0[0], a0[1]} * CS + (f32x2){bv0[0], bv0[1]}) * gs, p1 = ((f32x2){a0[2], a0[3]} * CS + (f32x2){bv0[2], bv0[3]}) * gs;
                        const f32x2 p2 = ((f32x2){a1[0], a1[1]} * CS + (f32x2){bv1[0], bv1[1]}) * gs, p3 = ((f32x2){a1[2], a1[3]} * CS + (f32x2){bv1[2], bv1[3]}) * gs;
                        u32x2 w; w.x = pk_fp8x4(p0.x, p0.y, p1.x, p1.y); w.y = pk_fp8x4(p2.x, p2.y, p3.x, p3.y);
                        *(u32x2*)(rowp + bj * HALF) = w; } }
        }
    }
};
}

#define XB_TMO      128
#define XB_XCNT(j)  (256  + 64 * (j))
#define XB_XSUB(j)  (1280 + 64 * (j))
#define XB_XGEN(j)  (2304 + 64 * (j))
#define XB_TOP      3328
#define XB_TOPGEN   3392
#define XCD_BAR_WORDS 3456
#define XB_SPIN_CAP (1u << 18)
__device__ __forceinline__ unsigned xb_ld(unsigned* p)              { return __hip_atomic_load(p, __ATOMIC_RELAXED, __HIP_MEMORY_SCOPE_AGENT); }
__device__ __forceinline__ unsigned xb_add(unsigned* p, unsigned v) { return __hip_atomic_fetch_add(p, v, __ATOMIC_RELAXED, __HIP_MEMORY_SCOPE_AGENT); }
__device__ __forceinline__ unsigned xb_xcc_id() { return (unsigned)__builtin_amdgcn_s_getreg((3 << 11) | 20) & 0xFu; }
#define XB_SPIN(cond, bar) do { unsigned _sp = 0; while (cond) { __builtin_amdgcn_s_sleep(1); \
    if ((++_sp & 255u) == 0u) { if (xb_ld(&(bar)[XB_TMO])) break; if (_sp > XB_SPIN_CAP) { atomicAdd(&(bar)[XB_TMO], 1u); break; } } } } while (0)
struct XcdBarrier { unsigned* bar; unsigned x; volatile LAS unsigned* st; };
__device__ __forceinline__ XcdBarrier xcd_barrier_post(unsigned* bar, volatile LAS unsigned* st) {
    XcdBarrier b; b.bar = bar; b.x = xb_xcc_id(); b.st = st;
    if (threadIdx.x == 0) (void)xb_add(&bar[XB_XCNT(b.x)], 1u);
    return b;
}
__device__ __forceinline__ void xcd_barrier_complete(unsigned* bar, unsigned x, unsigned& nloc, unsigned& nx) {
    const unsigned G = gridDim.x * gridDim.y * gridDim.z;
    unsigned sum, cnt, mine, sp = 0u;
    for (;;) {
        sum = 0u; cnt = 0u; mine = 0u;
#pragma unroll
        for (unsigned j = 0; j < 16; ++j) { const unsigned c = xb_ld(&bar[XB_XCNT(j)]); sum += c; cnt += (c > 0u) ? 1u : 0u; mine = (j == x) ? c : mine; }
        if (sum == G) break;
        __builtin_amdgcn_s_sleep(1);
        if ((++sp & 255u) == 0u) { if (xb_ld(&bar[XB_TMO])) break; if (sp > XB_SPIN_CAP) { atomicAdd(&bar[XB_TMO], 1u); break; } }
    }
    nloc = mine > 0u ? mine : 1u; nx = cnt > 0u ? cnt : 1u;
}
__device__ __forceinline__ void xcd_barrier(const XcdBarrier& b) {
    asm volatile("s_waitcnt vmcnt(0)" ::: "memory");
    __syncthreads();
    if (threadIdx.x == 0) {
        unsigned* bar = b.bar;
        __builtin_amdgcn_s_waitcnt(0);
        unsigned nloc = b.st[0], nx = b.st[1];
        if (nloc == 0u) { xcd_barrier_complete(bar, b.x, nloc, nx); b.st[0] = nloc; b.st[1] = nx; }
        const unsigned old = xb_add(&bar[XB_XSUB(b.x)], 1u);
        const unsigned gen = old / nloc;
        if (old + 1u == (gen + 1u) * nloc) {
            __builtin_amdgcn_fence(__ATOMIC_RELEASE, "agent");
            asm volatile("s_waitcnt vmcnt(0)" ::: "memory");
            const unsigned og = xb_add(&bar[XB_TOP], 1u);
            const unsigned tg = og / nx;
            if (og + 1u == (tg + 1u) * nx) xb_add(&bar[XB_TOPGEN], 1u);
            else XB_SPIN(xb_ld(&bar[XB_TOPGEN]) == tg, bar);
            __builtin_amdgcn_fence(__ATOMIC_ACQUIRE, "agent");
            xb_add(&bar[XB_XGEN(b.x)], 1u);
            asm volatile("s_waitcnt vmcnt(0)" ::: "memory");
        } else {
            XB_SPIN(xb_ld(&bar[XB_XGEN(b.x)]) == gen, bar);
            __builtin_amdgcn_fence(__ATOMIC_ACQUIRE, "agent");
            asm volatile("s_waitcnt vmcnt(0)" ::: "memory");
        }
    }
    __syncthreads();
}

constexpr int NWAVES = 8;
constexpr int RING_OFF = 0, RING_BYTES = 131072;
constexpr int LDSCTL_OFF = RING_BYTES + 12288, MISC_OFF = LDSCTL_OFF + 320;
constexpr int LDS_BYTES = 147456;
static_assert(MISC_OFF + 128 <= LDS_BYTES, "LDS map");

struct Frame {
    LAS unsigned char* lds; volatile LAS unsigned* MISC; unsigned* ctl; unsigned char* ws;
    int tid, lane, wave, vcu, G;
    const float* const* in; float* out;
};

__device__ __forceinline__ int nmap1(int n) { return n < 1024 ? (n >> 7) * 256 + (n & 127) : ((n - 1024) >> 7) * 256 + 128 + ((n - 1024) & 127); }
struct TItem { const float* W; bf16_t* WT; const float* g; int ldw, K, k0, n0, perm; };
__device__ __forceinline__ void titem_load(const TItem& t, f32x4 (&va)[8], f32x4 (&vb)[8], int lane) {
    const int nq = lane & 15, kp = lane >> 4;
#pragma unroll
    for (int it = 0; it < 8; ++it) { const int k = t.k0 + 2 * (kp + 4 * it); va[it] = __builtin_nontemporal_load((const f32x4*)(t.W + (size_t)k * t.ldw + t.n0 + 4 * nq)); vb[it] = __builtin_nontemporal_load((const f32x4*)(t.W + (size_t)(k + 1) * t.ldw + t.n0 + 4 * nq)); }
}
__device__ __forceinline__ void titem_store(const TItem& t, const f32x4 (&va)[8], const f32x4 (&vb)[8], LAS unsigned* scr, int lane) {
    const int nq = lane & 15, kp = lane >> 4;
#pragma unroll
    for (int it = 0; it < 8; ++it) { const int kk2 = kp + 4 * it; f32x4 a = va[it], b = vb[it];
        if (t.g) { const float g0 = t.g[t.k0 + 2 * kk2], g1 = t.g[t.k0 + 2 * kk2 + 1]; a = a * g0; b = b * g1; }
#pragma unroll
        for (int j = 0; j < 4; ++j) scr[(4 * nq + j) * 33 + kk2] = cvtpk_s(a[j], b[j]); }
    LDS_WAIT(); asm volatile("" ::: "memory");
    const int c = lane & 7;
#pragma unroll
    for (int it = 0; it < 8; ++it) { const int n = (lane >> 3) + 8 * it; const LAS unsigned* sp = scr + n * 33 + 4 * c;
        u32x4 o; o.x = sp[0]; o.y = sp[1]; o.z = sp[2]; o.w = sp[3];
        const int nn = t.n0 + n, nr = t.perm ? nmap1(nn) : nn;
        *(u32x4*)(t.WT + (size_t)nr * t.K + t.k0 + 8 * c) = o; }
    LDS_WAIT(); asm volatile("" ::: "memory");
}
template <int H> __device__ __forceinline__ void titem8_load(const TItem& t, f32x4 (&v)[4][4], int lane) {
    const int nq = lane & 15, kg = lane >> 4;
#pragma unroll
    for (int i = 0; i < 4; ++i) { const int k = t.k0 + 4 * (kg + 4 * (4 * H + i)); const float* p = t.W + (size_t)k * t.ldw + t.n0 + 4 * nq;
#pragma unroll
        for (int q = 0; q < 4; ++q) v[i][q] = __builtin_nontemporal_load((const f32x4*)(p + (size_t)q * t.ldw)); }
}
template <int H> __device__ __forceinline__ void titem8_half(const TItem& t, const f32x4 (&v)[4][4], LAS unsigned* scr, int lane) {
    const int nq = lane & 15, kg = lane >> 4;
#pragma unroll
    for (int i = 0; i < 4; ++i) { const int kq = kg + 4 * (4 * H + i);
        float g0 = W8_SCALE, g1 = W8_SCALE, g2 = W8_SCALE, g3 = W8_SCALE;
        if (t.g) { const f32x4 gv = *(const f32x4*)(t.g + t.k0 + 4 * kq); g0 *= gv[0]; g1 *= gv[1]; g2 *= gv[2]; g3 *= gv[3]; }
#pragma unroll
        for (int j = 0; j < 4; ++j) scr[(4 * nq + j) * 33 + kq] = pk_fp8x4(v[i][0][j] * g0, v[i][1][j] * g1, v[i][2][j] * g2, v[i][3][j] * g3); }
}
__device__ __forceinline__ void titem8_store(const TItem& t, LAS unsigned* scr, int lane) {
    LDS_WAIT(); asm volatile("" ::: "memory");
    const int c = lane & 7;
#pragma unroll
    for (int it = 0; it < 8; ++it) { const int n = (lane >> 3) + 8 * it; const LAS unsigned* sp = scr + n * 33 + 4 * c;
        u32x4 o; o.x = sp[0]; o.y = sp[1]; o.z = sp[2]; o.w = sp[3];
        const int nn = t.n0 + n, nr = t.perm ? nmap1(nn) : nn;
        __builtin_nontemporal_store(o, (u32x4*)((unsigned char*)t.WT + (size_t)nr * t.K + t.k0 + 16 * c)); }
    LDS_WAIT(); asm volatile("" ::: "memory");
}
template <class Dec> __device__ __forceinline__ void titem8_queue(LAS unsigned* ctr, int base, int n, LAS unsigned* scr, int lane, const Dec& dec) {
    n += base;
    auto claim = [&]() -> int { unsigned v = 0u; if (lane == 0) v = __hip_atomic_fetch_add(ctr, 1u, __ATOMIC_RELAXED, __HIP_MEMORY_SCOPE_WORKGROUP); return base + __builtin_amdgcn_readfirstlane((int)v); };
    TItem A, B; f32x4 va[4][4], vb[4][4];
    int ia = claim(); if (ia >= n) return;
    dec(ia, A); titem8_load<0>(A, va, lane); titem8_load<1>(A, vb, lane);
    for (;;) {
        const int ib = claim(); const bool hb = ib < n;
        titem8_half<0>(A, va, scr, lane);
        if (hb) { dec(ib, B); titem8_load<0>(B, va, lane); }
        titem8_half<1>(A, vb, scr, lane);
        if (hb) titem8_load<1>(B, vb, lane);
        titem8_store(A, scr, lane);
        if (!hb) break;
        A = B;
    }
}
template <bool F8, class Dec> __device__ __forceinline__ void titem_loop(int first, int stride, int n, LAS unsigned* scr, int lane, const Dec& dec) {
    if (first >= n) return;
    if constexpr (F8) {
        TItem A, B; f32x4 va[4][4], vb[4][4];
        int ia = first; dec(ia, A); titem8_load<0>(A, va, lane); titem8_load<1>(A, vb, lane);
        for (;;) {
            const int ib = ia + stride; const bool hb = ib < n;
            titem8_half<0>(A, va, scr, lane);
            if (hb) { dec(ib, B); titem8_load<0>(B, va, lane); }
            titem8_half<1>(A, vb, scr, lane);
            if (hb) titem8_load<1>(B, vb, lane);
            titem8_store(A, scr, lane);
            if (!hb) break;
            A = B; ia = ib;
        }
    }
    else {
        TItem A, B; f32x4 a0[8], a1[8], b0[8], b1[8];
        int ia = first; dec(ia, A); titem_load(A, a0, a1, lane);
        for (;;) {
            const int ib = ia + stride; const bool hb = ib < n;
            if (hb) { dec(ib, B); titem_load(B, b0, b1, lane); }
            titem_store(A, a0, a1, scr, lane);
            if (!hb) break;
            ia = ib + stride; const bool ha = ia < n;
            if (ha) { dec(ia, A); titem_load(A, a0, a1, lane); }
            titem_store(B, b0, b1, scr, lane);
            if (!ha) break;
        }
    }
}
template <bool RAW = false> __device__ __forceinline__ void rms_rows_to_bf16(const float* x, const float* g, bf16_t* o, int first, int stride, int n, int lane, float* rs = nullptr) {
    if (first >= n) return;
    const f32x4* gr = (const f32x4*)g + lane; f32x4 gg[4];
#pragma unroll
    for (int j = 0; j < 4; ++j) gg[j] = gr[64 * j];
    f32x4 v[4], w[4];
#pragma unroll
    for (int j = 0; j < 4; ++j) v[j] = __builtin_nontemporal_load((const f32x4*)(x + (size_t)first * D) + lane + 64 * j);
    for (int m = first; m < n; m += stride) {
        const int mn = m + stride;
        if (mn < n) {
#pragma unroll
            for (int j = 0; j < 4; ++j) w[j] = __builtin_nontemporal_load((const f32x4*)(x + (size_t)mn * D) + lane + 64 * j);
        }
        float sq = 0.f;
#pragma unroll
        for (int j = 0; j < 4; ++j) sq += (v[j][0] * v[j][0] + v[j][1] * v[j][1]) + (v[j][2] * v[j][2] + v[j][3] * v[j][3]);
        const float rstd = __builtin_amdgcn_rsqf(wave_sum(sq) * (1.f / D) + EPS);
        u32x2* o8 = (u32x2*)(o + (size_t)m * D) + lane;
#pragma unroll
        for (int j = 0; j < 4; ++j) { u32x2 q;
            if constexpr (RAW) { q.x = cvtpk_s(v[j][0], v[j][1]); q.y = cvtpk_s(v[j][2], v[j][3]); }
            else { q.x = cvtpk_s(v[j][0] * rstd * gg[j][0], v[j][1] * rstd * gg[j][1]); q.y = cvtpk_s(v[j][2] * rstd * gg[j][2], v[j][3] * rstd * gg[j][3]); }
            o8[64 * j] = q; }
        if constexpr (RAW) { if (lane == 0) rs[m] = rstd; }
#pragma unroll
        for (int j = 0; j < 4; ++j) v[j] = w[j];
    }
}
struct XDec {
    const float *g_moe, *w1, *w2; unsigned char *w1_t, *w2_t;
    __device__ __forceinline__ void operator()(int r, TItem& t) const {
        t.g = nullptr; t.perm = 0; t.K = D;
        if (r < I_W2) { const int ex = r / 128, q = r % 128; t.W = w2 + (size_t)ex * DEXP * D; t.WT = (bf16_t*)(w2_t + (size_t)ex * D * DEXP); t.ldw = D; t.k0 = (q / 16) * 128; t.n0 = (q % 16) * 64; return; } r -= I_W2;
        { const int ex = r / 256, q = r % 256; t.W = w1 + (size_t)ex * D * 2048; t.WT = (bf16_t*)(w1_t + (size_t)ex * 2048 * D); t.g = g_moe; t.ldw = 2048; t.perm = 1; t.k0 = (q / 32) * 128; t.n0 = (q % 32) * 64; }
    }
};
__device__ __forceinline__ XDec xdec(const Frame& F) { return XDec{F.in[13], F.in[16], F.in[18], F.ws + WS_W1_T, F.ws + WS_W2_T}; }
__device__ __forceinline__ void convert_experts(Frame& F, int first, int stride, int end) {
    titem_loop<true>(first, stride, end, (LAS unsigned*)(F.lds + RING_OFF + F.wave * 16384), F.lane, xdec(F));
}
__device__ __forceinline__ void p0_prologue(Frame& F) {
    LAS unsigned* scr = (LAS unsigned*)(F.lds + RING_OFF + F.wave * 16384);
    const int gw = F.vcu * NWAVES + F.wave, NGW = F.G * NWAVES;
    const float *x = F.in[0], *mem = F.in[1], *g_mix = F.in[2], *w_in = F.in[3], *w_out = F.in[7], *g_xattn = F.in[8], *g_mem = F.in[9], *w_q = F.in[10], *w_kv = F.in[11], *w_o = F.in[12], *g_moe = F.in[13], *w_router = F.in[14];
    bf16_t *win_t = (bf16_t*)(F.ws + WS_WIN_T), *wout_t = (bf16_t*)(F.ws + WS_WOUT_T), *wq_t = (bf16_t*)(F.ws + WS_WQ_T), *wkv_t = (bf16_t*)(F.ws + WS_WKV_T), *wo_t = (bf16_t*)(F.ws + WS_WO_T),
           *xn = (bf16_t*)(F.ws + WS_XN), *memn = (bf16_t*)(F.ws + WS_MEMN);
    bf16_t* wr = (bf16_t*)(F.ws + WS_WR);
    for (int i = gw; i < D * NE / 64; i += NGW) { const int idx = i * 64 + F.lane, k = idx >> 5, ex = idx & 31; const float w = w_router[idx] * g_moe[k];
        const unsigned hi = cvtpk_s(w, 0.f) & 0xffffu; const float rem = w - __uint_as_float(hi << 16); const unsigned lo = cvtpk_s(rem, 0.f) & 0xffffu;
        const int ti = (k >> 3) * 256 + ex * 8 + (k & 7);
        wr[ti] = (bf16_t)hi; wr[NE * D + ti] = (bf16_t)lo; }
    rms_rows_to_bf16(mem, g_mem, memn, gw, NGW, MROWS, F.lane);
    for (int i = gw * 64 + F.lane; i < D * D / 4; i += NGW * 64) {
        const f32x4 v = __builtin_nontemporal_load((const f32x4*)w_q + i) * g_xattn[i >> 8]; u32x2 w; w.x = cvtpk_s(v[0], v[1]); w.y = cvtpk_s(v[2], v[3]); ((u32x2*)wq_t)[i] = w; }
    constexpr int I_KV = 16 * 32, I_O = 16 * 16, I_OUT = 16 * 16, I_IN = 16 * 48;
    titem_loop<false>(gw, NGW, I_KV + I_O + I_OUT + I_IN, scr, F.lane, [=](int r, TItem& t) {
        t.g = nullptr; t.perm = 0; t.K = D; t.ldw = D;
        if (r < I_KV) { t.W = w_kv; t.WT = wkv_t; t.ldw = 2 * D; t.k0 = (r / 32) * 64; t.n0 = (r % 32) * 64; return; } r -= I_KV;
        if (r < I_O) { t.W = w_o; t.WT = wo_t; t.k0 = (r / 16) * 64; t.n0 = (r % 16) * 64; return; } r -= I_O;
        if (r < I_OUT) { t.W = w_out; t.WT = wout_t; t.k0 = (r / 16) * 64; t.n0 = (r % 16) * 64; return; } r -= I_OUT;
        { t.W = w_in; t.WT = win_t; t.g = g_mix; t.ldw = NPROJ; t.k0 = (r / 48) * 64; t.n0 = (r % 48) * 64; }
    });
    rms_rows_to_bf16<true>(x, g_mix, xn, gw, NGW, M, F.lane, (float*)(F.ws + WS_RSTD3));
}

__device__ __forceinline__ void conv_rows(Frame& F) {
    const bf16_t* proj = (const bf16_t*)(F.ws + WS_PROJ); bf16_t* ymix = (bf16_t*)(F.ws + WS_YMIX);
    const float* conv_w = F.in[4]; const float* g_conv = F.in[5];
    const int gw = F.vcu * NWAVES + F.wave, NGW = F.G * NWAVES, c0 = 8 * F.lane;
    float w0[8], w1[8], w2[8], gg[8];
#pragma unroll
    for (int j = 0; j < 8; ++j) { w0[j] = conv_w[c0 + j]; w1[j] = conv_w[512 + c0 + j]; w2[j] = conv_w[1024 + c0 + j]; gg[j] = g_conv[c0 + j]; }
    auto ld = [&](int m, u32x4 (&v)[7]) {
        const int t = m & (SEQ - 1); const bf16_t* row = proj + (size_t)m * NPROJ + c0;
        v[0] = *(const u32x4*)row; v[1] = *(const u32x4*)(row + 512); v[2] = *(const u32x4*)(row + 1024);
        v[3] = (u32x4){0, 0, 0, 0}; v[4] = v[3]; v[5] = v[3]; v[6] = v[3];
        if (t >= 1) { v[3] = *(const u32x4*)(row - NPROJ + 512); v[4] = *(const u32x4*)(row - NPROJ + 1024); }
        if (t >= 2) { v[5] = *(const u32x4*)(row - 2 * NPROJ + 512); v[6] = *(const u32x4*)(row - 2 * NPROJ + 1024); }
    };
    if (gw >= M) return;
    u32x4 cur[7], nx[7];
    ld(gw, cur);
    for (int m = gw; m < M; m += NGW) {
        if (m + NGW < M) ld(m + NGW, nx);
        const u32x4 bg = cur[0], cg0 = cur[1], xv0 = cur[2], cg1 = cur[3], xv1 = cur[4], cg2 = cur[5], xv2 = cur[6];
        float y[8]; float ss = 0.f;
#pragma unroll
        for (int j = 0; j < 4; ++j) {
            const float u0l = bf_lo(cg0[j]) * bf_lo(xv0[j]), u0h = bf_hi(cg0[j]) * bf_hi(xv0[j]);
            const float u1l = bf_lo(cg1[j]) * bf_lo(xv1[j]), u1h = bf_hi(cg1[j]) * bf_hi(xv1[j]);
            const float u2l = bf_lo(cg2[j]) * bf_lo(xv2[j]), u2h = bf_hi(cg2[j]) * bf_hi(xv2[j]);
            y[2 * j] = bf_lo(bg[j]) * (w0[2 * j] * u2l + w1[2 * j] * u1l + w2[2 * j] * u0l);
            y[2 * j + 1] = bf_hi(bg[j]) * (w0[2 * j + 1] * u2h + w1[2 * j + 1] * u1h + w2[2 * j + 1] * u0h);
            ss += y[2 * j] * y[2 * j] + y[2 * j + 1] * y[2 * j + 1];
        }
        ss += __shfl_xor(ss, 1); ss += __shfl_xor(ss, 2); ss += __shfl_xor(ss, 4);
        const float rstd = __builtin_amdgcn_rsqf(ss * (1.f / 64.f) + EPS);
        u32x4 o; o.x = cvtpk_s(y[0] * rstd * gg[0], y[1] * rstd * gg[1]); o.y = cvtpk_s(y[2] * rstd * gg[2], y[3] * rstd * gg[3]);
        o.z = cvtpk_s(y[4] * rstd * gg[4], y[5] * rstd * gg[5]); o.w = cvtpk_s(y[6] * rstd * gg[6], y[7] * rstd * gg[7]);
        *(u32x4*)(ymix + (size_t)m * D + c0) = o;
#pragma unroll
        for (int i = 0; i < 7; ++i) cur[i] = nx[i];
    }
}
constexpr int SB_SLOT = 16384, SB_V = 8192, SB_OST = 4 * SB_SLOT, SB_OSTW = 32 * 68 * 4, SB_FLAG = SB_OST + 8 * SB_OSTW;
static_assert(SB_FLAG + 32 <= RING_BYTES + 12288, "attention LDS (the O stage may extend into the GEMM phases' metadata area, unused here)");
__device__ __forceinline__ int crow(int r, int hi) { return (r & 3) + 8 * (r >> 2) + 4 * hi; }
__device__ __forceinline__ void sb_attn_unit(Frame& F, int b, int h, int qb) {
    const bf16_t* proj = (const bf16_t*)(F.ws + WS_PROJ); bf16_t* ymix = (bf16_t*)(F.ws + WS_YMIX); const float* g_sb = F.in[6];
    const int tid = F.tid, lane = F.lane, wid = F.wave, r32 = lane & 31, hi = lane >> 5;
    LAS unsigned char* lds = F.lds + RING_OFF;
    const int q0 = qb * 256, qlo = q0 + wid * 32, qpos = qlo + r32;
    const size_t rowbase = (size_t)b * SEQ;
    const bf16_t* Qp = proj + (rowbase + qlo) * NPROJ + 1536 + h * 64;
    const bf16_t* Kp = proj + rowbase * NPROJ + 2048 + h * 64;
    const bf16_t* Vp = proj + rowbase * NPROJ + 2560 + h * 64;
    bf16x8 qr[4];
#pragma unroll
    for (int s = 0; s < 4; ++s) qr[s] = *(const bf16x8*)(Qp + (size_t)r32 * NPROJ + 16 * s + 8 * hi);
    bf16x8 ntri[2], nones;
#pragma unroll
    for (int s = 0; s < 2; ++s)
#pragma unroll
        for (int j = 0; j < 8; ++j) { const int k = 16 * s + 8 * (j >> 2) + 4 * hi + (j & 3); ntri[s][j] = (k > r32) ? (short)0xBF80 : (short)0; }
#pragma unroll
    for (int j = 0; j < 8; ++j) nones[j] = (short)0xBF80;
    f32x16 R = {}; f32x16 o[2]; o[0] = f32x16{}; o[1] = f32x16{};
    const int skey = tid >> 3, sc = tid & 7;
    const int koff = skey * 128 + ((sc ^ ((skey >> 1) & 7)) << 4);
    const int voff = SB_V + (sc >> 2) * 4096 + (skey >> 4) * 1024 + (skey & 15) * 64 + (sc & 3) * 16;
    const int vbl = SB_V + ((lane >> 4) & 1) * 32 + (lane & 3) * 8 + (4 * hi + ((lane & 15) >> 2)) * 64;
    const int dw = 4 * qb + (wid >> 1);
    LAS int* dflag = (LAS int*)(lds + SB_FLAG);
    __syncthreads();
    {   u32x4 kr[4], vr[4];
#pragma unroll
        for (int p = 0; p < 4; ++p) { const size_t row = (size_t)((4 * qb + p) * 64 + skey) * NPROJ + sc * 8; kr[p] = *(const u32x4*)(Kp + row); vr[p] = *(const u32x4*)(Vp + row); }
#pragma unroll
        for (int p = 0; p < 4; ++p) { const int so = ((4 * qb + p) & 3) * SB_SLOT; *(LAS u32x4*)(lds + so + koff) = kr[p]; *(LAS u32x4*)(lds + so + voff) = vr[p]; } }
    int nb = 4 * qb - 1;
    u32x4 kreg = {0, 0, 0, 0}, vreg = {0, 0, 0, 0};
    if (nb >= 0) { const size_t row = (size_t)(nb * 64 + skey) * NPROJ + sc * 8; kreg = *(const u32x4*)(Kp + row); vreg = *(const u32x4*)(Vp + row); }
    __syncthreads();
    int done = 0;
    for (int kbi = dw; ; --kbi) {
        if (kbi < 0) done = 1;
        const int k0 = kbi * 64, so = (kbi & 3) * SB_SLOT, vb = so + vbl;
        if (!done) {
            f32x16 p0 = {}, p1 = {};
#pragma unroll
            for (int s = 0; s < 4; ++s) { const int c = 2 * s + hi;
                const bf16x8 ka = *(const LAS bf16x8*)(lds + so + r32 * 128 + ((c ^ ((r32 >> 1) & 7)) << 4));
                const bf16x8 kb = *(const LAS bf16x8*)(lds + so + (r32 + 32) * 128 + ((c ^ (((r32 + 32) >> 1) & 7)) << 4));
                p0 = __builtin_amdgcn_mfma_f32_32x32x16_bf16(ka, qr[s], p0, 0, 0, 0); p1 = __builtin_amdgcn_mfma_f32_32x32x16_bf16(kb, qr[s], p1, 0, 0, 0); }
            const bool diag = (k0 + 63 >= qlo);
            f32x16 s0, s1;
#pragma unroll
            for (int r = 0; r < 16; ++r) {
                const float z0 = p0[r], z1 = p1[r];
                float sp0 = fmaxf(z0, 0.f) + __builtin_amdgcn_logf(1.0f + __builtin_amdgcn_exp2f(-fabsf(z0)));
                float sp1 = fmaxf(z1, 0.f) + __builtin_amdgcn_logf(1.0f + __builtin_amdgcn_exp2f(-fabsf(z1)));
                if (diag) { const int key = k0 + crow(r, hi); if (key >= qpos) sp0 = 0.f; if (key + 32 >= qpos) sp1 = 0.f; }
                s0[r] = sp0; s1[r] = sp1; p0[r] = z0 - sp0; p1[r] = z1 - sp1;
            }
            u32x4 w00 = {cvtpk_s(s0[0], s0[1]), cvtpk_s(s0[2], s0[3]), cvtpk_s(s0[4], s0[5]), cvtpk_s(s0[6], s0[7])}, w01 = {cvtpk_s(s0[8], s0[9]), cvtpk_s(s0[10], s0[11]), cvtpk_s(s0[12], s0[13]), cvtpk_s(s0[14], s0[15])};
            u32x4 w10 = {cvtpk_s(s1[0], s1[1]), cvtpk_s(s1[2], s1[3]), cvtpk_s(s1[4], s1[5]), cvtpk_s(s1[6], s1[7])}, w11 = {cvtpk_s(s1[8], s1[9]), cvtpk_s(s1[10], s1[11]), cvtpk_s(s1[12], s1[13]), cvtpk_s(s1[14], s1[15])};
            const bf16x8 sb00 = __builtin_bit_cast(bf16x8, w00), sb01 = __builtin_bit_cast(bf16x8, w01), sb10 = __builtin_bit_cast(bf16x8, w10), sb11 = __builtin_bit_cast(bf16x8, w11);
            f32x16 rest1 = __builtin_amdgcn_mfma_f32_32x32x16_bf16(ntri[0], sb10, R, 0, 0, 0); rest1 = __builtin_amdgcn_mfma_f32_32x32x16_bf16(ntri[1], sb11, rest1, 0, 0, 0);
            f32x16 U = __builtin_amdgcn_mfma_f32_32x32x16_bf16(nones, sb10, R, 0, 0, 0); U = __builtin_amdgcn_mfma_f32_32x32x16_bf16(nones, sb11, U, 0, 0, 0);
            f32x16 rest0 = __builtin_amdgcn_mfma_f32_32x32x16_bf16(ntri[0], sb00, U, 0, 0, 0); rest0 = __builtin_amdgcn_mfma_f32_32x32x16_bf16(ntri[1], sb01, rest0, 0, 0, 0);
            R = __builtin_amdgcn_mfma_f32_32x32x16_bf16(nones, sb00, U, 0, 0, 0); R = __builtin_amdgcn_mfma_f32_32x32x16_bf16(nones, sb01, R, 0, 0, 0);
            done = __all(R[0] < -150.0f) ? 1 : 0;
#pragma unroll
            for (int r = 0; r < 16; ++r) {
                float a0 = __builtin_amdgcn_exp2f(p0[r] + rest0[r]), a1 = __builtin_amdgcn_exp2f(p1[r] + rest1[r]);
                if (diag) { const int key = k0 + crow(r, hi); if (key >= qpos) a0 = 0.f; if (key + 32 >= qpos) a1 = 0.f; }
                p0[r] = a0; p1[r] = a1;
            }
            u32x4 a00 = {cvtpk_s(p0[0], p0[1]), cvtpk_s(p0[2], p0[3]), cvtpk_s(p0[4], p0[5]), cvtpk_s(p0[6], p0[7])}, a01 = {cvtpk_s(p0[8], p0[9]), cvtpk_s(p0[10], p0[11]), cvtpk_s(p0[12], p0[13]), cvtpk_s(p0[14], p0[15])};
            u32x4 a10 = {cvtpk_s(p1[0], p1[1]), cvtpk_s(p1[2], p1[3]), cvtpk_s(p1[4], p1[5]), cvtpk_s(p1[6], p1[7])}, a11 = {cvtpk_s(p1[8], p1[9]), cvtpk_s(p1[10], p1[11]), cvtpk_s(p1[12], p1[13]), cvtpk_s(p1[14], p1[15])};
            const bf16x8 pa[4] = {__builtin_bit_cast(bf16x8, a00), __builtin_bit_cast(bf16x8, a01), __builtin_bit_cast(bf16x8, a10), __builtin_bit_cast(bf16x8, a11)};
#pragma unroll
            for (int d0 = 0; d0 < 2; ++d0)
#pragma unroll
                for (int ks = 0; ks < 4; ++ks) {
                    const s16x4 lo = __builtin_bit_cast(s16x4, __builtin_amdgcn_ds_read_tr16_b64_v4i16((LAS s16x4*)(lds + vb + d0 * 4096 + ks * 1024)));
                    const s16x4 hh = __builtin_bit_cast(s16x4, __builtin_amdgcn_ds_read_tr16_b64_v4i16((LAS s16x4*)(lds + vb + d0 * 4096 + ks * 1024 + 512)));
                    const bf16x8 vf = {lo[0], lo[1], lo[2], lo[3], hh[0], hh[1], hh[2], hh[3]};
                    o[d0] = __builtin_amdgcn_mfma_f32_32x32x16_bf16(pa[ks], vf, o[d0], 0, 0, 0);
                }
        }
        __syncthreads();
        if (nb >= 0) { const int sn = (nb & 3) * SB_SLOT; *(LAS u32x4*)(lds + sn + koff) = kreg; *(LAS u32x4*)(lds + sn + voff) = vreg; }
        if (lane == 0) dflag[wid] = done;
        __syncthreads();
        { const u32x4 f0 = *(const LAS u32x4*)dflag, f1 = *(const LAS u32x4*)(dflag + 4); if ((f0.x & f0.y & f0.z & f0.w & f1.x & f1.y & f1.z & f1.w) != 0u) break; }
        --nb;
        if (nb >= 0) { const size_t row = (size_t)(nb * 64 + skey) * NPROJ + sc * 8; kreg = *(const u32x4*)(Kp + row); vreg = *(const u32x4*)(Vp + row); }
    }
    LAS float* stg = (LAS float*)(lds + SB_OST + wid * SB_OSTW);
#pragma unroll
    for (int r = 0; r < 16; ++r) { const int q = crow(r, hi); stg[q * 68 + r32] = o[0][r]; stg[q * 68 + 32 + r32] = o[1][r]; }
    LDS_WAIT(); asm volatile("" ::: "memory");
    { const int q = lane >> 1, half = lane & 1; const LAS f32x4* sp = (const LAS f32x4*)(stg + q * 68 + 32 * half);
      f32x4 v[8]; float ss = 0.f;
#pragma unroll
      for (int i = 0; i < 8; ++i) { v[i] = sp[i]; ss += (v[i][0] * v[i][0] + v[i][1] * v[i][1]) + (v[i][2] * v[i][2] + v[i][3] * v[i][3]); }
      ss += __shfl_xor(ss, 1);
      const float rstd = __builtin_amdgcn_rsqf(ss * (1.f / 64.f) + EPS);
      const f32x4* gp = (const f32x4*)(g_sb + h * 64 + 32 * half);
      bf16_t* op = ymix + (rowbase + qlo + q) * D + 512 + h * 64 + 32 * half;
#pragma unroll
      for (int i = 0; i < 4; ++i) { const f32x4 g0 = gp[2 * i], g1 = gp[2 * i + 1], a = v[2 * i] * rstd * g0, c = v[2 * i + 1] * rstd * g1;
          u32x4 w; w.x = cvtpk_s(a[0], a[1]); w.y = cvtpk_s(a[2], a[3]); w.z = cvtpk_s(c[0], c[1]); w.w = cvtpk_s(c[2], c[3]); *(u32x4*)(op + 8 * i) = w; } }
    LDS_WAIT();
}
__device__ __forceinline__ void p2_mix(Frame& F) {
    conv_rows(F);
    if (F.G == 256) {
        const int bh = F.vcu >> 2, s = F.vcu & 3;
        sb_attn_unit(F, bh >> 3, bh & 7, 7 - s);
        sb_attn_unit(F, bh >> 3, bh & 7, s);
    } else {
        for (int u = F.vcu; u < 512; u += F.G) sb_attn_unit(F, u >> 6, (u >> 3) & 7, u & 7);
    }
}

__device__ __forceinline__ void p8_router(Frame& F) {
    const float* lpart = (const float*)(F.ws + WS_LPART); const float* ss2 = (const float*)(F.ws + WS_SS2); const float* b_router = F.in[15];
    float* lrstd = (float*)(F.ws + WS_LRSTD); int* ltok = (int*)(F.ws + WS_LTOK); float* lgate = (float*)(F.ws + WS_LGATE); unsigned* cnt = F.ctl + CW_CNT;
    const int lane = F.lane, c32 = lane & 31, hi = lane >> 5, wid = F.wave;
    if (F.tid == 0) F.MISC[25] = 0u;
    __syncthreads();
    if (wid < 2) {
        __builtin_amdgcn_s_setprio(3);
        for (int item = 2 * F.vcu + wid; item < M / 32; item += 2 * F.G) {
            const int tok = item * 32 + c32;
            const f32x4* lp = (const f32x4*)(lpart + (size_t)tok * 128 + 16 * hi);
            f32x4 pv[4][4];
#pragma unroll
            for (int pn = 0; pn < 4; ++pn)
#pragma unroll
                for (int q = 0; q < 4; ++q) pv[pn][q] = lp[pn * 8 + q];
            const float rstd = pg8::rstd_from_ss(ss2, tok);
            float lg[32];
#pragma unroll
            for (int q = 0; q < 4; ++q) { const f32x4 sm = (pv[0][q] + pv[1][q]) + (pv[2][q] + pv[3][q]);
#pragma unroll
                for (int j = 0; j < 4; ++j) { const float mine = sm[j], other = __shfl_xor(mine, 32); const int r = 4 * q + j;
                    lg[r] = (hi ? other : mine) * rstd + b_router[r]; lg[16 + r] = (hi ? mine : other) * rstd + b_router[16 + r]; } }
            float tv[4] = {0.f, 0.f, 0.f, 0.f}; int ti[4] = {0, 0, 0, 0}; unsigned used = 0u;
#pragma unroll 1
            for (int k = 0; k < 4; ++k) { float bv = -INFINITY; int bi = 0;
#pragma unroll
                for (int e = 0; e < 32; ++e) { const bool ok = !((used >> e) & 1u) && lg[e] > bv; bv = ok ? lg[e] : bv; bi = ok ? e : bi; }
                used |= 1u << bi;
                tv[3] = (k == 3) ? bv : tv[3]; tv[2] = (k == 2) ? bv : tv[2]; tv[1] = (k == 1) ? bv : tv[1]; tv[0] = (k == 0) ? bv : tv[0];
                ti[3] = (k == 3) ? bi : ti[3]; ti[2] = (k == 2) ? bi : ti[2]; ti[1] = (k == 1) ? bi : ti[1]; ti[0] = (k == 0) ? bi : ti[0]; }
            const float e1 = __expf(tv[1] - tv[0]), e2 = __expf(tv[2] - tv[0]), e3 = __expf(tv[3] - tv[0]); const float inv = 1.0f / (1.0f + e1 + e2 + e3);
            const int E0 = hi ? ti[2] : ti[0], E1 = hi ? ti[3] : ti[1];
            const float G0 = (hi ? e2 : 1.0f) * inv, G1 = (hi ? e3 : e1) * inv;
            int rank0 = 0, rank1 = 0, mycount = 0;
#pragma unroll 1
            for (int e = 0; e < NE; ++e) { const unsigned long long m0 = __ballot(E0 == e), m1 = __ballot(E1 == e); const int p0 = __popcll(m0), p1 = __popcll(m1);
                if (E0 == e) rank0 = __popcll(m0 & ((1ull << lane) - 1ull)); if (E1 == e) rank1 = p0 + __popcll(m1 & ((1ull << lane) - 1ull)); if (lane == e) mycount = p0 + p1; }
            unsigned base = 0u; if (lane < NE && mycount > 0) base = atomicAdd(cnt + 64 * lane, (unsigned)mycount);
            const size_t pos0 = (size_t)E0 * LISTCAP + (unsigned)__shfl((int)base, E0) + rank0, pos1 = (size_t)E1 * LISTCAP + (unsigned)__shfl((int)base, E1) + rank1;
            ltok[pos0] = tok * 4 + 2 * hi; lgate[pos0] = G0; lrstd[pos0] = rstd;
            ltok[pos1] = tok * 4 + 2 * hi + 1; lgate[pos1] = G1; lrstd[pos1] = rstd;
        }
        __builtin_amdgcn_s_setprio(0);
    }
    if (F.G == 256) titem8_queue((LAS unsigned*)(F.lds + MISC_OFF + 25 * 4), F.vcu * P8_XPW, P8_XPW, (LAS unsigned*)(F.lds + RING_OFF + wid * 16384), lane, xdec(F));
}

typedef float f32x2_ __attribute__((ext_vector_type(2)));
__device__ __forceinline__ void p11_load(const bf16_t* x2, const unsigned char* y, int m, int lane, u32x4 (&xv)[2], u32x2 (&yv)[8]) {
#pragma unroll
    for (int j = 0; j < 2; ++j) { const int c = 8 * lane + 512 * j; xv[j] = __builtin_nontemporal_load((const u32x4*)(x2 + (size_t)m * D + c));
#pragma unroll
        for (int sl = 0; sl < 4; ++sl) yv[4 * j + sl] = __builtin_nontemporal_load((const u32x2*)(y + ((size_t)m * 4 + sl) * D + c)); }
}
__device__ __forceinline__ void p11_final(Frame& F) {
    const bf16_t* x2 = (const bf16_t*)(F.ws + WS_X2); const unsigned char* y = (const unsigned char*)(F.ws + WS_Y); const float* g_final = F.in[20]; float* out = F.out;
    const int gw = F.vcu * NWAVES + F.wave, NGW = F.G * NWAVES, lane = F.lane;
    if (gw >= M) return;
    f32x4 gg[4];
#pragma unroll
    for (int j = 0; j < 2; ++j) { const int c = 8 * lane + 512 * j; gg[2 * j] = *(const f32x4*)(g_final + c); gg[2 * j + 1] = *(const f32x4*)(g_final + c + 4); }
    u32x4 xv[2], xn_[2]; u32x2 yv[8], yn_[8];
    p11_load(x2, y, gw, lane, xv, yv);
    for (int m = gw; m < M; m += NGW) {
        if (m + NGW < M) p11_load(x2, y, m + NGW, lane, xn_, yn_);
        f32x4 v[4]; float ss = 0.f;
#pragma unroll
        for (int j = 0; j < 2; ++j) { f32x4 s0 = {0.f, 0.f, 0.f, 0.f}, s1 = {0.f, 0.f, 0.f, 0.f};
#pragma unroll
            for (int sl = 0; sl < 4; ++sl) { const u32x2 w = yv[4 * j + sl];
                const f32x2_ a = __builtin_amdgcn_cvt_pk_f32_fp8((int)w.x, false), b = __builtin_amdgcn_cvt_pk_f32_fp8((int)w.x, true), c = __builtin_amdgcn_cvt_pk_f32_fp8((int)w.y, false), d = __builtin_amdgcn_cvt_pk_f32_fp8((int)w.y, true);
                s0[0] += a[0]; s0[1] += a[1]; s0[2] += b[0]; s0[3] += b[1]; s1[0] += c[0]; s1[1] += c[1]; s1[2] += d[0]; s1[3] += d[1]; }
            const u32x4 xw = xv[j]; const f32x4 x0 = {bf_lo(xw.x), bf_hi(xw.x), bf_lo(xw.y), bf_hi(xw.y)}, x1 = {bf_lo(xw.z), bf_hi(xw.z), bf_lo(xw.w), bf_hi(xw.w)};
            v[2 * j] = x0 + s0 * (1.0f / Y8_SCALE); v[2 * j + 1] = x1 + s1 * (1.0f / Y8_SCALE); }
#pragma unroll
        for (int i = 0; i < 4; ++i) ss += (v[i][0] * v[i][0] + v[i][1] * v[i][1]) + (v[i][2] * v[i][2] + v[i][3] * v[i][3]);
        const float rstd = __builtin_amdgcn_rsqf(wave_sum(ss) * (1.f / D) + EPS);
#pragma unroll
        for (int j = 0; j < 2; ++j) { const int c = 8 * lane + 512 * j;
            __builtin_nontemporal_store(v[2 * j] * rstd * gg[2 * j], (f32x4*)(out + (size_t)m * D + c)); __builtin_nontemporal_store(v[2 * j + 1] * rstd * gg[2 * j + 1], (f32x4*)(out + (size_t)m * D + c + 4)); }
        xv[0] = xn_[0]; xv[1] = xn_[1];
#pragma unroll
        for (int i = 0; i < 8; ++i) yv[i] = yn_[i];
    }
}

constexpr int NPHASE = 12;
struct Args { const float* in[21]; float* out; unsigned char* ws; int ph_lo, ph_hi; };
static_assert(sizeof(Args) == 21 * 8 + 8 + 8 + 8, "Args has no padding");

__global__ void __launch_bounds__(NWAVES * 64, 2) fwd(Args args) {
    extern __shared__ __attribute__((aligned(16))) unsigned char lds[];
    Frame F;
    F.lds = (LAS unsigned char*)lds; F.MISC = (volatile LAS unsigned*)(F.lds + MISC_OFF);
    F.tid = threadIdx.x; F.lane = F.tid & 63; F.wave = __builtin_amdgcn_readfirstlane(F.tid >> 6);
    F.G = gridDim.x; { const int bx = blockIdx.x; F.vcu = (F.G % 8 == 0) ? (bx % 8) * (F.G / 8) + bx / 8 : bx; }
    F.ws = args.ws; F.ctl = (unsigned*)(args.ws + WS_CTL); F.out = args.out;
    F.in = args.in;
    for (int u = F.tid; u < (LDS_BYTES - LDSCTL_OFF) / 4; u += NWAVES * 64) ((LAS unsigned*)(F.lds + LDSCTL_OFF))[u] = 0u;
    __syncthreads();
    const int lo = args.ph_lo, hi = args.ph_hi;
    const bool single = (hi - lo) > 1;
    XcdBarrier bar; bar.bar = F.ctl + CW_BAR; bar.x = 0; bar.st = nullptr;
    if (single) bar = xcd_barrier_post(F.ctl + CW_BAR, F.MISC + 8);
#ifndef PH_MASK
#define PH_MASK 0xFFF
#endif
#define IN(k) (((PH_MASK >> (k)) & 1) && lo <= (k) && (k) < hi)
#ifndef PROBE_LO
#define PROBE_LO -1
#define PROBE_HI -1
#endif
#define PROBE_DIV 10.0f
    unsigned long long pt0 = 0ull, pt1 = 0ull;
#define STAMP_B(k) do { if (PROBE_LO == (k) && bx == 0) pt0 = __builtin_amdgcn_s_memrealtime(); } while (0)
#define STAMP_A(k) do { if (PROBE_HI == (k) && bx == 0) pt1 = __builtin_amdgcn_s_memrealtime(); } while (0)
#define SEAM(k) do { if (IN(k) && IN((k) + 1)) xcd_barrier(bar); } while (0)
    unsigned char* ws = args.ws;
    const int bx = (int)blockIdx.x;

    STAMP_B(0);
    if (IN(0)) { p0_prologue(F); }
    SEAM(0);
    STAMP_A(0); STAMP_B(1);
    if (IN(1)) {
        const bool split = (F.G == 256);
        if (!split || bx < 256 - P1_NCONV) {
            pg8::OrderIn S; S.init(ws + WS_XN, ws + WS_WIN_T, ws + WS_MEMN, ws + WS_WKV_T, split ? 32 : 64, split ? 256 - P1_NCONV : F.G, bx);
            pg8::EpiP1 E{(bf16_t*)(ws + WS_PROJ), (bf16_t*)(ws + WS_KMEM), (bf16_t*)(ws + WS_VT), (const float*)(ws + WS_RSTD3)};
            pg8::gemm_phase<pg8::EpiP1, pg8::OrderIn, false, true, true>(F.lds + RING_OFF, 2 * D, 2 * D, 2 * D, S, E);
        }
        if (!split) convert_experts(F, bx * NWAVES + F.wave, F.G * NWAVES, N_XITEMS);
        else if (bx >= 256 - P1_NCONV) {
            const int cb = bx - (256 - P1_NCONV);
            if (cb < 32) { pg8::OrderKV S; S.init(ws + WS_MEMN, ws + WS_WKV_T, 32 + cb); pg8::EpiP1 E{(bf16_t*)(ws + WS_PROJ), (bf16_t*)(ws + WS_KMEM), (bf16_t*)(ws + WS_VT), (const float*)(ws + WS_RSTD3)};
                pg8::gemm_phase<pg8::EpiP1, pg8::OrderKV, false, false, true>(F.lds + RING_OFF, 2 * D, 2 * D, 2 * D, S, E); }
            constexpr int NSTAT = (int)((long)N_P1X * (100 - P1_DYN_PCT) / 100), NLOW = 32 * NWAVES, NHIGH = (P1_NCONV - 32) * NWAVES; constexpr int CUT = (int)((long)NSTAT * (5 * NLOW) / (5 * NLOW + 6 * NHIGH));
            if (cb < 32) convert_experts(F, X_P1 + cb * NWAVES + F.wave, NLOW, X_P1 + CUT);
            else convert_experts(F, X_P1 + CUT + (cb - 32) * NWAVES + F.wave, NHIGH, X_P1 + NSTAT);
        }
        if (split) {
            constexpr int NSTAT = (int)((long)N_P1X * (100 - P1_DYN_PCT) / 100);
            for (;;) {
                __syncthreads();
                if (F.tid == 0) F.MISC[24] = atomicAdd(F.ctl + CW_DYN, (unsigned)NWAVES);
                __syncthreads();
                const int base = X_P1 + NSTAT + (int)F.MISC[24];
                if (base >= N_XITEMS) break;
                convert_experts(F, base + F.wave, N_XITEMS, N_XITEMS);
            }
        }
    }
    SEAM(1);
    STAMP_A(1); STAMP_B(2);
    if (IN(2)) {
        {
            pg8::OrderPX S; S.init(ws + WS_KMEM, ws + WS_VT, ws + WS_WQ_T, ws + WS_WO_T, ws + WS_WQKT, ws + WS_VWOT, bx);
            pg8::EpiPX E;
            pg8::gemm_phase<pg8::EpiPX, pg8::OrderPX, false, false, true>(F.lds + RING_OFF, 2 * D, 2 * D, 2 * XHD, S, E);
        }
        p2_mix(F);
    }
    SEAM(2);
    STAMP_A(2); STAMP_B(3);
    if (IN(3)) {
        pg8::OrderPlain S; S.init(ws + WS_YMIX, ws + WS_WOUT_T, D, D, M / 256, D / 256, F.G, bx);
        pg8::EpiRes<true, true> E{ws + WS_XN, (bf16_t*)(ws + WS_X1B), ws + WS_X1B8, (float*)(ws + WS_SS1), 1.0f, nullptr, nullptr};
        pg8::gemm_phase<pg8::EpiRes<true, true>, pg8::OrderPlain, false, false, true>(F.lds + RING_OFF, 2 * D, 2 * D, 2 * D, S, E);
    }
    SEAM(3);
    STAMP_A(3); STAMP_B(4);
    if (IN(4)) {
        if (F.G == 256) {
            pg8::OrderXB S; S.init(ws + WS_X1B8, ws + WS_WQKT, F.G, bx);
            pg8::EpiSoftmax E{ws + WS_PB, (const float*)(ws + WS_SS1)};
            pg8::gemm_phase<pg8::EpiSoftmax, pg8::OrderXB, false, false, true, true>(F.lds + RING_OFF, D, D, D, S, E);
        }
    }
    SEAM(4);
    STAMP_A(4); STAMP_B(7);
    if (IN(7)) {
        pg8::OrderXB S; S.init(ws + WS_PB, ws + WS_VWOT, F.G, bx);
        pg8::EpiRes<true, true, true> E{ws + WS_X1B, (bf16_t*)(ws + WS_X2), ws + WS_X2B, (float*)(ws + WS_SS2), 1.0f / (P8_SCALE * PX8_SCALE), (const bf16_t*)(ws + WS_WR), (float*)(ws + WS_LPART)};
        pg8::gemm_phase<pg8::EpiRes<true, true, true>, pg8::OrderXB, false, false, true, true>(F.lds + RING_OFF, D, D, D, S, E);
    }
    SEAM(7);
    STAMP_A(7); STAMP_B(8);
    if (IN(8)) { p8_router(F); }
    SEAM(8);
    STAMP_A(8); STAMP_B(9);
    if (IN(9)) {
        pg8::OrderMoe<8, true> S; S.init(F.ctl + CW_CNT, (const int*)(ws + WS_LTOK), ws + WS_X2B, ws + WS_W1_T, F.G, bx);
        pg8::EpiAct E{(bf16_t*)(ws + WS_ACT), (const float*)(ws + WS_LRSTD), F.in[17]};
        pg8::gemm_phase<pg8::EpiAct, pg8::OrderMoe<8, true>, true, true, true, true>(F.lds + RING_OFF, D, D, D, S, E);
        if (F.G == 256 && P9_XTAIL > 0) {
            for (;;) {
                __syncthreads();
                if (F.tid == 0) F.MISC[24] = atomicAdd(F.ctl + CW_DYN9, (unsigned)NWAVES);
                __syncthreads();
                const int base = N_P8X + (int)F.MISC[24];
                if (base >= X_P1) break;
                convert_experts(F, base + F.wave, N_XITEMS, X_P1);
            }
        }
    }
    SEAM(9);
    STAMP_A(9); STAMP_B(10);
    if (IN(10)) {
        pg8::OrderMoe<4, false> S; S.init(F.ctl + CW_CNT, (const int*)(ws + WS_LTOK), ws + WS_ACT, ws + WS_W2_T, F.G, bx);
        pg8::EpiY E{(bf16_t*)(ws + WS_Y), (const float*)(ws + WS_LGATE), (const int*)(ws + WS_LTOK), F.in[19]};
        pg8::gemm_phase<pg8::EpiY, pg8::OrderMoe<4, false>, false, true, true, true>(F.lds + RING_OFF, DEXP, DEXP, DEXP, S, E);
    }
    SEAM(10);
    STAMP_A(10); STAMP_B(11);
    if (IN(11)) { p11_final(F); }
    STAMP_A(11);
    if (PROBE_LO >= 0 && bx == 0) { asm volatile("s_waitcnt vmcnt(0)" ::: "memory"); __syncthreads(); if (F.tid == 0) { const float us = (float)(pt1 - pt0) * 0.01f; F.out[(size_t)(F.vcu * NWAVES) * D] += us / PROBE_DIV; } }
#undef IN
#undef SEAM
}

extern "C" void kernel_launch(void* const* d_in, const int* in_sizes, int n_in, void* d_out, int out_size, void* d_ws, size_t ws_size, hipStream_t stream) {
    static int grid = 0;
    if (grid == 0) {
        if (n_in != 21 || in_sizes[0] != M * D || out_size != M * D || ws_size < WS_END) { fprintf(stderr, "kernel_launch: unexpected shapes (n_in %d, in0 %d, out %d, ws %zu)\n", n_in, n_in > 0 ? in_sizes[0] : -1, out_size, ws_size); grid = -1; return; }
        int dev = 0, cus = 0, per_cu = 0;
        if (hipGetDevice(&dev) != hipSuccess || hipDeviceGetAttribute(&cus, hipDeviceAttributeMultiprocessorCount, dev) != hipSuccess) { grid = -1; return; }
        if (hipFuncSetAttribute((const void*)fwd, hipFuncAttributeMaxDynamicSharedMemorySize, LDS_BYTES) != hipSuccess) { fprintf(stderr, "kernel_launch: hipFuncSetAttribute failed\n"); grid = -1; return; }
        if (hipOccupancyMaxActiveBlocksPerMultiprocessor(&per_cu, (const void*)fwd, NWAVES * 64, LDS_BYTES) != hipSuccess || per_cu < 1) { fprintf(stderr, "kernel_launch: occupancy query says %d\n", per_cu); per_cu = 1; }
        (void)hipGetLastError();
        if (cus != 256) fprintf(stderr, "kernel_launch: built for a 256-CU device (one 256x256 tile per workgroup in the fused phases); found %d CUs\n", cus);
        grid = cus;
    }
    if (grid < 0) return;
    (void)hipMemsetAsync((char*)d_ws + WS_CTL, 0, CTL_ZERO_BYTES, stream);
    Args a{};
    for (int i = 0; i < 21; ++i) a.in[i] = (const float*)d_in[i];
    a.out = (float*)d_out; a.ws = (unsigned char*)d_ws;
    if (MK_N_LAUNCHES == 1) {
        a.ph_lo = 0; a.ph_hi = NPHASE;
        void* kargs[] = {&a};
        hipError_t e = hipLaunchCooperativeKernel((const void*)fwd, dim3(grid), dim3(NWAVES * 64), kargs, LDS_BYTES, stream);
        if (e != hipSuccess) fprintf(stderr, "kernel_launch: cooperative launch failed: %s\n", hipGetErrorString(e));
    } else {
        for (int p = 0; p < NPHASE; ++p) { a.ph_lo = p; a.ph_hi = p + 1; for (int rep = 0; rep < NREP(p); ++rep) hipLaunchKernelGGL(fwd, dim3(grid), dim3(NWAVES * 64), LDS_BYTES, stream, a); }
    }
}
```
